# Optimizing an MI355X kernel written in HIP

```python
import math
import jax, jax.numpy as jnp
from jax import lax
import numpy as np

D_MODEL = 1024
BATCH = 16
SEQ = 256
DEPTH = 2
DEC_BATCH = 2
DEC_SEQ = 1024
PAST_LEN = 256

GRID_W = 64
ROPE_THETA = 10000.0
Q_BLOCK = 128
EPS = 1e-6
N_EVEN = (DEPTH + 1) // 2
N_ODD = DEPTH // 2
MLA_HEADS = 8
MLA_Q_LORA = 384
MLA_KV_LORA = 256
MLA_NOPE = 64
MLA_ROPE = 32
MLA_V = 64
MLA_W = MLA_HEADS * MLA_V
GQA_HEADS = 8
GQA_KV_HEADS = 2
GQA_HD = 64
GQA_W = GQA_HEADS * GQA_HD
MLSTM_HEADS = 4
MLSTM_HD = 128
MLSTM_CHUNK = 64
MLSTM_W = MLSTM_HEADS * MLSTM_HD
F_BIAS_OFFSET = 3.0
DIFF_HEADS = 4
DIFF_QK = 64
DIFF_V = 128
DIFF_W = DIFF_HEADS * DIFF_V

MIX_W = MLA_W + GQA_W
EVEN_SPLITS = (MLA_Q_LORA, MLA_KV_LORA, MLA_ROPE, MLA_W,
               GQA_HEADS * GQA_HD, GQA_KV_HEADS * GQA_HD, GQA_KV_HEADS * GQA_HD, GQA_W)
ODD_SPLITS = (MLSTM_W, MLSTM_W, MLSTM_W, MLSTM_W, 4 * MLSTM_HEADS, MLSTM_W,
              DIFF_HEADS * 2 * DIFF_QK, DIFF_HEADS * 2 * DIFF_QK, DIFF_HEADS * DIFF_V, DIFF_W)
EVEN_IN = sum(EVEN_SPLITS)
ODD_IN = sum(ODD_SPLITS)

kernel_name = 'hybrid_mla_gqa_mlstm_diff_prefix_dit_step'


def rmsnorm(x, g):
    xf = x.astype(jnp.float32)
    y = xf * lax.rsqrt(jnp.mean(xf * xf, axis=-1, keepdims=True) + EPS)
    return (y * g.astype(jnp.float32)).astype(x.dtype)


def split_cols(u, sizes):
    return jnp.split(u, np.cumsum(sizes)[:-1].tolist(), axis=-1)


def adaln(cvec, w, b):
    m = jax.nn.silu(cvec) @ w + b
    return jnp.split(m, 3, axis=-1)


def grid_rope(n_tokens, rot_dim):
    n_rows = n_tokens // GRID_W
    rows, cols = jnp.meshgrid(jnp.arange(n_rows), jnp.arange(GRID_W), indexing='ij')
    rows = rows.reshape(-1).astype(jnp.float32)
    cols = cols.reshape(-1).astype(jnp.float32)
    half = rot_dim // 2
    inv = 1.0 / (ROPE_THETA ** (jnp.arange(0, half, 2, dtype=jnp.float32) / half))
    ang = jnp.concatenate([rows[:, None] * inv, cols[:, None] * inv], axis=-1)
    return jnp.cos(ang), jnp.sin(ang)


def apply_rope(x, cos, sin):
    xf = x.astype(jnp.float32).reshape(*x.shape[:-1], -1, 2)
    x0, x1 = xf[..., 0], xf[..., 1]
    c = cos[None, :, None, :]
    s = sin[None, :, None, :]
    out = jnp.stack([x0 * c - x1 * s, x0 * s + x1 * c], axis=-1).reshape(x.shape)
    return out.astype(x.dtype)


def attend(q, k, v):
    B, S, Hk, G, dk = q.shape
    scale = dk ** -0.5
    nb = S // Q_BLOCK
    qb = jnp.moveaxis(q.reshape(B, nb, Q_BLOCK, Hk, G, dk), 1, 0)

    def block(qi):
        s = jnp.einsum('bqhgd,bthd->bhgqt', qi, k).astype(jnp.float32) * scale
        p = jax.nn.softmax(s, axis=-1).astype(v.dtype)
        return jnp.einsum('bhgqt,bthd->bqhgd', p, v)

    o = lax.map(block, qb)
    return jnp.moveaxis(o, 0, 1).reshape(B, S, Hk, G, v.shape[-1])


def mlstm_scan(q, k, v, ig, lf, C0, n0, m0):
    B, S, H, d = q.shape
    L = MLSTM_CHUNK
    nc = S // L

    def chunks(a):
        a = a.astype(jnp.float32).reshape(B, nc, L, H, *a.shape[3:])
        return jnp.moveaxis(jnp.moveaxis(a, 1, 0), 3, 2)

    causal = jnp.tril(jnp.ones((L, L), dtype=bool))

    def step(carry, xs):
        C, n, m = carry
        qc, kc, vc, ic, fc = xs
        b = jnp.cumsum(fc, axis=-1)
        Dm = jnp.where(causal, b[..., :, None] - b[..., None, :] + ic[..., None, :], -jnp.inf)
        inter = b + m[..., None]
        mt = jnp.maximum(inter, Dm.max(axis=-1))
        w_inter = jnp.exp(inter - mt)
        W = jnp.exp(Dm - mt[..., None])
        Sm = jnp.einsum('bhtk,bhsk->bhts', qc, kc) * W
        num = w_inter[..., None] * jnp.einsum('bhvk,bhtk->bhtv', C, qc) + jnp.einsum('bhts,bhsv->bhtv', Sm, vc)
        den = w_inter * jnp.einsum('bhk,bhtk->bht', n, qc) + Sm.sum(axis=-1)
        hc = num / jnp.maximum(jnp.abs(den), jnp.exp(-mt))[..., None]
        bL = b[..., -1]
        m_new = mt[..., -1]
        decay = jnp.exp(bL + m - m_new)
        wk = jnp.exp(bL[..., None] - b + ic - m_new[..., None])
        C_new = decay[..., None, None] * C + jnp.einsum('bhs,bhsv,bhsk->bhvk', wk, vc, kc)
        n_new = decay[..., None] * n + jnp.einsum('bhs,bhsk->bhk', wk, kc)
        return (C_new, n_new, m_new), hc

    init = (C0.astype(jnp.float32), n0.astype(jnp.float32), m0.astype(jnp.float32))
    (C, n, m), hs = lax.scan(step, init, (chunks(q), chunks(k), chunks(v), chunks(ig), chunks(lf)))
    hs = jnp.swapaxes(jnp.moveaxis(hs, 0, 1), 2, 3).reshape(B, S, H, d)
    return hs.astype(q.dtype), C, n, m


def even_mix(h, w_in, qn_g, w_uq, kvn_g, w_ukv, gq_g, gk_g, w_out, ctx):
    B, S, _ = h.shape
    u = h @ w_in
    cq, ckv, kr, g_a, q_b, k_b, v_b, g_b = split_cols(u, EVEN_SPLITS)
    q = (rmsnorm(cq, qn_g) @ w_uq).reshape(B, S, MLA_HEADS, MLA_NOPE + MLA_ROPE)
    q_nope, q_rope = q[..., :MLA_NOPE], q[..., MLA_NOPE:]
    ckv = rmsnorm(ckv, kvn_g)
    kr = kr[:, :, None, :]
    q_b = rmsnorm(q_b.reshape(B, S, GQA_HEADS, GQA_HD), gq_g)
    k_b = rmsnorm(k_b.reshape(B, S, GQA_KV_HEADS, GQA_HD), gk_g)
    v_b = v_b.reshape(B, S, GQA_KV_HEADS, GQA_HD)
    if ctx is None:
        new = (ckv, kr[:, :, 0], k_b, v_b)
        ckv_all, kr_all, kb_all, vb_all = ckv, kr, k_b, v_b
    else:
        c_ckv, c_kr, c_k, c_v = ctx
        cos_a, sin_a = grid_rope(S, MLA_ROPE)
        q_rope = apply_rope(q_rope, cos_a, sin_a)
        kr = apply_rope(kr, cos_a, sin_a)
        cos_b, sin_b = grid_rope(S, GQA_HD)
        q_b = apply_rope(q_b, cos_b, sin_b)
        k_b = apply_rope(k_b, cos_b, sin_b)
        ckv_all = jnp.concatenate([c_ckv.astype(ckv.dtype), ckv], axis=1)
        kr_all = jnp.concatenate([c_kr[:, :, None, :].astype(kr.dtype), kr], axis=1)
        kb_all = jnp.concatenate([c_k.astype(k_b.dtype), k_b], axis=1)
        vb_all = jnp.concatenate([c_v.astype(v_b.dtype), v_b], axis=1)
        new = None
    T = ckv_all.shape[1]
    kv = (ckv_all @ w_ukv).reshape(B, T, MLA_HEADS, MLA_NOPE + MLA_V)
    k_a = jnp.concatenate([kv[..., :MLA_NOPE], jnp.broadcast_to(kr_all, (B, T, MLA_HEADS, MLA_ROPE))], axis=-1)
    v_a = kv[..., MLA_NOPE:]
    q_a = jnp.concatenate([q_nope, q_rope], axis=-1)[:, :, :, None, :]
    o_a = attend(q_a, k_a, v_a).reshape(B, S, MLA_W) * jax.nn.silu(g_a)
    q_bg = q_b.reshape(B, S, GQA_KV_HEADS, GQA_HEADS // GQA_KV_HEADS, GQA_HD)
    o_b = attend(q_bg, kb_all, vb_all).reshape(B, S, GQA_W) * jax.nn.silu(g_b)
    return jnp.concatenate([o_a, o_b], axis=-1) @ w_out, new


def odd_mix(h, w_in, gate_b, mnorm_g, lam, dnorm_g, w_out, layer_idx, ctx):
    B, S, _ = h.shape
    u = h @ w_in
    qm, km, vm, om, gates, zm, qd, kd, vd, gd = split_cols(u, ODD_SPLITS)
    H, d = MLSTM_HEADS, MLSTM_HD
    qm = qm.reshape(B, S, H, d)
    km = km.reshape(B, S, H, d) * (d ** -0.5)
    vm = vm.reshape(B, S, H, d)
    g = (gates.astype(jnp.float32) + gate_b.astype(jnp.float32)).reshape(B, S, 4, H)
    ig_f, lf_f = g[:, :, 0], jax.nn.log_sigmoid(g[:, :, 1])
    ig_b, lf_b = g[:, :, 2], jax.nn.log_sigmoid(g[:, :, 3])
    if ctx is None:
        C0 = jnp.zeros((B, 2, H, d, d), jnp.float32)
        n0 = jnp.zeros((B, 2, H, d), jnp.float32)
        m0 = jnp.zeros((B, 2, H), jnp.float32)
    else:
        C0, n0, m0 = ctx[0], ctx[1], ctx[2]
    rev = lambda a: a[:, ::-1]
    h_f, Cf, nf, mf = mlstm_scan(qm, km, vm, ig_f, lf_f, C0[:, 0], n0[:, 0], m0[:, 0])
    h_b, Cb, nb, mb = mlstm_scan(rev(qm), rev(km), rev(vm), rev(ig_b), rev(lf_b), C0[:, 1], n0[:, 1], m0[:, 1])
    hm = jax.nn.sigmoid(om).reshape(B, S, H, d) * (h_f + rev(h_b))
    hm = rmsnorm(hm, mnorm_g.reshape(H, d)).reshape(B, S, MLSTM_W) * jax.nn.silu(zm)
    qd = qd.reshape(B, S, DIFF_HEADS * 2, DIFF_QK)
    kd = kd.reshape(B, S, DIFF_HEADS * 2, DIFF_QK)
    vd = vd.reshape(B, S, DIFF_HEADS, DIFF_V)
    if ctx is None:
        new = (jnp.stack([Cf, Cb], axis=1).astype(h.dtype), jnp.stack([nf, nb], axis=1).astype(h.dtype),
               jnp.stack([mf, mb], axis=1).astype(h.dtype),
               kd.reshape(B, S, DIFF_HEADS, 2 * DIFF_QK), vd)
        kd_all, vd_all = kd, vd
    else:
        c_kd, c_vd = ctx[3], ctx[4]
        cos_d, sin_d = grid_rope(S, DIFF_QK)
        qd = apply_rope(qd, cos_d, sin_d)
        kd = apply_rope(kd, cos_d, sin_d)
        kd_all = jnp.concatenate([c_kd.reshape(B, -1, DIFF_HEADS * 2, DIFF_QK).astype(kd.dtype), kd], axis=1)
        vd_all = jnp.concatenate([c_vd.astype(vd.dtype), vd], axis=1)
        new = None
    T = kd_all.shape[1]
    q4 = qd.reshape(B, S, DIFF_HEADS, 2, DIFF_QK)
    k4 = kd_all.reshape(B, T, DIFF_HEADS, 2, DIFF_QK)
    a1 = attend(q4[:, :, :, 0:1], k4[:, :, :, 0], vd_all)[:, :, :, 0]
    a2 = attend(q4[:, :, :, 1:2], k4[:, :, :, 1], vd_all)[:, :, :, 0]
    lam_init = 0.8 - 0.6 * math.exp(-0.3 * layer_idx)
    lf32 = lam.astype(jnp.float32)
    lam_val = jnp.exp(jnp.sum(lf32[0] * lf32[1])) - jnp.exp(jnp.sum(lf32[2] * lf32[3])) + lam_init
    od = a1 - lam_val.astype(a1.dtype) * a2
    od = (rmsnorm(od, dnorm_g) * (1.0 - lam_init)).reshape(B, S, DIFF_W) * jax.nn.silu(gd)
    return jnp.concatenate([hm, od], axis=-1) @ w_out, new


def setup_inputs(seed: int = 0) -> dict:
    key = jax.random.key(seed)
    ks = iter(jax.random.split(key, 40))
    nrm = lambda shape, s=1.0: s * jax.random.normal(next(ks), shape, jnp.float32)
    gain = lambda shape: 1.0 + 0.1 * jax.random.normal(next(ks), shape, jnp.float32)
    D = D_MODEL
    return {
        'x_prompt': nrm((BATCH, SEQ, D)),
        'x_sample': nrm((DEC_BATCH, DEC_SEQ, D)),
        'cache_mla_ckv': nrm((DEC_BATCH, N_EVEN, PAST_LEN, MLA_KV_LORA)),
        'cache_mla_krope': nrm((DEC_BATCH, N_EVEN, PAST_LEN, MLA_ROPE)),
        'cache_gqa_k': nrm((DEC_BATCH, N_EVEN, PAST_LEN, GQA_KV_HEADS, GQA_HD)),
        'cache_gqa_v': nrm((DEC_BATCH, N_EVEN, PAST_LEN, GQA_KV_HEADS, GQA_HD)),
        'state_mlstm_C': nrm((DEC_BATCH, N_ODD, 2, MLSTM_HEADS, MLSTM_HD, MLSTM_HD), 0.1),
        'state_mlstm_n': nrm((DEC_BATCH, N_ODD, 2, MLSTM_HEADS, MLSTM_HD), 0.1),
        'state_mlstm_m': nrm((DEC_BATCH, N_ODD, 2, MLSTM_HEADS), 0.5),
        'cache_diff_k': nrm((DEC_BATCH, N_ODD, PAST_LEN, DIFF_HEADS, 2 * DIFF_QK)),
        'cache_diff_v': nrm((DEC_BATCH, N_ODD, PAST_LEN, DIFF_HEADS, DIFF_V)),
        'c': nrm((DEC_BATCH, D)),
        'c_ctx': nrm((D,)),
        'e_norm_g': gain((N_EVEN, D)),
        'e_ada_w': nrm((N_EVEN, D, 3 * D), 0.5 * D ** -0.5),
        'e_ada_b': nrm((N_EVEN, 3 * D), 0.02),
        'e_w_in': nrm((N_EVEN, D, EVEN_IN), D ** -0.5),
        'e_mla_qnorm_g': gain((N_EVEN, MLA_Q_LORA)),
        'e_mla_w_uq': nrm((N_EVEN, MLA_Q_LORA, MLA_HEADS * (MLA_NOPE + MLA_ROPE)), MLA_Q_LORA ** -0.5),
        'e_mla_kvnorm_g': gain((N_EVEN, MLA_KV_LORA)),
        'e_mla_w_ukv': nrm((N_EVEN, MLA_KV_LORA, MLA_HEADS * (MLA_NOPE + MLA_V)), MLA_KV_LORA ** -0.5),
        'e_gqa_qnorm_g': gain((N_EVEN, GQA_HD)),
        'e_gqa_knorm_g': gain((N_EVEN, GQA_HD)),
        'e_w_out': nrm((N_EVEN, MIX_W, D), MIX_W ** -0.5),
        'o_norm_g': gain((N_ODD, D)),
        'o_ada_w': nrm((N_ODD, D, 3 * D), 0.5 * D ** -0.5),
        'o_ada_b': nrm((N_ODD, 3 * D), 0.02),
        'o_w_in': nrm((N_ODD, D, ODD_IN), D ** -0.5),
        'o_mlstm_gate_b': nrm((N_ODD, 4 * MLSTM_HEADS), 0.1)
            + jnp.repeat(jnp.array([0.0, F_BIAS_OFFSET, 0.0, F_BIAS_OFFSET], jnp.float32), MLSTM_HEADS),
        'o_mlstm_norm_g': gain((N_ODD, MLSTM_W)),
        'o_diff_lambda': nrm((N_ODD, 4, DIFF_QK), 0.1),
        'o_diff_norm_g': gain((N_ODD, DIFF_V)),
        'o_w_out': nrm((N_ODD, MIX_W, D), MIX_W ** -0.5),
        'final_norm_g': gain((D,)),
    }


def reference(x_prompt, x_sample, cache_mla_ckv, cache_mla_krope, cache_gqa_k, cache_gqa_v,
              state_mlstm_C, state_mlstm_n, state_mlstm_m, cache_diff_k, cache_diff_v, c,
              c_ctx, e_norm_g, e_ada_w, e_ada_b, e_w_in, e_mla_qnorm_g, e_mla_w_uq, e_mla_kvnorm_g,
              e_mla_w_ukv, e_gqa_qnorm_g, e_gqa_knorm_g, e_w_out, o_norm_g, o_ada_w, o_ada_b, o_w_in,
              o_mlstm_gate_b, o_mlstm_norm_g, o_diff_lambda, o_diff_norm_g, o_w_out, final_norm_g):

    def layer(x, cvec, l, ctx):
        j = l // 2
        if l % 2 == 0:
            shift, scale, gate = adaln(cvec, e_ada_w[j], e_ada_b[j])
            h = rmsnorm(x, e_norm_g[j]) * (1.0 + scale) + shift
            out, st = even_mix(h, e_w_in[j], e_mla_qnorm_g[j], e_mla_w_uq[j], e_mla_kvnorm_g[j],
                               e_mla_w_ukv[j], e_gqa_qnorm_g[j], e_gqa_knorm_g[j], e_w_out[j], ctx)
        else:
            shift, scale, gate = adaln(cvec, o_ada_w[j], o_ada_b[j])
            h = rmsnorm(x, o_norm_g[j]) * (1.0 + scale) + shift
            out, st = odd_mix(h, o_w_in[j], o_mlstm_gate_b[j], o_mlstm_norm_g[j], o_diff_lambda[j],
                              o_diff_norm_g[j], o_w_out[j], l, ctx)
        return x + gate * out, st

    x = x_prompt
    cvec_ctx = c_ctx[None, None, :]
    even_st, odd_st = [], []
    for l in range(DEPTH):
        x, st = layer(x, cvec_ctx, l, None)
        (even_st if l % 2 == 0 else odd_st).append(st)
    y_prompt = rmsnorm(x, final_norm_g)
    st_mla_ckv = jnp.stack([s[0] for s in even_st], axis=1)
    st_mla_krope = jnp.stack([s[1] for s in even_st], axis=1)
    st_gqa_k = jnp.stack([s[2] for s in even_st], axis=1)
    st_gqa_v = jnp.stack([s[3] for s in even_st], axis=1)
    st_mlstm_C = jnp.stack([s[0] for s in odd_st], axis=1)
    st_mlstm_n = jnp.stack([s[1] for s in odd_st], axis=1)
    st_mlstm_m = jnp.stack([s[2] for s in odd_st], axis=1)
    st_diff_k = jnp.stack([s[3] for s in odd_st], axis=1)
    st_diff_v = jnp.stack([s[4] for s in odd_st], axis=1)

    x = x_sample
    cvec = c[:, None, :]
    for l in range(DEPTH):
        j = l // 2
        if l % 2 == 0:
            ctx = (cache_mla_ckv[:, j], cache_mla_krope[:, j], cache_gqa_k[:, j], cache_gqa_v[:, j])
        else:
            ctx = (state_mlstm_C[:, j], state_mlstm_n[:, j], state_mlstm_m[:, j],
                   cache_diff_k[:, j], cache_diff_v[:, j])
        x, _ = layer(x, cvec, l, ctx)
    y_sample = rmsnorm(x, final_norm_g)

    return (y_prompt, y_sample, st_mla_ckv, st_mla_krope, st_gqa_k, st_gqa_v,
            st_mlstm_C, st_mlstm_n, st_mlstm_m, st_diff_k, st_diff_v)
```

```cpp
#include <hip/hip_runtime.h>
#include <hip/hip_cooperative_groups.h>
#include <cstdio>
namespace cg = cooperative_groups;

typedef unsigned short bf16_t;
using bf16x8 = __attribute__((ext_vector_type(8))) short;
using bf16x4 = __attribute__((ext_vector_type(4))) short;
using f32x4  = __attribute__((ext_vector_type(4))) float;
using u32x4  = __attribute__((ext_vector_type(4))) unsigned;
#define DI __device__ __forceinline__
#define MFMA16(a, b, c) __builtin_amdgcn_mfma_f32_16x16x32_bf16((a), (b), (c), 0, 0, 0)

#ifndef SINGLE_LAUNCH
#define SINGLE_LAUNCH 1
#endif

__device__ __forceinline__ unsigned ltid() { unsigned t = threadIdx.x; asm volatile("" : "+v"(t)); return t; }
#define TIDX ((int)(ltid() & 255u))
#define VBLK ((int)(blockIdx.x * 2 + (ltid() >> 8)))
#define NVBLK ((int)(gridDim.x * 2))
DI int vblk_xcd() {
  const int b = blockIdx.x, nb = gridDim.x;
  if (nb & 7) return VBLK;
  return ((b & 7) * (nb >> 3) + (b >> 3)) * 2 + (int)(ltid() >> 8);
}
constexpr int EIN = 2464, OIN = 4624;
constexpr int NROW = 6144, NTROW = 6656;
constexpr int NPHASE = 14;
constexpr int LDS_BYTES = 81920;
constexpr int LDT = 72;
constexpr float EPSF = 1e-6f;
constexpr float LAM_INIT = 0.35550906759097f;
constexpr size_t O_Y = 0, O_CKV = 6291456, O_KR = 7340032, O_GK = 7471104, O_GV = 7995392, O_C = 8519680,
                 O_N = 10616832, O_M = 10633216, O_DK = 10633344, O_DV = 12730496;

struct Params {
  const float *x_prompt, *x_sample, *cache_ckv, *cache_kr, *cache_gk, *cache_gv, *st_C, *st_n, *st_m, *cache_dk, *cache_dv, *c, *c_ctx;
  const float *e_norm_g, *e_ada_w, *e_ada_b, *e_w_in, *e_qn_g, *e_w_uq, *e_kvn_g, *e_w_ukv, *e_gq_g, *e_gk_g, *e_w_out;
  const float *o_norm_g, *o_ada_w, *o_ada_b, *o_w_in, *o_gate_b, *o_mnorm_g, *o_lam, *o_dnorm_g, *o_w_out, *final_g;
  float* out;
  float *MOD, *LAMV;
  float2 *ROPE32, *ROPE64;
  bf16_t *WinE, *WinO, *Wuq, *Wukv, *WoutE, *WoutO;
  bf16_t *H, *U0, *U1, *CQN, *CKVN, *KR, *QB, *KB, *VB, *Q, *KV, *O, *QD, *KD, *VD, *CST;
  float *X1, *SC, *UC, *NU, *NST, *OP, *ML, *SCM;
  unsigned* BAR;
  int phase_lo, phase_hi;
};

DI bf16_t f2bf(float x) { unsigned u = __float_as_uint(x); u += 0x7fffu + ((u >> 16) & 1u); return (bf16_t)(u >> 16); }
DI float bf2f(bf16_t b) { return __uint_as_float(((unsigned)b) << 16); }
typedef __bf16 bf2_t __attribute__((ext_vector_type(2)));
typedef float f2_t __attribute__((ext_vector_type(2)));
DI unsigned pack2(float a, float b) { f2_t v = {a, b}; return __builtin_bit_cast(unsigned, __builtin_convertvector(v, bf2_t)); }
DI float lo2f(unsigned w) { return __uint_as_float(w << 16); }
DI float hi2f(unsigned w) { return __uint_as_float(w & 0xffff0000u); }
DI float wave_sum(float v) { for (int d = 32; d; d >>= 1) v += __shfl_xor(v, d); return v; }
DI float wave_max(float v) { for (int d = 32; d; d >>= 1) v = fmaxf(v, __shfl_xor(v, d)); return v; }
DI float scan_add(float v, int lane) { for (int d = 1; d < 64; d <<= 1) { float t = __shfl_up(v, d); if (lane >= d) v += t; } return v; }
DI float scan_max(float v, int lane) { for (int d = 1; d < 64; d <<= 1) { float t = __shfl_up(v, d); if (lane >= d) v = fmaxf(v, t); } return v; }
DI float logsig(float x) { return fminf(x, 0.f) - log1pf(expf(-fabsf(x))); }
DI float siluf(float x) { return x / (1.f + expf(-x)); }
DI float sigmf(float x) { return 1.f / (1.f + expf(-x)); }
DI int cv_of_row(int row) { return row < 4096 ? 0 : 1 + ((row - 4096) >> 10); }
DI const float* xrow(const Params& p, int row) { return row < 4096 ? p.x_prompt + (size_t)row * 1024 : p.x_sample + (size_t)(row - 4096) * 1024; }

template <class Epi>
DI void gemm_tile(const bf16_t* __restrict__ X, int ldx, const bf16_t* __restrict__ W, int ldw, int N, int K, int m0, int n0, char* smem, Epi epi) {
  constexpr int LDG = 32;
  constexpr int BUFE = 256 * LDG;
  bf16_t* sb = (bf16_t*)smem;
  const int tid = TIDX, lane = tid & 63, wave = tid >> 6, wm = wave >> 1, wn = wave & 1;
  const int g = lane >> 4, l16 = lane & 15;
  f32x4 acc[4][4];
#pragma unroll
  for (int a = 0; a < 4; ++a)
#pragma unroll
    for (int b = 0; b < 4; ++b) acc[a][b] = f32x4{0.f, 0.f, 0.f, 0.f};
  const int lr = tid >> 2, lc = (tid & 3) * 8;
  const int lcs = ((tid & 3) ^ ((4 - ((lr >> 2) & 3)) & 3)) * 8;
  const int gs = (g ^ ((4 - (l16 >> 2)) & 3)) * 8;
  unsigned xoff[2], woff[2];
#pragma unroll
  for (int i = 0; i < 2; ++i) {
    xoff[i] = (unsigned)((m0 + lr + 64 * i) * ldx + lc);
    int n = n0 + lr + 64 * i; if (n > N - 1) n = N - 1;
    woff[i] = (unsigned)(n * ldw + lc);
  }
  const int nk = K >> 5;
  u32x4 rx[3][2], rw[3][2];
#define G_LOAD(S, KT) { const bf16_t* xb_ = X + (KT) * 32; const bf16_t* wb_ = W + (KT) * 32; \
    rx[S][0] = *(const u32x4*)(xb_ + xoff[0]); rx[S][1] = *(const u32x4*)(xb_ + xoff[1]); \
    rw[S][0] = *(const u32x4*)(wb_ + woff[0]); rw[S][1] = *(const u32x4*)(wb_ + woff[1]); }
#define G_STORE(S, B) { bf16_t* d_ = sb + (B) * BUFE + lr * LDG + lcs; \
    *(u32x4*)(d_) = rx[S][0]; *(u32x4*)(d_ + 64 * LDG) = rx[S][1]; \
    *(u32x4*)(d_ + 128 * LDG) = rw[S][0]; *(u32x4*)(d_ + 192 * LDG) = rw[S][1]; }
#define G_COMPUTE(B) { const bf16_t* bx_ = sb + (B) * BUFE; const bf16_t* bw_ = bx_ + 128 * LDG; \
    bf16x8 wf[4], xf[4]; \
    _Pragma("unroll") for (int i = 0; i < 4; ++i) { \
      wf[i] = *(const bf16x8*)(bw_ + (wn * 64 + i * 16 + l16) * LDG + gs); \
      xf[i] = *(const bf16x8*)(bx_ + (wm * 64 + i * 16 + l16) * LDG + gs); } \
    _Pragma("unroll") for (int ni = 0; ni < 4; ++ni) \
      _Pragma("unroll") for (int mi = 0; mi < 4; ++mi) acc[ni][mi] = MFMA16(wf[ni], xf[mi], acc[ni][mi]); }
#define G_STEP(KK, RL, RS) if ((KK) < nk) { \
    if ((KK) + 1 < nk) G_STORE(RS, ((KK) + 1) & 1) \
    if ((KK) + 3 < nk) G_LOAD(RL, (KK) + 3) \
    G_COMPUTE((KK) & 1) \
    __syncthreads(); }
  G_LOAD(0, 0) G_LOAD(1, 1) G_LOAD(2, 2)
  __syncthreads();
  G_STORE(0, 0)
  __syncthreads();
  for (int k0 = 0; k0 < nk; k0 += 3) {
    G_STEP(k0, 0, 1)
    G_STEP(k0 + 1, 1, 2)
    G_STEP(k0 + 2, 2, 0)
  }
#undef G_LOAD
#undef G_STORE
#undef G_COMPUTE
#undef G_STEP
#pragma unroll
  for (int ni = 0; ni < 4; ++ni) {
    const int n = n0 + wn * 64 + ni * 16 + g * 4;
    if (n < N) {
#pragma unroll
      for (int mi = 0; mi < 4; ++mi) epi(m0 + wm * 64 + mi * 16 + l16, n, acc[ni][mi]);
    }
  }
}

template <class Epi>
DI void gemm256(const bf16_t* __restrict__ X, int ldx, const bf16_t* __restrict__ W, int ldw, int N, int K, int m0, int n0, char* smem, Epi epi) {
  constexpr int LDG = 32;
  constexpr int BUFE = 512 * LDG;
  bf16_t* sb = (bf16_t*)smem;
  const int tid = (int)ltid(), lane = tid & 63, wave = tid >> 6, wm = wave >> 2, wn = wave & 3;
  const int g = lane >> 4, l16 = lane & 15;
  f32x4 acc[4][8];
#pragma unroll
  for (int a = 0; a < 4; ++a)
#pragma unroll
    for (int b = 0; b < 8; ++b) acc[a][b] = f32x4{0.f, 0.f, 0.f, 0.f};
  const int lr = tid >> 2, lc = (tid & 3) * 8;
  const int lcs = ((tid & 3) ^ ((4 - ((lr >> 2) & 3)) & 3)) * 8;
  const int gs = (g ^ ((4 - (l16 >> 2)) & 3)) * 8;
  unsigned xoff[2], woff[2];
#pragma unroll
  for (int i = 0; i < 2; ++i) {
    xoff[i] = (unsigned)((m0 + lr + 128 * i) * ldx + lc);
    int n = n0 + lr + 128 * i; if (n > N - 1) n = N - 1;
    woff[i] = (unsigned)(n * ldw + lc);
  }
  const int nk = K >> 5;
  u32x4 rx[3][2], rw[3][2];
#define G_LOAD(S, KT) { const bf16_t* xb_ = X + (KT) * 32; const bf16_t* wb_ = W + (KT) * 32; \
    rx[S][0] = *(const u32x4*)(xb_ + xoff[0]); rx[S][1] = *(const u32x4*)(xb_ + xoff[1]); \
    rw[S][0] = *(const u32x4*)(wb_ + woff[0]); rw[S][1] = *(const u32x4*)(wb_ + woff[1]); }
#define G_STORE(S, B) { bf16_t* d_ = sb + (B) * BUFE + lr * LDG + lcs; \
    *(u32x4*)(d_) = rx[S][0]; *(u32x4*)(d_ + 128 * LDG) = rx[S][1]; \
    *(u32x4*)(d_ + 256 * LDG) = rw[S][0]; *(u32x4*)(d_ + 384 * LDG) = rw[S][1]; }
#define G_COMPUTE(B) { const bf16_t* bx_ = sb + (B) * BUFE; const bf16_t* bw_ = bx_ + 256 * LDG; \
    bf16x8 wf[4], xf[8]; \
    _Pragma("unroll") for (int i = 0; i < 4; ++i) wf[i] = *(const bf16x8*)(bw_ + (wn * 64 + i * 16 + l16) * LDG + gs); \
    _Pragma("unroll") for (int i = 0; i < 8; ++i) xf[i] = *(const bf16x8*)(bx_ + (wm * 128 + i * 16 + l16) * LDG + gs); \
    _Pragma("unroll") for (int ni = 0; ni < 4; ++ni) \
      _Pragma("unroll") for (int mi = 0; mi < 8; ++mi) acc[ni][mi] = MFMA16(wf[ni], xf[mi], acc[ni][mi]); }
#define G_STEP(KK, RL, RS) if ((KK) < nk) { \
    if ((KK) + 1 < nk) G_STORE(RS, ((KK) + 1) & 1) \
    if ((KK) + 3 < nk) G_LOAD(RL, (KK) + 3) \
    G_COMPUTE((KK) & 1) \
    __syncthreads(); }
  G_LOAD(0, 0) G_LOAD(1, 1) G_LOAD(2, 2)
  __syncthreads();
  G_STORE(0, 0)
  __syncthreads();
  for (int k0 = 0; k0 < nk; k0 += 3) {
    G_STEP(k0, 0, 1)
    G_STEP(k0 + 1, 1, 2)
    G_STEP(k0 + 2, 2, 0)
  }
#undef G_LOAD
#undef G_STORE
#undef G_COMPUTE
#undef G_STEP
#pragma unroll
  for (int ni = 0; ni < 4; ++ni) {
    const int n = n0 + wn * 64 + ni * 16 + g * 4;
    if (n < N) {
#pragma unroll
      for (int mi = 0; mi < 8; ++mi) epi(m0 + wm * 128 + mi * 16 + l16, n, acc[ni][mi]);
    }
  }
}

template <int W>
DI void stage_rows64(bf16_t* dst, int ldd, int coff, const bf16_t* src, int lds) {
  for (int c = TIDX; c < 64 * (W / 8); c += 256) {
    const int r = c / (W / 8), cc = (c % (W / 8)) * 8;
    *(uint4*)(dst + r * ldd + coff + cc) = *(const uint4*)(src + (size_t)r * lds + cc);
  }
}
template <int W>
DI void stage_T64(bf16_t* dst, const bf16_t* src, int lds, const float* rscale) {
  for (int c = TIDX; c < 64 * (W / 8); c += 256) {
    const int r = c & 63, cc = (c >> 6) * 8;
    uint4 v = *(const uint4*)(src + (size_t)r * lds + cc);
    unsigned w[4] = {v.x, v.y, v.z, v.w};
    if (rscale) {
      const float s = rscale[r];
#pragma unroll
      for (int i = 0; i < 4; ++i) {
        dst[(cc + 2 * i) * LDT + r] = f2bf(lo2f(w[i]) * s);
        dst[(cc + 2 * i + 1) * LDT + r] = f2bf(hi2f(w[i]) * s);
      }
    } else {
#pragma unroll
      for (int i = 0; i < 4; ++i) {
        dst[(cc + 2 * i) * LDT + r] = (bf16_t)(w[i] & 0xffffu);
        dst[(cc + 2 * i + 1) * LDT + r] = (bf16_t)(w[i] >> 16);
      }
    }
  }
}

template <int DK, int DV, bool DUAL>
DI void attn_core(char* smem, const bf16_t* Qp, int ldq, const bf16_t* K1, int ldk1, const bf16_t* K2, int ldk2,
                  const bf16_t* V, int ldv, int T, float scale_log2, f32x4 (&o)[DUAL ? 2 : 1][DV / 16], float (&lsum)[DUAL ? 2 : 1], float (&mrun)[DUAL ? 2 : 1]) {
  constexpr int NS = DUAL ? 2 : 1;
  constexpr int DKT = DUAL ? 2 * DK : DK;
  constexpr int W1 = (DK == 96) ? 64 : DKT;
  constexpr int LDK = DKT + 8;
  constexpr int NK1 = 64 * (W1 / 8) / 256;
  constexpr int NV = 64 * (DV / 8) / 256;
  bf16_t* sK = (bf16_t*)smem;
  bf16_t* sVT = sK + 64 * LDK;
  const int tid = TIDX, lane = tid & 63, wave = tid >> 6, g = lane >> 4, l16 = lane & 15;
  bf16x8 qf[DKT / 32];
  const bf16_t* qrow = Qp + (size_t)(wave * 16 + l16) * ldq;
#pragma unroll
  for (int ks = 0; ks < DKT / 32; ++ks) qf[ks] = *(const bf16x8*)(qrow + ks * 32 + g * 8);
#pragma unroll
  for (int n = 0; n < NS; ++n) {
#pragma unroll
    for (int i = 0; i < DV / 16; ++i) o[n][i] = f32x4{0.f, 0.f, 0.f, 0.f};
    mrun[n] = -INFINITY; lsum[n] = 0.f;
  }
  constexpr int PD = 1;
  u32x4 pk[PD][NK1], pk2[PD], pv[PD][NV];
  unsigned koff[NK1], voff[NV];
#pragma unroll
  for (int i = 0; i < NK1; ++i) { const int c = tid + 256 * i, r = c / (W1 / 8), cc = (c % (W1 / 8)) * 8; koff[i] = (unsigned)(r * ldk1 + cc); }
#pragma unroll
  for (int i = 0; i < NV; ++i) { const int c = tid + 256 * i, r = c & 63, cc = (c >> 6) * 8; voff[i] = (unsigned)(r * ldv + cc); }
  const unsigned k2off = (unsigned)((tid >> 2) * ldk2 + (tid & 3) * 8);
#pragma unroll
  for (int u = 0; u < PD; ++u) {
    if (u * 64 < T) {
      const bf16_t* kbase = K1 + (size_t)(u * 64) * ldk1;
      const bf16_t* vbase = V + (size_t)(u * 64) * ldv;
#pragma unroll
      for (int i = 0; i < NK1; ++i) pk[u][i] = *(const u32x4*)(kbase + koff[i]);
      if (DK == 96) pk2[u] = *(const u32x4*)(K2 + (size_t)(u * 64) * ldk2 + k2off);
#pragma unroll
      for (int i = 0; i < NV; ++i) pv[u][i] = *(const u32x4*)(vbase + voff[i]);
    }
  }
  for (int tb = 0; tb < T; tb += 64 * PD) {
#pragma unroll
  for (int u = 0; u < PD; ++u) {
    const int t0 = tb + 64 * u;
    if (t0 < T) {
    __syncthreads();
#pragma unroll
    for (int i = 0; i < NK1; ++i) { const int c = tid + 256 * i, r = c / (W1 / 8), cc = (c % (W1 / 8)) * 8; *(u32x4*)(sK + r * LDK + cc) = pk[u][i]; }
    if (DK == 96) { const int r = tid >> 2, cc = (tid & 3) * 8; *(u32x4*)(sK + r * LDK + 64 + cc) = pk2[u]; }
#pragma unroll
    for (int i = 0; i < NV; ++i) {
      const int c = tid + 256 * i, r = c & 63, cc = (c >> 6) * 8;
#pragma unroll
      for (int j = 0; j < 4; ++j) {
        sVT[(cc + 2 * j) * LDT + r] = (bf16_t)(pv[u][i][j] & 0xffffu);
        sVT[(cc + 2 * j + 1) * LDT + r] = (bf16_t)(pv[u][i][j] >> 16);
      }
    }
    __syncthreads();
    if (t0 + 64 * PD < T) {
      const int tn = t0 + 64 * PD;
      const bf16_t* kbase = K1 + (size_t)tn * ldk1;
      const bf16_t* vbase = V + (size_t)tn * ldv;
#pragma unroll
      for (int i = 0; i < NK1; ++i) pk[u][i] = *(const u32x4*)(kbase + koff[i]);
      if (DK == 96) pk2[u] = *(const u32x4*)(K2 + (size_t)tn * ldk2 + k2off);
#pragma unroll
      for (int i = 0; i < NV; ++i) pv[u][i] = *(const u32x4*)(vbase + voff[i]);
    }
    bf16x8 pf[NS][2];
#pragma unroll
    for (int n = 0; n < NS; ++n) {
      f32x4 s[4];
#pragma unroll
      for (int t = 0; t < 4; ++t) {
        s[t] = f32x4{0.f, 0.f, 0.f, 0.f};
#pragma unroll
        for (int ks = 0; ks < DK / 32; ++ks) {
          const bf16x8 kf = *(const bf16x8*)(sK + (t * 16 + l16) * LDK + n * DK + ks * 32 + g * 8);
          s[t] = MFMA16(kf, qf[n * (DK / 32) + ks], s[t]);
        }
      }
      float mx = -INFINITY;
#pragma unroll
      for (int t = 0; t < 4; ++t)
#pragma unroll
        for (int j = 0; j < 4; ++j) { s[t][j] *= scale_log2; mx = fmaxf(mx, s[t][j]); }
      mx = fmaxf(mx, __shfl_xor(mx, 16));
      mx = fmaxf(mx, __shfl_xor(mx, 32));
      const float mnew = fmaxf(mrun[n], mx);
      const float alpha = __builtin_amdgcn_exp2f(mrun[n] - mnew);
      mrun[n] = mnew;
      float ps = 0.f;
#pragma unroll
      for (int t = 0; t < 4; ++t)
#pragma unroll
        for (int j = 0; j < 4; ++j) { s[t][j] = __builtin_amdgcn_exp2f(s[t][j] - mnew); ps += s[t][j]; }
      lsum[n] = lsum[n] * alpha + ps;
#pragma unroll
      for (int i = 0; i < DV / 16; ++i) o[n][i] *= alpha;
#pragma unroll
      for (int kb = 0; kb < 2; ++kb)
      {
        u32x4 w;
        w[0] = pack2(s[2 * kb][0], s[2 * kb][1]); w[1] = pack2(s[2 * kb][2], s[2 * kb][3]);
        w[2] = pack2(s[2 * kb + 1][0], s[2 * kb + 1][1]); w[3] = pack2(s[2 * kb + 1][2], s[2 * kb + 1][3]);
        pf[n][kb] = __builtin_bit_cast(bf16x8, w);
      }
    }
#pragma unroll
    for (int kb = 0; kb < 2; ++kb) {
#pragma unroll
      for (int i = 0; i < DV / 16; ++i) {
        const bf16_t* vp = sVT + (i * 16 + l16) * LDT + kb * 32 + g * 4;
        const bf16x4 lo = *(const bf16x4*)(vp);
        const bf16x4 hi = *(const bf16x4*)(vp + 16);
        const bf16x8 vf = __builtin_shufflevector(lo, hi, 0, 1, 2, 3, 4, 5, 6, 7);
#pragma unroll
        for (int n = 0; n < NS; ++n) o[n][i] = MFMA16(vf, pf[n][kb], o[n][i]);
        if (DUAL && (i & 3) == 3) asm volatile("" ::: "memory");
      }
    }
    }
  }
  }
}

DI void transpose_w(const float* __restrict__ src, int K, int N, bf16_t* __restrict__ dst, int tile, float* sT, int sc_lo, int sc_hi, float sc) {
  const int ntn = (N + 63) >> 6;
  const int kt = tile / ntn, nt = tile % ntn, k0 = kt * 64, n0 = nt * 64;
  __syncthreads();
#pragma unroll
  for (int q = 0; q < 4; ++q) {
    const int i = TIDX + 256 * q;
    const int r = i >> 4, c = (i & 15) * 4, n = n0 + c;
    float4 v = make_float4(0.f, 0.f, 0.f, 0.f);
    if (n < N) v = *(const float4*)(src + (size_t)(k0 + r) * N + n);
    if (n >= sc_lo && n < sc_hi) { v.x *= sc; v.y *= sc; v.z *= sc; v.w *= sc; }
    float* d = sT + r * 65 + c;
    d[0] = v.x; d[1] = v.y; d[2] = v.z; d[3] = v.w;
  }
  __syncthreads();
#pragma unroll
  for (int q = 0; q < 2; ++q) {
    const int i = TIDX + 256 * q;
    const int c = i >> 3, kc = (i & 7) * 8, n = n0 + c;
    if (n < N) {
      const float* sp = sT + kc * 65 + c;
      uint4 o;
      o.x = pack2(sp[0], sp[65]); o.y = pack2(sp[130], sp[195]); o.z = pack2(sp[260], sp[325]); o.w = pack2(sp[390], sp[455]);
      *(uint4*)(dst + (size_t)n * K + k0 + kc) = o;
    }
  }
}

DI void phase0(const Params& p, char* smem) {
  const int tid = TIDX;
  for (int it = VBLK; it < 384; it += NVBLK) {
    const int l = it / 192, cb = (it % 192) * 16;
    const float* W = l ? p.o_ada_w : p.e_ada_w;
    const float* bias = l ? p.o_ada_b : p.e_ada_b;
    float* sc = (float*)smem;
    float* red = sc + 3072;
    __syncthreads();
    for (int i = tid; i < 3072; i += 256) {
      const int j = i >> 10, k = i & 1023;
      const float v = (j == 0) ? p.c_ctx[k] : p.c[(j - 1) * 1024 + k];
      sc[i] = siluf(v);
    }
    __syncthreads();
    const int col = cb + (tid & 15), kg = tid >> 4;
    float a0 = 0.f, a1 = 0.f, a2 = 0.f;
    for (int kb = kg * 64; kb < kg * 64 + 64; kb += 16) {
      float w[16];
#pragma unroll
      for (int u = 0; u < 16; ++u) w[u] = W[(size_t)(kb + u) * 3072 + col];
#pragma unroll
      for (int u = 0; u < 16; ++u) { a0 += sc[kb + u] * w[u]; a1 += sc[1024 + kb + u] * w[u]; a2 += sc[2048 + kb + u] * w[u]; }
    }
    red[(kg * 3 + 0) * 16 + (tid & 15)] = a0;
    red[(kg * 3 + 1) * 16 + (tid & 15)] = a1;
    red[(kg * 3 + 2) * 16 + (tid & 15)] = a2;
    __syncthreads();
    if (tid < 48) {
      const int j = tid >> 4, c = tid & 15;
      float s = 0.f;
      for (int q = 0; q < 16; ++q) s += red[(q * 3 + j) * 16 + c];
      p.MOD[(l * 3 + j) * 3072 + cb + c] = s + bias[cb + c];
    }
  }
}

DI void phase0b(const Params& p, char* smem) {
  const int tid = TIDX;
  if (VBLK == 0 && tid < 64) {
    float a = p.o_lam[tid] * p.o_lam[64 + tid];
    float b = p.o_lam[128 + tid] * p.o_lam[192 + tid];
    a = wave_sum(a); b = wave_sum(b);
    if (tid == 0) p.LAMV[0] = expf(a) - expf(b) + LAM_INIT;
  }
  for (int idx = VBLK * 256 + tid; idx < 1024 * 48; idx += NVBLK * 256) {
    const int pos = idx / 48, e = idx % 48;
    const float rr = (float)(pos >> 6), cc = (float)(pos & 63);
    if (e < 16) {
      const int j = e & 7;
      const float inv = 1.0f / powf(10000.0f, (float)(2 * j) / 16.0f);
      const float ang = ((e < 8) ? rr : cc) * inv;
      p.ROPE32[pos * 16 + e] = make_float2(cosf(ang), sinf(ang));
    } else {
      const int i = e - 16, j = i & 15;
      const float inv = 1.0f / powf(10000.0f, (float)(2 * j) / 32.0f);
      const float ang = ((i < 16) ? rr : cc) * inv;
      p.ROPE64[pos * 32 + i] = make_float2(cosf(ang), sinf(ang));
    }
  }
  float* sT = (float*)smem;
  for (int it = VBLK; it < 2440; it += NVBLK) {
    if (it < 624) transpose_w(p.e_w_in, 1024, EIN, p.WinE, it, sT, 0, 0, 1.f);
    else if (it < 1792) transpose_w(p.o_w_in, 1024, OIN, p.WinO, it - 624, sT, 512, 1024, 0.08838834764831845f);
    else if (it < 1864) transpose_w(p.e_w_uq, 384, 768, p.Wuq, it - 1792, sT, 0, 0, 1.f);
    else if (it < 1928) transpose_w(p.e_w_ukv, 256, 1024, p.Wukv, it - 1864, sT, 0, 0, 1.f);
    else if (it < 2184) transpose_w(p.e_w_out, 1024, 1024, p.WoutE, it - 1928, sT, 0, 0, 1.f);
    else transpose_w(p.o_w_out, 1024, 1024, p.WoutO, it - 2184, sT, 0, 0, 1.f);
  }
}

DI void phase_norm(const Params& p, int layer) {
  const int tid = TIDX, lane = tid & 63, wave = tid >> 6;
  const float* g = layer ? p.o_norm_g : p.e_norm_g;
  for (int it = VBLK; it < NROW / 4; it += NVBLK) {
    const int row = it * 4 + wave;
    const float* x = layer ? (p.X1 + (size_t)row * 1024) : xrow(p, row);
    const float* md = p.MOD + (layer * 3 + cv_of_row(row)) * 3072;
    float4 v[4];
    float ss = 0.f;
#pragma unroll
    for (int i = 0; i < 4; ++i) {
      v[i] = *(const float4*)(x + i * 256 + lane * 4);
      ss += v[i].x * v[i].x + v[i].y * v[i].y + v[i].z * v[i].z + v[i].w * v[i].w;
    }
    ss = wave_sum(ss);
    const float r = rsqrtf(ss * (1.f / 1024.f) + EPSF);
#pragma unroll
    for (int i = 0; i < 4; ++i) {
      const int col = i * 256 + lane * 4;
      const float4 gg = *(const float4*)(g + col), sh = *(const float4*)(md + col), sc = *(const float4*)(md + 1024 + col);
      uint2 o;
      o.x = pack2(v[i].x * r * gg.x * (1.f + sc.x) + sh.x, v[i].y * r * gg.y * (1.f + sc.y) + sh.y);
      o.y = pack2(v[i].z * r * gg.z * (1.f + sc.z) + sh.z, v[i].w * r * gg.w * (1.f + sc.w) + sh.w);
      *(uint2*)(p.H + (size_t)row * 1024 + col) = o;
    }
  }
}

DI void store_bf4(bf16_t* dst, f32x4 v) {
  uint2 o; o.x = pack2(v[0], v[1]); o.y = pack2(v[2], v[3]);
  *(uint2*)dst = o;
}

DI void phase_gemm_in(const Params& p, int layer, char* smem) {
  const int N = layer ? OIN : EIN;
  const int ntn = (N + 255) / 256;
  const bf16_t* W = layer ? p.WinO : p.WinE;
  bf16_t* U = layer ? p.U1 : p.U0;
  for (int it = blockIdx.x; it < 24 * ntn; it += gridDim.x) {
    const int mt = it % 24, nt = it / 24;
    gemm256(p.H, 1024, W, 1024, N, 1024, mt * 256, nt * 256, smem,
            [=](int m, int n, f32x4 v) { store_bf4(U + (size_t)m * N + n, v); });
  }
}

DI void phase_gemm_out(const Params& p, int layer, char* smem) {
  const bf16_t* W = layer ? p.WoutO : p.WoutE;
  for (int it = VBLK; it < 48 * 8; it += NVBLK) {
    const int mt = it % 48, nt = it / 48;
    gemm_tile(p.O, 1024, W, 1024, 1024, 1024, mt * 128, nt * 128, smem,
              [=](int m, int n, f32x4 v) {
                const float4 gt = *(const float4*)(p.MOD + (layer * 3 + cv_of_row(m)) * 3072 + 2048 + n);
                const float* xs = layer ? (p.X1 + (size_t)m * 1024 + n) : (xrow(p, m) + n);
                const float4 xv = *(const float4*)xs;
                float4 r;
                r.x = xv.x + gt.x * v[0]; r.y = xv.y + gt.y * v[1]; r.z = xv.z + gt.z * v[2]; r.w = xv.w + gt.w * v[3];
                *(float4*)(p.X1 + (size_t)m * 1024 + n) = r;
              });
  }
}

DI void phase_gemm_mla(const Params& p, char* smem) {
  for (int it = VBLK; it < 288 + 416; it += NVBLK) {
    if (it < 288) {
      const int mt = it % 48, nt = it / 48;
      gemm_tile(p.CQN, 384, p.Wuq, 384, 768, 384, mt * 128, nt * 128, smem,
                [=](int m, int n, f32x4 v) {
                  const int d = n % 96;
                  if (m >= 4096 && d >= 64) {
                    const int pos = (m - 4096) & 1023;
                    const int pi = (d - 64) >> 1;
                    const float2 c0 = p.ROPE32[pos * 16 + pi], c1 = p.ROPE32[pos * 16 + pi + 1];
                    const float a0 = v[0] * c0.x - v[1] * c0.y, a1 = v[0] * c0.y + v[1] * c0.x;
                    const float a2 = v[2] * c1.x - v[3] * c1.y, a3 = v[2] * c1.y + v[3] * c1.x;
                    v = f32x4{a0, a1, a2, a3};
                  }
                  store_bf4(p.Q + (size_t)m * 768 + n, v);
                });
    } else {
      const int i2 = it - 288;
      const int mt = i2 % 52, nt = i2 / 52;
      gemm_tile(p.CKVN, 256, p.Wukv, 256, 1024, 256, mt * 128, nt * 128, smem,
                [=](int m, int n, f32x4 v) { store_bf4(p.KV + (size_t)m * 1024 + n, v); });
    }
  }
}

struct TRow { int row, pos, cb, ct; bool cache, lat; };
DI TRow decode_trow(int trow) {
  TRow t; t.row = -1; t.pos = 0; t.cb = 0; t.ct = 0; t.cache = false; t.lat = false;
  if (trow < 4096) { t.row = trow; }
  else {
    const int r = trow - 4096; const int b = r / 1280, tt = r % 1280;
    t.lat = true;
    if (tt < 256) { t.cache = true; t.cb = b; t.ct = tt; }
    else { t.pos = tt - 256; t.row = 4096 + b * 1024 + t.pos; }
  }
  return t;
}
DI void cvt_store4(bf16_t* dst, const float* src) {
  const float4 v = *(const float4*)src;
  uint2 o; o.x = pack2(v.x, v.y); o.y = pack2(v.z, v.w);
  *(uint2*)dst = o;
}

DI void phase3(const Params& p) {
  const int tid = TIDX, lane = tid & 63, wave = tid >> 6;
  for (int it = VBLK; it < NTROW / 4; it += NVBLK) {
    const int trow = it * 4 + wave;
    const TRow t = decode_trow(trow);
    if (t.cache) {
      const size_t ci = (size_t)t.cb * 256 + t.ct;
      cvt_store4(p.CKVN + (size_t)trow * 256 + lane * 4, p.cache_ckv + ci * 256 + lane * 4);
      if (lane < 8) cvt_store4(p.KR + (size_t)trow * 32 + lane * 4, p.cache_kr + ci * 32 + lane * 4);
      if (lane < 32) {
        cvt_store4(p.KB + (size_t)trow * 128 + lane * 4, p.cache_gk + ci * 128 + lane * 4);
        cvt_store4(p.VB + (size_t)trow * 128 + lane * 4, p.cache_gv + ci * 128 + lane * 4);
      }
      continue;
    }
    const int row = t.row;
    const bf16_t* u = p.U0 + (size_t)row * EIN;
    {
      float x[6]; float ss = 0.f;
#pragma unroll
      for (int i = 0; i < 3; ++i) {
        const unsigned w = *(const unsigned*)(u + i * 128 + lane * 2);
        x[2 * i] = lo2f(w); x[2 * i + 1] = hi2f(w);
        ss += x[2 * i] * x[2 * i] + x[2 * i + 1] * x[2 * i + 1];
      }
      ss = wave_sum(ss);
      const float r = rsqrtf(ss * (1.f / 384.f) + EPSF);
#pragma unroll
      for (int i = 0; i < 3; ++i) {
        const int col = i * 128 + lane * 2;
        *(unsigned*)(p.CQN + (size_t)row * 384 + col) = pack2(x[2 * i] * r * p.e_qn_g[col], x[2 * i + 1] * r * p.e_qn_g[col + 1]);
      }
    }
    {
      const uint2 w = *(const uint2*)(u + 384 + lane * 4);
      float x0 = lo2f(w.x), x1 = hi2f(w.x), x2 = lo2f(w.y), x3 = hi2f(w.y);
      float ss = wave_sum(x0 * x0 + x1 * x1 + x2 * x2 + x3 * x3);
      const float r = rsqrtf(ss * (1.f / 256.f) + EPSF);
      const float4 gg = *(const float4*)(p.e_kvn_g + lane * 4);
      x0 *= r * gg.x; x1 *= r * gg.y; x2 *= r * gg.z; x3 *= r * gg.w;
      uint2 o; o.x = pack2(x0, x1); o.y = pack2(x2, x3);
      *(uint2*)(p.CKVN + (size_t)trow * 256 + lane * 4) = o;
      if (!t.lat) *(float4*)(p.out + O_CKV + (size_t)row * 256 + lane * 4) = make_float4(x0, x1, x2, x3);
    }
    if (lane < 16) {
      const unsigned w = *(const unsigned*)(u + 640 + lane * 2);
      float x0 = lo2f(w), x1 = hi2f(w);
      if (t.lat) {
        const float2 cs = p.ROPE32[t.pos * 16 + lane];
        const float y0 = x0 * cs.x - x1 * cs.y, y1 = x0 * cs.y + x1 * cs.x;
        x0 = y0; x1 = y1;
      } else {
        *(float2*)(p.out + O_KR + (size_t)row * 32 + lane * 2) = make_float2(x0, x1);
      }
      *(unsigned*)(p.KR + (size_t)trow * 32 + lane * 2) = pack2(x0, x1);
    }
#pragma unroll
    for (int which = 0; which < 2; ++which) {
      const int lsrc = which ? (lane & 15) : lane;
      const uint4 w = *(const uint4*)(u + (which ? 1696 : 1184) + lsrc * 8);
      float x[8] = {lo2f(w.x), hi2f(w.x), lo2f(w.y), hi2f(w.y), lo2f(w.z), hi2f(w.z), lo2f(w.w), hi2f(w.w)};
      float ss = 0.f;
#pragma unroll
      for (int j = 0; j < 8; ++j) ss += x[j] * x[j];
      ss += __shfl_xor(ss, 1); ss += __shfl_xor(ss, 2); ss += __shfl_xor(ss, 4);
      const float r = rsqrtf(ss * (1.f / 64.f) + EPSF);
      const float* gp = (which ? p.e_gk_g : p.e_gq_g) + (lane & 7) * 8;
#pragma unroll
      for (int j = 0; j < 8; ++j) x[j] *= r * gp[j];
      if (t.lat) {
#pragma unroll
        for (int jj = 0; jj < 4; ++jj) {
          const float2 cs = p.ROPE64[t.pos * 32 + (lane & 7) * 4 + jj];
          const float y0 = x[2 * jj] * cs.x - x[2 * jj + 1] * cs.y, y1 = x[2 * jj] * cs.y + x[2 * jj + 1] * cs.x;
          x[2 * jj] = y0; x[2 * jj + 1] = y1;
        }
      }
      uint4 o; o.x = pack2(x[0], x[1]); o.y = pack2(x[2], x[3]); o.z = pack2(x[4], x[5]); o.w = pack2(x[6], x[7]);
      if (which == 0) {
        *(uint4*)(p.QB + (size_t)row * 512 + lane * 8) = o;
      } else if (lane < 16) {
        *(uint4*)(p.KB + (size_t)trow * 128 + lane * 8) = o;
        if (!t.lat) {
          float* op = p.out + O_GK + (size_t)row * 128 + lane * 8;
          *(float4*)op = make_float4(x[0], x[1], x[2], x[3]);
          *(float4*)(op + 4) = make_float4(x[4], x[5], x[6], x[7]);
        }
      }
    }
    if (lane < 16) {
      const uint4 w = *(const uint4*)(u + 1824 + lane * 8);
      *(uint4*)(p.VB + (size_t)trow * 128 + lane * 8) = w;
      if (!t.lat) {
        float* op = p.out + O_GV + (size_t)row * 128 + lane * 8;
        *(float4*)op = make_float4(lo2f(w.x), hi2f(w.x), lo2f(w.y), hi2f(w.y));
        *(float4*)(op + 4) = make_float4(lo2f(w.z), hi2f(w.z), lo2f(w.w), hi2f(w.w));
      }
    }
  }
}

DI void phase_attn0(const Params& p, char* smem) {
  const int lane = TIDX & 63, wave = TIDX >> 6, g = lane >> 4, l16 = lane & 15;
  for (int it = vblk_xcd(); it < 1536; it += NVBLK) {
    int kind, b, h, qb, row0, trow0, T;
    if (it < 512) { const int i = it & 255; kind = it >> 8; b = i >> 7; h = (i >> 4) & 7; qb = i & 15; row0 = 4096 + b * 1024 + qb * 64; trow0 = 4096 + b * 1280; T = 1280; }
    else { const int i2 = it - 512; kind = i2 >> 9; const int i = i2 & 511; b = i >> 5; h = (i >> 2) & 7; qb = i & 3; row0 = b * 256 + qb * 64; trow0 = b * 256; T = 256; }
    f32x4 oo[1][4];
    float lss[1], mss[1];
    int gcol, ocol;
    if (kind == 0) {
      attn_core<96, 64, false>(smem, p.Q + (size_t)row0 * 768 + h * 96, 768, p.KV + (size_t)trow0 * 1024 + h * 128, 1024,
                        p.KR + (size_t)trow0 * 32, 32, p.KV + (size_t)trow0 * 1024 + h * 128 + 64, 1024, T,
                        0.10206207261596575f * 1.4426950408889634f, oo, lss, mss);
      gcol = 672 + h * 64; ocol = h * 64;
    } else {
      const int kvh = h >> 2;
      attn_core<64, 64, false>(smem, p.QB + (size_t)row0 * 512 + h * 64, 512, p.KB + (size_t)trow0 * 128 + kvh * 64, 128,
                        nullptr, 0, p.VB + (size_t)trow0 * 128 + kvh * 64, 128, T, 0.125f * 1.4426950408889634f, oo, lss, mss);
      gcol = 1952 + h * 64; ocol = 512 + h * 64;
    }
    float ls = lss[0];
    ls += __shfl_xor(ls, 16); ls += __shfl_xor(ls, 32);
    const float inv = 1.f / ls;
    f32x4 (&o)[4] = oo[0];
    const int row = row0 + wave * 16 + l16;
#pragma unroll
    for (int i = 0; i < 4; ++i) {
      const int dv = i * 16 + g * 4;
      const uint2 gw = *(const uint2*)(p.U0 + (size_t)row * EIN + gcol + dv);
      f32x4 r;
      r[0] = o[i][0] * inv * siluf(lo2f(gw.x)); r[1] = o[i][1] * inv * siluf(hi2f(gw.x));
      r[2] = o[i][2] * inv * siluf(lo2f(gw.y)); r[3] = o[i][3] * inv * siluf(hi2f(gw.y));
      store_bf4(p.O + (size_t)row * 1024 + ocol + dv, r);
    }
  }
}

DI void mlstm_gates(const Params& p, int rowbase, int nc, int h, int dir, int j, int lane, float& ig, float& lf) {
  const int oc = dir ? nc - 1 - j : j;
  const int s = dir ? 63 - lane : lane;
  const int row = rowbase + oc * 64 + s;
  const bf16_t* up = p.U1 + (size_t)row * OIN + 2048;
  ig = bf2f(up[dir * 8 + h]) + p.o_gate_b[dir * 8 + h];
  lf = logsig(bf2f(up[dir * 8 + 4 + h]) + p.o_gate_b[dir * 8 + 4 + h]);
}
DI void mitem_decode(int it, int& sq, int& h, int& dir, int& j, int& nc, int& rowbase) {
  if (it < 512) { j = it & 3; dir = (it >> 2) & 1; h = (it >> 3) & 3; sq = it >> 5; nc = 4; rowbase = sq * 256; }
  else { const int i = it - 512; j = i & 15; dir = (i >> 4) & 1; h = (i >> 5) & 3; sq = 16 + (i >> 7); nc = 16; rowbase = 4096 + (sq - 16) * 1024; }
}
DI int mitem_id(int sq, int h, int dir, int j) {
  return sq < 16 ? (((sq * 4 + h) * 2 + dir) * 4 + j) : (512 + ((((sq - 16) * 4 + h) * 2 + dir) * 16 + j));
}

DI void phase9(const Params& p, char* smem) {
  const int tid = TIDX, lane = tid & 63, wave = tid >> 6, g = lane >> 4, l16 = lane & 15;
  for (int it = VBLK; it < NTROW / 4; it += NVBLK) {
    const int trow = it * 4 + wave;
    const TRow t = decode_trow(trow);
    if (t.cache) {
      const size_t ci = (size_t)t.cb * 256 + t.ct;
      cvt_store4(p.KD + (size_t)trow * 512 + lane * 8, p.cache_dk + ci * 512 + lane * 8);
      cvt_store4(p.KD + (size_t)trow * 512 + lane * 8 + 4, p.cache_dk + ci * 512 + lane * 8 + 4);
      cvt_store4(p.VD + (size_t)trow * 512 + lane * 8, p.cache_dv + ci * 512 + lane * 8);
      cvt_store4(p.VD + (size_t)trow * 512 + lane * 8 + 4, p.cache_dv + ci * 512 + lane * 8 + 4);
      continue;
    }
    const int row = t.row;
    const bf16_t* u = p.U1 + (size_t)row * OIN;
#pragma unroll
    for (int which = 0; which < 2; ++which) {
      const uint4 w = *(const uint4*)(u + (which ? 3088 : 2576) + lane * 8);
      float x[8] = {lo2f(w.x), hi2f(w.x), lo2f(w.y), hi2f(w.y), lo2f(w.z), hi2f(w.z), lo2f(w.w), hi2f(w.w)};
      if (t.lat) {
#pragma unroll
        for (int jj = 0; jj < 4; ++jj) {
          const float2 cs = p.ROPE64[t.pos * 32 + (lane & 7) * 4 + jj];
          const float y0 = x[2 * jj] * cs.x - x[2 * jj + 1] * cs.y, y1 = x[2 * jj] * cs.y + x[2 * jj + 1] * cs.x;
          x[2 * jj] = y0; x[2 * jj + 1] = y1;
        }
      }
      uint4 o; o.x = pack2(x[0], x[1]); o.y = pack2(x[2], x[3]); o.z = pack2(x[4], x[5]); o.w = pack2(x[6], x[7]);
      if (which == 0) *(uint4*)(p.QD + (size_t)row * 512 + lane * 8) = o;
      else {
        *(uint4*)(p.KD + (size_t)trow * 512 + lane * 8) = o;
        if (!t.lat) {
          float* op = p.out + O_DK + (size_t)row * 512 + lane * 8;
          *(float4*)op = make_float4(x[0], x[1], x[2], x[3]);
          *(float4*)(op + 4) = make_float4(x[4], x[5], x[6], x[7]);
        }
      }
    }
    {
      const uint4 w = *(const uint4*)(u + 3600 + lane * 8);
      *(uint4*)(p.VD + (size_t)trow * 512 + lane * 8) = w;
      if (!t.lat) {
        float* op = p.out + O_DV + (size_t)row * 512 + lane * 8;
        *(float4*)op = make_float4(lo2f(w.x), hi2f(w.x), lo2f(w.y), hi2f(w.y));
        *(float4*)(op + 4) = make_float4(lo2f(w.z), hi2f(w.z), lo2f(w.w), hi2f(w.w));
      }
    }
  }
  bf16_t* sKT = (bf16_t*)smem;
  bf16_t* sVT = sKT + 128 * LDT;
  float* swk = (float*)(sVT + 128 * LDT);
  for (int it = VBLK; it < 768; it += NVBLK) {
    int sq, h, dir, j, nc, rowbase;
    mitem_decode(it, sq, h, dir, j, nc, rowbase);
    float ig, lf;
    mlstm_gates(p, rowbase, nc, h, dir, j, lane, ig, lf);
    const float b = scan_add(lf, lane);
    const float bL = __shfl(b, 63);
    const float mx = wave_max(bL - b + ig);
    const float wk = expf(bL - b + ig - mx);
    __syncthreads();
    if (wave == 0) {
      swk[dir ? 63 - lane : lane] = wk;
      if (lane == 0) { p.SC[it * 4 + 0] = bL; p.SC[it * 4 + 1] = mx; }
    }
    __syncthreads();
    const int oc = dir ? nc - 1 - j : j;
    const int row0 = rowbase + oc * 64;
    stage_T64<128>(sKT, p.U1 + (size_t)row0 * OIN + 512 + h * 128, OIN, nullptr);
    stage_T64<128>(sVT, p.U1 + (size_t)row0 * OIN + 1024 + h * 128, OIN, swk);
    __syncthreads();
    f32x4 acc[2][8];
#pragma unroll
    for (int a = 0; a < 2; ++a)
#pragma unroll
      for (int c = 0; c < 8; ++c) acc[a][c] = f32x4{0.f, 0.f, 0.f, 0.f};
#pragma unroll
    for (int ks = 0; ks < 2; ++ks) {
      bf16x8 vf[2];
#pragma unroll
      for (int a = 0; a < 2; ++a) vf[a] = *(const bf16x8*)(sVT + ((wave * 2 + a) * 16 + l16) * LDT + ks * 32 + g * 8);
#pragma unroll
      for (int kt = 0; kt < 8; ++kt) {
        const bf16x8 kf = *(const bf16x8*)(sKT + (kt * 16 + l16) * LDT + ks * 32 + g * 8);
#pragma unroll
        for (int a = 0; a < 2; ++a) acc[a][kt] = MFMA16(kf, vf[a], acc[a][kt]);
      }
    }
    float* uc = p.UC + (size_t)it * 16384;
#pragma unroll
    for (int a = 0; a < 2; ++a)
#pragma unroll
      for (int kt = 0; kt < 8; ++kt) {
        const int v = (wave * 2 + a) * 16 + l16, k = kt * 16 + g * 4;
        *(float4*)(uc + v * 128 + k) = make_float4(acc[a][kt][0], acc[a][kt][1], acc[a][kt][2], acc[a][kt][3]);
      }
    if (tid < 128) {
      float s = 0.f;
      for (int ss = 0; ss < 64; ++ss) s += bf2f(sKT[tid * LDT + ss]) * swk[ss];
      p.NU[it * 128 + tid] = s;
    }
  }
}

DI void diff_finish(const Params& p, f32x4 (&o1)[8], f32x4 (&o2)[8], float l1, float l2, int row0, int hd) {
  const int lane = TIDX & 63, wave = TIDX >> 6, g = lane >> 4, l16 = lane & 15;
  l1 += __shfl_xor(l1, 16); l1 += __shfl_xor(l1, 32);
  l2 += __shfl_xor(l2, 16); l2 += __shfl_xor(l2, 32);
  const float i1 = 1.f / l1, i2 = p.LAMV[0] / l2;
  float ss = 0.f;
#pragma unroll
  for (int i = 0; i < 8; ++i)
#pragma unroll
    for (int j = 0; j < 4; ++j) { o1[i][j] = o1[i][j] * i1 - o2[i][j] * i2; ss += o1[i][j] * o1[i][j]; }
  ss += __shfl_xor(ss, 16); ss += __shfl_xor(ss, 32);
  const float r = rsqrtf(ss * (1.f / 128.f) + EPSF) * (1.f - LAM_INIT);
  const int row = row0 + wave * 16 + l16;
#pragma unroll
  for (int i = 0; i < 8; ++i) {
    const int dv = i * 16 + g * 4;
    const uint2 gw = *(const uint2*)(p.U1 + (size_t)row * OIN + 4112 + hd * 128 + dv);
    const float4 gn = *(const float4*)(p.o_dnorm_g + dv);
    f32x4 rr;
    rr[0] = o1[i][0] * r * gn.x * siluf(lo2f(gw.x)); rr[1] = o1[i][1] * r * gn.y * siluf(hi2f(gw.x));
    rr[2] = o1[i][2] * r * gn.z * siluf(lo2f(gw.y)); rr[3] = o1[i][3] * r * gn.w * siluf(hi2f(gw.y));
    store_bf4(p.O + (size_t)row * 1024 + 512 + hd * 128 + dv, rr);
  }
}

DI void phase10(const Params& p, char* smem) {
  const int tid = TIDX, lane = tid & 63, wave = tid >> 6, g = lane >> 4, l16 = lane & 15;
  for (int it = vblk_xcd(); it < 512; it += NVBLK) {
    int b, hd, qb, row0, trow0, T;
    const bool lat = it < 256;
    const int li = it >> 1, split = it & 1;
    if (lat) { b = li >> 6; hd = (li >> 4) & 3; qb = li & 15; row0 = 4096 + b * 1024 + qb * 64; trow0 = 4096 + b * 1280 + split * 640; T = 640; }
    else { const int i = it - 256; b = i >> 4; hd = (i >> 2) & 3; qb = i & 3; row0 = b * 256 + qb * 64; trow0 = b * 256; T = 256; }
    f32x4 od[2][8];
    float ld2[2], md2[2];
    const float sc = 0.125f * 1.4426950408889634f;
    attn_core<64, 128, true>(smem, p.QD + (size_t)row0 * 512 + hd * 128, 512, p.KD + (size_t)trow0 * 512 + hd * 128, 512, nullptr, 0,
                             p.VD + (size_t)trow0 * 512 + hd * 128, 512, T, sc, od, ld2, md2);
    if (lat) {
#pragma unroll
      for (int n = 0; n < 2; ++n) {
        const size_t base = (size_t)((li * 2 + split) * 2 + n) * 4 + wave;
#pragma unroll
        for (int i = 0; i < 8; ++i) *(f32x4*)(p.OP + ((base * 8 + i) * 64 + lane) * 4) = od[n][i];
        *(float2*)(p.ML + (base * 64 + lane) * 2) = make_float2(md2[n], ld2[n]);
      }
    } else {
      diff_finish(p, od[0], od[1], ld2[0], ld2[1], row0, hd);
    }
  }
  const int vb = (vblk_xcd() + (NVBLK >> 1)) % NVBLK;
  for (int it = vb; it < 144 * 16; it += NVBLK) {
    const int chain = it < 256 ? 128 + (it >> 4) : ((it - 256) >> 4), eb = it & 15;
    const int sq = chain >> 3, h = (chain >> 1) & 3, dir = chain & 1;
    const int nc = sq < 16 ? 4 : 16;
    const int ib = mitem_id(sq, h, dir, 0);
    const int e = eb * 1024 + tid * 4;
    float4 C = make_float4(0.f, 0.f, 0.f, 0.f);
    if (sq >= 16) C = *(const float4*)(p.st_C + (size_t)(((sq - 16) * 2 + dir) * 4 + h) * 16384 + e);
    float4 uu[16];
    float dcs[16], scl[16], bLs[16], mxs[16];
#pragma unroll
    for (int j = 0; j < 16; ++j) {
      if (j < nc) { bLs[j] = p.SC[(ib + j) * 4 + 0]; mxs[j] = p.SC[(ib + j) * 4 + 1]; uu[j] = *(const float4*)(p.UC + (size_t)(ib + j) * 16384 + e); }
    }
    float mrun = 0.f;
    if (sq >= 16) mrun = p.st_m[((sq - 16) * 2 + dir) * 4 + h];
#pragma unroll
    for (int j = 0; j < 16; ++j) {
      if (j < nc) {
        const float mnext = fmaxf(bLs[j] + mrun, mxs[j]);
        dcs[j] = expf(bLs[j] + mrun - mnext);
        scl[j] = expf(mxs[j] - mnext);
        if (eb == 0 && tid == 0) p.SCM[ib + j] = mrun;
        mrun = mnext;
      }
    }
#pragma unroll
    for (int j = 0; j < 16; ++j) {
      if (j < nc) {
        uint2 o; o.x = pack2(C.x, C.y); o.y = pack2(C.z, C.w);
        *(uint2*)(p.CST + (size_t)(ib + j) * 16384 + e) = o;
        const float dc = dcs[j], sc = scl[j];
        C.x = dc * C.x + sc * uu[j].x; C.y = dc * C.y + sc * uu[j].y; C.z = dc * C.z + sc * uu[j].z; C.w = dc * C.w + sc * uu[j].w;
      }
    }
    if (sq < 16) *(float4*)(p.out + O_C + (size_t)((sq * 2 + dir) * 4 + h) * 16384 + e) = C;
    if (eb == 0 && tid < 128) {
      float n = 0.f;
      if (sq >= 16) n = p.st_n[(((sq - 16) * 2 + dir) * 4 + h) * 128 + tid];
#pragma unroll
      for (int j = 0; j < 16; ++j) {
        if (j < nc) {
          p.NST[(ib + j) * 128 + tid] = n;
          n = dcs[j] * n + scl[j] * p.NU[(ib + j) * 128 + tid];
        }
      }
      if (sq < 16) {
        p.out[O_N + ((sq * 2 + dir) * 4 + h) * 128 + tid] = n;
        if (tid == 0) p.out[O_M + (sq * 2 + dir) * 4 + h] = mrun;
      }
    }
  }
}

DI void phase11(const Params& p, char* smem) {
  const int tid = TIDX, lane = tid & 63, wave = tid >> 6, g = lane >> 4, l16 = lane & 15;
  bf16_t* sK = (bf16_t*)smem;
  bf16_t* sVT = sK + 64 * 136;
  float* sB = (float*)(sVT + 128 * LDT);
  float* sA = sB + 128;
  float* sMT = sA + 128;
  for (int it = VBLK; it < 512; it += NVBLK) {
    if (it >= 384) {
    const int li = it - 384;
    const int b = li >> 6, hd = (li >> 4) & 3, qb = li & 15, row0 = 4096 + b * 1024 + qb * 64;
    f32x4 oc[2][8];
    float lc[2];
#pragma unroll
    for (int n = 0; n < 2; ++n) {
      const size_t b0 = (size_t)((li * 2 + 0) * 2 + n) * 4 + wave, b1 = (size_t)((li * 2 + 1) * 2 + n) * 4 + wave;
      const float2 ml0 = *(const float2*)(p.ML + (b0 * 64 + lane) * 2), ml1 = *(const float2*)(p.ML + (b1 * 64 + lane) * 2);
      const float m = fmaxf(ml0.x, ml1.x);
      const float f0 = __builtin_amdgcn_exp2f(ml0.x - m), f1 = __builtin_amdgcn_exp2f(ml1.x - m);
      lc[n] = ml0.y * f0 + ml1.y * f1;
#pragma unroll
      for (int i = 0; i < 8; ++i) {
        const f32x4 a0 = *(const f32x4*)(p.OP + ((b0 * 8 + i) * 64 + lane) * 4), a1 = *(const f32x4*)(p.OP + ((b1 * 8 + i) * 64 + lane) * 4);
        oc[n][i] = a0 * f0 + a1 * f1;
      }
    }
    diff_finish(p, oc[0], oc[1], lc[0], lc[1], row0, hd);
    continue;
    }
    int sq, h, c, nc, rowbase;
    if (it < 128) { sq = 16 + (it >> 6); h = (it >> 4) & 3; c = it & 15; nc = 16; rowbase = 4096 + (sq - 16) * 1024; }
    else { const int i = it - 128; sq = i >> 4; h = (i >> 2) & 3; c = i & 3; nc = 4; rowbase = sq * 256; }
    const int row0 = rowbase + c * 64;
    float mst[2];
    int item[2];
    __syncthreads();
#pragma unroll
    for (int dir = 0; dir < 2; ++dir) {
      const int j = dir ? nc - 1 - c : c;
      item[dir] = mitem_id(sq, h, dir, j);
      mst[dir] = p.SCM[item[dir]];
      if (wave == 0) {
        float ig, lf;
        mlstm_gates(p, rowbase, nc, h, dir, j, lane, ig, lf);
        const float b = scan_add(lf, lane);
        const float a = ig - b;
        const float pm = scan_max(a, lane);
        const float mt = b + fmaxf(mst[dir], pm);
        const int so = dir ? 63 - lane : lane;
        sB[dir * 64 + so] = b; sA[dir * 64 + so] = a; sMT[dir * 64 + so] = mt;
      }
    }
    stage_rows64<128>(sK, 136, 0, p.U1 + (size_t)row0 * OIN + 512 + h * 128, OIN);
    stage_T64<128>(sVT, p.U1 + (size_t)row0 * OIN + 1024 + h * 128, OIN, nullptr);
    bf16x8 qf[4];
    const int tq = wave * 16 + l16;
    const int row = row0 + tq;
#pragma unroll
    for (int ks = 0; ks < 4; ++ks) qf[ks] = *(const bf16x8*)(p.U1 + (size_t)row * OIN + h * 128 + ks * 32 + g * 8);
    __syncthreads();
    f32x4 hsum[8];
#pragma unroll
    for (int i = 0; i < 8; ++i) hsum[i] = f32x4{0.f, 0.f, 0.f, 0.f};
#pragma unroll 1
    for (int dir = 0; dir < 2; ++dir) {
      const float bt = sB[dir * 64 + tq], mtt = sMT[dir * 64 + tq];
      const float mst_d = dir ? mst[1] : mst[0];
      const int item_d = dir ? item[1] : item[0];
      const float w_inter = expf(bt + mst_d - mtt);
      const float et = bt - mtt;
      f32x4 s[4];
      float dsum = 0.f;
#pragma unroll
      for (int t = 0; t < 4; ++t) {
        s[t] = f32x4{0.f, 0.f, 0.f, 0.f};
#pragma unroll
        for (int ks = 0; ks < 4; ++ks) {
          const bf16x8 kf = *(const bf16x8*)(sK + (t * 16 + l16) * 136 + ks * 32 + g * 8);
          s[t] = MFMA16(kf, qf[ks], s[t]);
        }
#pragma unroll
        for (int j = 0; j < 4; ++j) {
          const int sk = t * 16 + g * 4 + j;
          const bool ok = dir ? (sk >= tq) : (sk <= tq);
          const float w = ok ? expf(et + sA[dir * 64 + sk]) : 0.f;
          s[t][j] *= w;
          dsum += s[t][j];
        }
      }
      dsum += __shfl_xor(dsum, 16); dsum += __shfl_xor(dsum, 32);
      f32x4 acc[8];
      const bf16_t* cst = p.CST + (size_t)item_d * 16384;
#pragma unroll
      for (int vt = 0; vt < 8; ++vt) {
        acc[vt] = f32x4{0.f, 0.f, 0.f, 0.f};
#pragma unroll
        for (int ks = 0; ks < 4; ++ks) {
          const bf16x8 cf = *(const bf16x8*)(cst + (vt * 16 + l16) * 128 + ks * 32 + g * 8);
          acc[vt] = MFMA16(cf, qf[ks], acc[vt]);
        }
        acc[vt] *= w_inter;
        if ((vt & 3) == 3) asm volatile("" ::: "memory");
      }
#pragma unroll
      for (int kb = 0; kb < 2; ++kb) {
        bf16x8 pf;
#pragma unroll
        for (int j = 0; j < 4; ++j) { pf[j] = (short)f2bf(s[2 * kb][j]); pf[4 + j] = (short)f2bf(s[2 * kb + 1][j]); }
#pragma unroll
        for (int vt = 0; vt < 8; ++vt) {
          const bf16_t* vp = sVT + (vt * 16 + l16) * LDT + kb * 32 + g * 4;
          const bf16x4 lo = *(const bf16x4*)(vp);
          const bf16x4 hi = *(const bf16x4*)(vp + 16);
          const bf16x8 vf = __builtin_shufflevector(lo, hi, 0, 1, 2, 3, 4, 5, 6, 7);
          acc[vt] = MFMA16(vf, pf, acc[vt]);
        }
      }
      float nq = 0.f;
      const float* nst = p.NST + (size_t)item_d * 128;
#pragma unroll
      for (int ks = 0; ks < 4; ++ks) {
        const float4 n0 = *(const float4*)(nst + ks * 32 + g * 8), n1 = *(const float4*)(nst + ks * 32 + g * 8 + 4);
        nq += n0.x * bf2f((bf16_t)qf[ks][0]) + n0.y * bf2f((bf16_t)qf[ks][1]) + n0.z * bf2f((bf16_t)qf[ks][2]) + n0.w * bf2f((bf16_t)qf[ks][3]);
        nq += n1.x * bf2f((bf16_t)qf[ks][4]) + n1.y * bf2f((bf16_t)qf[ks][5]) + n1.z * bf2f((bf16_t)qf[ks][6]) + n1.w * bf2f((bf16_t)qf[ks][7]);
      }
      nq += __shfl_xor(nq, 16); nq += __shfl_xor(nq, 32);
      const float den = w_inter * nq + dsum;
      const float dinv = 1.f / fmaxf(fabsf(den), expf(-mtt));
#pragma unroll
      for (int vt = 0; vt < 8; ++vt) hsum[vt] += acc[vt] * dinv;
    }
    const bf16_t* u = p.U1 + (size_t)row * OIN;
    float ss = 0.f;
#pragma unroll
    for (int vt = 0; vt < 8; ++vt) {
      const uint2 ow = *(const uint2*)(u + 1536 + h * 128 + vt * 16 + g * 4);
      hsum[vt][0] *= sigmf(lo2f(ow.x)); hsum[vt][1] *= sigmf(hi2f(ow.x));
      hsum[vt][2] *= sigmf(lo2f(ow.y)); hsum[vt][3] *= sigmf(hi2f(ow.y));
#pragma unroll
      for (int j = 0; j < 4; ++j) ss += hsum[vt][j] * hsum[vt][j];
    }
    ss += __shfl_xor(ss, 16); ss += __shfl_xor(ss, 32);
    const float r = rsqrtf(ss * (1.f / 128.f) + EPSF);
#pragma unroll
    for (int vt = 0; vt < 8; ++vt) {
      const int v = h * 128 + vt * 16 + g * 4;
      const uint2 zw = *(const uint2*)(u + 2064 + v);
      const float4 gn = *(const float4*)(p.o_mnorm_g + v);
      f32x4 rr;
      rr[0] = hsum[vt][0] * r * gn.x * siluf(lo2f(zw.x)); rr[1] = hsum[vt][1] * r * gn.y * siluf(hi2f(zw.x));
      rr[2] = hsum[vt][2] * r * gn.z * siluf(lo2f(zw.y)); rr[3] = hsum[vt][3] * r * gn.w * siluf(hi2f(zw.y));
      store_bf4(p.O + (size_t)row * 1024 + v, rr);
    }
  }
}

DI void phase_final(const Params& p) {
  const int tid = TIDX, lane = tid & 63, wave = tid >> 6;
  for (int it = VBLK; it < NROW / 4; it += NVBLK) {
    const int row = it * 4 + wave;
    const float* x = p.X1 + (size_t)row * 1024;
    float4 v[4];
    float ss = 0.f;
#pragma unroll
    for (int i = 0; i < 4; ++i) {
      v[i] = *(const float4*)(x + i * 256 + lane * 4);
      ss += v[i].x * v[i].x + v[i].y * v[i].y + v[i].z * v[i].z + v[i].w * v[i].w;
    }
    ss = wave_sum(ss);
    const float r = rsqrtf(ss * (1.f / 1024.f) + EPSF);
#pragma unroll
    for (int i = 0; i < 4; ++i) {
      const int col = i * 256 + lane * 4;
      const float4 gg = *(const float4*)(p.final_g + col);
      *(float4*)(p.out + O_Y + (size_t)row * 1024 + col) = make_float4(v[i].x * r * gg.x, v[i].y * r * gg.y, v[i].z * r * gg.z, v[i].w * r * gg.w);
    }
  }
}


#define XB_TMO      128
#define XB_XCNT(j)  (256  + 64 * (j))
#define XB_XSUB(j)  (1280 + 64 * (j))
#define XB_XGEN(j)  (2304 + 64 * (j))
#define XB_TOP      3328
#define XB_TOPGEN   3392
#define XCD_BAR_WORDS 3456
#define XB_SPIN_CAP (1u << 18)
#define LAS __attribute__((address_space(3)))
DI unsigned xb_ld(unsigned* p) { return __hip_atomic_load(p, __ATOMIC_RELAXED, __HIP_MEMORY_SCOPE_AGENT); }
DI unsigned xb_add(unsigned* p, unsigned v) { return __hip_atomic_fetch_add(p, v, __ATOMIC_RELAXED, __HIP_MEMORY_SCOPE_AGENT); }
DI unsigned xb_xcc_id() { return (unsigned)__builtin_amdgcn_s_getreg((3 << 11) | 20) & 0xFu; }
#define XB_SPIN(cond, bar) do { unsigned _sp = 0; while (cond) { __builtin_amdgcn_s_sleep(1); \
    if ((++_sp & 255u) == 0u) { if (xb_ld(&(bar)[XB_TMO])) break; if (_sp > XB_SPIN_CAP) { atomicAdd(&(bar)[XB_TMO], 1u); break; } } } } while (0)
struct XcdBarrier { unsigned* bar; unsigned x; volatile LAS unsigned* st; };
DI XcdBarrier xcd_barrier_post(unsigned* bar, volatile LAS unsigned* st) {
  XcdBarrier b; b.bar = bar; b.x = xb_xcc_id(); b.st = st;
  if (threadIdx.x == 0) (void)xb_add(&bar[XB_XCNT(b.x)], 1u);
  return b;
}
DI void xcd_barrier_complete(unsigned* bar, unsigned x, unsigned& nloc, unsigned& nx) {
  const unsigned G = gridDim.x * gridDim.y * gridDim.z;
  unsigned sum, cnt, mine, sp = 0u;
  for (;;) {
    sum = 0u; cnt = 0u; mine = 0u;
#pragma unroll
    for (unsigned j = 0; j < 16; ++j) { const unsigned c = xb_ld(&bar[XB_XCNT(j)]); sum += c; cnt += (c > 0u) ? 1u : 0u; mine = (j == x) ? c : mine; }
    if (sum == G) break;
    __builtin_amdgcn_s_sleep(1);
    if ((++sp & 255u) == 0u) { if (xb_ld(&bar[XB_TMO])) break; if (sp > XB_SPIN_CAP) { atomicAdd(&bar[XB_TMO], 1u); break; } }
  }
  nloc = mine > 0u ? mine : 1u; nx = cnt > 0u ? cnt : 1u;
}
DI void xcd_barrier(const XcdBarrier& b) {
  asm volatile("s_waitcnt vmcnt(0)" ::: "memory");
  __syncthreads();
  if (threadIdx.x == 0) {
    unsigned* bar = b.bar;
    __builtin_amdgcn_s_waitcnt(0);
    unsigned nloc = b.st[0], nx = b.st[1];
    if (nloc == 0u) { xcd_barrier_complete(bar, b.x, nloc, nx); b.st[0] = nloc; b.st[1] = nx; }
    const unsigned old = xb_add(&bar[XB_XSUB(b.x)], 1u);
    const unsigned gen = old / nloc;
    if (old + 1u == (gen + 1u) * nloc) {
      __builtin_amdgcn_fence(__ATOMIC_RELEASE, "agent");
      asm volatile("s_waitcnt vmcnt(0)" ::: "memory");
      const unsigned og = xb_add(&bar[XB_TOP], 1u);
      const unsigned tg = og / nx;
      if (og + 1u == (tg + 1u) * nx) xb_add(&bar[XB_TOPGEN], 1u);
      else XB_SPIN(xb_ld(&bar[XB_TOPGEN]) == tg, bar);
      __builtin_amdgcn_fence(__ATOMIC_ACQUIRE, "agent");
      xb_add(&bar[XB_XGEN(b.x)], 1u);
      asm volatile("s_waitcnt vmcnt(0)" ::: "memory");
    } else {
      XB_SPIN(xb_ld(&bar[XB_XGEN(b.x)]) == gen, bar);
      __builtin_amdgcn_fence(__ATOMIC_ACQUIRE, "agent");
      asm volatile("s_waitcnt vmcnt(0)" ::: "memory");
    }
  }
  __syncthreads();
}

DI void run_phase(const Params& p, char* smem0, int ph) {
  char* smem = smem0 + (ltid() >> 8) * 40960;
  switch (ph) {
    case 0: phase0(p, smem); break;
    case 1: phase0b(p, smem); phase_norm(p, 0); break;
    case 2: phase_gemm_in(p, 0, smem0); break;
    case 3: phase3(p); break;
    case 4: phase_gemm_mla(p, smem); break;
    case 5: phase_attn0(p, smem); break;
    case 6: phase_gemm_out(p, 0, smem); break;
    case 7: phase_norm(p, 1); break;
    case 8: phase_gemm_in(p, 1, smem0); break;
    case 9: phase9(p, smem); break;
    case 10: phase10(p, smem); break;
    case 11: phase11(p, smem); break;
    case 12: phase_gemm_out(p, 1, smem); break;
    case 13: phase_final(p); break;
  }
}

__global__ void __launch_bounds__(512, 2) mk_fwd(Params p) {
#if SINGLE_LAUNCH
  extern __shared__ __attribute__((aligned(16))) char smem[];
  __shared__ uint4 xb_words;
  if (threadIdx.x == 0) xb_words = make_uint4(0u, 0u, 0u, 0u);
  __syncthreads();
  const XcdBarrier xb = xcd_barrier_post(p.BAR, (volatile LAS unsigned*)&xb_words);
  if (p.phase_hi == 12345) {
    const unsigned long long* ia = (const unsigned long long*)__builtin_amdgcn_implicitarg_ptr();
    p.BAR[XB_TMO] = (unsigned)ia[11];
  }
  run_phase(p, smem, 0); xcd_barrier(xb);
  run_phase(p, smem, 1); xcd_barrier(xb);
  run_phase(p, smem, 2); xcd_barrier(xb);
  run_phase(p, smem, 3); xcd_barrier(xb);
  run_phase(p, smem, 4); xcd_barrier(xb);
  run_phase(p, smem, 5); xcd_barrier(xb);
  run_phase(p, smem, 6); xcd_barrier(xb);
  run_phase(p, smem, 7); xcd_barrier(xb);
  run_phase(p, smem, 8); xcd_barrier(xb);
  run_phase(p, smem, 9); xcd_barrier(xb);
  run_phase(p, smem, 10); xcd_barrier(xb);
  run_phase(p, smem, 11); xcd_barrier(xb);
  run_phase(p, smem, 12); xcd_barrier(xb);
  run_phase(p, smem, 13);
#endif
}

template <int PH>
__global__ void __launch_bounds__(512, 2) mk_phase(Params p) {
  extern __shared__ __attribute__((aligned(16))) char smem[];
  run_phase(p, smem, PH);
}
template <int PH>
static void launch_phases(const Params& p, hipStream_t stream) {
  hipFuncSetAttribute((const void*)mk_phase<PH>, hipFuncAttributeMaxDynamicSharedMemorySize, LDS_BYTES);
  hipLaunchKernelGGL(mk_phase<PH>, dim3(256), dim3(512), LDS_BYTES, stream, p);
  if constexpr (PH + 1 < NPHASE) launch_phases<PH + 1>(p, stream);
}

extern "C" void kernel_launch(void* const* d_in, const int* in_sizes, int n_in, void* d_out, int out_size, void* d_ws, size_t ws_size, hipStream_t stream) {
  Params p{};
  const float** fp = (const float**)&p;
  for (int i = 0; i < 34; ++i) fp[i] = (const float*)d_in[i];
  p.out = (float*)d_out;
  char* w = (char*)d_ws;
  size_t off = 0;
  auto take = [&](size_t bytes) { char* r = w + off; off += (bytes + 255) & ~(size_t)255; return r; };
  p.BAR = (unsigned*)take(XCD_BAR_WORDS * 4);
  p.MOD = (float*)take(2 * 3 * 3072 * 4);
  p.LAMV = (float*)take(256);
  p.ROPE32 = (float2*)take(1024 * 16 * 8);
  p.ROPE64 = (float2*)take(1024 * 32 * 8);
  p.WinE = (bf16_t*)take((size_t)EIN * 1024 * 2);
  p.WinO = (bf16_t*)take((size_t)OIN * 1024 * 2);
  p.Wuq = (bf16_t*)take(768 * 384 * 2);
  p.Wukv = (bf16_t*)take(1024 * 256 * 2);
  p.WoutE = (bf16_t*)take(1024 * 1024 * 2);
  p.WoutO = (bf16_t*)take(1024 * 1024 * 2);
  p.H = (bf16_t*)take((size_t)NROW * 1024 * 2);
  p.O = (bf16_t*)take((size_t)NROW * 1024 * 2);
  p.X1 = (float*)take((size_t)NROW * 1024 * 4);
  p.SC = (float*)take(768 * 4 * 4);
  p.SCM = (float*)take(768 * 4);
  p.UC = (float*)take((size_t)768 * 16384 * 4);
  p.NU = (float*)take(768 * 128 * 4);
  p.NST = (float*)take(768 * 128 * 4);
  p.OP = (float*)take((size_t)128 * 2 * 2 * 4 * 8 * 64 * 16);
  p.ML = (float*)take((size_t)128 * 2 * 2 * 4 * 64 * 8);
  p.CST = (bf16_t*)take((size_t)768 * 16384 * 2);
  const size_t region = off;
  p.U0 = (bf16_t*)take((size_t)NROW * EIN * 2);
  p.CQN = (bf16_t*)take((size_t)NROW * 384 * 2);
  p.CKVN = (bf16_t*)take((size_t)NTROW * 256 * 2);
  p.KR = (bf16_t*)take((size_t)NTROW * 32 * 2);
  p.QB = (bf16_t*)take((size_t)NROW * 512 * 2);
  p.KB = (bf16_t*)take((size_t)NTROW * 128 * 2);
  p.VB = (bf16_t*)take((size_t)NTROW * 128 * 2);
  p.Q = (bf16_t*)take((size_t)NROW * 768 * 2);
  p.KV = (bf16_t*)take((size_t)NTROW * 1024 * 2);
  const size_t end0 = off;
  off = region;
  p.U1 = (bf16_t*)take((size_t)NROW * OIN * 2);
  p.QD = (bf16_t*)take((size_t)NROW * 512 * 2);
  p.KD = (bf16_t*)take((size_t)NTROW * 512 * 2);
  p.VD = (bf16_t*)take((size_t)NTROW * 512 * 2);
  const size_t end1 = off;
  const size_t need = end0 > end1 ? end0 : end1;
  if (need > ws_size) { fprintf(stderr, "workspace too small: need %zu have %zu\n", need, ws_size); return; }

#if SINGLE_LAUNCH
  static int grid_blocks = 0;
  if (!grid_blocks) {
    int dev = 0, cus = 0, per_cu = 0;
    hipGetDevice(&dev);
    hipDeviceGetAttribute(&cus, hipDeviceAttributeMultiprocessorCount, dev);
    hipFuncSetAttribute((const void*)mk_fwd, hipFuncAttributeMaxDynamicSharedMemorySize, LDS_BYTES);
    hipOccupancyMaxActiveBlocksPerMultiprocessor(&per_cu, mk_fwd, 512, LDS_BYTES);
    if (per_cu < 1) per_cu = 1;
    grid_blocks = cus;
  }
  p.phase_lo = 0; p.phase_hi = NPHASE;
  hipMemsetAsync(p.BAR, 0, XCD_BAR_WORDS * 4, stream);
  void* args[] = {&p};
  hipError_t e = hipLaunchCooperativeKernel((void*)mk_fwd, dim3(grid_blocks), dim3(512), args, LDS_BYTES, stream);
  if (e != hipSuccess) fprintf(stderr, "cooperative launch failed: %s (grid %d)\n", hipGetErrorString(e), grid_blocks);
#else
  launch_phases<0>(p, stream);
#endif
}
```

```cpp
#include <hip/hip_runtime.h>
#include <hip/hip_cooperative_groups.h>
#include <cstdio>
namespace cg = cooperative_groups;

typedef unsigned short bf16_t;
using bf16x8 = __attribute__((ext_vector_type(8))) short;
using bf16x4 = __attribute__((ext_vector_type(4))) short;
using f32x4  = __attribute__((ext_vector_type(4))) float;
using u32x4  = __attribute__((ext_vector_type(4))) unsigned;
#define DI __device__ __forceinline__
#define MFMA16(a, b, c) __builtin_amdgcn_mfma_f32_16x16x32_bf16((a), (b), (c), 0, 0, 0)

#ifndef SINGLE_LAUNCH
#define SINGLE_LAUNCH 1
#endif

__device__ __forceinline__ unsigned ltid() { unsigned t = threadIdx.x; asm volatile("" : "+v"(t)); return t; }
#define TIDX ((int)(ltid() & 255u))
#define VBLK ((int)(blockIdx.x * 2 + (ltid() >> 8)))
#define NVBLK ((int)(gridDim.x * 2))
DI int vblk_xcd() {
  const int b = blockIdx.x, nb = gridDim.x;
  if (nb & 7) return VBLK;
  return ((b & 7) * (nb >> 3) + (b >> 3)) * 2 + (int)(ltid() >> 8);
}
constexpr int EIN = 2464, OIN = 4624;
constexpr int NROW = 6144, NTROW = 6656;
constexpr int NPHASE = 14;
constexpr int LDS_BYTES = 81920;
constexpr int LDT = 72;
constexpr float EPSF = 1e-6f;
constexpr float LAM_INIT = 0.35550906759097f;
constexpr size_t O_Y = 0, O_CKV = 6291456, O_KR = 7340032, O_GK = 7471104, O_GV = 7995392, O_C = 8519680,
                 O_N = 10616832, O_M = 10633216, O_DK = 10633344, O_DV = 12730496;

struct Params {
  const float *x_prompt, *x_sample, *cache_ckv, *cache_kr, *cache_gk, *cache_gv, *st_C, *st_n, *st_m, *cache_dk, *cache_dv, *c, *c_ctx;
  const float *e_norm_g, *e_ada_w, *e_ada_b, *e_w_in, *e_qn_g, *e_w_uq, *e_kvn_g, *e_w_ukv, *e_gq_g, *e_gk_g, *e_w_out;
  const float *o_norm_g, *o_ada_w, *o_ada_b, *o_w_in, *o_gate_b, *o_mnorm_g, *o_lam, *o_dnorm_g, *o_w_out, *final_g;
  float* out;
  float *MOD, *LAMV;
  float2 *ROPE32, *ROPE64;
  bf16_t *WinE, *WinO, *Wuq, *Wukv, *WoutE, *WoutO;
  bf16_t *H, *U0, *U1, *CQN, *CKVN, *KR, *QB, *KB, *VB, *Q, *KV, *O, *QD, *KD, *VD, *CST;
  float *X1, *SC, *UC, *NU, *NST, *OP, *ML, *SCM;
  unsigned* BAR;
  int phase_lo, phase_hi;
};

DI bf16_t f2bf(float x) { unsigned u = __float_as_uint(x); u += 0x7fffu + ((u >> 16) & 1u); return (bf16_t)(u >> 16); }
DI float bf2f(bf16_t b) { return __uint_as_float(((unsigned)b) << 16); }
typedef __bf16 bf2_t __attribute__((ext_vector_type(2)));
typedef float f2_t __attribute__((ext_vector_type(2)));
DI unsigned pack2(float a, float b) { f2_t v = {a, b}; return __builtin_bit_cast(unsigned, __builtin_convertvector(v, bf2_t)); }
DI float lo2f(unsigned w) { return __uint_as_float(w << 16); }
DI float hi2f(unsigned w) { return __uint_as_float(w & 0xffff0000u); }
DI float wave_sum(float v) { for (int d = 32; d; d >>= 1) v += __shfl_xor(v, d); return v; }
DI float wave_max(float v) { for (int d = 32; d; d >>= 1) v = fmaxf(v, __shfl_xor(v, d)); return v; }
DI float scan_add(float v, int lane) { for (int d = 1; d < 64; d <<= 1) { float t = __shfl_up(v, d); if (lane >= d) v += t; } return v; }
DI float scan_max(float v, int lane) { for (int d = 1; d < 64; d <<= 1) { float t = __shfl_up(v, d); if (lane >= d) v = fmaxf(v, t); } return v; }
DI float logsig(float x) { return fminf(x, 0.f) - log1pf(expf(-fabsf(x))); }
DI float siluf(float x) { return x / (1.f + expf(-x)); }
DI float sigmf(float x) { return 1.f / (1.f + expf(-x)); }
DI int cv_of_row(int row) { return row < 4096 ? 0 : 1 + ((row - 4096) >> 10); }
DI const float* xrow(const Params& p, int row) { return row < 4096 ? p.x_prompt + (size_t)row * 1024 : p.x_sample + (size_t)(row - 4096) * 1024; }

template <class Epi>
DI void gemm_tile(const bf16_t* __restrict__ X, int ldx, const bf16_t* __restrict__ W, int ldw, int N, int K, int m0, int n0, char* smem, Epi epi) {
  constexpr int LDG = 32;
  constexpr int BUFE = 256 * LDG;
  bf16_t* sb = (bf16_t*)smem;
  const int tid = TIDX, lane = tid & 63, wave = tid >> 6, wm = wave >> 1, wn = wave & 1;
  const int g = lane >> 4, l16 = lane & 15;
  f32x4 acc[4][4];
#pragma unroll
  for (int a = 0; a < 4; ++a)
#pragma unroll
    for (int b = 0; b < 4; ++b) acc[a][b] = f32x4{0.f, 0.f, 0.f, 0.f};
  const int lr = tid >> 2, lc = (tid & 3) * 8;
  const int lcs = ((tid & 3) ^ ((4 - ((lr >> 2) & 3)) & 3)) * 8;
  const int gs = (g ^ ((4 - (l16 >> 2)) & 3)) * 8;
  unsigned xoff[2], woff[2];
#pragma unroll
  for (int i = 0; i < 2; ++i) {
    xoff[i] = (unsigned)((m0 + lr + 64 * i) * ldx + lc);
    int n = n0 + lr + 64 * i; if (n > N - 1) n = N - 1;
    woff[i] = (unsigned)(n * ldw + lc);
  }
  const int nk = K >> 5;
  u32x4 rx[3][2], rw[3][2];
#define G_LOAD(S, KT) { const bf16_t* xb_ = X + (KT) * 32; const bf16_t* wb_ = W + (KT) * 32; \
    rx[S][0] = *(const u32x4*)(xb_ + xoff[0]); rx[S][1] = *(const u32x4*)(xb_ + xoff[1]); \
    rw[S][0] = *(const u32x4*)(wb_ + woff[0]); rw[S][1] = *(const u32x4*)(wb_ + woff[1]); }
#define G_STORE(S, B) { bf16_t* d_ = sb + (B) * BUFE + lr * LDG + lcs; \
    *(u32x4*)(d_) = rx[S][0]; *(u32x4*)(d_ + 64 * LDG) = rx[S][1]; \
    *(u32x4*)(d_ + 128 * LDG) = rw[S][0]; *(u32x4*)(d_ + 192 * LDG) = rw[S][1]; }
#define G_COMPUTE(B) { const bf16_t* bx_ = sb + (B) * BUFE; const bf16_t* bw_ = bx_ + 128 * LDG; \
    bf16x8 wf[4], xf[4]; \
    _Pragma("unroll") for (int i = 0; i < 4; ++i) { \
      wf[i] = *(const bf16x8*)(bw_ + (wn * 64 + i * 16 + l16) * LDG + gs); \
      xf[i] = *(const bf16x8*)(bx_ + (wm * 64 + i * 16 + l16) * LDG + gs); } \
    _Pragma("unroll") for (int ni = 0; ni < 4; ++ni) \
      _Pragma("unroll") for (int mi = 0; mi < 4; ++mi) acc[ni][mi] = MFMA16(wf[ni], xf[mi], acc[ni][mi]); }
#define G_STEP(KK, RL, RS) if ((KK) < nk) { \
    if ((KK) + 1 < nk) G_STORE(RS, ((KK) + 1) & 1) \
    if ((KK) + 3 < nk) G_LOAD(RL, (KK) + 3) \
    G_COMPUTE((KK) & 1) \
    __syncthreads(); }
  G_LOAD(0, 0) G_LOAD(1, 1) G_LOAD(2, 2)
  __syncthreads();
  G_STORE(0, 0)
  __syncthreads();
  for (int k0 = 0; k0 < nk; k0 += 3) {
    G_STEP(k0, 0, 1)
    G_STEP(k0 + 1, 1, 2)
    G_STEP(k0 + 2, 2, 0)
  }
#undef G_LOAD
#undef G_STORE
#undef G_COMPUTE
#undef G_STEP
#pragma unroll
  for (int ni = 0; ni < 4; ++ni) {
    const int n = n0 + wn * 64 + ni * 16 + g * 4;
    if (n < N) {
#pragma unroll
      for (int mi = 0; mi < 4; ++mi) epi(m0 + wm * 64 + mi * 16 + l16, n, acc[ni][mi]);
    }
  }
}

template <class Epi>
DI void gemm256(const bf16_t* __restrict__ X, int ldx, const bf16_t* __restrict__ W, int ldw, int N, int K, int m0, int n0, char* smem, Epi epi) {
  constexpr int LDG = 32;
  constexpr int BUFE = 512 * LDG;
  bf16_t* sb = (bf16_t*)smem;
  const int tid = (int)ltid(), lane = tid & 63, wave = tid >> 6, wm = wave >> 2, wn = wave & 3;
  const int g = lane >> 4, l16 = lane & 15;
  f32x4 acc[4][8];
#pragma unroll
  for (int a = 0; a < 4; ++a)
#pragma unroll
    for (int b = 0; b < 8; ++b) acc[a][b] = f32x4{0.f, 0.f, 0.f, 0.f};
  const int lr = tid >> 2, lc = (tid & 3) * 8;
  const int lcs = ((tid & 3) ^ ((4 - ((lr >> 2) & 3)) & 3)) * 8;
  const int gs = (g ^ ((4 - (l16 >> 2)) & 3)) * 8;
  unsigned xoff[2], woff[2];
#pragma unroll
  for (int i = 0; i < 2; ++i) {
    xoff[i] = (unsigned)((m0 + lr + 128 * i) * ldx + lc);
    int n = n0 + lr + 128 * i; if (n > N - 1) n = N - 1;
    woff[i] = (unsigned)(n * ldw + lc);
  }
  const int nk = K >> 5;
  u32x4 rx[3][2], rw[3][2];
#define G_LOAD(S, KT) { const bf16_t* xb_ = X + (KT) * 32; const bf16_t* wb_ = W + (KT) * 32; \
    rx[S][0] = *(const u32x4*)(xb_ + xoff[0]); rx[S][1] = *(const u32x4*)(xb_ + xoff[1]); \
    rw[S][0] = *(const u32x4*)(wb_ + woff[0]); rw[S][1] = *(const u32x4*)(wb_ + woff[1]); }
#define G_STORE(S, B) { bf16_t* d_ = sb + (B) * BUFE + lr * LDG + lcs; \
    *(u32x4*)(d_) = rx[S][0]; *(u32x4*)(d_ + 128 * LDG) = rx[S][1]; \
    *(u32x4*)(d_ + 256 * LDG) = rw[S][0]; *(u32x4*)(d_ + 384 * LDG) = rw[S][1]; }
#define G_COMPUTE(B) { const bf16_t* bx_ = sb + (B) * BUFE; const bf16_t* bw_ = bx_ + 256 * LDG; \
    bf16x8 wf[4], xf[8]; \
    _Pragma("unroll") for (int i = 0; i < 4; ++i) wf[i] = *(const bf16x8*)(bw_ + (wn * 64 + i * 16 + l16) * LDG + gs); \
    _Pragma("unroll") for (int i = 0; i < 8; ++i) xf[i] = *(const bf16x8*)(bx_ + (wm * 128 + i * 16 + l16) * LDG + gs); \
    _Pragma("unroll") for (int ni = 0; ni < 4; ++ni) \
      _Pragma("unroll") for (int mi = 0; mi < 8; ++mi) acc[ni][mi] = MFMA16(wf[ni], xf[mi], acc[ni][mi]); }
#define G_STEP(KK, RL, RS) if ((KK) < nk) { \
    if ((KK) + 1 < nk) G_STORE(RS, ((KK) + 1) & 1) \
    if ((KK) + 3 < nk) G_LOAD(RL, (KK) + 3) \
    G_COMPUTE((KK) & 1) \
    __syncthreads(); }
  G_LOAD(0, 0) G_LOAD(1, 1) G_LOAD(2, 2)
  __syncthreads();
  G_STORE(0, 0)
  __syncthreads();
  for (int k0 = 0; k0 < nk; k0 += 3) {
    G_STEP(k0, 0, 1)
    G_STEP(k0 + 1, 1, 2)
    G_STEP(k0 + 2, 2, 0)
  }
#undef G_LOAD
#undef G_STORE
#undef G_COMPUTE
#undef G_STEP
#pragma unroll
  for (int ni = 0; ni < 4; ++ni) {
    const int n = n0 + wn * 64 + ni * 16 + g * 4;
    if (n < N) {
#pragma unroll
      for (int mi = 0; mi < 8; ++mi) epi(m0 + wm * 128 + mi * 16 + l16, n, acc[ni][mi]);
    }
  }
}

template <int W>
DI void stage_rows64(bf16_t* dst, int ldd, int coff, const bf16_t* src, int lds) {
  for (int c = TIDX; c < 64 * (W / 8); c += 256) {
    const int r = c / (W / 8), cc = (c % (W / 8)) * 8;
    *(uint4*)(dst + r * ldd + coff + cc) = *(const uint4*)(src + (size_t)r * lds + cc);
  }
}
template <int W>
DI void stage_T64(bf16_t* dst, const bf16_t* src, int lds, const float* rscale) {
  for (int c = TIDX; c < 64 * (W / 8); c += 256) {
    const int r = c & 63, cc = (c >> 6) * 8;
    uint4 v = *(const uint4*)(src + (size_t)r * lds + cc);
    unsigned w[4] = {v.x, v.y, v.z, v.w};
    if (rscale) {
      const float s = rscale[r];
#pragma unroll
      for (int i = 0; i < 4; ++i) {
        dst[(cc + 2 * i) * LDT + r] = f2bf(lo2f(w[i]) * s);
        dst[(cc + 2 * i + 1) * LDT + r] = f2bf(hi2f(w[i]) * s);
      }
    } else {
#pragma unroll
      for (int i = 0; i < 4; ++i) {
        dst[(cc + 2 * i) * LDT + r] = (bf16_t)(w[i] & 0xffffu);
        dst[(cc + 2 * i + 1) * LDT + r] = (bf16_t)(w[i] >> 16);
      }
    }
  }
}

template <int DK, int DV, bool DUAL>
DI void attn_core(char* smem, const bf16_t* Qp, int ldq, const bf16_t* K1, int ldk1, const bf16_t* K2, int ldk2,
                  const bf16_t* V, int ldv, int T, float scale_log2, f32x4 (&o)[DUAL ? 2 : 1][DV / 16], float (&lsum)[DUAL ? 2 : 1], float (&mrun)[DUAL ? 2 : 1]) {
  constexpr int NS = DUAL ? 2 : 1;
  constexpr int DKT = DUAL ? 2 * DK : DK;
  constexpr int W1 = (DK == 96) ? 64 : DKT;
  constexpr int LDK = DKT + 8;
  constexpr int NK1 = 64 * (W1 / 8) / 256;
  constexpr int NV = 64 * (DV / 8) / 256;
  bf16_t* sK = (bf16_t*)smem;
  bf16_t* sVT = sK + 64 * DKT;
  const int tid = TIDX, lane = tid & 63, wave = tid >> 6, g = lane >> 4, l16 = lane & 15;
  const int gsw = (g ^ ((4 - (l16 >> 2)) & 3)) * 8;
  bf16x8 qf[DKT / 32];
  const bf16_t* qrow = Qp + (size_t)(wave * 16 + l16) * ldq;
#pragma unroll
  for (int ks = 0; ks < DKT / 32; ++ks) qf[ks] = *(const bf16x8*)(qrow + ks * 32 + g * 8);
#pragma unroll
  for (int n = 0; n < NS; ++n) {
#pragma unroll
    for (int i = 0; i < DV / 16; ++i) o[n][i] = f32x4{0.f, 0.f, 0.f, 0.f};
    mrun[n] = -INFINITY; lsum[n] = 0.f;
  }
  constexpr int PD = 1;
  u32x4 pk[PD][NK1], pk2[PD], pv[PD][NV];
  unsigned koff[NK1], voff[NV];
#pragma unroll
  for (int i = 0; i < NK1; ++i) { const int c = tid + 256 * i, r = c / (W1 / 8), cc = (c % (W1 / 8)) * 8; koff[i] = (unsigned)(r * ldk1 + cc); }
#pragma unroll
  for (int i = 0; i < NV; ++i) { const int c = tid + 256 * i, r = c & 63, cc = (c >> 6) * 8; voff[i] = (unsigned)(r * ldv + cc); }
  const unsigned k2off = (unsigned)((tid >> 2) * ldk2 + (tid & 3) * 8);
#pragma unroll
  for (int u = 0; u < PD; ++u) {
    if (u * 64 < T) {
      const bf16_t* kbase = K1 + (size_t)(u * 64) * ldk1;
      const bf16_t* vbase = V + (size_t)(u * 64) * ldv;
#pragma unroll
      for (int i = 0; i < NK1; ++i) pk[u][i] = *(const u32x4*)(kbase + koff[i]);
      if (DK == 96) pk2[u] = *(const u32x4*)(K2 + (size_t)(u * 64) * ldk2 + k2off);
#pragma unroll
      for (int i = 0; i < NV; ++i) pv[u][i] = *(const u32x4*)(vbase + voff[i]);
    }
  }
  for (int tb = 0; tb < T; tb += 64 * PD) {
#pragma unroll
  for (int u = 0; u < PD; ++u) {
    const int t0 = tb + 64 * u;
    if (t0 < T) {
    __syncthreads();
#pragma unroll
    for (int i = 0; i < NK1; ++i) { const int c = tid + 256 * i, r = c / (W1 / 8), ch = c % (W1 / 8); *(u32x4*)(sK + (ch >> 2) * 2048 + r * 32 + (((ch & 3) ^ ((4 - ((r >> 2) & 3)) & 3)) * 8)) = pk[u][i]; }
    if (DK == 96) { const int r = tid >> 2, ch = tid & 3; *(u32x4*)(sK + 2 * 2048 + r * 32 + ((ch ^ ((4 - ((r >> 2) & 3)) & 3)) * 8)) = pk2[u]; }
#pragma unroll
    for (int i = 0; i < NV; ++i) {
      const int c = tid + 256 * i, r = c & 63, cc = (c >> 6) * 8;
#pragma unroll
      for (int j = 0; j < 4; ++j) {
        sVT[(cc + 2 * j) * LDT + r] = (bf16_t)(pv[u][i][j] & 0xffffu);
        sVT[(cc + 2 * j + 1) * LDT + r] = (bf16_t)(pv[u][i][j] >> 16);
      }
    }
    __syncthreads();
    if (t0 + 64 * PD < T) {
      const int tn = t0 + 64 * PD;
      const bf16_t* kbase = K1 + (size_t)tn * ldk1;
      const bf16_t* vbase = V + (size_t)tn * ldv;
#pragma unroll
      for (int i = 0; i < NK1; ++i) pk[u][i] = *(const u32x4*)(kbase + koff[i]);
      if (DK == 96) pk2[u] = *(const u32x4*)(K2 + (size_t)tn * ldk2 + k2off);
#pragma unroll
      for (int i = 0; i < NV; ++i) pv[u][i] = *(const u32x4*)(vbase + voff[i]);
    }
    bf16x8 pf[NS][2];
#pragma unroll
    for (int n = 0; n < NS; ++n) {
      f32x4 s[4];
#pragma unroll
      for (int t = 0; t < 4; ++t) {
        s[t] = f32x4{0.f, 0.f, 0.f, 0.f};
#pragma unroll
        for (int ks = 0; ks < DK / 32; ++ks) {
          const bf16x8 kf = *(const bf16x8*)(sK + (n * (DK / 32) + ks) * 2048 + (t * 16 + l16) * 32 + gsw);
          s[t] = MFMA16(kf, qf[n * (DK / 32) + ks], s[t]);
        }
      }
      float mx = -INFINITY;
#pragma unroll
      for (int t = 0; t < 4; ++t)
#pragma unroll
        for (int j = 0; j < 4; ++j) { s[t][j] *= scale_log2; mx = fmaxf(mx, s[t][j]); }
      mx = fmaxf(mx, __shfl_xor(mx, 16));
      mx = fmaxf(mx, __shfl_xor(mx, 32));
      const float mnew = fmaxf(mrun[n], mx);
      const float alpha = __builtin_amdgcn_exp2f(mrun[n] - mnew);
      mrun[n] = mnew;
      float ps = 0.f;
#pragma unroll
      for (int t = 0; t < 4; ++t)
#pragma unroll
        for (int j = 0; j < 4; ++j) { s[t][j] = __builtin_amdgcn_exp2f(s[t][j] - mnew); ps += s[t][j]; }
      lsum[n] = lsum[n] * alpha + ps;
#pragma unroll
      for (int i = 0; i < DV / 16; ++i) o[n][i] *= alpha;
#pragma unroll
      for (int kb = 0; kb < 2; ++kb)
      {
        u32x4 w;
        w[0] = pack2(s[2 * kb][0], s[2 * kb][1]); w[1] = pack2(s[2 * kb][2], s[2 * kb][3]);
        w[2] = pack2(s[2 * kb + 1][0], s[2 * kb + 1][1]); w[3] = pack2(s[2 * kb + 1][2], s[2 * kb + 1][3]);
        pf[n][kb] = __builtin_bit_cast(bf16x8, w);
      }
    }
#pragma unroll
    for (int kb = 0; kb < 2; ++kb) {
#pragma unroll
      for (int i = 0; i < DV / 16; ++i) {
        const bf16_t* vp = sVT + (i * 16 + l16) * LDT + kb * 32 + g * 4;
        const bf16x4 lo = *(const bf16x4*)(vp);
        const bf16x4 hi = *(const bf16x4*)(vp + 16);
        const bf16x8 vf = __builtin_shufflevector(lo, hi, 0, 1, 2, 3, 4, 5, 6, 7);
#pragma unroll
        for (int n = 0; n < NS; ++n) o[n][i] = MFMA16(vf, pf[n][kb], o[n][i]);
        if (DUAL && (i & 3) == 3) asm volatile("" ::: "memory");
      }
    }
    }
  }
  }
}

DI void transpose_w(const float* __restrict__ src, int K, int N, bf16_t* __restrict__ dst, int tile, float* sT, int sc_lo, int sc_hi, float sc) {
  const int ntn = (N + 63) >> 6;
  const int kt = tile / ntn, nt = tile % ntn, k0 = kt * 64, n0 = nt * 64;
  __syncthreads();
#pragma unroll
  for (int q = 0; q < 4; ++q) {
    const int i = TIDX + 256 * q;
    const int r = i >> 4, c = (i & 15) * 4, n = n0 + c;
    float4 v = make_float4(0.f, 0.f, 0.f, 0.f);
    if (n < N) v = *(const float4*)(src + (size_t)(k0 + r) * N + n);
    if (n >= sc_lo && n < sc_hi) { v.x *= sc; v.y *= sc; v.z *= sc; v.w *= sc; }
    float* d = sT + r * 65 + c;
    d[0] = v.x; d[1] = v.y; d[2] = v.z; d[3] = v.w;
  }
  __syncthreads();
#pragma unroll
  for (int q = 0; q < 2; ++q) {
    const int i = TIDX + 256 * q;
    const int c = i >> 3, kc = (i & 7) * 8, n = n0 + c;
    if (n < N) {
      const float* sp = sT + kc * 65 + c;
      uint4 o;
      o.x = pack2(sp[0], sp[65]); o.y = pack2(sp[130], sp[195]); o.z = pack2(sp[260], sp[325]); o.w = pack2(sp[390], sp[455]);
      *(uint4*)(dst + (size_t)n * K + k0 + kc) = o;
    }
  }
}

DI void phase0(const Params& p, char* smem) {
  const int tid = TIDX;
  for (int it = VBLK; it < 384; it += NVBLK) {
    const int l = it / 192, cb = (it % 192) * 16;
    const float* W = l ? p.o_ada_w : p.e_ada_w;
    const float* bias = l ? p.o_ada_b : p.e_ada_b;
    float* sc = (float*)smem;
    float* red = sc + 3072;
    __syncthreads();
    for (int i = tid; i < 3072; i += 256) {
      const int j = i >> 10, k = i & 1023;
      const float v = (j == 0) ? p.c_ctx[k] : p.c[(j - 1) * 1024 + k];
      sc[i] = siluf(v);
    }
    __syncthreads();
    const int col = cb + (tid & 15), kg = tid >> 4;
    float a0 = 0.f, a1 = 0.f, a2 = 0.f;
    for (int kb = kg * 64; kb < kg * 64 + 64; kb += 16) {
      float w[16];
#pragma unroll
      for (int u = 0; u < 16; ++u) w[u] = W[(size_t)(kb + u) * 3072 + col];
#pragma unroll
      for (int u = 0; u < 16; ++u) { a0 += sc[kb + u] * w[u]; a1 += sc[1024 + kb + u] * w[u]; a2 += sc[2048 + kb + u] * w[u]; }
    }
    red[(kg * 3 + 0) * 16 + (tid & 15)] = a0;
    red[(kg * 3 + 1) * 16 + (tid & 15)] = a1;
    red[(kg * 3 + 2) * 16 + (tid & 15)] = a2;
    __syncthreads();
    if (tid < 48) {
      const int j = tid >> 4, c = tid & 15;
      float s = 0.f;
      for (int q = 0; q < 16; ++q) s += red[(q * 3 + j) * 16 + c];
      p.MOD[(l * 3 + j) * 3072 + cb + c] = s + bias[cb + c];
    }
  }
}

DI void phase0b(const Params& p, char* smem) {
  const int tid = TIDX;
  if (VBLK == 0 && tid < 64) {
    float a = p.o_lam[tid] * p.o_lam[64 + tid];
    float b = p.o_lam[128 + tid] * p.o_lam[192 + tid];
    a = wave_sum(a); b = wave_sum(b);
    if (tid == 0) p.LAMV[0] = expf(a) - expf(b) + LAM_INIT;
  }
  for (int idx = VBLK * 256 + tid; idx < 1024 * 48; idx += NVBLK * 256) {
    const int pos = idx / 48, e = idx % 48;
    const float rr = (float)(pos >> 6), cc = (float)(pos & 63);
    if (e < 16) {
      const int j = e & 7;
      const float inv = 1.0f / powf(10000.0f, (float)(2 * j) / 16.0f);
      const float ang = ((e < 8) ? rr : cc) * inv;
      p.ROPE32[pos * 16 + e] = make_float2(cosf(ang), sinf(ang));
    } else {
      const int i = e - 16, j = i & 15;
      const float inv = 1.0f / powf(10000.0f, (float)(2 * j) / 32.0f);
      const float ang = ((i < 16) ? rr : cc) * inv;
      p.ROPE64[pos * 32 + i] = make_float2(cosf(ang), sinf(ang));
    }
  }
  float* sT = (float*)smem;
  for (int it = VBLK; it < 2440; it += NVBLK) {
    if (it < 624) transpose_w(p.e_w_in, 1024, EIN, p.WinE, it, sT, 0, 0, 1.f);
    else if (it < 1792) transpose_w(p.o_w_in, 1024, OIN, p.WinO, it - 624, sT, 512, 1024, 0.08838834764831845f);
    else if (it < 1864) transpose_w(p.e_w_uq, 384, 768, p.Wuq, it - 1792, sT, 0, 0, 1.f);
    else if (it < 1928) transpose_w(p.e_w_ukv, 256, 1024, p.Wukv, it - 1864, sT, 0, 0, 1.f);
    else if (it < 2184) transpose_w(p.e_w_out, 1024, 1024, p.WoutE, it - 1928, sT, 0, 0, 1.f);
    else transpose_w(p.o_w_out, 1024, 1024, p.WoutO, it - 2184, sT, 0, 0, 1.f);
  }
}

DI void phase_norm(const Params& p, int layer) {
  const int tid = TIDX, lane = tid & 63, wave = tid >> 6;
  const float* g = layer ? p.o_norm_g : p.e_norm_g;
  for (int it = VBLK; it < NROW / 4; it += NVBLK) {
    const int row = it * 4 + wave;
    const float* x = layer ? (p.X1 + (size_t)row * 1024) : xrow(p, row);
    const float* md = p.MOD + (layer * 3 + cv_of_row(row)) * 3072;
    float4 v[4];
    float ss = 0.f;
#pragma unroll
    for (int i = 0; i < 4; ++i) {
      v[i] = *(const float4*)(x + i * 256 + lane * 4);
      ss += v[i].x * v[i].x + v[i].y * v[i].y + v[i].z * v[i].z + v[i].w * v[i].w;
    }
    ss = wave_sum(ss);
    const float r = rsqrtf(ss * (1.f / 1024.f) + EPSF);
#pragma unroll
    for (int i = 0; i < 4; ++i) {
      const int col = i * 256 + lane * 4;
      const float4 gg = *(const float4*)(g + col), sh = *(const float4*)(md + col), sc = *(const float4*)(md + 1024 + col);
      uint2 o;
      o.x = pack2(v[i].x * r * gg.x * (1.f + sc.x) + sh.x, v[i].y * r * gg.y * (1.f + sc.y) + sh.y);
      o.y = pack2(v[i].z * r * gg.z * (1.f + sc.z) + sh.z, v[i].w * r * gg.w * (1.f + sc.w) + sh.w);
      *(uint2*)(p.H + (size_t)row * 1024 + col) = o;
    }
  }
}

DI void store_bf4(bf16_t* dst, f32x4 v) {
  uint2 o; o.x = pack2(v[0], v[1]); o.y = pack2(v[2], v[3]);
  *(uint2*)dst = o;
}

DI void phase_gemm_in(const Params& p, int layer, char* smem) {
  const int N = layer ? OIN : EIN;
  const int ntn = (N + 255) / 256;
  const bf16_t* W = layer ? p.WinO : p.WinE;
  bf16_t* U = layer ? p.U1 : p.U0;
  for (int it = blockIdx.x; it < 24 * ntn; it += gridDim.x) {
    const int mt = it % 24, nt = it / 24;
    gemm256(p.H, 1024, W, 1024, N, 1024, mt * 256, nt * 256, smem,
            [=](int m, int n, f32x4 v) { store_bf4(U + (size_t)m * N + n, v); });
  }
}

DI void phase_gemm_out(const Params& p, int layer, char* smem) {
  const bf16_t* W = layer ? p.WoutO : p.WoutE;
  for (int it = VBLK; it < 48 * 8; it += NVBLK) {
    const int mt = it % 48, nt = it / 48;
    gemm_tile(p.O, 1024, W, 1024, 1024, 1024, mt * 128, nt * 128, smem,
              [=](int m, int n, f32x4 v) {
                const float4 gt = *(const float4*)(p.MOD + (layer * 3 + cv_of_row(m)) * 3072 + 2048 + n);
                const float* xs = layer ? (p.X1 + (size_t)m * 1024 + n) : (xrow(p, m) + n);
                const float4 xv = *(const float4*)xs;
                float4 r;
                r.x = xv.x + gt.x * v[0]; r.y = xv.y + gt.y * v[1]; r.z = xv.z + gt.z * v[2]; r.w = xv.w + gt.w * v[3];
                *(float4*)(p.X1 + (size_t)m * 1024 + n) = r;
              });
  }
}

DI void phase_gemm_mla(const Params& p, char* smem) {
  for (int it = VBLK; it < 288 + 416; it += NVBLK) {
    if (it < 288) {
      const int mt = it % 48, nt = it / 48;
      gemm_tile(p.CQN, 384, p.Wuq, 384, 768, 384, mt * 128, nt * 128, smem,
                [=](int m, int n, f32x4 v) {
                  const int d = n % 96;
                  if (m >= 4096 && d >= 64) {
                    const int pos = (m - 4096) & 1023;
                    const int pi = (d - 64) >> 1;
                    const float2 c0 = p.ROPE32[pos * 16 + pi], c1 = p.ROPE32[pos * 16 + pi + 1];
                    const float a0 = v[0] * c0.x - v[1] * c0.y, a1 = v[0] * c0.y + v[1] * c0.x;
                    const float a2 = v[2] * c1.x - v[3] * c1.y, a3 = v[2] * c1.y + v[3] * c1.x;
                    v = f32x4{a0, a1, a2, a3};
                  }
                  store_bf4(p.Q + (size_t)m * 768 + n, v);
                });
    } else {
      const int i2 = it - 288;
      const int mt = i2 % 52, nt = i2 / 52;
      gemm_tile(p.CKVN, 256, p.Wukv, 256, 1024, 256, mt * 128, nt * 128, smem,
                [=](int m, int n, f32x4 v) { store_bf4(p.KV + (size_t)m * 1024 + n, v); });
    }
  }
}

struct TRow { int row, pos, cb, ct; bool cache, lat; };
DI TRow decode_trow(int trow) {
  TRow t; t.row = -1; t.pos = 0; t.cb = 0; t.ct = 0; t.cache = false; t.lat = false;
  if (trow < 4096) { t.row = trow; }
  else {
    const int r = trow - 4096; const int b = r / 1280, tt = r % 1280;
    t.lat = true;
    if (tt < 256) { t.cache = true; t.cb = b; t.ct = tt; }
    else { t.pos = tt - 256; t.row = 4096 + b * 1024 + t.pos; }
  }
  return t;
}
DI void cvt_store4(bf16_t* dst, const float* src) {
  const float4 v = *(const float4*)src;
  uint2 o; o.x = pack2(v.x, v.y); o.y = pack2(v.z, v.w);
  *(uint2*)dst = o;
}

DI void phase3(const Params& p) {
  const int tid = TIDX, lane = tid & 63, wave = tid >> 6;
  for (int it = VBLK; it < NTROW / 4; it += NVBLK) {
    const int trow = it * 4 + wave;
    const TRow t = decode_trow(trow);
    if (t.cache) {
      const size_t ci = (size_t)t.cb * 256 + t.ct;
      cvt_store4(p.CKVN + (size_t)trow * 256 + lane * 4, p.cache_ckv + ci * 256 + lane * 4);
      if (lane < 8) cvt_store4(p.KR + (size_t)trow * 32 + lane * 4, p.cache_kr + ci * 32 + lane * 4);
      if (lane < 32) {
        cvt_store4(p.KB + (size_t)trow * 128 + lane * 4, p.cache_gk + ci * 128 + lane * 4);
        cvt_store4(p.VB + (size_t)trow * 128 + lane * 4, p.cache_gv + ci * 128 + lane * 4);
      }
      continue;
    }
    const int row = t.row;
    const bf16_t* u = p.U0 + (size_t)row * EIN;
    {
      float x[6]; float ss = 0.f;
#pragma unroll
      for (int i = 0; i < 3; ++i) {
        const unsigned w = *(const unsigned*)(u + i * 128 + lane * 2);
        x[2 * i] = lo2f(w); x[2 * i + 1] = hi2f(w);
        ss += x[2 * i] * x[2 * i] + x[2 * i + 1] * x[2 * i + 1];
      }
      ss = wave_sum(ss);
      const float r = rsqrtf(ss * (1.f / 384.f) + EPSF);
#pragma unroll
      for (int i = 0; i < 3; ++i) {
        const int col = i * 128 + lane * 2;
        *(unsigned*)(p.CQN + (size_t)row * 384 + col) = pack2(x[2 * i] * r * p.e_qn_g[col], x[2 * i + 1] * r * p.e_qn_g[col + 1]);
      }
    }
    {
      const uint2 w = *(const uint2*)(u + 384 + lane * 4);
      float x0 = lo2f(w.x), x1 = hi2f(w.x), x2 = lo2f(w.y), x3 = hi2f(w.y);
      float ss = wave_sum(x0 * x0 + x1 * x1 + x2 * x2 + x3 * x3);
      const float r = rsqrtf(ss * (1.f / 256.f) + EPSF);
      const float4 gg = *(const float4*)(p.e_kvn_g + lane * 4);
      x0 *= r * gg.x; x1 *= r * gg.y; x2 *= r * gg.z; x3 *= r * gg.w;
      uint2 o; o.x = pack2(x0, x1); o.y = pack2(x2, x3);
      *(uint2*)(p.CKVN + (size_t)trow * 256 + lane * 4) = o;
      if (!t.lat) *(float4*)(p.out + O_CKV + (size_t)row * 256 + lane * 4) = make_float4(x0, x1, x2, x3);
    }
    if (lane < 16) {
      const unsigned w = *(const unsigned*)(u + 640 + lane * 2);
      float x0 = lo2f(w), x1 = hi2f(w);
      if (t.lat) {
        const float2 cs = p.ROPE32[t.pos * 16 + lane];
        const float y0 = x0 * cs.x - x1 * cs.y, y1 = x0 * cs.y + x1 * cs.x;
        x0 = y0; x1 = y1;
      } else {
        *(float2*)(p.out + O_KR + (size_t)row * 32 + lane * 2) = make_float2(x0, x1);
      }
      *(unsigned*)(p.KR + (size_t)trow * 32 + lane * 2) = pack2(x0, x1);
    }
#pragma unroll
    for (int which = 0; which < 2; ++which) {
      const int lsrc = which ? (lane & 15) : lane;
      const uint4 w = *(const uint4*)(u + (which ? 1696 : 1184) + lsrc * 8);
      float x[8] = {lo2f(w.x), hi2f(w.x), lo2f(w.y), hi2f(w.y), lo2f(w.z), hi2f(w.z), lo2f(w.w), hi2f(w.w)};
      float ss = 0.f;
#pragma unroll
      for (int j = 0; j < 8; ++j) ss += x[j] * x[j];
      ss += __shfl_xor(ss, 1); ss += __shfl_xor(ss, 2); ss += __shfl_xor(ss, 4);
      const float r = rsqrtf(ss * (1.f / 64.f) + EPSF);
      const float* gp = (which ? p.e_gk_g : p.e_gq_g) + (lane & 7) * 8;
#pragma unroll
      for (int j = 0; j < 8; ++j) x[j] *= r * gp[j];
      if (t.lat) {
#pragma unroll
        for (int jj = 0; jj < 4; ++jj) {
          const float2 cs = p.ROPE64[t.pos * 32 + (lane & 7) * 4 + jj];
          const float y0 = x[2 * jj] * cs.x - x[2 * jj + 1] * cs.y, y1 = x[2 * jj] * cs.y + x[2 * jj + 1] * cs.x;
          x[2 * jj] = y0; x[2 * jj + 1] = y1;
        }
      }
      uint4 o; o.x = pack2(x[0], x[1]); o.y = pack2(x[2], x[3]); o.z = pack2(x[4], x[5]); o.w = pack2(x[6], x[7]);
      if (which == 0) {
        *(uint4*)(p.QB + (size_t)row * 512 + lane * 8) = o;
      } else if (lane < 16) {
        *(uint4*)(p.KB + (size_t)trow * 128 + lane * 8) = o;
        if (!t.lat) {
          float* op = p.out + O_GK + (size_t)row * 128 + lane * 8;
          *(float4*)op = make_float4(x[0], x[1], x[2], x[3]);
          *(float4*)(op + 4) = make_float4(x[4], x[5], x[6], x[7]);
        }
      }
    }
    if (lane < 16) {
      const uint4 w = *(const uint4*)(u + 1824 + lane * 8);
      *(uint4*)(p.VB + (size_t)trow * 128 + lane * 8) = w;
      if (!t.lat) {
        float* op = p.out + O_GV + (size_t)row * 128 + lane * 8;
        *(float4*)op = make_float4(lo2f(w.x), hi2f(w.x), lo2f(w.y), hi2f(w.y));
        *(float4*)(op + 4) = make_float4(lo2f(w.z), hi2f(w.z), lo2f(w.w), hi2f(w.w));
      }
    }
  }
}

DI void phase_attn0(const Params& p, char* smem) {
  const int lane = TIDX & 63, wave = TIDX >> 6, g = lane >> 4, l16 = lane & 15;
  for (int it = vblk_xcd(); it < 1536; it += NVBLK) {
    int kind, b, h, qb, row0, trow0, T;
    if (it < 512) { const int i = it & 255; kind = it >> 8; b = i >> 7; h = (i >> 4) & 7; qb = i & 15; row0 = 4096 + b * 1024 + qb * 64; trow0 = 4096 + b * 1280; T = 1280; }
    else { const int i2 = it - 512; kind = i2 >> 9; const int i = i2 & 511; b = i >> 5; h = (i >> 2) & 7; qb = i & 3; row0 = b * 256 + qb * 64; trow0 = b * 256; T = 256; }
    f32x4 oo[1][4];
    float lss[1], mss[1];
    int gcol, ocol;
    if (kind == 0) {
      attn_core<96, 64, false>(smem, p.Q + (size_t)row0 * 768 + h * 96, 768, p.KV + (size_t)trow0 * 1024 + h * 128, 1024,
                        p.KR + (size_t)trow0 * 32, 32, p.KV + (size_t)trow0 * 1024 + h * 128 + 64, 1024, T,
                        0.10206207261596575f * 1.4426950408889634f, oo, lss, mss);
      gcol = 672 + h * 64; ocol = h * 64;
    } else {
      const int kvh = h >> 2;
      attn_core<64, 64, false>(smem, p.QB + (size_t)row0 * 512 + h * 64, 512, p.KB + (size_t)trow0 * 128 + kvh * 64, 128,
                        nullptr, 0, p.VB + (size_t)trow0 * 128 + kvh * 64, 128, T, 0.125f * 1.4426950408889634f, oo, lss, mss);
      gcol = 1952 + h * 64; ocol = 512 + h * 64;
    }
    float ls = lss[0];
    ls += __shfl_xor(ls, 16); ls += __shfl_xor(ls, 32);
    const float inv = 1.f / ls;
    f32x4 (&o)[4] = oo[0];
    const int row = row0 + wave * 16 + l16;
#pragma unroll
    for (int i = 0; i < 4; ++i) {
      const int dv = i * 16 + g * 4;
      const uint2 gw = *(const uint2*)(p.U0 + (size_t)row * EIN + gcol + dv);
      f32x4 r;
      r[0] = o[i][0] * inv * siluf(lo2f(gw.x)); r[1] = o[i][1] * inv * siluf(hi2f(gw.x));
      r[2] = o[i][2] * inv * siluf(lo2f(gw.y)); r[3] = o[i][3] * inv * siluf(hi2f(gw.y));
      store_bf4(p.O + (size_t)row * 1024 + ocol + dv, r);
    }
  }
}

DI void mlstm_gates(const Params& p, int rowbase, int nc, int h, int dir, int j, int lane, float& ig, float& lf) {
  const int oc = dir ? nc - 1 - j : j;
  const int s = dir ? 63 - lane : lane;
  const int row = rowbase + oc * 64 + s;
  const bf16_t* up = p.U1 + (size_t)row * OIN + 2048;
  ig = bf2f(up[dir * 8 + h]) + p.o_gate_b[dir * 8 + h];
  lf = logsig(bf2f(up[dir * 8 + 4 + h]) + p.o_gate_b[dir * 8 + 4 + h]);
}
DI void mitem_decode(int it, int& sq, int& h, int& dir, int& j, int& nc, int& rowbase) {
  if (it < 512) { j = it & 3; dir = (it >> 2) & 1; h = (it >> 3) & 3; sq = it >> 5; nc = 4; rowbase = sq * 256; }
  else { const int i = it - 512; j = i & 15; dir = (i >> 4) & 1; h = (i >> 5) & 3; sq = 16 + (i >> 7); nc = 16; rowbase = 4096 + (sq - 16) * 1024; }
}
DI int mitem_id(int sq, int h, int dir, int j) {
  return sq < 16 ? (((sq * 4 + h) * 2 + dir) * 4 + j) : (512 + ((((sq - 16) * 4 + h) * 2 + dir) * 16 + j));
}

DI void phase9(const Params& p, char* smem) {
  const int tid = TIDX, lane = tid & 63, wave = tid >> 6, g = lane >> 4, l16 = lane & 15;
  for (int it = VBLK; it < NTROW / 4; it += NVBLK) {
    const int trow = it * 4 + wave;
    const TRow t = decode_trow(trow);
    if (t.cache) {
      const size_t ci = (size_t)t.cb * 256 + t.ct;
      cvt_store4(p.KD + (size_t)trow * 512 + lane * 8, p.cache_dk + ci * 512 + lane * 8);
      cvt_store4(p.KD + (size_t)trow * 512 + lane * 8 + 4, p.cache_dk + ci * 512 + lane * 8 + 4);
      cvt_store4(p.VD + (size_t)trow * 512 + lane * 8, p.cache_dv + ci * 512 + lane * 8);
      cvt_store4(p.VD + (size_t)trow * 512 + lane * 8 + 4, p.cache_dv + ci * 512 + lane * 8 + 4);
      continue;
    }
    const int row = t.row;
    const bf16_t* u = p.U1 + (size_t)row * OIN;
#pragma unroll
    for (int which = 0; which < 2; ++which) {
      const uint4 w = *(const uint4*)(u + (which ? 3088 : 2576) + lane * 8);
      float x[8] = {lo2f(w.x), hi2f(w.x), lo2f(w.y), hi2f(w.y), lo2f(w.z), hi2f(w.z), lo2f(w.w), hi2f(w.w)};
      if (t.lat) {
#pragma unroll
        for (int jj = 0; jj < 4; ++jj) {
          const float2 cs = p.ROPE64[t.pos * 32 + (lane & 7) * 4 + jj];
          const float y0 = x[2 * jj] * cs.x - x[2 * jj + 1] * cs.y, y1 = x[2 * jj] * cs.y + x[2 * jj + 1] * cs.x;
          x[2 * jj] = y0; x[2 * jj + 1] = y1;
        }
      }
      uint4 o; o.x = pack2(x[0], x[1]); o.y = pack2(x[2], x[3]); o.z = pack2(x[4], x[5]); o.w = pack2(x[6], x[7]);
      if (which == 0) *(uint4*)(p.QD + (size_t)row * 512 + lane * 8) = o;
      else {
        *(uint4*)(p.KD + (size_t)trow * 512 + lane * 8) = o;
        if (!t.lat) {
          float* op = p.out + O_DK + (size_t)row * 512 + lane * 8;
          *(float4*)op = make_float4(x[0], x[1], x[2], x[3]);
          *(float4*)(op + 4) = make_float4(x[4], x[5], x[6], x[7]);
        }
      }
    }
    {
      const uint4 w = *(const uint4*)(u + 3600 + lane * 8);
      *(uint4*)(p.VD + (size_t)trow * 512 + lane * 8) = w;
      if (!t.lat) {
        float* op = p.out + O_DV + (size_t)row * 512 + lane * 8;
        *(float4*)op = make_float4(lo2f(w.x), hi2f(w.x), lo2f(w.y), hi2f(w.y));
        *(float4*)(op + 4) = make_float4(lo2f(w.z), hi2f(w.z), lo2f(w.w), hi2f(w.w));
      }
    }
  }
  bf16_t* sKT = (bf16_t*)smem;
  bf16_t* sVT = sKT + 128 * LDT;
  float* swk = (float*)(sVT + 128 * LDT);
  for (int it = VBLK; it < 768; it += NVBLK) {
    int sq, h, dir, j, nc, rowbase;
    mitem_decode(it, sq, h, dir, j, nc, rowbase);
    float ig, lf;
    mlstm_gates(p, rowbase, nc, h, dir, j, lane, ig, lf);
    const float b = scan_add(lf, lane);
    const float bL = __shfl(b, 63);
    const float mx = wave_max(bL - b + ig);
    const float wk = expf(bL - b + ig - mx);
    __syncthreads();
    if (wave == 0) {
      swk[dir ? 63 - lane : lane] = wk;
      if (lane == 0) { p.SC[it * 4 + 0] = bL; p.SC[it * 4 + 1] = mx; }
    }
    __syncthreads();
    const int oc = dir ? nc - 1 - j : j;
    const int row0 = rowbase + oc * 64;
    stage_T64<128>(sKT, p.U1 + (size_t)row0 * OIN + 512 + h * 128, OIN, nullptr);
    stage_T64<128>(sVT, p.U1 + (size_t)row0 * OIN + 1024 + h * 128, OIN, swk);
    __syncthreads();
    f32x4 acc[2][8];
#pragma unroll
    for (int a = 0; a < 2; ++a)
#pragma unroll
      for (int c = 0; c < 8; ++c) acc[a][c] = f32x4{0.f, 0.f, 0.f, 0.f};
#pragma unroll
    for (int ks = 0; ks < 2; ++ks) {
      bf16x8 vf[2];
#pragma unroll
      for (int a = 0; a < 2; ++a) vf[a] = *(const bf16x8*)(sVT + ((wave * 2 + a) * 16 + l16) * LDT + ks * 32 + g * 8);
#pragma unroll
      for (int kt = 0; kt < 8; ++kt) {
        const bf16x8 kf = *(const bf16x8*)(sKT + (kt * 16 + l16) * LDT + ks * 32 + g * 8);
#pragma unroll
        for (int a = 0; a < 2; ++a) acc[a][kt] = MFMA16(kf, vf[a], acc[a][kt]);
      }
    }
    float* uc = p.UC + (size_t)it * 16384;
#pragma unroll
    for (int a = 0; a < 2; ++a)
#pragma unroll
      for (int kt = 0; kt < 8; ++kt) {
        const int v = (wave * 2 + a) * 16 + l16, k = kt * 16 + g * 4;
        *(float4*)(uc + v * 128 + k) = make_float4(acc[a][kt][0], acc[a][kt][1], acc[a][kt][2], acc[a][kt][3]);
      }
    if (tid < 128) {
      float s = 0.f;
      for (int ss = 0; ss < 64; ++ss) s += bf2f(sKT[tid * LDT + ss]) * swk[ss];
      p.NU[it * 128 + tid] = s;
    }
  }
}

DI void diff_finish(const Params& p, f32x4 (&o1)[8], f32x4 (&o2)[8], float l1, float l2, int row0, int hd) {
  const int lane = TIDX & 63, wave = TIDX >> 6, g = lane >> 4, l16 = lane & 15;
  l1 += __shfl_xor(l1, 16); l1 += __shfl_xor(l1, 32);
  l2 += __shfl_xor(l2, 16); l2 += __shfl_xor(l2, 32);
  const float i1 = 1.f / l1, i2 = p.LAMV[0] / l2;
  float ss = 0.f;
#pragma unroll
  for (int i = 0; i < 8; ++i)
#pragma unroll
    for (int j = 0; j < 4; ++j) { o1[i][j] = o1[i][j] * i1 - o2[i][j] * i2; ss += o1[i][j] * o1[i][j]; }
  ss += __shfl_xor(ss, 16); ss += __shfl_xor(ss, 32);
  const float r = rsqrtf(ss * (1.f / 128.f) + EPSF) * (1.f - LAM_INIT);
  const int row = row0 + wave * 16 + l16;
#pragma unroll
  for (int i = 0; i < 8; ++i) {
    const int dv = i * 16 + g * 4;
    const uint2 gw = *(const uint2*)(p.U1 + (size_t)row * OIN + 4112 + hd * 128 + dv);
    const float4 gn = *(const float4*)(p.o_dnorm_g + dv);
    f32x4 rr;
    rr[0] = o1[i][0] * r * gn.x * siluf(lo2f(gw.x)); rr[1] = o1[i][1] * r * gn.y * siluf(hi2f(gw.x));
    rr[2] = o1[i][2] * r * gn.z * siluf(lo2f(gw.y)); rr[3] = o1[i][3] * r * gn.w * siluf(hi2f(gw.y));
    store_bf4(p.O + (size_t)row * 1024 + 512 + hd * 128 + dv, rr);
  }
}

DI void phase10(const Params& p, char* smem) {
  const int tid = TIDX, lane = tid & 63, wave = tid >> 6, g = lane >> 4, l16 = lane & 15;
  for (int it = vblk_xcd(); it < 512; it += NVBLK) {
    int b, hd, qb, row0, trow0, T;
    const bool lat = it < 256;
    const int li = it >> 1, split = it & 1;
    if (lat) { b = li >> 6; hd = (li >> 4) & 3; qb = li & 15; row0 = 4096 + b * 1024 + qb * 64; trow0 = 4096 + b * 1280 + split * 640; T = 640; }
    else { const int i = it - 256; b = i >> 4; hd = (i >> 2) & 3; qb = i & 3; row0 = b * 256 + qb * 64; trow0 = b * 256; T = 256; }
    f32x4 od[2][8];
    float ld2[2], md2[2];
    const float sc = 0.125f * 1.4426950408889634f;
    attn_core<64, 128, true>(smem, p.QD + (size_t)row0 * 512 + hd * 128, 512, p.KD + (size_t)trow0 * 512 + hd * 128, 512, nullptr, 0,
                             p.VD + (size_t)trow0 * 512 + hd * 128, 512, T, sc, od, ld2, md2);
    if (lat) {
#pragma unroll
      for (int n = 0; n < 2; ++n) {
        const size_t base = (size_t)((li * 2 + split) * 2 + n) * 4 + wave;
#pragma unroll
        for (int i = 0; i < 8; ++i) *(f32x4*)(p.OP + ((base * 8 + i) * 64 + lane) * 4) = od[n][i];
        *(float2*)(p.ML + (base * 64 + lane) * 2) = make_float2(md2[n], ld2[n]);
      }
    } else {
      diff_finish(p, od[0], od[1], ld2[0], ld2[1], row0, hd);
    }
  }
  const int vb = (vblk_xcd() + (NVBLK >> 1)) % NVBLK;
  for (int it = vb; it < 144 * 16; it += NVBLK) {
    const int chain = it < 256 ? 128 + (it >> 4) : ((it - 256) >> 4), eb = it & 15;
    const int sq = chain >> 3, h = (chain >> 1) & 3, dir = chain & 1;
    const int nc = sq < 16 ? 4 : 16;
    const int ib = mitem_id(sq, h, dir, 0);
    const int e = eb * 1024 + tid * 4;
    float4 C = make_float4(0.f, 0.f, 0.f, 0.f);
    if (sq >= 16) C = *(const float4*)(p.st_C + (size_t)(((sq - 16) * 2 + dir) * 4 + h) * 16384 + e);
    float4 uu[16];
    float dcs[16], scl[16], bLs[16], mxs[16];
#pragma unroll
    for (int j = 0; j < 16; ++j) {
      if (j < nc) { bLs[j] = p.SC[(ib + j) * 4 + 0]; mxs[j] = p.SC[(ib + j) * 4 + 1]; uu[j] = *(const float4*)(p.UC + (size_t)(ib + j) * 16384 + e); }
    }
    float mrun = 0.f;
    if (sq >= 16) mrun = p.st_m[((sq - 16) * 2 + dir) * 4 + h];
#pragma unroll
    for (int j = 0; j < 16; ++j) {
      if (j < nc) {
        const float mnext = fmaxf(bLs[j] + mrun, mxs[j]);
        dcs[j] = expf(bLs[j] + mrun - mnext);
        scl[j] = expf(mxs[j] - mnext);
        if (eb == 0 && tid == 0) p.SCM[ib + j] = mrun;
        mrun = mnext;
      }
    }
#pragma unroll
    for (int j = 0; j < 16; ++j) {
      if (j < nc) {
        uint2 o; o.x = pack2(C.x, C.y); o.y = pack2(C.z, C.w);
        *(uint2*)(p.CST + (size_t)(ib + j) * 16384 + e) = o;
        const float dc = dcs[j], sc = scl[j];
        C.x = dc * C.x + sc * uu[j].x; C.y = dc * C.y + sc * uu[j].y; C.z = dc * C.z + sc * uu[j].z; C.w = dc * C.w + sc * uu[j].w;
      }
    }
    if (sq < 16) *(float4*)(p.out + O_C + (size_t)((sq * 2 + dir) * 4 + h) * 16384 + e) = C;
    if (eb == 0 && tid < 128) {
      float n = 0.f;
      if (sq >= 16) n = p.st_n[(((sq - 16) * 2 + dir) * 4 + h) * 128 + tid];
#pragma unroll
      for (int j = 0; j < 16; ++j) {
        if (j < nc) {
          p.NST[(ib + j) * 128 + tid] = n;
          n = dcs[j] * n + scl[j] * p.NU[(ib + j) * 128 + tid];
        }
      }
      if (sq < 16) {
        p.out[O_N + ((sq * 2 + dir) * 4 + h) * 128 + tid] = n;
        if (tid == 0) p.out[O_M + (sq * 2 + dir) * 4 + h] = mrun;
      }
    }
  }
}

DI void phase11(const Params& p, char* smem) {
  const int tid = TIDX, lane = tid & 63, wave = tid >> 6, g = lane >> 4, l16 = lane & 15;
  bf16_t* sK = (bf16_t*)smem;
  bf16_t* sVT = sK + 64 * 136;
  float* sB = (float*)(sVT + 128 * LDT);
  float* sA = sB + 128;
  float* sMT = sA + 128;
  for (int it = VBLK; it < 512; it += NVBLK) {
    if (it >= 384) {
    const int li = it - 384;
    const int b = li >> 6, hd = (li >> 4) & 3, qb = li & 15, row0 = 4096 + b * 1024 + qb * 64;
    f32x4 oc[2][8];
    float lc[2];
#pragma unroll
    for (int n = 0; n < 2; ++n) {
      const size_t b0 = (size_t)((li * 2 + 0) * 2 + n) * 4 + wave, b1 = (size_t)((li * 2 + 1) * 2 + n) * 4 + wave;
      const float2 ml0 = *(const float2*)(p.ML + (b0 * 64 + lane) * 2), ml1 = *(const float2*)(p.ML + (b1 * 64 + lane) * 2);
      const float m = fmaxf(ml0.x, ml1.x);
      const float f0 = __builtin_amdgcn_exp2f(ml0.x - m), f1 = __builtin_amdgcn_exp2f(ml1.x - m);
      lc[n] = ml0.y * f0 + ml1.y * f1;
#pragma unroll
      for (int i = 0; i < 8; ++i) {
        const f32x4 a0 = *(const f32x4*)(p.OP + ((b0 * 8 + i) * 64 + lane) * 4), a1 = *(const f32x4*)(p.OP + ((b1 * 8 + i) * 64 + lane) * 4);
        oc[n][i] = a0 * f0 + a1 * f1;
      }
    }
    diff_finish(p, oc[0], oc[1], lc[0], lc[1], row0, hd);
    continue;
    }
    int sq, h, c, nc, rowbase;
    if (it < 128) { sq = 16 + (it >> 6); h = (it >> 4) & 3; c = it & 15; nc = 16; rowbase = 4096 + (sq - 16) * 1024; }
    else { const int i = it - 128; sq = i >> 4; h = (i >> 2) & 3; c = i & 3; nc = 4; rowbase = sq * 256; }
    const int row0 = rowbase + c * 64;
    float mst[2];
    int item[2];
    __syncthreads();
#pragma unroll
    for (int dir = 0; dir < 2; ++dir) {
      const int j = dir ? nc - 1 - c : c;
      item[dir] = mitem_id(sq, h, dir, j);
      mst[dir] = p.SCM[item[dir]];
      if (wave == 0) {
        float ig, lf;
        mlstm_gates(p, rowbase, nc, h, dir, j, lane, ig, lf);
        const float b = scan_add(lf, lane);
        const float a = ig - b;
        const float pm = scan_max(a, lane);
        const float mt = b + fmaxf(mst[dir], pm);
        const int so = dir ? 63 - lane : lane;
        sB[dir * 64 + so] = b; sA[dir * 64 + so] = a; sMT[dir * 64 + so] = mt;
      }
    }
    for (int c = tid; c < 64 * 16; c += 256) {
      const int r = c >> 4, ch = c & 15;
      *(uint4*)(sK + (ch >> 2) * 2048 + r * 32 + (((ch & 3) ^ ((4 - ((r >> 2) & 3)) & 3)) * 8)) = *(const uint4*)(p.U1 + (size_t)(row0 + r) * OIN + 512 + h * 128 + ch * 8);
    }
    stage_T64<128>(sVT, p.U1 + (size_t)row0 * OIN + 1024 + h * 128, OIN, nullptr);
    bf16x8 qf[4];
    const int tq = wave * 16 + l16;
    const int row = row0 + tq;
#pragma unroll
    for (int ks = 0; ks < 4; ++ks) qf[ks] = *(const bf16x8*)(p.U1 + (size_t)row * OIN + h * 128 + ks * 32 + g * 8);
    __syncthreads();
    f32x4 hsum[8];
#pragma unroll
    for (int i = 0; i < 8; ++i) hsum[i] = f32x4{0.f, 0.f, 0.f, 0.f};
#pragma unroll 1
    for (int dir = 0; dir < 2; ++dir) {
      const float bt = sB[dir * 64 + tq], mtt = sMT[dir * 64 + tq];
      const float mst_d = dir ? mst[1] : mst[0];
      const int item_d = dir ? item[1] : item[0];
      const float w_inter = expf(bt + mst_d - mtt);
      const float et = bt - mtt;
      f32x4 s[4];
      float dsum = 0.f;
#pragma unroll
      for (int t = 0; t < 4; ++t) {
        s[t] = f32x4{0.f, 0.f, 0.f, 0.f};
#pragma unroll
        for (int ks = 0; ks < 4; ++ks) {
          const bf16x8 kf = *(const bf16x8*)(sK + ks * 2048 + (t * 16 + l16) * 32 + ((g ^ ((4 - (l16 >> 2)) & 3)) * 8));
          s[t] = MFMA16(kf, qf[ks], s[t]);
        }
#pragma unroll
        for (int j = 0; j < 4; ++j) {
          const int sk = t * 16 + g * 4 + j;
          const bool ok = dir ? (sk >= tq) : (sk <= tq);
          const float w = ok ? expf(et + sA[dir * 64 + sk]) : 0.f;
          s[t][j] *= w;
          dsum += s[t][j];
        }
      }
      dsum += __shfl_xor(dsum, 16); dsum += __shfl_xor(dsum, 32);
      f32x4 acc[8];
      const bf16_t* cst = p.CST + (size_t)item_d * 16384;
#pragma unroll
      for (int vt = 0; vt < 8; ++vt) {
        acc[vt] = f32x4{0.f, 0.f, 0.f, 0.f};
#pragma unroll
        for (int ks = 0; ks < 4; ++ks) {
          const bf16x8 cf = *(const bf16x8*)(cst + (vt * 16 + l16) * 128 + ks * 32 + g * 8);
          acc[vt] = MFMA16(cf, qf[ks], acc[vt]);
        }
        acc[vt] *= w_inter;
        if ((vt & 3) == 3) asm volatile("" ::: "memory");
      }
#pragma unroll
      for (int kb = 0; kb < 2; ++kb) {
        bf16x8 pf;
#pragma unroll
        for (int j = 0; j < 4; ++j) { pf[j] = (short)f2bf(s[2 * kb][j]); pf[4 + j] = (short)f2bf(s[2 * kb + 1][j]); }
#pragma unroll
        for (int vt = 0; vt < 8; ++vt) {
          const bf16_t* vp = sVT + (vt * 16 + l16) * LDT + kb * 32 + g * 4;
          const bf16x4 lo = *(const bf16x4*)(vp);
          const bf16x4 hi = *(const bf16x4*)(vp + 16);
          const bf16x8 vf = __builtin_shufflevector(lo, hi, 0, 1, 2, 3, 4, 5, 6, 7);
          acc[vt] = MFMA16(vf, pf, acc[vt]);
        }
      }
      float nq = 0.f;
      const float* nst = p.NST + (size_t)item_d * 128;
#pragma unroll
      for (int ks = 0; ks < 4; ++ks) {
        const float4 n0 = *(const float4*)(nst + ks * 32 + g * 8), n1 = *(const float4*)(nst + ks * 32 + g * 8 + 4);
        nq += n0.x * bf2f((bf16_t)qf[ks][0]) + n0.y * bf2f((bf16_t)qf[ks][1]) + n0.z * bf2f((bf16_t)qf[ks][2]) + n0.w * bf2f((bf16_t)qf[ks][3]);
        nq += n1.x * bf2f((bf16_t)qf[ks][4]) + n1.y * bf2f((bf16_t)qf[ks][5]) + n1.z * bf2f((bf16_t)qf[ks][6]) + n1.w * bf2f((bf16_t)qf[ks][7]);
      }
      nq += __shfl_xor(nq, 16); nq += __shfl_xor(nq, 32);
      const float den = w_inter * nq + dsum;
      const float dinv = 1.f / fmaxf(fabsf(den), expf(-mtt));
#pragma unroll
      for (int vt = 0; vt < 8; ++vt) hsum[vt] += acc[vt] * dinv;
    }
    const bf16_t* u = p.U1 + (size_t)row * OIN;
    float ss = 0.f;
#pragma unroll
    for (int vt = 0; vt < 8; ++vt) {
      const uint2 ow = *(const uint2*)(u + 1536 + h * 128 + vt * 16 + g * 4);
      hsum[vt][0] *= sigmf(lo2f(ow.x)); hsum[vt][1] *= sigmf(hi2f(ow.x));
      hsum[vt][2] *= sigmf(lo2f(ow.y)); hsum[vt][3] *= sigmf(hi2f(ow.y));
#pragma unroll
      for (int j = 0; j < 4; ++j) ss += hsum[vt][j] * hsum[vt][j];
    }
    ss += __shfl_xor(ss, 16); ss += __shfl_xor(ss, 32);
    const float r = rsqrtf(ss * (1.f / 128.f) + EPSF);
#pragma unroll
    for (int vt = 0; vt < 8; ++vt) {
      const int v = h * 128 + vt * 16 + g * 4;
      const uint2 zw = *(const uint2*)(u + 2064 + v);
      const float4 gn = *(const float4*)(p.o_mnorm_g + v);
      f32x4 rr;
      rr[0] = hsum[vt][0] * r * gn.x * siluf(lo2f(zw.x)); rr[1] = hsum[vt][1] * r * gn.y * siluf(hi2f(zw.x));
      rr[2] = hsum[vt][2] * r * gn.z * siluf(lo2f(zw.y)); rr[3] = hsum[vt][3] * r * gn.w * siluf(hi2f(zw.y));
      store_bf4(p.O + (size_t)row * 1024 + v, rr);
    }
  }
}

DI void phase_final(const Params& p) {
  const int tid = TIDX, lane = tid & 63, wave = tid >> 6;
  for (int it = VBLK; it < NROW / 4; it += NVBLK) {
    const int row = it * 4 + wave;
    const float* x = p.X1 + (size_t)row * 1024;
    float4 v[4];
    float ss = 0.f;
#pragma unroll
    for (int i = 0; i < 4; ++i) {
      v[i] = *(const float4*)(x + i * 256 + lane * 4);
      ss += v[i].x * v[i].x + v[i].y * v[i].y + v[i].z * v[i].z + v[i].w * v[i].w;
    }
    ss = wave_sum(ss);
    const float r = rsqrtf(ss * (1.f / 1024.f) + EPSF);
#pragma unroll
    for (int i = 0; i < 4; ++i) {
      const int col = i * 256 + lane * 4;
      const float4 gg = *(const float4*)(p.final_g + col);
      *(float4*)(p.out + O_Y + (size_t)row * 1024 + col) = make_float4(v[i].x * r * gg.x, v[i].y * r * gg.y, v[i].z * r * gg.z, v[i].w * r * gg.w);
    }
  }
}


#define XB_TMO      128
#define XB_XCNT(j)  (256  + 64 * (j))
#define XB_XSUB(j)  (1280 + 64 * (j))
#define XB_XGEN(j)  (2304 + 64 * (j))
#define XB_TOP      3328
#define XB_TOPGEN   3392
#define XCD_BAR_WORDS 3456
#define XB_SPIN_CAP (1u << 18)
#define LAS __attribute__((address_space(3)))
DI unsigned xb_ld(unsigned* p) { return __hip_atomic_load(p, __ATOMIC_RELAXED, __HIP_MEMORY_SCOPE_AGENT); }
DI unsigned xb_add(unsigned* p, unsigned v) { return __hip_atomic_fetch_add(p, v, __ATOMIC_RELAXED, __HIP_MEMORY_SCOPE_AGENT); }
DI unsigned xb_xcc_id() { return (unsigned)__builtin_amdgcn_s_getreg((3 << 11) | 20) & 0xFu; }
#define XB_SPIN(cond, bar) do { unsigned _sp = 0; while (cond) { __builtin_amdgcn_s_sleep(1); \
    if ((++_sp & 255u) == 0u) { if (xb_ld(&(bar)[XB_TMO])) break; if (_sp > XB_SPIN_CAP) { atomicAdd(&(bar)[XB_TMO], 1u); break; } } } } while (0)
struct XcdBarrier { unsigned* bar; unsigned x; volatile LAS unsigned* st; };
DI XcdBarrier xcd_barrier_post(unsigned* bar, volatile LAS unsigned* st) {
  XcdBarrier b; b.bar = bar; b.x = xb_xcc_id(); b.st = st;
  if (threadIdx.x == 0) (void)xb_add(&bar[XB_XCNT(b.x)], 1u);
  return b;
}
DI void xcd_barrier_complete(unsigned* bar, unsigned x, unsigned& nloc, unsigned& nx) {
  const unsigned G = gridDim.x * gridDim.y * gridDim.z;
  unsigned sum, cnt, mine, sp = 0u;
  for (;;) {
    sum = 0u; cnt = 0u; mine = 0u;
#pragma unroll
    for (unsigned j = 0; j < 16; ++j) { const unsigned c = xb_ld(&bar[XB_XCNT(j)]); sum += c; cnt += (c > 0u) ? 1u : 0u; mine = (j == x) ? c : mine; }
    if (sum == G) break;
    __builtin_amdgcn_s_sleep(1);
    if ((++sp & 255u) == 0u) { if (xb_ld(&bar[XB_TMO])) break; if (sp > XB_SPIN_CAP) { atomicAdd(&bar[XB_TMO], 1u); break; } }
  }
  nloc = mine > 0u ? mine : 1u; nx = cnt > 0u ? cnt : 1u;
}
DI void xcd_barrier(const XcdBarrier& b) {
  asm volatile("s_waitcnt vmcnt(0)" ::: "memory");
  __syncthreads();
  if (threadIdx.x == 0) {
    unsigned* bar = b.bar;
    __builtin_amdgcn_s_waitcnt(0);
    unsigned nloc = b.st[0], nx = b.st[1];
    if (nloc == 0u) { xcd_barrier_complete(bar, b.x, nloc, nx); b.st[0] = nloc; b.st[1] = nx; }
    const unsigned old = xb_add(&bar[XB_XSUB(b.x)], 1u);
    const unsigned gen = old / nloc;
    if (old + 1u == (gen + 1u) * nloc) {
      __builtin_amdgcn_fence(__ATOMIC_RELEASE, "agent");
      asm volatile("s_waitcnt vmcnt(0)" ::: "memory");
      const unsigned og = xb_add(&bar[XB_TOP], 1u);
      const unsigned tg = og / nx;
      if (og + 1u == (tg + 1u) * nx) xb_add(&bar[XB_TOPGEN], 1u);
      else XB_SPIN(xb_ld(&bar[XB_TOPGEN]) == tg, bar);
      __builtin_amdgcn_fence(__ATOMIC_ACQUIRE, "agent");
      xb_add(&bar[XB_XGEN(b.x)], 1u);
      asm volatile("s_waitcnt vmcnt(0)" ::: "memory");
    } else {
      XB_SPIN(xb_ld(&bar[XB_XGEN(b.x)]) == gen, bar);
      __builtin_amdgcn_fence(__ATOMIC_ACQUIRE, "agent");
      asm volatile("s_waitcnt vmcnt(0)" ::: "memory");
    }
  }
  __syncthreads();
}

DI void run_phase(const Params& p, char* smem0, int ph) {
  char* smem = smem0 + (ltid() >> 8) * 40960;
  switch (ph) {
    case 0: phase0(p, smem); break;
    case 1: phase0b(p, smem); phase_norm(p, 0); break;
    case 2: phase_gemm_in(p, 0, smem0); break;
    case 3: phase3(p); break;
    case 4: phase_gemm_mla(p, smem); break;
    case 5: phase_attn0(p, smem); break;
    case 6: phase_gemm_out(p, 0, smem); break;
    case 7: phase_norm(p, 1); break;
    case 8: phase_gemm_in(p, 1, smem0); break;
    case 9: phase9(p, smem); break;
    case 10: phase10(p, smem); break;
    case 11: phase11(p, smem); break;
    case 12: phase_gemm_out(p, 1, smem); break;
    case 13: phase_final(p); break;
  }
}

__global__ void __launch_bounds__(512, 2) mk_fwd(Params p) {
#if SINGLE_LAUNCH
  extern __shared__ __attribute__((aligned(16))) char smem[];
  __shared__ uint4 xb_words;
  if (threadIdx.x == 0) xb_words = make_uint4(0u, 0u, 0u, 0u);
  __syncthreads();
  const XcdBarrier xb = xcd_barrier_post(p.BAR, (volatile LAS unsigned*)&xb_words);
  if (p.phase_hi == 12345) {
    const unsigned long long* ia = (const unsigned long long*)__builtin_amdgcn_implicitarg_ptr();
    p.BAR[XB_TMO] = (unsigned)ia[11];
  }
  run_phase(p, smem, 0); xcd_barrier(xb);
  run_phase(p, smem, 1); xcd_barrier(xb);
  run_phase(p, smem, 2); xcd_barrier(xb);
  run_phase(p, smem, 3); xcd_barrier(xb);
  run_phase(p, smem, 4); xcd_barrier(xb);
  run_phase(p, smem, 5); xcd_barrier(xb);
  run_phase(p, smem, 6); xcd_barrier(xb);
  run_phase(p, smem, 7); xcd_barrier(xb);
  run_phase(p, smem, 8); xcd_barrier(xb);
  run_phase(p, smem, 9); xcd_barrier(xb);
  run_phase(p, smem, 10); xcd_barrier(xb);
  run_phase(p, smem, 11); xcd_barrier(xb);
  run_phase(p, smem, 12); xcd_barrier(xb);
  run_phase(p, smem, 13);
#endif
}

template <int PH>
__global__ void __launch_bounds__(512, 2) mk_phase(Params p) {
  extern __shared__ __attribute__((aligned(16))) char smem[];
  run_phase(p, smem, PH);
}
template <int PH>
static void launch_phases(const Params& p, hipStream_t stream) {
  hipFuncSetAttribute((const void*)mk_phase<PH>, hipFuncAttributeMaxDynamicSharedMemorySize, LDS_BYTES);
  hipLaunchKernelGGL(mk_phase<PH>, dim3(256), dim3(512), LDS_BYTES, stream, p);
  if constexpr (PH + 1 < NPHASE) launch_phases<PH + 1>(p, stream);
}

extern "C" void kernel_launch(void* const* d_in, const int* in_sizes, int n_in, void* d_out, int out_size, void* d_ws, size_t ws_size, hipStream_t stream) {
  Params p{};
  const float** fp = (const float**)&p;
  for (int i = 0; i < 34; ++i) fp[i] = (const float*)d_in[i];
  p.out = (float*)d_out;
  char* w = (char*)d_ws;
  size_t off = 0;
  auto take = [&](size_t bytes) { char* r = w + off; off += (bytes + 255) & ~(size_t)255; return r; };
  p.BAR = (unsigned*)take(XCD_BAR_WORDS * 4);
  p.MOD = (float*)take(2 * 3 * 3072 * 4);
  p.LAMV = (float*)take(256);
  p.ROPE32 = (float2*)take(1024 * 16 * 8);
  p.ROPE64 = (float2*)take(1024 * 32 * 8);
  p.WinE = (bf16_t*)take((size_t)EIN * 1024 * 2);
  p.WinO = (bf16_t*)take((size_t)OIN * 1024 * 2);
  p.Wuq = (bf16_t*)take(768 * 384 * 2);
  p.Wukv = (bf16_t*)take(1024 * 256 * 2);
  p.WoutE = (bf16_t*)take(1024 * 1024 * 2);
  p.WoutO = (bf16_t*)take(1024 * 1024 * 2);
  p.H = (bf16_t*)take((size_t)NROW * 1024 * 2);
  p.O = (bf16_t*)take((size_t)NROW * 1024 * 2);
  p.X1 = (float*)take((size_t)NROW * 1024 * 4);
  p.SC = (float*)take(768 * 4 * 4);
  p.SCM = (float*)take(768 * 4);
  p.UC = (float*)take((size_t)768 * 16384 * 4);
  p.NU = (float*)take(768 * 128 * 4);
  p.NST = (float*)take(768 * 128 * 4);
  p.OP = (float*)take((size_t)128 * 2 * 2 * 4 * 8 * 64 * 16);
  p.ML = (float*)take((size_t)128 * 2 * 2 * 4 * 64 * 8);
  p.CST = (bf16_t*)take((size_t)768 * 16384 * 2);
  const size_t region = off;
  p.U0 = (bf16_t*)take((size_t)NROW * EIN * 2);
  p.CQN = (bf16_t*)take((size_t)NROW * 384 * 2);
  p.CKVN = (bf16_t*)take((size_t)NTROW * 256 * 2);
  p.KR = (bf16_t*)take((size_t)NTROW * 32 * 2);
  p.QB = (bf16_t*)take((size_t)NROW * 512 * 2);
  p.KB = (bf16_t*)take((size_t)NTROW * 128 * 2);
  p.VB = (bf16_t*)take((size_t)NTROW * 128 * 2);
  p.Q = (bf16_t*)take((size_t)NROW * 768 * 2);
  p.KV = (bf16_t*)take((size_t)NTROW * 1024 * 2);
  const size_t end0 = off;
  off = region;
  p.U1 = (bf16_t*)take((size_t)NROW * OIN * 2);
  p.QD = (bf16_t*)take((size_t)NROW * 512 * 2);
  p.KD = (bf16_t*)take((size_t)NTROW * 512 * 2);
  p.VD = (bf16_t*)take((size_t)NTROW * 512 * 2);
  const size_t end1 = off;
  const size_t need = end0 > end1 ? end0 : end1;
  if (need > ws_size) { fprintf(stderr, "workspace too small: need %zu have %zu\n", need, ws_size); return; }

#if SINGLE_LAUNCH
  static int grid_blocks = 0;
  if (!grid_blocks) {
    int dev = 0, cus = 0, per_cu = 0;
    hipGetDevice(&dev);
    hipDeviceGetAttribute(&cus, hipDeviceAttributeMultiprocessorCount, dev);
    hipFuncSetAttribute((const void*)mk_fwd, hipFuncAttributeMaxDynamicSharedMemorySize, LDS_BYTES);
    hipOccupancyMaxActiveBlocksPerMultiprocessor(&per_cu, mk_fwd, 512, LDS_BYTES);
    if (per_cu < 1) per_cu = 1;
    grid_blocks = cus;
  }
  p.phase_lo = 0; p.phase_hi = NPHASE;
  hipMemsetAsync(p.BAR, 0, XCD_BAR_WORDS * 4, stream);
  void* args[] = {&p};
  hipError_t e = hipLaunchCooperativeKernel((void*)mk_fwd, dim3(grid_blocks), dim3(512), args, LDS_BYTES, stream);
  if (e != hipSuccess) fprintf(stderr, "cooperative launch failed: %s (grid %d)\n", hipGetErrorString(e), grid_blocks);
#else
  launch_phases<0>(p, stream);
#endif
}
```

```cpp
#include <hip/hip_runtime.h>
#include <hip/hip_cooperative_groups.h>
#include <cstdio>
namespace cg = cooperative_groups;

typedef unsigned short bf16_t;
using bf16x8 = __attribute__((ext_vector_type(8))) short;
using bf16x4 = __attribute__((ext_vector_type(4))) short;
using f32x4  = __attribute__((ext_vector_type(4))) float;
using u32x4  = __attribute__((ext_vector_type(4))) unsigned;
#define DI __device__ __forceinline__
#define MFMA16(a, b, c) __builtin_amdgcn_mfma_f32_16x16x32_bf16((a), (b), (c), 0, 0, 0)

#ifndef SINGLE_LAUNCH
#define SINGLE_LAUNCH 1
#endif

__device__ __forceinline__ unsigned ltid() { unsigned t = threadIdx.x; asm volatile("" : "+v"(t)); return t; }
#define TIDX ((int)(ltid() & 255u))
#define VBLK ((int)(blockIdx.x * 2 + (ltid() >> 8)))
#define NVBLK ((int)(gridDim.x * 2))
DI int vblk_xcd() {
  const int b = blockIdx.x, nb = gridDim.x;
  if (nb & 7) return VBLK;
  return ((b & 7) * (nb >> 3) + (b >> 3)) * 2 + (int)(ltid() >> 8);
}
constexpr int EIN = 2464, OIN = 4624;
constexpr int EIN_PAD = 2560, OIN_PAD = 4864;
constexpr int NROW = 6144, NTROW = 6656;
constexpr int NPHASE = 14;
constexpr int LDS_BYTES = 139264;
constexpr int GRP_LDS = 69632;
constexpr int LDT = 72;
constexpr float EPSF = 1e-6f;
constexpr float LAM_INIT = 0.35550906759097f;
constexpr size_t O_Y = 0, O_CKV = 6291456, O_KR = 7340032, O_GK = 7471104, O_GV = 7995392, O_C = 8519680,
                 O_N = 10616832, O_M = 10633216, O_DK = 10633344, O_DV = 12730496;

struct Params {
  const float *x_prompt, *x_sample, *cache_ckv, *cache_kr, *cache_gk, *cache_gv, *st_C, *st_n, *st_m, *cache_dk, *cache_dv, *c, *c_ctx;
  const float *e_norm_g, *e_ada_w, *e_ada_b, *e_w_in, *e_qn_g, *e_w_uq, *e_kvn_g, *e_w_ukv, *e_gq_g, *e_gk_g, *e_w_out;
  const float *o_norm_g, *o_ada_w, *o_ada_b, *o_w_in, *o_gate_b, *o_mnorm_g, *o_lam, *o_dnorm_g, *o_w_out, *final_g;
  float* out;
  float *MOD, *LAMV;
  float2 *ROPE32, *ROPE64;
  bf16_t *WinE, *WinO, *Wuq, *Wukv, *WoutE, *WoutO;
  bf16_t *H, *U0, *U1, *CQN, *CKVN, *KR, *QB, *KB, *VB, *Q, *KV, *O, *QD, *KD, *VD, *CST;
  float *X1, *SC, *NU, *NST, *ML, *SCM;
  bf16_t *X1B, *UC, *OP;
  unsigned* BAR;
  unsigned* CNT;
  float* SSQ;
  int phase_lo, phase_hi;
};

DI bf16_t f2bf(float x) { unsigned u = __float_as_uint(x); u += 0x7fffu + ((u >> 16) & 1u); return (bf16_t)(u >> 16); }
DI float bf2f(bf16_t b) { return __uint_as_float(((unsigned)b) << 16); }
typedef __bf16 bf2_t __attribute__((ext_vector_type(2)));
typedef float f2_t __attribute__((ext_vector_type(2)));
DI unsigned pack2(float a, float b) { f2_t v = {a, b}; return __builtin_bit_cast(unsigned, __builtin_convertvector(v, bf2_t)); }
DI float lo2f(unsigned w) { return __uint_as_float(w << 16); }
DI float hi2f(unsigned w) { return __uint_as_float(w & 0xffff0000u); }
DI float wave_sum(float v) { for (int d = 32; d; d >>= 1) v += __shfl_xor(v, d); return v; }
DI float wave_max(float v) { for (int d = 32; d; d >>= 1) v = fmaxf(v, __shfl_xor(v, d)); return v; }
DI float scan_add(float v, int lane) { for (int d = 1; d < 64; d <<= 1) { float t = __shfl_up(v, d); if (lane >= d) v += t; } return v; }
DI float scan_max(float v, int lane) { for (int d = 1; d < 64; d <<= 1) { float t = __shfl_up(v, d); if (lane >= d) v = fmaxf(v, t); } return v; }
DI float fexp(float x) { return __builtin_amdgcn_exp2f(x * 1.4426950408889634f); }
DI float logsig(float x) { return fminf(x, 0.f) - log1pf(fexp(-fabsf(x))); }
DI float siluf(float x) { return x * __builtin_amdgcn_rcpf(1.f + fexp(-x)); }
DI float sigmf(float x) { return __builtin_amdgcn_rcpf(1.f + fexp(-x)); }
DI int cv_of_row(int row) { return row < 4096 ? 0 : 1 + ((row - 4096) >> 10); }
DI const float* xrow(const Params& p, int row) { return row < 4096 ? p.x_prompt + (size_t)row * 1024 : p.x_sample + (size_t)(row - 4096) * 1024; }

template <class Epi>
DI void gemm_tile(const bf16_t* __restrict__ X, int ldx, const bf16_t* __restrict__ W, int ldw, int N, int K, int m0, int n0, char* smem, Epi epi) {
  constexpr int LDG = 32;
  constexpr int BUFE = 256 * LDG;
  bf16_t* sb = (bf16_t*)smem;
  const int tid = TIDX, lane = tid & 63, wave = tid >> 6, wm = wave >> 1, wn = wave & 1;
  const int g = lane >> 4, l16 = lane & 15;
  f32x4 acc[4][4];
#pragma unroll
  for (int a = 0; a < 4; ++a)
#pragma unroll
    for (int b = 0; b < 4; ++b) acc[a][b] = f32x4{0.f, 0.f, 0.f, 0.f};
  const int lr = tid >> 2, lc = (tid & 3) * 8;
  const int lcs = ((tid & 3) ^ ((4 - ((lr >> 2) & 3)) & 3)) * 8;
  const int gs = (g ^ ((4 - (l16 >> 2)) & 3)) * 8;
  unsigned xoff[2], woff[2];
#pragma unroll
  for (int i = 0; i < 2; ++i) {
    xoff[i] = (unsigned)((m0 + lr + 64 * i) * ldx + lc);
    int n = n0 + lr + 64 * i; if (n > N - 1) n = N - 1;
    woff[i] = (unsigned)(n * ldw + lc);
  }
  const int nk = K >> 5;
  u32x4 rx[3][2], rw[3][2];
#define G_LOAD(S, KT) { const bf16_t* xb_ = X + (KT) * 32; const bf16_t* wb_ = W + (KT) * 32; \
    rx[S][0] = *(const u32x4*)(xb_ + xoff[0]); rx[S][1] = *(const u32x4*)(xb_ + xoff[1]); \
    rw[S][0] = *(const u32x4*)(wb_ + woff[0]); rw[S][1] = *(const u32x4*)(wb_ + woff[1]); }
#define G_STORE(S, B) { bf16_t* d_ = sb + (B) * BUFE + lr * LDG + lcs; \
    *(u32x4*)(d_) = rx[S][0]; *(u32x4*)(d_ + 64 * LDG) = rx[S][1]; \
    *(u32x4*)(d_ + 128 * LDG) = rw[S][0]; *(u32x4*)(d_ + 192 * LDG) = rw[S][1]; }
#define G_COMPUTE(B) { const bf16_t* bx_ = sb + (B) * BUFE; const bf16_t* bw_ = bx_ + 128 * LDG; \
    bf16x8 wf[4], xf[4]; \
    _Pragma("unroll") for (int i = 0; i < 4; ++i) { \
      wf[i] = *(const bf16x8*)(bw_ + (wn * 64 + i * 16 + l16) * LDG + gs); \
      xf[i] = *(const bf16x8*)(bx_ + (wm * 64 + i * 16 + l16) * LDG + gs); } \
    _Pragma("unroll") for (int ni = 0; ni < 4; ++ni) \
      _Pragma("unroll") for (int mi = 0; mi < 4; ++mi) acc[ni][mi] = MFMA16(wf[ni], xf[mi], acc[ni][mi]); }
#define G_STEP(KK, RL, RS) if ((KK) < nk) { \
    if ((KK) + 1 < nk) G_STORE(RS, ((KK) + 1) & 1) \
    if ((KK) + 3 < nk) G_LOAD(RL, (KK) + 3) \
    G_COMPUTE((KK) & 1) \
    __syncthreads(); }
  G_LOAD(0, 0) G_LOAD(1, 1) G_LOAD(2, 2)
  __syncthreads();
  G_STORE(0, 0)
  __syncthreads();
  for (int k0 = 0; k0 < nk; k0 += 3) {
    G_STEP(k0, 0, 1)
    G_STEP(k0 + 1, 1, 2)
    G_STEP(k0 + 2, 2, 0)
  }
#undef G_LOAD
#undef G_STORE
#undef G_COMPUTE
#undef G_STEP
#pragma unroll
  for (int ni = 0; ni < 4; ++ni) {
    const int n = n0 + wn * 64 + ni * 16 + g * 4;
    if (n < N) {
#pragma unroll
      for (int mi = 0; mi < 4; ++mi) epi(m0 + wm * 64 + mi * 16 + l16, n, acc[ni][mi]);
    }
  }
}

template <class Epi>
DI void gemm_tile64(const bf16_t* __restrict__ X, int ldx, const bf16_t* __restrict__ W, int ldw, int N, int K, int m0, int n0, char* smem, Epi epi) {
  constexpr int PANE = 256 * 32;
  constexpr int BUFE = 2 * PANE;
  bf16_t* sb = (bf16_t*)smem;
  const int tid = TIDX, lane = tid & 63, wave = tid >> 6, wm = wave >> 1, wn = wave & 1;
  const int g = lane >> 4, l16 = lane & 15;
  f32x4 acc[4][4];
#pragma unroll
  for (int a = 0; a < 4; ++a)
#pragma unroll
    for (int b = 0; b < 4; ++b) acc[a][b] = f32x4{0.f, 0.f, 0.f, 0.f};
  const int lr = tid >> 3, ch = tid & 7;
  const int soff = (ch >> 2) * PANE + lr * 32 + (((ch & 3) ^ ((4 - ((lr >> 2) & 3)) & 3)) * 8);
  const int gs = (g ^ ((4 - (l16 >> 2)) & 3)) * 8;
  unsigned xoff[4], woff[4];
#pragma unroll
  for (int i = 0; i < 4; ++i) {
    xoff[i] = (unsigned)((m0 + lr + 32 * i) * ldx + ch * 8);
    int n = n0 + lr + 32 * i; if (n > N - 1) n = N - 1;
    woff[i] = (unsigned)(n * ldw + ch * 8);
  }
  const int nk = K >> 6;
  u32x4 rx[2][4], rw[2][4];
#define H_LOAD(S, KT) { const bf16_t* xb_ = X + (KT) * 64; const bf16_t* wb_ = W + (KT) * 64; \
    _Pragma("unroll") for (int i = 0; i < 4; ++i) { rx[S][i] = *(const u32x4*)(xb_ + xoff[i]); rw[S][i] = *(const u32x4*)(wb_ + woff[i]); } }
#define H_STORE(S, B) { bf16_t* d_ = sb + (B) * BUFE + soff; \
    _Pragma("unroll") for (int i = 0; i < 4; ++i) { *(u32x4*)(d_ + (32 * i) * 32) = rx[S][i]; *(u32x4*)(d_ + (128 + 32 * i) * 32) = rw[S][i]; } }
#define H_COMPUTE(B) { _Pragma("unroll") for (int ks = 0; ks < 2; ++ks) { const bf16_t* bx_ = sb + (B) * BUFE + ks * PANE; const bf16_t* bw_ = bx_ + 128 * 32; \
    bf16x8 wf[4], xf[4]; \
    _Pragma("unroll") for (int i = 0; i < 4; ++i) { \
      wf[i] = *(const bf16x8*)(bw_ + (wn * 64 + i * 16 + l16) * 32 + gs); \
      xf[i] = *(const bf16x8*)(bx_ + (wm * 64 + i * 16 + l16) * 32 + gs); } \
    _Pragma("unroll") for (int ni = 0; ni < 4; ++ni) \
      _Pragma("unroll") for (int mi = 0; mi < 4; ++mi) acc[ni][mi] = MFMA16(wf[ni], xf[mi], acc[ni][mi]); } }
#define H_STEP(KK, SL) if ((KK) < nk) { \
    if ((KK) + 1 < nk) H_STORE((SL) ^ 1, ((KK) + 1) & 1) \
    if ((KK) + 2 < nk) H_LOAD(SL, (KK) + 2) \
    H_COMPUTE((KK) & 1) \
    __syncthreads(); }
  H_LOAD(0, 0)
  if (nk > 1) H_LOAD(1, 1)
  __syncthreads();
  H_STORE(0, 0)
  __syncthreads();
  for (int k0 = 0; k0 < nk; k0 += 2) {
    H_STEP(k0, 0)
    H_STEP(k0 + 1, 1)
  }
#undef H_LOAD
#undef H_STORE
#undef H_COMPUTE
#undef H_STEP
#pragma unroll
  for (int ni = 0; ni < 4; ++ni) {
    const int n = n0 + wn * 64 + ni * 16 + g * 4;
    if (n < N) {
#pragma unroll
      for (int mi = 0; mi < 4; ++mi) epi(m0 + wm * 64 + mi * 16 + l16, n, acc[ni][mi]);
    }
  }
}

DI void gemm_tile64_acc(const bf16_t* __restrict__ X, int ldx, const bf16_t* __restrict__ W, int ldw, int N, int K, int m0, int n0, char* smem, f32x4 (&acc)[4][4]) {
  constexpr int PANE = 256 * 32;
  constexpr int BUFE = 2 * PANE;
  bf16_t* sb = (bf16_t*)smem;
  const int tid = TIDX, lane = tid & 63, wave = tid >> 6, wm = wave >> 1, wn = wave & 1;
  const int g = lane >> 4, l16 = lane & 15;
#pragma unroll
  for (int a = 0; a < 4; ++a)
#pragma unroll
    for (int b = 0; b < 4; ++b) acc[a][b] = f32x4{0.f, 0.f, 0.f, 0.f};
  const int lr = tid >> 3, ch = tid & 7;
  const int soff = (ch >> 2) * PANE + lr * 32 + (((ch & 3) ^ ((4 - ((lr >> 2) & 3)) & 3)) * 8);
  const int gs = (g ^ ((4 - (l16 >> 2)) & 3)) * 8;
  unsigned xoff[4], woff[4];
#pragma unroll
  for (int i = 0; i < 4; ++i) {
    xoff[i] = (unsigned)((m0 + lr + 32 * i) * ldx + ch * 8);
    int n = n0 + lr + 32 * i; if (n > N - 1) n = N - 1;
    woff[i] = (unsigned)(n * ldw + ch * 8);
  }
  const int nk = K >> 6;
  u32x4 rx[2][4], rw[2][4];
#define H_LOAD(S, KT) { const bf16_t* xb_ = X + (KT) * 64; const bf16_t* wb_ = W + (KT) * 64; \
    _Pragma("unroll") for (int i = 0; i < 4; ++i) { rx[S][i] = *(const u32x4*)(xb_ + xoff[i]); rw[S][i] = *(const u32x4*)(wb_ + woff[i]); } }
#define H_STORE(S, B) { bf16_t* d_ = sb + (B) * BUFE + soff; \
    _Pragma("unroll") for (int i = 0; i < 4; ++i) { *(u32x4*)(d_ + (32 * i) * 32) = rx[S][i]; *(u32x4*)(d_ + (128 + 32 * i) * 32) = rw[S][i]; } }
#define H_COMPUTE(B) { _Pragma("unroll") for (int ks = 0; ks < 2; ++ks) { const bf16_t* bx_ = sb + (B) * BUFE + ks * PANE; const bf16_t* bw_ = bx_ + 128 * 32; \
    bf16x8 wf[4], xf[4]; \
    _Pragma("unroll") for (int i = 0; i < 4; ++i) { \
      wf[i] = *(const bf16x8*)(bw_ + (wn * 64 + i * 16 + l16) * 32 + gs); \
      xf[i] = *(const bf16x8*)(bx_ + (wm * 64 + i * 16 + l16) * 32 + gs); } \
    _Pragma("unroll") for (int ni = 0; ni < 4; ++ni) \
      _Pragma("unroll") for (int mi = 0; mi < 4; ++mi) acc[ni][mi] = MFMA16(wf[ni], xf[mi], acc[ni][mi]); } }
#define H_STEP(KK, SL) if ((KK) < nk) { \
    if ((KK) + 1 < nk) H_STORE((SL) ^ 1, ((KK) + 1) & 1) \
    if ((KK) + 2 < nk) H_LOAD(SL, (KK) + 2) \
    H_COMPUTE((KK) & 1) \
    __syncthreads(); }
  H_LOAD(0, 0)
  if (nk > 1) H_LOAD(1, 1)
  __syncthreads();
  H_STORE(0, 0)
  __syncthreads();
  for (int k0 = 0; k0 < nk; k0 += 2) {
    H_STEP(k0, 0)
    H_STEP(k0 + 1, 1)
  }
#undef H_LOAD
#undef H_STORE
#undef H_COMPUTE
#undef H_STEP
}

template <class Epi>
DI void gemm256(const bf16_t* __restrict__ X, int ldx, const bf16_t* __restrict__ W, int ldw, int N, int K, int m0, int n0, char* smem, Epi epi) {
  constexpr int LDG = 32;
  constexpr int BUFE = 512 * LDG;
  bf16_t* sb = (bf16_t*)smem;
  const int tid = (int)ltid(), lane = tid & 63, wave = tid >> 6, wm = wave >> 2, wn = wave & 3;
  const int g = lane >> 4, l16 = lane & 15;
  f32x4 acc[4][8];
#pragma unroll
  for (int a = 0; a < 4; ++a)
#pragma unroll
    for (int b = 0; b < 8; ++b) acc[a][b] = f32x4{0.f, 0.f, 0.f, 0.f};
  const int lr = tid >> 2, lc = (tid & 3) * 8;
  const int lcs = ((tid & 3) ^ ((4 - ((lr >> 2) & 3)) & 3)) * 8;
  const int gs = (g ^ ((4 - (l16 >> 2)) & 3)) * 8;
  unsigned xoff[2], woff[2];
#pragma unroll
  for (int i = 0; i < 2; ++i) {
    xoff[i] = (unsigned)((m0 + lr + 128 * i) * ldx + lc);
    int n = n0 + lr + 128 * i; if (n > N - 1) n = N - 1;
    woff[i] = (unsigned)(n * ldw + lc);
  }
  const int nk = K >> 5;
  u32x4 rx[3][2], rw[3][2];
#define G_LOAD(S, KT) { const bf16_t* xb_ = X + (KT) * 32; const bf16_t* wb_ = W + (KT) * 32; \
    rx[S][0] = *(const u32x4*)(xb_ + xoff[0]); rx[S][1] = *(const u32x4*)(xb_ + xoff[1]); \
    rw[S][0] = *(const u32x4*)(wb_ + woff[0]); rw[S][1] = *(const u32x4*)(wb_ + woff[1]); }
#define G_STORE(S, B) { bf16_t* d_ = sb + (B) * BUFE + lr * LDG + lcs; \
    *(u32x4*)(d_) = rx[S][0]; *(u32x4*)(d_ + 128 * LDG) = rx[S][1]; \
    *(u32x4*)(d_ + 256 * LDG) = rw[S][0]; *(u32x4*)(d_ + 384 * LDG) = rw[S][1]; }
#define G_COMPUTE(B) { const bf16_t* bx_ = sb + (B) * BUFE; const bf16_t* bw_ = bx_ + 256 * LDG; \
    bf16x8 wf[4], xf[8]; \
    _Pragma("unroll") for (int i = 0; i < 4; ++i) wf[i] = *(const bf16x8*)(bw_ + (wn * 64 + i * 16 + l16) * LDG + gs); \
    _Pragma("unroll") for (int i = 0; i < 8; ++i) xf[i] = *(const bf16x8*)(bx_ + (wm * 128 + i * 16 + l16) * LDG + gs); \
    _Pragma("unroll") for (int ni = 0; ni < 4; ++ni) \
      _Pragma("unroll") for (int mi = 0; mi < 8; ++mi) acc[ni][mi] = MFMA16(wf[ni], xf[mi], acc[ni][mi]); }
#define G_STEP(KK, RL, RS) if ((KK) < nk) { \
    if ((KK) + 1 < nk) G_STORE(RS, ((KK) + 1) & 1) \
    if ((KK) + 3 < nk) G_LOAD(RL, (KK) + 3) \
    G_COMPUTE((KK) & 1) \
    __syncthreads(); }
  G_LOAD(0, 0) G_LOAD(1, 1) G_LOAD(2, 2)
  __syncthreads();
  G_STORE(0, 0)
  __syncthreads();
  for (int k0 = 0; k0 < nk; k0 += 3) {
    G_STEP(k0, 0, 1)
    G_STEP(k0 + 1, 1, 2)
    G_STEP(k0 + 2, 2, 0)
  }
#undef G_LOAD
#undef G_STORE
#undef G_COMPUTE
#undef G_STEP
#pragma unroll
  for (int ni = 0; ni < 4; ++ni) {
    const int n = n0 + wn * 64 + ni * 16 + g * 4;
    if (n < N) {
#pragma unroll
      for (int mi = 0; mi < 8; ++mi) epi(m0 + wm * 128 + mi * 16 + l16, n, acc[ni][mi]);
    }
  }
}

namespace pg8 {
#define PG8_LAS __attribute__((address_space(3)))
typedef unsigned short bf16_t;
typedef short bf16x8 __attribute__((ext_vector_type(8)));
typedef float f32x4 __attribute__((ext_vector_type(4)));
typedef unsigned u32x4 __attribute__((ext_vector_type(4)));
constexpr int BM = 256, BK = 64, HALF = 128, HTB = HALF * BK * 2  , STAGE_BYTES = 8 * HTB, NXCD = 8, WGM = 8;

__host__ __device__ __forceinline__ int lds_byte(int r, int c) { const int st = (r >> 4) * 2 + (c >> 5), rr = r & 15, cc = c & 31, ob = rr * 64 + cc * 2; return st * 1024 + (ob ^ (((ob >> 9) & 1) << 5)); }
__host__ __device__ __forceinline__ void stage_rc(int b, int& R, int& C) { const int st = b / 1024, sb = b % 1024, swz = sb ^ (((sb >> 9) & 1) << 5); R = (st >> 1) * 16 + swz / 64; C = (st & 1) * 32 + (swz % 64) / 2; }
__host__ __device__ __forceinline__ int perm32(int rho) { const int n = rho >> 4, i = rho & 15; return 8 * (i >> 2) + 4 * n + (i & 3); }

struct Unit { int pm, pn; };
struct Gemm { const bf16_t* A; const bf16_t* Bt; int M, N, K; };

struct StaticOrder {
    int nM, nN, nwg, G, c;
    __host__ __device__ void init(int M, int N, int G_, int c_) { nM = M / BM; nN = N / BM; nwg = nM * nN; G = G_; c = c_; }
    __host__ __device__ bool next(int i, Unit& u) const {
        const long L = (long)i * G + c; if (L >= nwg) return false;
        int wgid = (int)L; { const int q = nwg / NXCD, r = nwg % NXCD, xcd = wgid % NXCD, off = wgid / NXCD; wgid = (xcd < r ? xcd * (q + 1) : r * (q + 1) + (xcd - r) * q) + off; }
        const int nig = WGM * nN, gid = wgid / nig, fm = gid * WGM, gsz = (nM - fm) < WGM ? (nM - fm) : WGM;
        u.pm = fm + ((wgid % nig) % gsz); u.pn = (wgid % nig) / gsz; return true;
    }
    __device__ __forceinline__ void a_ready(const Unit&) const {}
    __device__ __forceinline__ void done(const Unit&) const {}
};
__device__ __forceinline__ unsigned cvt_pk_bf16(float lo, float hi) { unsigned r; asm volatile("v_cvt_pk_bf16_f32 %0, %1, %2" : "=v"(r) : "v"(lo), "v"(hi)); return r; }
template <class Epi, class Sched, bool STAMP = false>
__device__ __forceinline__ void gemm_phase(PG8_LAS unsigned char* lds, const Gemm g, const Sched& S, const Epi& E, unsigned long long* stamps) {
    const int tid = (int)ltid(), wid = __builtin_amdgcn_readfirstlane(tid >> 6), lane = tid & 63, wr = wid >> 2, wc = wid & 3, fr = lane & 15, fq = lane >> 4;
    const int K = g.K, nt = K / BK;
    int ts_lo = 0, ts_hi = 0, nts = 0; const unsigned long long rt_entry = STAMP ? (unsigned long long)wall_clock64() : 0ull;
#define PG8_STAMP() do { if (STAMP && wid == 0 && nts < 64) { const unsigned long long _c = (unsigned long long)clock64(); \
        ts_lo = (lane == nts) ? (int)(unsigned)_c : ts_lo; ts_hi = (lane == nts) ? (int)(unsigned)(_c >> 32) : ts_hi; ++nts; } } while (0)
    PG8_STAMP();
    unsigned voffA[2], voffB[2];
#pragma unroll
    for (int i = 0; i < 2; ++i) { int R, C; stage_rc(tid * 16 + i * 8192, R, C); const int Rb = Epi::PERM ? ((R & ~31) + perm32(R & 31)) : R;
        voffA[i] = (unsigned)(R * K + C) * 2u; voffB[i] = (unsigned)(Rb * K + C) * 2u; }
    const size_t kstep = (size_t)(BK * 2);
    const size_t hstep = (size_t)HALF * K * 2;
    const size_t tstep = 2 * hstep;
    const unsigned ldsw = (unsigned)wid * 1024u;
    const int aoff = lds_byte(wr * 64 + fr, fq * 8), boff = lds_byte(wc * 32 + fr, fq * 8);
#define PG8_SA(b, h) (((b) * 2 + (h)) * HTB)
#define PG8_SB(b, h) ((4 + (b) * 2 + (h)) * HTB)
#define PG8_STAGE(bufoff, gbase, voff) do { _Pragma("unroll") for (int _i = 0; _i < 2; ++_i) \
        __builtin_amdgcn_global_load_lds((const unsigned*)((const char*)(gbase) + (voff)[_i]), (PG8_LAS unsigned*)(lds + (bufoff) + ldsw + _i * 8192), 16, 0, 0); } while (0)
#define PG8_LDA(dst, b, h) do { _Pragma("unroll") for (int m = 0; m < 4; ++m) _Pragma("unroll") for (int k = 0; k < 2; ++k) dst[m][k] = *(const PG8_LAS bf16x8*)(lds + PG8_SA(b, h) + aoff + m * 2048 + k * 1024); } while (0)
#define PG8_LDB(dst, b, h) do { _Pragma("unroll") for (int n = 0; n < 2; ++n) _Pragma("unroll") for (int k = 0; k < 2; ++k) dst[n][k] = *(const PG8_LAS bf16x8*)(lds + PG8_SB(b, h) + boff + n * 2048 + k * 1024); } while (0)
#define PG8_MMA(ai, bj, At, Bt) do { __builtin_amdgcn_s_setprio(1); _Pragma("unroll") for (int m = 0; m < 4; ++m) _Pragma("unroll") for (int n = 0; n < 2; ++n) _Pragma("unroll") for (int k = 0; k < 2; ++k) \
        acc[ai][bj][m][n] = __builtin_amdgcn_mfma_f32_16x16x32_bf16(Bt[n][k], At[m][k], acc[ai][bj][m][n], 0, 0, 0); __builtin_amdgcn_s_setprio(0); } while (0)
#define PG8_WAIT_V(n) asm volatile("s_waitcnt vmcnt(" #n ")" ::: "memory")
#define PG8_WAIT_L(n) asm volatile("s_waitcnt lgkmcnt(" #n ")" ::: "memory")
#define PG8_BAR __builtin_amdgcn_s_barrier()
#define PG8_SCHED __builtin_amdgcn_sched_barrier(0)
    Unit cur, nxt; int ui = 0;
    if (!S.next(0, cur)) return;
    f32x4 acc[2][2][4][2];
#pragma unroll
    for (int a = 0; a < 2; ++a)
#pragma unroll
        for (int b = 0; b < 2; ++b)
#pragma unroll
            for (int m = 0; m < 4; ++m)
#pragma unroll
                for (int n = 0; n < 2; ++n) acc[a][b][m][n] = (f32x4){0.f, 0.f, 0.f, 0.f};
    bf16x8 At[4][2], B0[2][2], B1[2][2];
    const char* cA = (const char*)g.A + (size_t)cur.pm * tstep; const char* cB = (const char*)g.Bt + (size_t)cur.pn * tstep;
    S.a_ready(cur);
    PG8_STAGE(PG8_SB(0, 0), cB, voffB); PG8_STAGE(PG8_SA(0, 0), cA, voffA); PG8_STAGE(PG8_SB(0, 1), cB + hstep, voffB); PG8_STAGE(PG8_SA(0, 1), cA + hstep, voffA);
    if (wr == 1) PG8_BAR;
    PG8_WAIT_V(4); PG8_BAR;
    PG8_STAGE(PG8_SB(1, 0), cB + kstep, voffB); PG8_STAGE(PG8_SA(1, 0), cA + kstep, voffA); PG8_STAGE(PG8_SB(1, 1), cB + hstep + kstep, voffB);
    PG8_WAIT_V(6); PG8_BAR;
    PG8_STAMP();
    for (;;) {
        const bool has_next = S.next(ui + 1, nxt);
        const char* nA = has_next ? (const char*)g.A + (size_t)nxt.pm * tstep : cA; const char* nB = has_next ? (const char*)g.Bt + (size_t)nxt.pn * tstep : cB;
        for (int t = 0; t < nt; t += 2) {
            const bool last = (t == nt - 2);
            const char* a1 = cA + (size_t)(t + 1) * kstep;
            const char* a2 = last ? nA : cA + (size_t)(t + 2) * kstep; const char* b2 = last ? nB : cB + (size_t)(t + 2) * kstep;
            const char* a3 = a2 + kstep; const char* b3 = b2 + kstep;
            if (last && has_next) S.a_ready(nxt);
            PG8_LDB(B0, 0, 0); PG8_SCHED; PG8_LDA(At, 0, 0); PG8_STAGE(PG8_SA(1, 1), a1 + hstep, voffA);
            PG8_WAIT_L(8); PG8_BAR; PG8_WAIT_L(0); PG8_MMA(0, 0, At, B0); PG8_BAR; PG8_SCHED;
            PG8_LDB(B1, 0, 1); PG8_STAGE(PG8_SB(0, 0), b2, voffB);
            PG8_BAR; PG8_WAIT_L(0); PG8_MMA(0, 1, At, B1); PG8_BAR;
            PG8_LDA(At, 0, 1); PG8_STAGE(PG8_SA(0, 0), a2, voffA);
            PG8_BAR; PG8_WAIT_L(0); PG8_MMA(1, 0, At, B0); PG8_BAR; PG8_SCHED;
            PG8_STAGE(PG8_SB(0, 1), b2 + hstep, voffB);
            PG8_WAIT_V(6); PG8_BAR; PG8_MMA(1, 1, At, B1); PG8_BAR;
            PG8_LDB(B0, 1, 0); PG8_SCHED; PG8_LDA(At, 1, 0); PG8_STAGE(PG8_SA(0, 1), a2 + hstep, voffA);
            PG8_WAIT_L(8); PG8_BAR; PG8_WAIT_L(0); PG8_MMA(0, 0, At, B0); PG8_BAR; PG8_SCHED;
            PG8_LDB(B1, 1, 1); PG8_STAGE(PG8_SB(1, 0), b3, voffB);
            PG8_BAR; PG8_WAIT_L(0); PG8_MMA(0, 1, At, B1); PG8_BAR;
            PG8_LDA(At, 1, 1); PG8_STAGE(PG8_SA(1, 0), a3, voffA);
            PG8_BAR; PG8_WAIT_L(0); PG8_MMA(1, 0, At, B0); PG8_BAR; PG8_SCHED;
            PG8_STAGE(PG8_SB(1, 1), b3 + hstep, voffB);
            PG8_WAIT_V(6); PG8_BAR; PG8_MMA(1, 1, At, B1); PG8_BAR;
        }
        PG8_STAMP();
        if constexpr (!Epi::AFTER_DRAIN) { E(acc, cur, wr, wc, fr, fq); S.done(cur); }
        PG8_STAMP();
        if (!has_next) break;
#pragma unroll
        for (int a = 0; a < 2; ++a)
#pragma unroll
            for (int b = 0; b < 2; ++b)
#pragma unroll
                for (int m = 0; m < 4; ++m)
#pragma unroll
                    for (int n = 0; n < 2; ++n) acc[a][b][m][n] = (f32x4){0.f, 0.f, 0.f, 0.f};
        cur = nxt; cA = nA; cB = nB; ++ui;
    }
    PG8_WAIT_V(0);
    if (wr == 0) PG8_BAR;
    PG8_BAR;
    if constexpr (Epi::AFTER_DRAIN) { E.fused(acc, cur, wr, wc, fr, fq, lds, wid, lane); S.done(cur); }
    PG8_STAMP();
    if (STAMP && wid == 0) { stamps[lane] = lane < nts ? (((unsigned long long)(unsigned)ts_hi << 32) | (unsigned)ts_lo) : 0ull;
        if (lane == 62) stamps[62] = rt_entry; if (lane == 63) stamps[63] = (unsigned long long)wall_clock64(); }
#undef PG8_STAMP
#undef PG8_SA
#undef PG8_SB
#undef PG8_STAGE
#undef PG8_LDA
#undef PG8_LDB
#undef PG8_MMA
#undef PG8_WAIT_V
#undef PG8_WAIT_L
#undef PG8_BAR
#undef PG8_SCHED
}
}

struct EpiU {
  static constexpr bool PERM = true, AFTER_DRAIN = false;
  bf16_t* U; int ldu; int nvalid;
  float* aux;
  __device__ __forceinline__ void operator()(const f32x4 (&acc)[2][2][4][2], const pg8::Unit& u, int wr, int wc, int fr, int fq) const {
    const int row0 = u.pm * 256 + wr * 64 + fr, col0 = u.pn * 256 + wc * 32 + 8 * fq;
#pragma unroll
    for (int ai = 0; ai < 2; ++ai)
#pragma unroll
      for (int m = 0; m < 4; ++m) {
        bf16_t* rowp = U + (size_t)(row0 + ai * 128 + m * 16) * ldu;
#pragma unroll
        for (int bj = 0; bj < 2; ++bj) {
          const int col = col0 + bj * 128;
          if (col < nvalid) {
            const f32x4 v0 = acc[ai][bj][m][0], v1 = acc[ai][bj][m][1];
            u32x4 w;
            w[0] = pack2(v0[0], v0[1]); w[1] = pack2(v0[2], v0[3]); w[2] = pack2(v1[0], v1[1]); w[3] = pack2(v1[2], v1[3]);
            *(u32x4*)(rowp + col) = w;
            if (aux && col >= 3088 && col < 4112 && (row0 + ai * 128 + m * 16) < 4096) {
              float* ap = aux + (size_t)((col - 3088) >> 9) * 2097152 + (size_t)(row0 + ai * 128 + m * 16) * 512 + ((col - 3088) & 511);
              *(f32x4*)ap = v0; *(f32x4*)(ap + 4) = v1;
            }
          }
        }
      }
  }
};


struct EpiOut {
  static constexpr bool PERM = true, AFTER_DRAIN = false;
  const float* MOD; const float* x_prompt; const float* x_sample; bf16_t* X1B; int layer;
  __device__ __forceinline__ void operator()(const f32x4 (&acc)[2][2][4][2], const pg8::Unit& u, int wr, int wc, int fr, int fq) const {
    const int row0 = u.pm * 256 + wr * 64 + fr, col0 = u.pn * 256 + wc * 32 + 8 * fq;
#pragma unroll
    for (int ai = 0; ai < 2; ++ai)
#pragma unroll
      for (int m = 0; m < 4; ++m) {
        const int row = row0 + ai * 128 + m * 16;
        const float* gp = MOD + (layer * 3 + (row < 4096 ? 0 : 1 + ((row - 4096) >> 10))) * 3072 + 2048;
        const float* xr = row < 4096 ? x_prompt + (size_t)row * 1024 : x_sample + (size_t)(row - 4096) * 1024;
        bf16_t* xb = X1B + (size_t)row * 1024;
#pragma unroll
        for (int bj = 0; bj < 2; ++bj) {
          const int col = col0 + bj * 128;
          const f32x4 v0 = acc[ai][bj][m][0], v1 = acc[ai][bj][m][1];
          const float4 g0 = *(const float4*)(gp + col), g1 = *(const float4*)(gp + col + 4);
          float4 x0, x1;
          if (layer) {
            const uint4 w = *(const uint4*)(xb + col);
            x0 = make_float4(__uint_as_float(w.x << 16), __uint_as_float(w.x & 0xffff0000u), __uint_as_float(w.y << 16), __uint_as_float(w.y & 0xffff0000u));
            x1 = make_float4(__uint_as_float(w.z << 16), __uint_as_float(w.z & 0xffff0000u), __uint_as_float(w.w << 16), __uint_as_float(w.w & 0xffff0000u));
          } else { x0 = *(const float4*)(xr + col); x1 = *(const float4*)(xr + col + 4); }
          u32x4 o;
          o[0] = pack2(x0.x + g0.x * v0[0], x0.y + g0.y * v0[1]); o[1] = pack2(x0.z + g0.z * v0[2], x0.w + g0.w * v0[3]);
          o[2] = pack2(x1.x + g1.x * v1[0], x1.y + g1.y * v1[1]); o[3] = pack2(x1.z + g1.z * v1[2], x1.w + g1.w * v1[3]);
          *(u32x4*)(xb + col) = o;
        }
        asm volatile("" ::: "memory");
      }
  }
};

template <int W>
DI void stage_rows64(bf16_t* dst, int ldd, int coff, const bf16_t* src, int lds) {
  for (int c = TIDX; c < 64 * (W / 8); c += 256) {
    const int r = c / (W / 8), cc = (c % (W / 8)) * 8;
    *(uint4*)(dst + r * ldd + coff + cc) = *(const uint4*)(src + (size_t)r * lds + cc);
  }
}
template <int W>
DI void stage_T64(bf16_t* dst, const bf16_t* src, int lds, const float* rscale) {
  for (int c = TIDX; c < 64 * (W / 8); c += 256) {
    const int r = c & 63, cc = (c >> 6) * 8;
    uint4 v = *(const uint4*)(src + (size_t)r * lds + cc);
    unsigned w[4] = {v.x, v.y, v.z, v.w};
    if (rscale) {
      const float s = rscale[r];
#pragma unroll
      for (int i = 0; i < 4; ++i) {
        const unsigned pw = pack2(lo2f(w[i]) * s, hi2f(w[i]) * s);
        dst[(cc + 2 * i) * LDT + r] = (bf16_t)(pw & 0xffffu);
        dst[(cc + 2 * i + 1) * LDT + r] = (bf16_t)(pw >> 16);
      }
    } else {
#pragma unroll
      for (int i = 0; i < 4; ++i) {
        dst[(cc + 2 * i) * LDT + r] = (bf16_t)(w[i] & 0xffffu);
        dst[(cc + 2 * i + 1) * LDT + r] = (bf16_t)(w[i] >> 16);
      }
    }
  }
}

template <int DK, int DV, bool DUAL>
DI void attn_core(char* smem, const bf16_t* Qp, int ldq, const bf16_t* K1, int ldk1, const bf16_t* K2, int ldk2,
                  const bf16_t* V, int ldv, int T, float scale_log2, f32x4 (&o)[DUAL ? 2 : 1][DV / 16], float (&lsum)[DUAL ? 2 : 1], float (&mrun)[DUAL ? 2 : 1],
                  const float2* qrope = nullptr) {
  constexpr int NS = DUAL ? 2 : 1;
  constexpr int DKT = DUAL ? 2 * DK : DK;
  constexpr int W1 = (DK == 96) ? 64 : DKT;
  constexpr int LDK = DKT + 8;
  constexpr int NK1 = 64 * (W1 / 8) / 512;
  constexpr int NV = 64 * (DV / 8) / 512;
  constexpr int BUFE = 64 * DKT + DV * LDT;
  bf16_t* sbase = (bf16_t*)smem;
  const int tid = TIDX, lane = tid & 63, wave = tid >> 6, g = lane >> 4, l16 = lane & 15;
  const int st = (int)ltid();
  const int gsw = (g ^ ((4 - (l16 >> 2)) & 3)) * 8;
  bf16x8 qf[DKT / 32];
  const bf16_t* qrow = Qp + (size_t)(wave * 16 + l16) * ldq;
#pragma unroll
  for (int ks = 0; ks < DKT / 32; ++ks) qf[ks] = *(const bf16x8*)(qrow + ks * 32 + g * 8);
  if (DK == 96 && qrope) {
    const float2* rp = qrope + (wave * 16 + l16) * 16 + g * 4;
    const u32x4 w = __builtin_bit_cast(u32x4, qf[DKT / 32 - 1]);
    u32x4 r;
#pragma unroll
    for (int j = 0; j < 4; ++j) {
      const float2 cs = rp[j];
      const float x0 = lo2f(w[j]), x1 = hi2f(w[j]);
      r[j] = pack2(x0 * cs.x - x1 * cs.y, x0 * cs.y + x1 * cs.x);
    }
    qf[DKT / 32 - 1] = __builtin_bit_cast(bf16x8, r);
  }
#pragma unroll
  for (int n = 0; n < NS; ++n) {
#pragma unroll
    for (int i = 0; i < DV / 16; ++i) o[n][i] = f32x4{0.f, 0.f, 0.f, 0.f};
    mrun[n] = -INFINITY; lsum[n] = 0.f;
  }
  u32x4 pk[NK1], pk2, pv[NV];
  unsigned koff[NK1], voff[NV];
#pragma unroll
  for (int i = 0; i < NK1; ++i) { const int c = st + 512 * i, r = c / (W1 / 8), cc = (c % (W1 / 8)) * 8; koff[i] = (unsigned)(r * ldk1 + cc); }
#pragma unroll
  for (int i = 0; i < NV; ++i) { const int c = st + 512 * i, r = c & 63, cc = (c >> 6) * 8; voff[i] = (unsigned)(r * ldv + cc); }
  const unsigned k2off = (unsigned)(((st & 255) >> 2) * ldk2 + (st & 3) * 8);
#define A_LOAD(TN) { const bf16_t* kbase_ = K1 + (size_t)(TN) * ldk1; const bf16_t* vbase_ = V + (size_t)(TN) * ldv; \
    _Pragma("unroll") for (int i = 0; i < NK1; ++i) pk[i] = *(const u32x4*)(kbase_ + koff[i]); \
    if (DK == 96 && st < 256) pk2 = *(const u32x4*)(K2 + (size_t)(TN) * ldk2 + k2off); \
    _Pragma("unroll") for (int i = 0; i < NV; ++i) pv[i] = *(const u32x4*)(vbase_ + voff[i]); }
#define A_COMMIT(B) { bf16_t* sK_ = sbase + (B) * BUFE; bf16_t* sVT_ = sK_ + 64 * DKT; \
    _Pragma("unroll") for (int i = 0; i < NK1; ++i) { const int c = st + 512 * i, r = c / (W1 / 8), ch = c % (W1 / 8); *(u32x4*)(sK_ + (ch >> 2) * 2048 + r * 32 + (((ch & 3) ^ ((4 - ((r >> 2) & 3)) & 3)) * 8)) = pk[i]; } \
    if (DK == 96 && st < 256) { const int r = st >> 2, ch = st & 3; *(u32x4*)(sK_ + 2 * 2048 + r * 32 + ((ch ^ ((4 - ((r >> 2) & 3)) & 3)) * 8)) = pk2; } \
    _Pragma("unroll") for (int i = 0; i < NV; ++i) { const int c = st + 512 * i, r = c & 63, cc = (c >> 6) * 8; \
      _Pragma("unroll") for (int j = 0; j < 4; ++j) { sVT_[(cc + 2 * j) * LDT + r] = (bf16_t)(pv[i][j] & 0xffffu); sVT_[(cc + 2 * j + 1) * LDT + r] = (bf16_t)(pv[i][j] >> 16); } } }
  A_LOAD(0)
  __syncthreads();
  A_COMMIT(0)
  if (64 < T) A_LOAD(64)
  __syncthreads();
  int par = 0;
  for (int t0 = 0; t0 < T; t0 += 64, par ^= 1) {
    {
    {
    if (t0 + 64 < T) {
      A_COMMIT(par ^ 1)
      if (t0 + 128 < T) A_LOAD(t0 + 128)
    }
    const bf16_t* sK = sbase + par * BUFE;
    const bf16_t* sVT = sK + 64 * DKT;
    bf16x8 pf[NS][2];
#pragma unroll
    for (int n = 0; n < NS; ++n) {
      f32x4 s[4];
#pragma unroll
      for (int t = 0; t < 4; ++t) {
        s[t] = f32x4{0.f, 0.f, 0.f, 0.f};
#pragma unroll
        for (int ks = 0; ks < DK / 32; ++ks) {
          const bf16x8 kf = *(const bf16x8*)(sK + (n * (DK / 32) + ks) * 2048 + (t * 16 + l16) * 32 + gsw);
          s[t] = MFMA16(kf, qf[n * (DK / 32) + ks], s[t]);
        }
      }
      float mx = -INFINITY;
#pragma unroll
      for (int t = 0; t < 4; ++t)
#pragma unroll
        for (int j = 0; j < 4; ++j) mx = fmaxf(mx, s[t][j]);
      mx = fmaxf(mx, __shfl_xor(mx, 16));
      mx = fmaxf(mx, __shfl_xor(mx, 32));
      const float mnew = fmaxf(mrun[n], mx);
      const float alpha = __builtin_amdgcn_exp2f((mrun[n] - mnew) * scale_log2);
      mrun[n] = mnew;
      const float moff = -mnew * scale_log2;
      float ps = 0.f;
#pragma unroll
      for (int t = 0; t < 4; ++t)
#pragma unroll
        for (int j = 0; j < 4; ++j) { s[t][j] = __builtin_amdgcn_exp2f(fmaf(s[t][j], scale_log2, moff)); ps += s[t][j]; }
      lsum[n] = lsum[n] * alpha + ps;
#pragma unroll
      for (int i = 0; i < DV / 16; ++i) o[n][i] *= alpha;
#pragma unroll
      for (int kb = 0; kb < 2; ++kb)
      {
        u32x4 w;
        w[0] = pack2(s[2 * kb][0], s[2 * kb][1]); w[1] = pack2(s[2 * kb][2], s[2 * kb][3]);
        w[2] = pack2(s[2 * kb + 1][0], s[2 * kb + 1][1]); w[3] = pack2(s[2 * kb + 1][2], s[2 * kb + 1][3]);
        pf[n][kb] = __builtin_bit_cast(bf16x8, w);
      }
    }
#pragma unroll
    for (int kb = 0; kb < 2; ++kb) {
#pragma unroll
      for (int i = 0; i < DV / 16; ++i) {
        const bf16_t* vp = sVT + (i * 16 + l16) * LDT + kb * 32 + g * 4;
        const bf16x4 lo = *(const bf16x4*)(vp);
        const bf16x4 hi = *(const bf16x4*)(vp + 16);
        const bf16x8 vf = __builtin_shufflevector(lo, hi, 0, 1, 2, 3, 4, 5, 6, 7);
#pragma unroll
        for (int n = 0; n < NS; ++n) o[n][i] = MFMA16(vf, pf[n][kb], o[n][i]);
        if (DUAL && (i & 3) == 3) asm volatile("" ::: "memory");
      }
    }
    }
    }
    __syncthreads();
  }
#undef A_LOAD
#undef A_COMMIT
}

DI void transpose_w(const float* __restrict__ src, int K, int N, bf16_t* __restrict__ dst, int tile, float* sT, int sc_lo, int sc_hi, float sc) {
  const int ntn = (N + 63) >> 6;
  const int kt = tile / ntn, nt = tile % ntn, k0 = kt * 64, n0 = nt * 64;
  __syncthreads();
#pragma unroll
  for (int q = 0; q < 4; ++q) {
    const int i = TIDX + 256 * q;
    const int r = i >> 4, c = (i & 15) * 4, n = n0 + c;
    float4 v = make_float4(0.f, 0.f, 0.f, 0.f);
    if (n < N) v = *(const float4*)(src + (size_t)(k0 + r) * N + n);
    if (n >= sc_lo && n < sc_hi) { v.x *= sc; v.y *= sc; v.z *= sc; v.w *= sc; }
    float* d = sT + r * 65 + c;
    d[0] = v.x; d[1] = v.y; d[2] = v.z; d[3] = v.w;
  }
  __syncthreads();
#pragma unroll
  for (int q = 0; q < 2; ++q) {
    const int i = TIDX + 256 * q;
    const int c = i >> 3, kc = (i & 7) * 8, n = n0 + c;
    if (n < N) {
      const float* sp = sT + kc * 65 + c;
      uint4 o;
      o.x = pack2(sp[0], sp[65]); o.y = pack2(sp[130], sp[195]); o.z = pack2(sp[260], sp[325]); o.w = pack2(sp[390], sp[455]);
      *(uint4*)(dst + (size_t)n * K + k0 + kc) = o;
    }
  }
}

DI void phase0(const Params& p, char* smem) {
  const int tid = TIDX;
  for (int it = VBLK; it < 384; it += NVBLK) {
    const int l = it / 192, cb = (it % 192) * 16;
    const float* W = l ? p.o_ada_w : p.e_ada_w;
    const float* bias = l ? p.o_ada_b : p.e_ada_b;
    float* sc = (float*)smem;
    float* red = sc + 3072;
    __syncthreads();
    for (int i = tid; i < 3072; i += 256) {
      const int j = i >> 10, k = i & 1023;
      const float v = (j == 0) ? p.c_ctx[k] : p.c[(j - 1) * 1024 + k];
      sc[i] = siluf(v);
    }
    __syncthreads();
    const int col = cb + (tid & 15), kg = tid >> 4;
    float a0 = 0.f, a1 = 0.f, a2 = 0.f;
    for (int kb = kg * 64; kb < kg * 64 + 64; kb += 16) {
      float w[16];
#pragma unroll
      for (int u = 0; u < 16; ++u) w[u] = W[(size_t)(kb + u) * 3072 + col];
#pragma unroll
      for (int u = 0; u < 16; ++u) { a0 += sc[kb + u] * w[u]; a1 += sc[1024 + kb + u] * w[u]; a2 += sc[2048 + kb + u] * w[u]; }
    }
    red[(kg * 3 + 0) * 16 + (tid & 15)] = a0;
    red[(kg * 3 + 1) * 16 + (tid & 15)] = a1;
    red[(kg * 3 + 2) * 16 + (tid & 15)] = a2;
    __syncthreads();
    if (tid < 48) {
      const int j = tid >> 4, c = tid & 15;
      float s = 0.f;
      for (int q = 0; q < 16; ++q) s += red[(q * 3 + j) * 16 + c];
      __hip_atomic_store(p.MOD + (l * 3 + j) * 3072 + cb + c, s + bias[cb + c], __ATOMIC_RELAXED, __HIP_MEMORY_SCOPE_AGENT);
    }
    asm volatile("s_waitcnt vmcnt(0)" ::: "memory");
    __syncthreads();
    if (tid == 0) __hip_atomic_fetch_add(p.CNT + 2 * 48 * 64, 1u, __ATOMIC_RELAXED, __HIP_MEMORY_SCOPE_AGENT);
  }
}

DI void wait_mod_ready(const Params& p) {
  if (TIDX == 0) {
    unsigned* cnt = p.CNT + 2 * 48 * 64;
    unsigned sp = 0;
    while (__hip_atomic_load(cnt, __ATOMIC_RELAXED, __HIP_MEMORY_SCOPE_AGENT) < 384u) {
      __builtin_amdgcn_s_sleep(1);
      if (++sp > (1u << 22)) break;
    }
    __builtin_amdgcn_fence(__ATOMIC_ACQUIRE, "agent");
    asm volatile("s_waitcnt vmcnt(0)" ::: "memory");
  }
  __syncthreads();
}

DI void phase0b(const Params& p, char* smem) {
  const int tid = TIDX;
  if (VBLK == 0 && tid < 64) {
    float a = p.o_lam[tid] * p.o_lam[64 + tid];
    float b = p.o_lam[128 + tid] * p.o_lam[192 + tid];
    a = wave_sum(a); b = wave_sum(b);
    if (tid == 0) p.LAMV[0] = fexp(a) - fexp(b) + LAM_INIT;
  }
  for (int idx = VBLK * 256 + tid; idx < 1024 * 48; idx += NVBLK * 256) {
    const int pos = idx / 48, e = idx % 48;
    const float rr = (float)(pos >> 6), cc = (float)(pos & 63);
    if (e < 16) {
      const int j = e & 7;
      const float inv = 1.0f / powf(10000.0f, (float)(2 * j) / 16.0f);
      const float ang = ((e < 8) ? rr : cc) * inv;
      p.ROPE32[pos * 16 + e] = make_float2(cosf(ang), sinf(ang));
    } else {
      const int i = e - 16, j = i & 15;
      const float inv = 1.0f / powf(10000.0f, (float)(2 * j) / 32.0f);
      const float ang = ((i < 16) ? rr : cc) * inv;
      p.ROPE64[pos * 32 + i] = make_float2(cosf(ang), sinf(ang));
    }
  }
  float* sT = (float*)smem;
  for (int it = VBLK; it < 1016; it += NVBLK) {
    if (it < 624) transpose_w(p.e_w_in, 1024, EIN, p.WinE, it, sT, 0, 0, 1.f);
    else if (it < 696) transpose_w(p.e_w_uq, 384, 768, p.Wuq, it - 624, sT, 0, 0, 1.f);
    else if (it < 760) transpose_w(p.e_w_ukv, 256, 1024, p.Wukv, it - 696, sT, 0, 0, 1.f);
    else transpose_w(p.e_w_out, 1024, 1024, p.WoutE, it - 760, sT, 0, 0, 1.f);
  }
}

DI void late_weight_prep(const Params& p, char* smem, int first_group, int tile_lo, int tile_hi) {
  float* sT = (float*)smem;
  const int ng = NVBLK - first_group;
  if (ng <= 0 || VBLK < first_group) return;
  for (int it = tile_lo + VBLK - first_group; it < tile_hi; it += ng) {
    if (it < 1168) transpose_w(p.o_w_in, 1024, OIN, p.WinO, it, sT, 512, 1024, 0.08838834764831845f);
    else transpose_w(p.o_w_out, 1024, 1024, p.WoutO, it - 1168, sT, 0, 0, 1.f);
  }
}

DI void store_bf4(bf16_t* dst, f32x4 v) {
  uint2 o; o.x = pack2(v[0], v[1]); o.y = pack2(v[2], v[3]);
  *(uint2*)dst = o;
}
DI float4 load_bf4(const bf16_t* src) {
  const uint2 w = *(const uint2*)src;
  return make_float4(lo2f(w.x), hi2f(w.x), lo2f(w.y), hi2f(w.y));
}

DI void phase_norm(const Params& p, int layer) {
  const int tid = TIDX, lane = tid & 63, wave = tid >> 6;
  const float* g = layer ? p.o_norm_g : p.e_norm_g;
  for (int it = VBLK; it < NROW / 4; it += NVBLK) {
    const int row = it * 4 + wave;
    const float* x = xrow(p, row);
    const bf16_t* xb = p.X1B + (size_t)row * 1024;
    const float* md = p.MOD + (layer * 3 + cv_of_row(row)) * 3072;
    float4 v[4];
    float ss = 0.f;
#pragma unroll
    for (int i = 0; i < 4; ++i) {
      v[i] = layer ? load_bf4(xb + i * 256 + lane * 4) : *(const float4*)(x + i * 256 + lane * 4);
      ss += v[i].x * v[i].x + v[i].y * v[i].y + v[i].z * v[i].z + v[i].w * v[i].w;
    }
    ss = wave_sum(ss);
    const float r = rsqrtf(ss * (1.f / 1024.f) + EPSF);
#pragma unroll
    for (int i = 0; i < 4; ++i) {
      const int col = i * 256 + lane * 4;
      const float4 gg = *(const float4*)(g + col), sh = *(const float4*)(md + col), sc = *(const float4*)(md + 1024 + col);
      uint2 o;
      o.x = pack2(v[i].x * r * gg.x * (1.f + sc.x) + sh.x, v[i].y * r * gg.y * (1.f + sc.y) + sh.y);
      o.y = pack2(v[i].z * r * gg.z * (1.f + sc.z) + sh.z, v[i].w * r * gg.w * (1.f + sc.w) + sh.w);
      *(uint2*)(p.H + (size_t)row * 1024 + col) = o;
    }
  }
}


DI void phase_gemm_in(const Params& p, int layer, char* smem) {
  const int N = layer ? OIN : EIN;
  const int Npad = layer ? OIN_PAD : EIN_PAD;
  pg8::Gemm g;
  g.A = p.H; g.Bt = layer ? p.WinO : p.WinE; g.M = NROW; g.N = Npad; g.K = 1024;
  pg8::StaticOrder S;
  S.init(NROW, Npad, (int)gridDim.x, (int)blockIdx.x);
  EpiU E;
  E.U = layer ? p.U1 : p.U0; E.ldu = N; E.nvalid = N; E.aux = layer ? p.out + O_DK : nullptr;
  pg8::gemm_phase<EpiU, pg8::StaticOrder, false>((PG8_LAS unsigned char*)smem, g, S, E, nullptr);
}

DI void phase_gemm_out(const Params& p, int layer, char* smem) {
  const bf16_t* W = layer ? p.WoutO : p.WoutE;
  for (int it = VBLK; it < 48 * 8; it += NVBLK) {
    const int mt = it % 48, nt = it / 48;
    gemm_tile64(p.O, 1024, W, 1024, 1024, 1024, mt * 128, nt * 128, smem,
              [=](int m, int n, f32x4 v) {
                const float4 gt = *(const float4*)(p.MOD + (layer * 3 + cv_of_row(m)) * 3072 + 2048 + n);
                const float4 xv = layer ? load_bf4(p.X1B + (size_t)m * 1024 + n) : *(const float4*)(xrow(p, m) + n);
                f32x4 r;
                r[0] = xv.x + gt.x * v[0]; r[1] = xv.y + gt.y * v[1]; r[2] = xv.z + gt.z * v[2]; r[3] = xv.w + gt.w * v[3];
                store_bf4(p.X1B + (size_t)m * 1024 + n, r);
              });
  }
}

DI void phase_out_norm_fused(const Params& p, int layer, char* smem) {
  const int tid = TIDX, lane = tid & 63, wave = tid >> 6, wm = wave >> 1, wn = wave & 1, g = lane >> 4, l16 = lane & 15;
  float* sSS = (float*)(smem + 65536);
  float* sR = sSS + 256;
  for (int it = VBLK; it < 48 * 8; it += NVBLK) {
    const int mt = it % 48, nt = it / 48, m0 = mt * 128, n0 = nt * 128;
    f32x4 acc[4][4];
    gemm_tile64_acc(p.O, 1024, layer ? p.WoutO : p.WoutE, 1024, 1024, 1024, m0, n0, smem, acc);
    float* ssq_slots = p.SSQ + (size_t)layer * NROW * 8;
    unsigned* cnt_base = p.CNT + layer * 48 * 64;
    float ssq[4];
#pragma unroll
    for (int mi = 0; mi < 4; ++mi) {
      const int row = m0 + wm * 64 + mi * 16 + l16;
      const float* gp = p.MOD + (layer * 3 + cv_of_row(row)) * 3072 + 2048;
      ssq[mi] = 0.f;
#pragma unroll
      for (int ni = 0; ni < 4; ++ni) {
        const int n = n0 + wn * 64 + ni * 16 + g * 4;
        const float4 gt = *(const float4*)(gp + n);
        const float4 xv = layer ? load_bf4(p.X1B + (size_t)row * 1024 + n) : *(const float4*)(xrow(p, row) + n);
        f32x4 r;
        r[0] = xv.x + gt.x * acc[ni][mi][0]; r[1] = xv.y + gt.y * acc[ni][mi][1]; r[2] = xv.z + gt.z * acc[ni][mi][2]; r[3] = xv.w + gt.w * acc[ni][mi][3];
        acc[ni][mi] = r;
        if (!layer) store_bf4(p.X1B + (size_t)row * 1024 + n, r);
        ssq[mi] += r[0] * r[0] + r[1] * r[1] + r[2] * r[2] + r[3] * r[3];
      }
      ssq[mi] += __shfl_xor(ssq[mi], 16); ssq[mi] += __shfl_xor(ssq[mi], 32);
    }
    if (g == 0) {
#pragma unroll
      for (int mi = 0; mi < 4; ++mi) sSS[wn * 128 + wm * 64 + mi * 16 + l16] = ssq[mi];
    }
    __syncthreads();
    if (tid < 128) __hip_atomic_store(ssq_slots + (size_t)(m0 + tid) * 8 + nt, sSS[tid] + sSS[128 + tid], __ATOMIC_RELAXED, __HIP_MEMORY_SCOPE_AGENT);
    asm volatile("s_waitcnt vmcnt(0)" ::: "memory");
    __syncthreads();
    if (tid == 0) {
      unsigned* cnt = cnt_base + mt * 64;
      __hip_atomic_fetch_add(cnt, 1u, __ATOMIC_RELAXED, __HIP_MEMORY_SCOPE_AGENT);
      unsigned sp = 0;
      while (__hip_atomic_load(cnt, __ATOMIC_RELAXED, __HIP_MEMORY_SCOPE_AGENT) < 8u) {
        __builtin_amdgcn_s_sleep(1);
        if (++sp > (1u << 22)) break;
      }
      asm volatile("" ::: "memory");
    }
    __syncthreads();
    if (tid < 128) {
      const float* sl = ssq_slots + (size_t)(m0 + tid) * 8;
      float t = 0.f;
#pragma unroll
      for (int q = 0; q < 8; ++q) t += __hip_atomic_load(sl + q, __ATOMIC_RELAXED, __HIP_MEMORY_SCOPE_AGENT);
      sR[tid] = rsqrtf(t * (1.f / 1024.f) + EPSF);
    }
    __syncthreads();
#pragma unroll
    for (int mi = 0; mi < 4; ++mi) {
      const int rl = wm * 64 + mi * 16 + l16;
      const float r = sR[rl];
      float* op = p.out + O_Y + (size_t)(m0 + rl) * 1024;
      const float* md = p.MOD + (3 + cv_of_row(m0 + rl)) * 3072;
#pragma unroll
      for (int ni = 0; ni < 4; ++ni) {
        const int n = n0 + wn * 64 + ni * 16 + g * 4;
        if (layer) {
          const float4 gg = *(const float4*)(p.final_g + n);
          *(float4*)(op + n) = make_float4(acc[ni][mi][0] * r * gg.x, acc[ni][mi][1] * r * gg.y, acc[ni][mi][2] * r * gg.z, acc[ni][mi][3] * r * gg.w);
        } else {
          const float4 gg = *(const float4*)(p.o_norm_g + n), sh = *(const float4*)(md + n), sc = *(const float4*)(md + 1024 + n);
          f32x4 hv;
          hv[0] = acc[ni][mi][0] * r * gg.x * (1.f + sc.x) + sh.x; hv[1] = acc[ni][mi][1] * r * gg.y * (1.f + sc.y) + sh.y;
          hv[2] = acc[ni][mi][2] * r * gg.z * (1.f + sc.z) + sh.z; hv[3] = acc[ni][mi][3] * r * gg.w * (1.f + sc.w) + sh.w;
          store_bf4(p.H + (size_t)(m0 + rl) * 1024 + n, hv);
        }
      }
    }
  }
}

DI void phase_gemm_mla(const Params& p, char* smem) {
  const int G = (int)gridDim.x, bid = (int)blockIdx.x;
  const bool split = G >= 176;
  if (!split || bid < 72) {
    pg8::Gemm g;
    g.A = p.CQN; g.Bt = p.Wuq; g.M = NROW; g.N = 768; g.K = 384;
    pg8::StaticOrder S;
    S.init(NROW, 768, G, bid);
    EpiU E;
    E.U = p.Q; E.ldu = 768; E.nvalid = 768; E.aux = nullptr;
    pg8::gemm_phase<EpiU, pg8::StaticOrder, false>((PG8_LAS unsigned char*)smem, g, S, E, nullptr);
  }
  if (!split || bid >= 72) {
    pg8::Gemm g;
    g.A = p.CKVN; g.Bt = p.Wukv; g.M = NTROW; g.N = 1024; g.K = 256;
    pg8::StaticOrder S;
    S.init(NTROW, 1024, G, split ? bid - 72 : bid);
    EpiU E;
    E.U = p.KV; E.ldu = 1024; E.nvalid = 1024; E.aux = nullptr;
    pg8::gemm_phase<EpiU, pg8::StaticOrder, false>((PG8_LAS unsigned char*)smem, g, S, E, nullptr);
  }
}

struct TRow { int row, pos, cb, ct; bool cache, lat; };
DI TRow decode_trow(int trow) {
  TRow t; t.row = -1; t.pos = 0; t.cb = 0; t.ct = 0; t.cache = false; t.lat = false;
  if (trow < 4096) { t.row = trow; }
  else {
    const int r = trow - 4096; const int b = r / 1280, tt = r % 1280;
    t.lat = true;
    if (tt < 256) { t.cache = true; t.cb = b; t.ct = tt; }
    else { t.pos = tt - 256; t.row = 4096 + b * 1024 + t.pos; }
  }
  return t;
}
DI void cvt_store4(bf16_t* dst, const float* src) {
  const float4 v = *(const float4*)src;
  uint2 o; o.x = pack2(v.x, v.y); o.y = pack2(v.z, v.w);
  *(uint2*)dst = o;
}

DI void phase3(const Params& p) {
  const int tid = TIDX, lane = tid & 63, wave = tid >> 6;
  for (int it = VBLK; it < NTROW / 4; it += NVBLK) {
    const int trow = it * 4 + wave;
    const TRow t = decode_trow(trow);
    if (t.cache) {
      const size_t ci = (size_t)t.cb * 256 + t.ct;
      cvt_store4(p.CKVN + (size_t)trow * 256 + lane * 4, p.cache_ckv + ci * 256 + lane * 4);
      if (lane < 8) cvt_store4(p.KR + (size_t)trow * 32 + lane * 4, p.cache_kr + ci * 32 + lane * 4);
      if (lane < 32) {
        cvt_store4(p.KB + (size_t)trow * 128 + lane * 4, p.cache_gk + ci * 128 + lane * 4);
        cvt_store4(p.VB + (size_t)trow * 128 + lane * 4, p.cache_gv + ci * 128 + lane * 4);
      }
      continue;
    }
    const int row = t.row;
    const bf16_t* u = p.U0 + (size_t)row * EIN;
    {
      float x[6]; float ss = 0.f;
#pragma unroll
      for (int i = 0; i < 3; ++i) {
        const unsigned w = *(const unsigned*)(u + i * 128 + lane * 2);
        x[2 * i] = lo2f(w); x[2 * i + 1] = hi2f(w);
        ss += x[2 * i] * x[2 * i] + x[2 * i + 1] * x[2 * i + 1];
      }
      ss = wave_sum(ss);
      const float r = rsqrtf(ss * (1.f / 384.f) + EPSF);
#pragma unroll
      for (int i = 0; i < 3; ++i) {
        const int col = i * 128 + lane * 2;
        *(unsigned*)(p.CQN + (size_t)row * 384 + col) = pack2(x[2 * i] * r * p.e_qn_g[col], x[2 * i + 1] * r * p.e_qn_g[col + 1]);
      }
    }
    {
      const uint2 w = *(const uint2*)(u + 384 + lane * 4);
      float x0 = lo2f(w.x), x1 = hi2f(w.x), x2 = lo2f(w.y), x3 = hi2f(w.y);
      float ss = wave_sum(x0 * x0 + x1 * x1 + x2 * x2 + x3 * x3);
      const float r = rsqrtf(ss * (1.f / 256.f) + EPSF);
      const float4 gg = *(const float4*)(p.e_kvn_g + lane * 4);
      x0 *= r * gg.x; x1 *= r * gg.y; x2 *= r * gg.z; x3 *= r * gg.w;
      uint2 o; o.x = pack2(x0, x1); o.y = pack2(x2, x3);
      *(uint2*)(p.CKVN + (size_t)trow * 256 + lane * 4) = o;
      if (!t.lat) *(float4*)(p.out + O_CKV + (size_t)row * 256 + lane * 4) = make_float4(x0, x1, x2, x3);
    }
    if (lane < 16) {
      const unsigned w = *(const unsigned*)(u + 640 + lane * 2);
      float x0 = lo2f(w), x1 = hi2f(w);
      if (t.lat) {
        const float2 cs = p.ROPE32[t.pos * 16 + lane];
        const float y0 = x0 * cs.x - x1 * cs.y, y1 = x0 * cs.y + x1 * cs.x;
        x0 = y0; x1 = y1;
      } else {
        *(float2*)(p.out + O_KR + (size_t)row * 32 + lane * 2) = make_float2(x0, x1);
      }
      *(unsigned*)(p.KR + (size_t)trow * 32 + lane * 2) = pack2(x0, x1);
    }
#pragma unroll
    for (int which = 0; which < 2; ++which) {
      const int lsrc = which ? (lane & 15) : lane;
      const uint4 w = *(const uint4*)(u + (which ? 1696 : 1184) + lsrc * 8);
      float x[8] = {lo2f(w.x), hi2f(w.x), lo2f(w.y), hi2f(w.y), lo2f(w.z), hi2f(w.z), lo2f(w.w), hi2f(w.w)};
      float ss = 0.f;
#pragma unroll
      for (int j = 0; j < 8; ++j) ss += x[j] * x[j];
      ss += __shfl_xor(ss, 1); ss += __shfl_xor(ss, 2); ss += __shfl_xor(ss, 4);
      const float r = rsqrtf(ss * (1.f / 64.f) + EPSF);
      const float* gp = (which ? p.e_gk_g : p.e_gq_g) + (lane & 7) * 8;
#pragma unroll
      for (int j = 0; j < 8; ++j) x[j] *= r * gp[j];
      if (t.lat) {
#pragma unroll
        for (int jj = 0; jj < 4; ++jj) {
          const float2 cs = p.ROPE64[t.pos * 32 + (lane & 7) * 4 + jj];
          const float y0 = x[2 * jj] * cs.x - x[2 * jj + 1] * cs.y, y1 = x[2 * jj] * cs.y + x[2 * jj + 1] * cs.x;
          x[2 * jj] = y0; x[2 * jj + 1] = y1;
        }
      }
      uint4 o; o.x = pack2(x[0], x[1]); o.y = pack2(x[2], x[3]); o.z = pack2(x[4], x[5]); o.w = pack2(x[6], x[7]);
      if (which == 0) {
        *(uint4*)(p.QB + (size_t)row * 512 + lane * 8) = o;
      } else if (lane < 16) {
        *(uint4*)(p.KB + (size_t)trow * 128 + lane * 8) = o;
        if (!t.lat) {
          float* op = p.out + O_GK + (size_t)row * 128 + lane * 8;
          *(float4*)op = make_float4(x[0], x[1], x[2], x[3]);
          *(float4*)(op + 4) = make_float4(x[4], x[5], x[6], x[7]);
        }
      }
    }
    if (lane < 16) {
      const uint4 w = *(const uint4*)(u + 1824 + lane * 8);
      *(uint4*)(p.VB + (size_t)trow * 128 + lane * 8) = w;
      if (!t.lat) {
        float* op = p.out + O_GV + (size_t)row * 128 + lane * 8;
        *(float4*)op = make_float4(lo2f(w.x), hi2f(w.x), lo2f(w.y), hi2f(w.y));
        *(float4*)(op + 4) = make_float4(lo2f(w.z), hi2f(w.z), lo2f(w.w), hi2f(w.w));
      }
    }
  }
}

DI void phase_attn0(const Params& p, char* smem) {
  const int lane = TIDX & 63, wave = TIDX >> 6, g = lane >> 4, l16 = lane & 15;
  for (int it = vblk_xcd(); it < 1536; it += NVBLK) {
    int kind, b, h, qb, row0, trow0, T;
    if (it < 512) { const int i = it & 255; kind = it >> 8; b = i >> 7; h = (i >> 4) & 7; qb = i & 15; row0 = 4096 + b * 1024 + qb * 64; trow0 = 4096 + b * 1280; T = 1280; }
    else { const int i2 = it - 512; kind = i2 >> 9; const int i = i2 & 511; b = i >> 5; h = (i >> 2) & 7; qb = i & 3; row0 = b * 256 + qb * 64; trow0 = b * 256; T = 256; }
    f32x4 oo[1][4];
    float lss[1], mss[1];
    int gcol, ocol;
    const int row = row0 + wave * 16 + l16;
    uint2 gwv[4];
    {
      const int gc = kind == 0 ? 672 + h * 64 : 1952 + h * 64;
#pragma unroll
      for (int i = 0; i < 4; ++i) gwv[i] = *(const uint2*)(p.U0 + (size_t)row * EIN + gc + i * 16 + g * 4);
    }
    if (kind == 0) {
      attn_core<96, 64, false>(smem, p.Q + (size_t)row0 * 768 + h * 96, 768, p.KV + (size_t)trow0 * 1024 + h * 128, 1024,
                        p.KR + (size_t)trow0 * 32, 32, p.KV + (size_t)trow0 * 1024 + h * 128 + 64, 1024, T,
                        0.10206207261596575f * 1.4426950408889634f, oo, lss, mss,
                        it < 512 ? p.ROPE32 + (size_t)(qb * 64) * 16 : nullptr);
      gcol = 672 + h * 64; ocol = h * 64;
    } else {
      const int kvh = h >> 2;
      attn_core<64, 64, false>(smem, p.QB + (size_t)row0 * 512 + h * 64, 512, p.KB + (size_t)trow0 * 128 + kvh * 64, 128,
                        nullptr, 0, p.VB + (size_t)trow0 * 128 + kvh * 64, 128, T, 0.125f * 1.4426950408889634f, oo, lss, mss);
      gcol = 1952 + h * 64; ocol = 512 + h * 64;
    }
    float ls = lss[0];
    ls += __shfl_xor(ls, 16); ls += __shfl_xor(ls, 32);
    const float inv = 1.f / ls;
    f32x4 (&o)[4] = oo[0];
#pragma unroll
    for (int i = 0; i < 4; ++i) {
      const int dv = i * 16 + g * 4;
      const uint2 gw = gwv[i];
      f32x4 r;
      r[0] = o[i][0] * inv * siluf(lo2f(gw.x)); r[1] = o[i][1] * inv * siluf(hi2f(gw.x));
      r[2] = o[i][2] * inv * siluf(lo2f(gw.y)); r[3] = o[i][3] * inv * siluf(hi2f(gw.y));
      store_bf4(p.O + (size_t)row * 1024 + ocol + dv, r);
    }
  }
}

DI void mlstm_gates(const Params& p, int rowbase, int nc, int h, int dir, int j, int lane, float& ig, float& lf) {
  const int oc = dir ? nc - 1 - j : j;
  const int s = dir ? 63 - lane : lane;
  const int row = rowbase + oc * 64 + s;
  const bf16_t* up = p.U1 + (size_t)row * OIN + 2048;
  ig = bf2f(up[dir * 8 + h]) + p.o_gate_b[dir * 8 + h];
  lf = logsig(bf2f(up[dir * 8 + 4 + h]) + p.o_gate_b[dir * 8 + 4 + h]);
}
DI void mitem_decode(int it, int& sq, int& h, int& dir, int& j, int& nc, int& rowbase) {
  if (it < 512) { j = it & 3; dir = (it >> 2) & 1; h = (it >> 3) & 3; sq = it >> 5; nc = 4; rowbase = sq * 256; }
  else { const int i = it - 512; j = i & 15; dir = (i >> 4) & 1; h = (i >> 5) & 3; sq = 16 + (i >> 7); nc = 16; rowbase = 4096 + (sq - 16) * 1024; }
}
DI int mitem_id(int sq, int h, int dir, int j) {
  return sq < 16 ? (((sq * 4 + h) * 2 + dir) * 4 + j) : (512 + ((((sq - 16) * 4 + h) * 2 + dir) * 16 + j));
}

DI void phase9(const Params& p, char* smem) {
  const int tid = TIDX, lane = tid & 63, wave = tid >> 6, g = lane >> 4, l16 = lane & 15;
  for (int it = VBLK; it < NTROW / 4; it += NVBLK) {
    const int trow = it * 4 + wave;
    const TRow t = decode_trow(trow);
    if (t.cache) {
      const size_t ci = (size_t)t.cb * 256 + t.ct;
      cvt_store4(p.KD + (size_t)trow * 512 + lane * 8, p.cache_dk + ci * 512 + lane * 8);
      cvt_store4(p.KD + (size_t)trow * 512 + lane * 8 + 4, p.cache_dk + ci * 512 + lane * 8 + 4);
      cvt_store4(p.VD + (size_t)trow * 512 + lane * 8, p.cache_dv + ci * 512 + lane * 8);
      cvt_store4(p.VD + (size_t)trow * 512 + lane * 8 + 4, p.cache_dv + ci * 512 + lane * 8 + 4);
      continue;
    }
    if (!t.lat) continue;
    const int row = t.row;
    const bf16_t* u = p.U1 + (size_t)row * OIN;
#pragma unroll
    for (int which = 0; which < 2; ++which) {
      const uint4 w = *(const uint4*)(u + (which ? 3088 : 2576) + lane * 8);
      float x[8] = {lo2f(w.x), hi2f(w.x), lo2f(w.y), hi2f(w.y), lo2f(w.z), hi2f(w.z), lo2f(w.w), hi2f(w.w)};
      if (t.lat) {
#pragma unroll
        for (int jj = 0; jj < 4; ++jj) {
          const float2 cs = p.ROPE64[t.pos * 32 + (lane & 7) * 4 + jj];
          const float y0 = x[2 * jj] * cs.x - x[2 * jj + 1] * cs.y, y1 = x[2 * jj] * cs.y + x[2 * jj + 1] * cs.x;
          x[2 * jj] = y0; x[2 * jj + 1] = y1;
        }
      }
      uint4 o; o.x = pack2(x[0], x[1]); o.y = pack2(x[2], x[3]); o.z = pack2(x[4], x[5]); o.w = pack2(x[6], x[7]);
      if (which == 0) { if (t.lat) *(uint4*)(p.QD + (size_t)row * 512 + lane * 8) = o; }
      else {
        if (t.lat) *(uint4*)(p.KD + (size_t)trow * 512 + lane * 8) = o;
        if (!t.lat) {
          float* op = p.out + O_DK + (size_t)row * 512 + lane * 8;
          *(float4*)op = make_float4(x[0], x[1], x[2], x[3]);
          *(float4*)(op + 4) = make_float4(x[4], x[5], x[6], x[7]);
        }
      }
    }
    {
      const uint4 w = *(const uint4*)(u + 3600 + lane * 8);
      if (t.lat) *(uint4*)(p.VD + (size_t)trow * 512 + lane * 8) = w;
      if (!t.lat) {
        float* op = p.out + O_DV + (size_t)row * 512 + lane * 8;
        *(float4*)op = make_float4(lo2f(w.x), hi2f(w.x), lo2f(w.y), hi2f(w.y));
        *(float4*)(op + 4) = make_float4(lo2f(w.z), hi2f(w.z), lo2f(w.w), hi2f(w.w));
      }
    }
  }
  bf16_t* sKT = (bf16_t*)smem;
  bf16_t* sVT = sKT + 128 * LDT;
  float* swk = (float*)(sVT + 128 * LDT);
  for (int it = VBLK; it < 768; it += NVBLK) {
    int sq, h, dir, j, nc, rowbase;
    mitem_decode(it, sq, h, dir, j, nc, rowbase);
    float ig, lf;
    mlstm_gates(p, rowbase, nc, h, dir, j, lane, ig, lf);
    const float b = scan_add(lf, lane);
    const float bL = __shfl(b, 63);
    const float mx = wave_max(bL - b + ig);
    const float wk = fexp(bL - b + ig - mx);
    __syncthreads();
    if (wave == 0) {
      swk[dir ? 63 - lane : lane] = wk;
      if (lane == 0) { p.SC[it * 4 + 0] = bL; p.SC[it * 4 + 1] = mx; }
    }
    __syncthreads();
    const int oc = dir ? nc - 1 - j : j;
    const int row0 = rowbase + oc * 64;
    stage_T64<128>(sKT, p.U1 + (size_t)row0 * OIN + 512 + h * 128, OIN, nullptr);
    stage_T64<128>(sVT, p.U1 + (size_t)row0 * OIN + 1024 + h * 128, OIN, swk);
    __syncthreads();
    f32x4 acc[2][8];
#pragma unroll
    for (int a = 0; a < 2; ++a)
#pragma unroll
      for (int c = 0; c < 8; ++c) acc[a][c] = f32x4{0.f, 0.f, 0.f, 0.f};
#pragma unroll
    for (int ks = 0; ks < 2; ++ks) {
      bf16x8 vf[2];
#pragma unroll
      for (int a = 0; a < 2; ++a) vf[a] = *(const bf16x8*)(sVT + ((wave * 2 + a) * 16 + l16) * LDT + ks * 32 + g * 8);
#pragma unroll
      for (int kt = 0; kt < 8; ++kt) {
        const bf16x8 kf = *(const bf16x8*)(sKT + (kt * 16 + l16) * LDT + ks * 32 + g * 8);
#pragma unroll
        for (int a = 0; a < 2; ++a) acc[a][kt] = MFMA16(kf, vf[a], acc[a][kt]);
      }
    }
    bf16_t* uc = p.UC + (size_t)it * 16384;
#pragma unroll
    for (int a = 0; a < 2; ++a)
#pragma unroll
      for (int kt = 0; kt < 8; ++kt) {
        const int v = (wave * 2 + a) * 16 + l16, k = kt * 16 + g * 4;
        store_bf4(uc + v * 128 + k, acc[a][kt]);
      }
    if (tid < 128) {
      float s = 0.f;
#pragma unroll
      for (int c8 = 0; c8 < 8; ++c8) {
        const u32x4 kw = *(const u32x4*)(sKT + tid * LDT + c8 * 8);
        const float4 w0 = *(const float4*)(swk + c8 * 8), w1 = *(const float4*)(swk + c8 * 8 + 4);
        s += lo2f(kw[0]) * w0.x + hi2f(kw[0]) * w0.y + lo2f(kw[1]) * w0.z + hi2f(kw[1]) * w0.w
           + lo2f(kw[2]) * w1.x + hi2f(kw[2]) * w1.y + lo2f(kw[3]) * w1.z + hi2f(kw[3]) * w1.w;
      }
      p.NU[it * 128 + tid] = s;
    }
  }
}

DI void diff_finish(const Params& p, f32x4 (&o1)[8], f32x4 (&o2)[8], float l1, float l2, int row0, int hd) {
  const int lane = TIDX & 63, wave = TIDX >> 6, g = lane >> 4, l16 = lane & 15;
  l1 += __shfl_xor(l1, 16); l1 += __shfl_xor(l1, 32);
  l2 += __shfl_xor(l2, 16); l2 += __shfl_xor(l2, 32);
  const float i1 = 1.f / l1, i2 = p.LAMV[0] / l2;
  float ss = 0.f;
#pragma unroll
  for (int i = 0; i < 8; ++i)
#pragma unroll
    for (int j = 0; j < 4; ++j) { o1[i][j] = o1[i][j] * i1 - o2[i][j] * i2; ss += o1[i][j] * o1[i][j]; }
  ss += __shfl_xor(ss, 16); ss += __shfl_xor(ss, 32);
  const float r = rsqrtf(ss * (1.f / 128.f) + EPSF) * (1.f - LAM_INIT);
  const int row = row0 + wave * 16 + l16;
#pragma unroll
  for (int i = 0; i < 8; ++i) {
    const int dv = i * 16 + g * 4;
    const uint2 gw = *(const uint2*)(p.U1 + (size_t)row * OIN + 4112 + hd * 128 + dv);
    const float4 gn = *(const float4*)(p.o_dnorm_g + dv);
    f32x4 rr;
    rr[0] = o1[i][0] * r * gn.x * siluf(lo2f(gw.x)); rr[1] = o1[i][1] * r * gn.y * siluf(hi2f(gw.x));
    rr[2] = o1[i][2] * r * gn.z * siluf(lo2f(gw.y)); rr[3] = o1[i][3] * r * gn.w * siluf(hi2f(gw.y));
    store_bf4(p.O + (size_t)row * 1024 + 512 + hd * 128 + dv, rr);
  }
}

DI void phase10(const Params& p, char* smem) {
  const int tid = TIDX, lane = tid & 63, wave = tid >> 6, g = lane >> 4, l16 = lane & 15;
  for (int it = vblk_xcd(); it < 512; it += NVBLK) {
    int b, hd, qb, row0, trow0, T;
    const bool lat = it < 256;
    const int split = (it >> 1) & 1;
    const int li = ((it >> 7) * 4 + ((it >> 5) & 3)) * 16 + ((it >> 2) & 7) * 2 + (it & 1);
    if (lat) { b = li >> 6; hd = (li >> 4) & 3; qb = li & 15; row0 = 4096 + b * 1024 + qb * 64; trow0 = 4096 + b * 1280 + split * 640; T = 640; }
    else { const int i = it - 256; b = i >> 4; hd = (i >> 2) & 3; qb = i & 3; row0 = b * 256 + qb * 64; trow0 = b * 256; T = 256; }
    f32x4 od[2][8];
    float ld2[2], md2[2];
    const float sc = 0.125f * 1.4426950408889634f;
    const bf16_t* qp = lat ? p.QD + (size_t)row0 * 512 + hd * 128 : p.U1 + (size_t)row0 * OIN + 2576 + hd * 128;
    const bf16_t* kp = lat ? p.KD + (size_t)trow0 * 512 + hd * 128 : p.U1 + (size_t)trow0 * OIN + 3088 + hd * 128;
    const bf16_t* vp = lat ? p.VD + (size_t)trow0 * 512 + hd * 128 : p.U1 + (size_t)trow0 * OIN + 3600 + hd * 128;
    const int ldqkv = lat ? 512 : OIN;
    attn_core<64, 128, true>(smem, qp, ldqkv, kp, ldqkv, nullptr, 0, vp, ldqkv, T, sc, od, ld2, md2);
    if (lat) {
#pragma unroll
      for (int n = 0; n < 2; ++n) {
        const size_t base = (size_t)((li * 2 + split) * 2 + n) * 4 + wave;
#pragma unroll
        for (int i = 0; i < 8; ++i) store_bf4(p.OP + ((base * 8 + i) * 64 + lane) * 4, od[n][i]);
        *(float2*)(p.ML + (base * 64 + lane) * 2) = make_float2(md2[n], ld2[n]);
      }
    } else {
      diff_finish(p, od[0], od[1], ld2[0], ld2[1], row0, hd);
    }
  }
  const int vb = (vblk_xcd() + (NVBLK >> 1)) % NVBLK;
  for (int it = vb; it < 144 * 16; it += NVBLK) {
    const int chain = it < 256 ? 128 + (it >> 4) : ((it - 256) >> 4), eb = it & 15;
    const int sq = chain >> 3, h = (chain >> 1) & 3, dir = chain & 1;
    const int nc = sq < 16 ? 4 : 16;
    const int ib = mitem_id(sq, h, dir, 0);
    const int e = eb * 1024 + tid * 4;
    float4 C = make_float4(0.f, 0.f, 0.f, 0.f);
    if (sq >= 16) C = *(const float4*)(p.st_C + (size_t)(((sq - 16) * 2 + dir) * 4 + h) * 16384 + e);
    float4 uu[16];
    float dcs[16], scl[16], bLs[16], mxs[16];
#pragma unroll
    for (int j = 0; j < 16; ++j) {
      if (j < nc) { bLs[j] = p.SC[(ib + j) * 4 + 0]; mxs[j] = p.SC[(ib + j) * 4 + 1]; uu[j] = load_bf4(p.UC + (size_t)(ib + j) * 16384 + e); }
    }
    float mrun = 0.f;
    if (sq >= 16) mrun = p.st_m[((sq - 16) * 2 + dir) * 4 + h];
#pragma unroll
    for (int j = 0; j < 16; ++j) {
      if (j < nc) {
        const float mnext = fmaxf(bLs[j] + mrun, mxs[j]);
        dcs[j] = fexp(bLs[j] + mrun - mnext);
        scl[j] = fexp(mxs[j] - mnext);
        if (eb == 0 && tid == 0) p.SCM[ib + j] = mrun;
        mrun = mnext;
      }
    }
#pragma unroll
    for (int j = 0; j < 16; ++j) {
      if (j < nc) {
        uint2 o; o.x = pack2(C.x, C.y); o.y = pack2(C.z, C.w);
        *(uint2*)(p.CST + (size_t)(ib + j) * 16384 + e) = o;
        const float dc = dcs[j], sc = scl[j];
        C.x = dc * C.x + sc * uu[j].x; C.y = dc * C.y + sc * uu[j].y; C.z = dc * C.z + sc * uu[j].z; C.w = dc * C.w + sc * uu[j].w;
      }
    }
    if (sq < 16) *(float4*)(p.out + O_C + (size_t)((sq * 2 + dir) * 4 + h) * 16384 + e) = C;
    if (eb == 0 && tid < 128) {
      float n = 0.f;
      if (sq >= 16) n = p.st_n[(((sq - 16) * 2 + dir) * 4 + h) * 128 + tid];
#pragma unroll
      for (int j = 0; j < 16; ++j) {
        if (j < nc) {
          p.NST[(ib + j) * 128 + tid] = n;
          n = dcs[j] * n + scl[j] * p.NU[(ib + j) * 128 + tid];
        }
      }
      if (sq < 16) {
        p.out[O_N + ((sq * 2 + dir) * 4 + h) * 128 + tid] = n;
        if (tid == 0) p.out[O_M + (sq * 2 + dir) * 4 + h] = mrun;
      }
    }
  }
}

DI void phase11(const Params& p, char* smem) {
  const int tid = TIDX, lane = tid & 63, wave = tid >> 6, g = lane >> 4, l16 = lane & 15;
  bf16_t* sK = (bf16_t*)smem;
  bf16_t* sVT = sK + 64 * 128;
  float* sB = (float*)(sVT + 128 * LDT);
  float* sA = sB + 128;
  float* sMT = sA + 128;
  bf16_t* sC = (bf16_t*)(smem + 36352);
  for (int it = VBLK; it < 512; it += NVBLK) {
    if (it >= 384) {
    const int li = it - 384;
    const int b = li >> 6, hd = (li >> 4) & 3, qb = li & 15, row0 = 4096 + b * 1024 + qb * 64;
    f32x4 oc[2][8];
    float lc[2];
#pragma unroll
    for (int n = 0; n < 2; ++n) {
      const size_t b0 = (size_t)((li * 2 + 0) * 2 + n) * 4 + wave, b1 = (size_t)((li * 2 + 1) * 2 + n) * 4 + wave;
      const float2 ml0 = *(const float2*)(p.ML + (b0 * 64 + lane) * 2), ml1 = *(const float2*)(p.ML + (b1 * 64 + lane) * 2);
      const float m = fmaxf(ml0.x, ml1.x);
      const float f0 = __builtin_amdgcn_exp2f((ml0.x - m) * (0.125f * 1.4426950408889634f)), f1 = __builtin_amdgcn_exp2f((ml1.x - m) * (0.125f * 1.4426950408889634f));
      lc[n] = ml0.y * f0 + ml1.y * f1;
#pragma unroll
      for (int i = 0; i < 8; ++i) {
        const float4 a0 = load_bf4(p.OP + ((b0 * 8 + i) * 64 + lane) * 4), a1 = load_bf4(p.OP + ((b1 * 8 + i) * 64 + lane) * 4);
        oc[n][i] = f32x4{a0.x * f0 + a1.x * f1, a0.y * f0 + a1.y * f1, a0.z * f0 + a1.z * f1, a0.w * f0 + a1.w * f1};
      }
    }
    diff_finish(p, oc[0], oc[1], lc[0], lc[1], row0, hd);
    continue;
    }
    int sq, h, c, nc, rowbase;
    if (it < 128) { sq = 16 + (it >> 6); h = (it >> 4) & 3; c = it & 15; nc = 16; rowbase = 4096 + (sq - 16) * 1024; }
    else { const int i = it - 128; sq = i >> 4; h = (i >> 2) & 3; c = i & 3; nc = 4; rowbase = sq * 256; }
    const int row0 = rowbase + c * 64;
    float mst[2];
    int item[2];
    item[0] = mitem_id(sq, h, 0, c);
    item[1] = mitem_id(sq, h, 1, nc - 1 - c);
    u32x4 cr[8];
    {
      const bf16_t* cst0 = p.CST + (size_t)item[0] * 16384;
#pragma unroll
      for (int i = 0; i < 8; ++i) cr[i] = *(const u32x4*)(cst0 + (tid + 256 * i) * 8);
    }
    __syncthreads();
#pragma unroll
    for (int dir = 0; dir < 2; ++dir) {
      const int j = dir ? nc - 1 - c : c;
      mst[dir] = p.SCM[item[dir]];
      if (wave == 0) {
        float ig, lf;
        mlstm_gates(p, rowbase, nc, h, dir, j, lane, ig, lf);
        const float b = scan_add(lf, lane);
        const float a = ig - b;
        const float pm = scan_max(a, lane);
        const float mt = b + fmaxf(mst[dir], pm);
        const int so = dir ? 63 - lane : lane;
        sB[dir * 64 + so] = b; sA[dir * 64 + so] = a; sMT[dir * 64 + so] = mt;
      }
    }
    for (int c = tid; c < 64 * 16; c += 256) {
      const int r = c >> 4, ch = c & 15;
      *(uint4*)(sK + (ch >> 2) * 2048 + r * 32 + (((ch & 3) ^ ((4 - ((r >> 2) & 3)) & 3)) * 8)) = *(const uint4*)(p.U1 + (size_t)(row0 + r) * OIN + 512 + h * 128 + ch * 8);
    }
    stage_T64<128>(sVT, p.U1 + (size_t)row0 * OIN + 1024 + h * 128, OIN, nullptr);
#pragma unroll
    for (int i = 0; i < 8; ++i) {
      const int cc = tid + 256 * i, r = cc >> 4, ch = cc & 15;
      *(u32x4*)(sC + (ch >> 2) * 4096 + r * 32 + (((ch & 3) ^ ((4 - ((r >> 2) & 3)) & 3)) * 8)) = cr[i];
    }
    bf16x8 qf[4];
    const int tq = wave * 16 + l16;
    const int row = row0 + tq;
#pragma unroll
    for (int ks = 0; ks < 4; ++ks) qf[ks] = *(const bf16x8*)(p.U1 + (size_t)row * OIN + h * 128 + ks * 32 + g * 8);
    __syncthreads();
    f32x4 hsum[8];
#pragma unroll
    for (int i = 0; i < 8; ++i) hsum[i] = f32x4{0.f, 0.f, 0.f, 0.f};
#pragma unroll 1
    for (int dir = 0; dir < 2; ++dir) {
      const float bt = sB[dir * 64 + tq], mtt = sMT[dir * 64 + tq];
      const float mst_d = dir ? mst[1] : mst[0];
      const int item_d = dir ? item[1] : item[0];
      const float w_inter = fexp(bt + mst_d - mtt);
      const float et = bt - mtt;
      if (dir == 0) {
        const bf16_t* cst1 = p.CST + (size_t)item[1] * 16384;
#pragma unroll
        for (int i = 0; i < 8; ++i) cr[i] = *(const u32x4*)(cst1 + (tid + 256 * i) * 8);
      }
      f32x4 s[4];
      float dsum = 0.f;
#pragma unroll
      for (int t = 0; t < 4; ++t) {
        s[t] = f32x4{0.f, 0.f, 0.f, 0.f};
#pragma unroll
        for (int ks = 0; ks < 4; ++ks) {
          const bf16x8 kf = *(const bf16x8*)(sK + ks * 2048 + (t * 16 + l16) * 32 + ((g ^ ((4 - (l16 >> 2)) & 3)) * 8));
          s[t] = MFMA16(kf, qf[ks], s[t]);
        }
#pragma unroll
        for (int j = 0; j < 4; ++j) {
          const int sk = t * 16 + g * 4 + j;
          const bool ok = dir ? (sk >= tq) : (sk <= tq);
          const float w = ok ? fexp(et + sA[dir * 64 + sk]) : 0.f;
          s[t][j] *= w;
          dsum += s[t][j];
        }
      }
      dsum += __shfl_xor(dsum, 16); dsum += __shfl_xor(dsum, 32);
      f32x4 acc[8];
#pragma unroll
      for (int vt = 0; vt < 8; ++vt) {
        acc[vt] = f32x4{0.f, 0.f, 0.f, 0.f};
#pragma unroll
        for (int ks = 0; ks < 4; ++ks) {
          const bf16x8 cf = *(const bf16x8*)(sC + ks * 4096 + (vt * 16 + l16) * 32 + ((g ^ ((4 - (l16 >> 2)) & 3)) * 8));
          acc[vt] = MFMA16(cf, qf[ks], acc[vt]);
        }
        acc[vt] *= w_inter;
        if ((vt & 3) == 3) asm volatile("" ::: "memory");
      }
#pragma unroll
      for (int kb = 0; kb < 2; ++kb) {
        bf16x8 pf;
#pragma unroll
        for (int j = 0; j < 4; ++j) { pf[j] = (short)f2bf(s[2 * kb][j]); pf[4 + j] = (short)f2bf(s[2 * kb + 1][j]); }
#pragma unroll
        for (int vt = 0; vt < 8; ++vt) {
          const bf16_t* vp = sVT + (vt * 16 + l16) * LDT + kb * 32 + g * 4;
          const bf16x4 lo = *(const bf16x4*)(vp);
          const bf16x4 hi = *(const bf16x4*)(vp + 16);
          const bf16x8 vf = __builtin_shufflevector(lo, hi, 0, 1, 2, 3, 4, 5, 6, 7);
          acc[vt] = MFMA16(vf, pf, acc[vt]);
        }
      }
      float nq = 0.f;
      const float* nst = p.NST + (size_t)item_d * 128;
#pragma unroll
      for (int ks = 0; ks < 4; ++ks) {
        const float4 n0 = *(const float4*)(nst + ks * 32 + g * 8), n1 = *(const float4*)(nst + ks * 32 + g * 8 + 4);
        nq += n0.x * bf2f((bf16_t)qf[ks][0]) + n0.y * bf2f((bf16_t)qf[ks][1]) + n0.z * bf2f((bf16_t)qf[ks][2]) + n0.w * bf2f((bf16_t)qf[ks][3]);
        nq += n1.x * bf2f((bf16_t)qf[ks][4]) + n1.y * bf2f((bf16_t)qf[ks][5]) + n1.z * bf2f((bf16_t)qf[ks][6]) + n1.w * bf2f((bf16_t)qf[ks][7]);
      }
      nq += __shfl_xor(nq, 16); nq += __shfl_xor(nq, 32);
      const float den = w_inter * nq + dsum;
      const float dinv = 1.f / fmaxf(fabsf(den), fexp(-mtt));
#pragma unroll
      for (int vt = 0; vt < 8; ++vt) hsum[vt] += acc[vt] * dinv;
      if (dir == 0) {
        __syncthreads();
#pragma unroll
        for (int i = 0; i < 8; ++i) {
          const int cc = tid + 256 * i, r = cc >> 4, ch = cc & 15;
          *(u32x4*)(sC + (ch >> 2) * 4096 + r * 32 + (((ch & 3) ^ ((4 - ((r >> 2) & 3)) & 3)) * 8)) = cr[i];
        }
        __syncthreads();
      }
    }
    const bf16_t* u = p.U1 + (size_t)row * OIN;
    float ss = 0.f;
#pragma unroll
    for (int vt = 0; vt < 8; ++vt) {
      const uint2 ow = *(const uint2*)(u + 1536 + h * 128 + vt * 16 + g * 4);
      hsum[vt][0] *= sigmf(lo2f(ow.x)); hsum[vt][1] *= sigmf(hi2f(ow.x));
      hsum[vt][2] *= sigmf(lo2f(ow.y)); hsum[vt][3] *= sigmf(hi2f(ow.y));
#pragma unroll
      for (int j = 0; j < 4; ++j) ss += hsum[vt][j] * hsum[vt][j];
    }
    ss += __shfl_xor(ss, 16); ss += __shfl_xor(ss, 32);
    const float r = rsqrtf(ss * (1.f / 128.f) + EPSF);
#pragma unroll
    for (int vt = 0; vt < 8; ++vt) {
      const int v = h * 128 + vt * 16 + g * 4;
      const uint2 zw = *(const uint2*)(u + 2064 + v);
      const float4 gn = *(const float4*)(p.o_mnorm_g + v);
      f32x4 rr;
      rr[0] = hsum[vt][0] * r * gn.x * siluf(lo2f(zw.x)); rr[1] = hsum[vt][1] * r * gn.y * siluf(hi2f(zw.x));
      rr[2] = hsum[vt][2] * r * gn.z * siluf(lo2f(zw.y)); rr[3] = hsum[vt][3] * r * gn.w * siluf(hi2f(zw.y));
      store_bf4(p.O + (size_t)row * 1024 + v, rr);
    }
  }
}

DI void phase_final(const Params& p) {
  const int tid = TIDX, lane = tid & 63, wave = tid >> 6;
  for (int it = VBLK; it < NROW / 4; it += NVBLK) {
    const int row = it * 4 + wave;
    const bf16_t* x = p.X1B + (size_t)row * 1024;
    float4 v[4];
    float ss = 0.f;
#pragma unroll
    for (int i = 0; i < 4; ++i) {
      v[i] = load_bf4(x + i * 256 + lane * 4);
      ss += v[i].x * v[i].x + v[i].y * v[i].y + v[i].z * v[i].z + v[i].w * v[i].w;
    }
    ss = wave_sum(ss);
    const float r = rsqrtf(ss * (1.f / 1024.f) + EPSF);
#pragma unroll
    for (int i = 0; i < 4; ++i) {
      const int col = i * 256 + lane * 4;
      const float4 gg = *(const float4*)(p.final_g + col);
      *(float4*)(p.out + O_Y + (size_t)row * 1024 + col) = make_float4(v[i].x * r * gg.x, v[i].y * r * gg.y, v[i].z * r * gg.z, v[i].w * r * gg.w);
    }
  }
}


#define XB_TMO      128
#define XB_XCNT(j)  (256  + 64 * (j))
#define XB_XSUB(j)  (1280 + 64 * (j))
#define XB_XGEN(j)  (2304 + 64 * (j))
#define XB_TOP      3328
#define XB_TOPGEN   3392
#define XCD_BAR_WORDS 3456
#define XB_SPIN_CAP (1u << 18)
#define LAS __attribute__((address_space(3)))
DI unsigned xb_ld(unsigned* p) { return __hip_atomic_load(p, __ATOMIC_RELAXED, __HIP_MEMORY_SCOPE_AGENT); }
DI unsigned xb_add(unsigned* p, unsigned v) { return __hip_atomic_fetch_add(p, v, __ATOMIC_RELAXED, __HIP_MEMORY_SCOPE_AGENT); }
DI unsigned xb_xcc_id() { return (unsigned)__builtin_amdgcn_s_getreg((3 << 11) | 20) & 0xFu; }
#define XB_SPIN(cond, bar) do { unsigned _sp = 0; while (cond) { __builtin_amdgcn_s_sleep(1); \
    if ((++_sp & 255u) == 0u) { if (xb_ld(&(bar)[XB_TMO])) break; if (_sp > XB_SPIN_CAP) { atomicAdd(&(bar)[XB_TMO], 1u); break; } } } } while (0)
struct XcdBarrier { unsigned* bar; unsigned x; volatile LAS unsigned* st; };
DI XcdBarrier xcd_barrier_post(unsigned* bar, volatile LAS unsigned* st) {
  XcdBarrier b; b.bar = bar; b.x = xb_xcc_id(); b.st = st;
  if (threadIdx.x == 0) (void)xb_add(&bar[XB_XCNT(b.x)], 1u);
  return b;
}
DI void xcd_barrier_complete(unsigned* bar, unsigned x, unsigned& nloc, unsigned& nx) {
  const unsigned G = gridDim.x * gridDim.y * gridDim.z;
  unsigned sum, cnt, mine, sp = 0u;
  for (;;) {
    sum = 0u; cnt = 0u; mine = 0u;
#pragma unroll
    for (unsigned j = 0; j < 16; ++j) { const unsigned c = xb_ld(&bar[XB_XCNT(j)]); sum += c; cnt += (c > 0u) ? 1u : 0u; mine = (j == x) ? c : mine; }
    if (sum == G) break;
    __builtin_amdgcn_s_sleep(1);
    if ((++sp & 255u) == 0u) { if (xb_ld(&bar[XB_TMO])) break; if (sp > XB_SPIN_CAP) { atomicAdd(&bar[XB_TMO], 1u); break; } }
  }
  nloc = mine > 0u ? mine : 1u; nx = cnt > 0u ? cnt : 1u;
}
DI void xcd_barrier(const XcdBarrier& b) {
  asm volatile("s_waitcnt vmcnt(0)" ::: "memory");
  __syncthreads();
  if (threadIdx.x == 0) {
    unsigned* bar = b.bar;
    __builtin_amdgcn_s_waitcnt(0);
    unsigned nloc = b.st[0], nx = b.st[1];
    if (nloc == 0u) { xcd_barrier_complete(bar, b.x, nloc, nx); b.st[0] = nloc; b.st[1] = nx; }
    const unsigned old = xb_add(&bar[XB_XSUB(b.x)], 1u);
    const unsigned gen = old / nloc;
    if (old + 1u == (gen + 1u) * nloc) {
      __builtin_amdgcn_fence(__ATOMIC_RELEASE, "agent");
      asm volatile("s_waitcnt vmcnt(0)" ::: "memory");
      const unsigned og = xb_add(&bar[XB_TOP], 1u);
      const unsigned tg = og / nx;
      if (og + 1u == (tg + 1u) * nx) xb_add(&bar[XB_TOPGEN], 1u);
      else XB_SPIN(xb_ld(&bar[XB_TOPGEN]) == tg, bar);
      __builtin_amdgcn_fence(__ATOMIC_ACQUIRE, "agent");
      xb_add(&bar[XB_XGEN(b.x)], 1u);
      asm volatile("s_waitcnt vmcnt(0)" ::: "memory");
    } else {
      XB_SPIN(xb_ld(&bar[XB_XGEN(b.x)]) == gen, bar);
      __builtin_amdgcn_fence(__ATOMIC_ACQUIRE, "agent");
      asm volatile("s_waitcnt vmcnt(0)" ::: "memory");
    }
  }
  __syncthreads();
}

DI void run_phase(const Params& p, char* smem0, int ph) {
  char* smem = smem0 + (ltid() >> 8) * GRP_LDS;
  switch (ph) {
    case 0: phase0(p, smem); break;
    case 1: phase0b(p, smem); wait_mod_ready(p); phase_norm(p, 0); break;
    case 2: phase_gemm_in(p, 0, smem0); break;
    case 3: phase3(p); break;
    case 4: phase_gemm_mla(p, smem0); if (NVBLK >= 512) late_weight_prep(p, smem, 352, 0, 800); else late_weight_prep(p, smem, 0, 0, 1424); break;
    case 5: phase_attn0(p, smem0); break;
    case 6: if (NVBLK >= 384) phase_out_norm_fused(p, 0, smem); else phase_gemm_out(p, 0, smem); if (NVBLK >= 512) late_weight_prep(p, smem, 384, 800, 1424); break;
    case 7: if (NVBLK < 384) phase_norm(p, 1); break;
    case 8: phase_gemm_in(p, 1, smem0); break;
    case 9: phase9(p, smem); break;
    case 10: phase10(p, smem0); break;
    case 11: phase11(p, smem); break;
    case 12: if (NVBLK >= 384) phase_out_norm_fused(p, 1, smem); else phase_gemm_out(p, 1, smem); break;
    case 13: if (NVBLK < 384) phase_final(p); break;
  }
}

__global__ void __launch_bounds__(512, 2) mk_fwd(Params p) {
#if SINGLE_LAUNCH
  extern __shared__ __attribute__((aligned(16))) char smem[];
  __shared__ uint4 xb_words;
  if (threadIdx.x == 0) xb_words = make_uint4(0u, 0u, 0u, 0u);
  __syncthreads();
  const XcdBarrier xb = xcd_barrier_post(p.BAR, (volatile LAS unsigned*)&xb_words);
  if (p.phase_hi == 12345) {
    const unsigned long long* ia = (const unsigned long long*)__builtin_amdgcn_implicitarg_ptr();
    p.BAR[XB_TMO] = (unsigned)ia[11];
  }
  run_phase(p, smem, 0);
  run_phase(p, smem, 1); xcd_barrier(xb);
  run_phase(p, smem, 2); xcd_barrier(xb);
  run_phase(p, smem, 3); xcd_barrier(xb);
  run_phase(p, smem, 4); xcd_barrier(xb);
  run_phase(p, smem, 5); xcd_barrier(xb);
  run_phase(p, smem, 6); xcd_barrier(xb);
  if (NVBLK < 384) { run_phase(p, smem, 7); xcd_barrier(xb); }
  run_phase(p, smem, 8); xcd_barrier(xb);
  run_phase(p, smem, 9); xcd_barrier(xb);
  run_phase(p, smem, 10); xcd_barrier(xb);
  run_phase(p, smem, 11); xcd_barrier(xb);
  run_phase(p, smem, 12);
  if (NVBLK < 384) { xcd_barrier(xb); run_phase(p, smem, 13); }
#endif
}

template <int PH>
__global__ void __launch_bounds__(512, 2) mk_phase(Params p) {
  extern __shared__ __attribute__((aligned(16))) char smem[];
  run_phase(p, smem, PH);
}
template <int PH>
static void launch_phases(const Params& p, hipStream_t stream) {
  hipFuncSetAttribute((const void*)mk_phase<PH>, hipFuncAttributeMaxDynamicSharedMemorySize, LDS_BYTES);
  hipLaunchKernelGGL(mk_phase<PH>, dim3(256), dim3(512), LDS_BYTES, stream, p);
  if constexpr (PH + 1 < NPHASE) launch_phases<PH + 1>(p, stream);
}

extern "C" void kernel_launch(void* const* d_in, const int* in_sizes, int n_in, void* d_out, int out_size, void* d_ws, size_t ws_size, hipStream_t stream) {
  Params p{};
  const float** fp = (const float**)&p;
  for (int i = 0; i < 34; ++i) fp[i] = (const float*)d_in[i];
  p.out = (float*)d_out;
  char* w = (char*)d_ws;
  size_t off = 0;
  auto take = [&](size_t bytes) { char* r = w + off; off += (bytes + 255) & ~(size_t)255; return r; };
  p.BAR = (unsigned*)take(XCD_BAR_WORDS * 4);
  p.CNT = (unsigned*)take((2 * 48 * 64 + 64) * 4);
  p.SSQ = (float*)take((size_t)2 * NROW * 8 * 4);
  p.MOD = (float*)take(2 * 3 * 3072 * 4);
  p.LAMV = (float*)take(256);
  p.ROPE32 = (float2*)take(1024 * 16 * 8);
  p.ROPE64 = (float2*)take(1024 * 32 * 8);
  p.WinE = (bf16_t*)take((size_t)EIN_PAD * 1024 * 2);
  p.WinO = (bf16_t*)take((size_t)OIN_PAD * 1024 * 2);
  p.Wuq = (bf16_t*)take(768 * 384 * 2);
  p.Wukv = (bf16_t*)take(1024 * 256 * 2);
  p.WoutE = (bf16_t*)take(1024 * 1024 * 2);
  p.WoutO = (bf16_t*)take(1024 * 1024 * 2);
  p.H = (bf16_t*)take((size_t)NROW * 1024 * 2);
  p.O = (bf16_t*)take((size_t)NROW * 1024 * 2);
  p.X1 = (float*)take(256);
  p.X1B = (bf16_t*)take((size_t)NROW * 1024 * 2);
  p.SC = (float*)take(768 * 4 * 4);
  p.SCM = (float*)take(768 * 4);
  p.UC = (bf16_t*)take((size_t)768 * 16384 * 2);
  p.NU = (float*)take(768 * 128 * 4);
  p.NST = (float*)take(768 * 128 * 4);
  p.OP = (bf16_t*)take((size_t)128 * 2 * 2 * 4 * 8 * 64 * 8);
  p.ML = (float*)take((size_t)128 * 2 * 2 * 4 * 64 * 8);
  p.CST = (bf16_t*)take((size_t)768 * 16384 * 2);
  const size_t region = off;
  p.U0 = (bf16_t*)take((size_t)NROW * EIN * 2);
  p.CQN = (bf16_t*)take((size_t)NROW * 384 * 2);
  p.CKVN = (bf16_t*)take((size_t)NTROW * 256 * 2);
  p.KR = (bf16_t*)take((size_t)NTROW * 32 * 2);
  p.QB = (bf16_t*)take((size_t)NROW * 512 * 2);
  p.KB = (bf16_t*)take((size_t)NTROW * 128 * 2);
  p.VB = (bf16_t*)take((size_t)NTROW * 128 * 2);
  p.Q = (bf16_t*)take((size_t)NROW * 768 * 2);
  p.KV = (bf16_t*)take((size_t)NTROW * 1024 * 2);
  const size_t end0 = off;
  off = region;
  p.U1 = (bf16_t*)take((size_t)NROW * OIN * 2);
  p.QD = (bf16_t*)take((size_t)NROW * 512 * 2);
  p.KD = (bf16_t*)take((size_t)NTROW * 512 * 2);
  p.VD = (bf16_t*)take((size_t)NTROW * 512 * 2);
  const size_t end1 = off;
  const size_t need = end0 > end1 ? end0 : end1;
  if (need > ws_size) { fprintf(stderr, "workspace too small: need %zu have %zu\n", need, ws_size); return; }

#if SINGLE_LAUNCH
  static int grid_blocks = 0;
  if (!grid_blocks) {
    int dev = 0, cus = 0, per_cu = 0;
    hipGetDevice(&dev);
    hipDeviceGetAttribute(&cus, hipDeviceAttributeMultiprocessorCount, dev);
    hipFuncSetAttribute((const void*)mk_fwd, hipFuncAttributeMaxDynamicSharedMemorySize, LDS_BYTES);
    hipOccupancyMaxActiveBlocksPerMultiprocessor(&per_cu, mk_fwd, 512, LDS_BYTES);
    if (per_cu < 1) per_cu = 1;
    grid_blocks = cus;
  }
  p.phase_lo = 0; p.phase_hi = NPHASE;
  hipMemsetAsync(p.BAR, 0, (size_t)((char*)(p.CNT + 2 * 48 * 64 + 64) - (char*)p.BAR), stream);
  void* args[] = {&p};
  hipError_t e = hipLaunchCooperativeKernel((void*)mk_fwd, dim3(grid_blocks), dim3(512), args, LDS_BYTES, stream);
  if (e != hipSuccess) fprintf(stderr, "cooperative launch failed: %s (grid %d)\n", hipGetErrorString(e), grid_blocks);
#else
  launch_phases<0>(p, stream);
#endif
}
```

```cpp
#include <hip/hip_runtime.h>
#include <hip/hip_cooperative_groups.h>
#include <cstdio>
namespace cg = cooperative_groups;

typedef unsigned short bf16_t;
using bf16x8 = __attribute__((ext_vector_type(8))) short;
using bf16x4 = __attribute__((ext_vector_type(4))) short;
using f32x4  = __attribute__((ext_vector_type(4))) float;
using u32x4  = __attribute__((ext_vector_type(4))) unsigned;
#define DI __device__ __forceinline__
#define MFMA16(a, b, c) __builtin_amdgcn_mfma_f32_16x16x32_bf16((a), (b), (c), 0, 0, 0)

#ifndef SINGLE_LAUNCH
#define SINGLE_LAUNCH 1
#endif

__device__ __forceinline__ unsigned ltid() { unsigned t = threadIdx.x; asm volatile("" : "+v"(t)); return t; }
#define TIDX ((int)(ltid() & 255u))
#define VBLK ((int)(blockIdx.x * 2 + (ltid() >> 8)))
#define NVBLK ((int)(gridDim.x * 2))
DI int vblk_xcd() {
  const int b = blockIdx.x, nb = gridDim.x;
  if (nb & 7) return VBLK;
  return ((b & 7) * (nb >> 3) + (b >> 3)) * 2 + (int)(ltid() >> 8);
}
constexpr int EIN = 2464, OIN = 4624;
constexpr int EIN_PAD = 2560, OIN_PAD = 4864;
constexpr int NROW = 6144, NTROW = 6656;
constexpr int NPHASE = 14;
constexpr int LDS_BYTES = 139264;
constexpr int GRP_LDS = 69632;
constexpr int LDT = 72;
constexpr float EPSF = 1e-6f;
constexpr float LAM_INIT = 0.35550906759097f;
constexpr size_t O_Y = 0, O_CKV = 6291456, O_KR = 7340032, O_GK = 7471104, O_GV = 7995392, O_C = 8519680,
                 O_N = 10616832, O_M = 10633216, O_DK = 10633344, O_DV = 12730496;

struct Params {
  const float *x_prompt, *x_sample, *cache_ckv, *cache_kr, *cache_gk, *cache_gv, *st_C, *st_n, *st_m, *cache_dk, *cache_dv, *c, *c_ctx;
  const float *e_norm_g, *e_ada_w, *e_ada_b, *e_w_in, *e_qn_g, *e_w_uq, *e_kvn_g, *e_w_ukv, *e_gq_g, *e_gk_g, *e_w_out;
  const float *o_norm_g, *o_ada_w, *o_ada_b, *o_w_in, *o_gate_b, *o_mnorm_g, *o_lam, *o_dnorm_g, *o_w_out, *final_g;
  float* out;
  float *MOD, *LAMV;
  float2 *ROPE32, *ROPE64;
  bf16_t *WinE, *WinO, *Wuq, *Wukv, *WoutE, *WoutO;
  bf16_t *H, *U0, *U1, *CQN, *CKVN, *KR, *QB, *KB, *VB, *Q, *KV, *O, *QD, *KD, *VD, *CST;
  float *X1, *SC, *NU, *NST, *ML, *SCM;
  bf16_t *X1B, *UC, *OP;
  unsigned* BAR;
  unsigned* CNT;
  float* SSQ;
  int phase_lo, phase_hi;
};

DI bf16_t f2bf(float x) { unsigned u = __float_as_uint(x); u += 0x7fffu + ((u >> 16) & 1u); return (bf16_t)(u >> 16); }
DI float bf2f(bf16_t b) { return __uint_as_float(((unsigned)b) << 16); }
typedef __bf16 bf2_t __attribute__((ext_vector_type(2)));
typedef float f2_t __attribute__((ext_vector_type(2)));
DI unsigned pack2(float a, float b) { f2_t v = {a, b}; return __builtin_bit_cast(unsigned, __builtin_convertvector(v, bf2_t)); }
DI float lo2f(unsigned w) { return __uint_as_float(w << 16); }
DI float hi2f(unsigned w) { return __uint_as_float(w & 0xffff0000u); }
DI float xsum_16_32(float x) {
  auto a = __builtin_amdgcn_permlane16_swap(__float_as_uint(x), __float_as_uint(x), false, false);
  const float s = __uint_as_float(a[0]) + __uint_as_float(a[1]);
  auto b = __builtin_amdgcn_permlane32_swap(__float_as_uint(s), __float_as_uint(s), false, false);
  return __uint_as_float(b[0]) + __uint_as_float(b[1]);
}
DI float xmax_16_32(float x) {
  auto a = __builtin_amdgcn_permlane16_swap(__float_as_uint(x), __float_as_uint(x), false, false);
  const float s = fmaxf(__uint_as_float(a[0]), __uint_as_float(a[1]));
  auto b = __builtin_amdgcn_permlane32_swap(__float_as_uint(s), __float_as_uint(s), false, false);
  return fmaxf(__uint_as_float(b[0]), __uint_as_float(b[1]));
}
DI float wave_sum(float v) { v = xsum_16_32(v); for (int d = 8; d; d >>= 1) v += __shfl_xor(v, d); return v; }
DI float wave_max(float v) { v = xmax_16_32(v); for (int d = 8; d; d >>= 1) v = fmaxf(v, __shfl_xor(v, d)); return v; }
DI float scan_add(float v, int lane) { for (int d = 1; d < 64; d <<= 1) { float t = __shfl_up(v, d); if (lane >= d) v += t; } return v; }
DI float scan_max(float v, int lane) { for (int d = 1; d < 64; d <<= 1) { float t = __shfl_up(v, d); if (lane >= d) v = fmaxf(v, t); } return v; }
DI float fexp(float x) { return __builtin_amdgcn_exp2f(x * 1.4426950408889634f); }
DI float logsig(float x) { return fminf(x, 0.f) - log1pf(fexp(-fabsf(x))); }
DI float siluf(float x) { return x * __builtin_amdgcn_rcpf(1.f + fexp(-x)); }
DI float sigmf(float x) { return __builtin_amdgcn_rcpf(1.f + fexp(-x)); }
DI int cv_of_row(int row) { return row < 4096 ? 0 : 1 + ((row - 4096) >> 10); }
DI const float* xrow(const Params& p, int row) { return row < 4096 ? p.x_prompt + (size_t)row * 1024 : p.x_sample + (size_t)(row - 4096) * 1024; }

template <class Epi>
DI void gemm_tile(const bf16_t* __restrict__ X, int ldx, const bf16_t* __restrict__ W, int ldw, int N, int K, int m0, int n0, char* smem, Epi epi) {
  constexpr int LDG = 32;
  constexpr int BUFE = 256 * LDG;
  bf16_t* sb = (bf16_t*)smem;
  const int tid = TIDX, lane = tid & 63, wave = tid >> 6, wm = wave >> 1, wn = wave & 1;
  const int g = lane >> 4, l16 = lane & 15;
  f32x4 acc[4][4];
#pragma unroll
  for (int a = 0; a < 4; ++a)
#pragma unroll
    for (int b = 0; b < 4; ++b) acc[a][b] = f32x4{0.f, 0.f, 0.f, 0.f};
  const int lr = tid >> 2, lc = (tid & 3) * 8;
  const int lcs = ((tid & 3) ^ ((4 - ((lr >> 2) & 3)) & 3)) * 8;
  const int gs = (g ^ ((4 - (l16 >> 2)) & 3)) * 8;
  unsigned xoff[2], woff[2];
#pragma unroll
  for (int i = 0; i < 2; ++i) {
    xoff[i] = (unsigned)((m0 + lr + 64 * i) * ldx + lc);
    int n = n0 + lr + 64 * i; if (n > N - 1) n = N - 1;
    woff[i] = (unsigned)(n * ldw + lc);
  }
  const int nk = K >> 5;
  u32x4 rx[3][2], rw[3][2];
#define G_LOAD(S, KT) { const bf16_t* xb_ = X + (KT) * 32; const bf16_t* wb_ = W + (KT) * 32; \
    rx[S][0] = *(const u32x4*)(xb_ + xoff[0]); rx[S][1] = *(const u32x4*)(xb_ + xoff[1]); \
    rw[S][0] = *(const u32x4*)(wb_ + woff[0]); rw[S][1] = *(const u32x4*)(wb_ + woff[1]); }
#define G_STORE(S, B) { bf16_t* d_ = sb + (B) * BUFE + lr * LDG + lcs; \
    *(u32x4*)(d_) = rx[S][0]; *(u32x4*)(d_ + 64 * LDG) = rx[S][1]; \
    *(u32x4*)(d_ + 128 * LDG) = rw[S][0]; *(u32x4*)(d_ + 192 * LDG) = rw[S][1]; }
#define G_COMPUTE(B) { const bf16_t* bx_ = sb + (B) * BUFE; const bf16_t* bw_ = bx_ + 128 * LDG; \
    bf16x8 wf[4], xf[4]; \
    _Pragma("unroll") for (int i = 0; i < 4; ++i) { \
      wf[i] = *(const bf16x8*)(bw_ + (wn * 64 + i * 16 + l16) * LDG + gs); \
      xf[i] = *(const bf16x8*)(bx_ + (wm * 64 + i * 16 + l16) * LDG + gs); } \
    _Pragma("unroll") for (int ni = 0; ni < 4; ++ni) \
      _Pragma("unroll") for (int mi = 0; mi < 4; ++mi) acc[ni][mi] = MFMA16(wf[ni], xf[mi], acc[ni][mi]); }
#define G_STEP(KK, RL, RS) if ((KK) < nk) { \
    if ((KK) + 1 < nk) G_STORE(RS, ((KK) + 1) & 1) \
    if ((KK) + 3 < nk) G_LOAD(RL, (KK) + 3) \
    G_COMPUTE((KK) & 1) \
    __syncthreads(); }
  G_LOAD(0, 0) G_LOAD(1, 1) G_LOAD(2, 2)
  __syncthreads();
  G_STORE(0, 0)
  __syncthreads();
  for (int k0 = 0; k0 < nk; k0 += 3) {
    G_STEP(k0, 0, 1)
    G_STEP(k0 + 1, 1, 2)
    G_STEP(k0 + 2, 2, 0)
  }
#undef G_LOAD
#undef G_STORE
#undef G_COMPUTE
#undef G_STEP
#pragma unroll
  for (int ni = 0; ni < 4; ++ni) {
    const int n = n0 + wn * 64 + ni * 16 + g * 4;
    if (n < N) {
#pragma unroll
      for (int mi = 0; mi < 4; ++mi) epi(m0 + wm * 64 + mi * 16 + l16, n, acc[ni][mi]);
    }
  }
}

template <class Epi>
DI void gemm_tile64(const bf16_t* __restrict__ X, int ldx, const bf16_t* __restrict__ W, int ldw, int N, int K, int m0, int n0, char* smem, Epi epi) {
  constexpr int PANE = 256 * 32;
  constexpr int BUFE = 2 * PANE;
  bf16_t* sb = (bf16_t*)smem;
  const int tid = TIDX, lane = tid & 63, wave = tid >> 6, wm = wave >> 1, wn = wave & 1;
  const int g = lane >> 4, l16 = lane & 15;
  f32x4 acc[4][4];
#pragma unroll
  for (int a = 0; a < 4; ++a)
#pragma unroll
    for (int b = 0; b < 4; ++b) acc[a][b] = f32x4{0.f, 0.f, 0.f, 0.f};
  const int lr = tid >> 3, ch = tid & 7;
  const int soff = (ch >> 2) * PANE + lr * 32 + (((ch & 3) ^ ((4 - ((lr >> 2) & 3)) & 3)) * 8);
  const int gs = (g ^ ((4 - (l16 >> 2)) & 3)) * 8;
  unsigned xoff[4], woff[4];
#pragma unroll
  for (int i = 0; i < 4; ++i) {
    xoff[i] = (unsigned)((m0 + lr + 32 * i) * ldx + ch * 8);
    int n = n0 + lr + 32 * i; if (n > N - 1) n = N - 1;
    woff[i] = (unsigned)(n * ldw + ch * 8);
  }
  const int nk = K >> 6;
  u32x4 rx[2][4], rw[2][4];
#define H_LOAD(S, KT) { const bf16_t* xb_ = X + (KT) * 64; const bf16_t* wb_ = W + (KT) * 64; \
    _Pragma("unroll") for (int i = 0; i < 4; ++i) { rx[S][i] = *(const u32x4*)(xb_ + xoff[i]); rw[S][i] = *(const u32x4*)(wb_ + woff[i]); } }
#define H_STORE(S, B) { bf16_t* d_ = sb + (B) * BUFE + soff; \
    _Pragma("unroll") for (int i = 0; i < 4; ++i) { *(u32x4*)(d_ + (32 * i) * 32) = rx[S][i]; *(u32x4*)(d_ + (128 + 32 * i) * 32) = rw[S][i]; } }
#define H_COMPUTE(B) { _Pragma("unroll") for (int ks = 0; ks < 2; ++ks) { const bf16_t* bx_ = sb + (B) * BUFE + ks * PANE; const bf16_t* bw_ = bx_ + 128 * 32; \
    bf16x8 wf[4], xf[4]; \
    _Pragma("unroll") for (int i = 0; i < 4; ++i) { \
      wf[i] = *(const bf16x8*)(bw_ + (wn * 64 + i * 16 + l16) * 32 + gs); \
      xf[i] = *(const bf16x8*)(bx_ + (wm * 64 + i * 16 + l16) * 32 + gs); } \
    _Pragma("unroll") for (int ni = 0; ni < 4; ++ni) \
      _Pragma("unroll") for (int mi = 0; mi < 4; ++mi) acc[ni][mi] = MFMA16(wf[ni], xf[mi], acc[ni][mi]); } }
#define H_STEP(KK, SL) if ((KK) < nk) { \
    if ((KK) + 1 < nk) H_STORE((SL) ^ 1, ((KK) + 1) & 1) \
    if ((KK) + 2 < nk) H_LOAD(SL, (KK) + 2) \
    H_COMPUTE((KK) & 1) \
    __syncthreads(); }
  H_LOAD(0, 0)
  if (nk > 1) H_LOAD(1, 1)
  __syncthreads();
  H_STORE(0, 0)
  __syncthreads();
  for (int k0 = 0; k0 < nk; k0 += 2) {
    H_STEP(k0, 0)
    H_STEP(k0 + 1, 1)
  }
#undef H_LOAD
#undef H_STORE
#undef H_COMPUTE
#undef H_STEP
#pragma unroll
  for (int ni = 0; ni < 4; ++ni) {
    const int n = n0 + wn * 64 + ni * 16 + g * 4;
    if (n < N) {
#pragma unroll
      for (int mi = 0; mi < 4; ++mi) epi(m0 + wm * 64 + mi * 16 + l16, n, acc[ni][mi]);
    }
  }
}

DI void gemm_tile64_acc(const bf16_t* __restrict__ X, int ldx, const bf16_t* __restrict__ W, int ldw, int N, int K, int m0, int n0, char* smem, f32x4 (&acc)[4][4]) {
  constexpr int PANE = 256 * 32;
  constexpr int BUFE = 2 * PANE;
  bf16_t* sb = (bf16_t*)smem;
  const int tid = TIDX, lane = tid & 63, wave = tid >> 6, wm = wave >> 1, wn = wave & 1;
  const int g = lane >> 4, l16 = lane & 15;
#pragma unroll
  for (int a = 0; a < 4; ++a)
#pragma unroll
    for (int b = 0; b < 4; ++b) acc[a][b] = f32x4{0.f, 0.f, 0.f, 0.f};
  const int lr = tid >> 3, ch = tid & 7;
  const int soff = (ch >> 2) * PANE + lr * 32 + (((ch & 3) ^ ((4 - ((lr >> 2) & 3)) & 3)) * 8);
  const int gs = (g ^ ((4 - (l16 >> 2)) & 3)) * 8;
  unsigned xoff[4], woff[4];
#pragma unroll
  for (int i = 0; i < 4; ++i) {
    xoff[i] = (unsigned)((m0 + lr + 32 * i) * ldx + ch * 8);
    int n = n0 + lr + 32 * i; if (n > N - 1) n = N - 1;
    woff[i] = (unsigned)(n * ldw + ch * 8);
  }
  const int nk = K >> 6;
  u32x4 rx[2][4], rw[2][4];
#define H_LOAD(S, KT) { const bf16_t* xb_ = X + (KT) * 64; const bf16_t* wb_ = W + (KT) * 64; \
    _Pragma("unroll") for (int i = 0; i < 4; ++i) { rx[S][i] = *(const u32x4*)(xb_ + xoff[i]); rw[S][i] = *(const u32x4*)(wb_ + woff[i]); } }
#define H_STORE(S, B) { bf16_t* d_ = sb + (B) * BUFE + soff; \
    _Pragma("unroll") for (int i = 0; i < 4; ++i) { *(u32x4*)(d_ + (32 * i) * 32) = rx[S][i]; *(u32x4*)(d_ + (128 + 32 * i) * 32) = rw[S][i]; } }
#define H_COMPUTE(B) { _Pragma("unroll") for (int ks = 0; ks < 2; ++ks) { const bf16_t* bx_ = sb + (B) * BUFE + ks * PANE; const bf16_t* bw_ = bx_ + 128 * 32; \
    bf16x8 wf[4], xf[4]; \
    _Pragma("unroll") for (int i = 0; i < 4; ++i) { \
      wf[i] = *(const bf16x8*)(bw_ + (wn * 64 + i * 16 + l16) * 32 + gs); \
      xf[i] = *(const bf16x8*)(bx_ + (wm * 64 + i * 16 + l16) * 32 + gs); } \
    _Pragma("unroll") for (int ni = 0; ni < 4; ++ni) \
      _Pragma("unroll") for (int mi = 0; mi < 4; ++mi) acc[ni][mi] = MFMA16(wf[ni], xf[mi], acc[ni][mi]); } }
#define H_STEP(KK, SL) if ((KK) < nk) { \
    if ((KK) + 1 < nk) H_STORE((SL) ^ 1, ((KK) + 1) & 1) \
    if ((KK) + 2 < nk) H_LOAD(SL, (KK) + 2) \
    H_COMPUTE((KK) & 1) \
    __syncthreads(); }
  H_LOAD(0, 0)
  if (nk > 1) H_LOAD(1, 1)
  __syncthreads();
  H_STORE(0, 0)
  __syncthreads();
  for (int k0 = 0; k0 < nk; k0 += 2) {
    H_STEP(k0, 0)
    H_STEP(k0 + 1, 1)
  }
#undef H_LOAD
#undef H_STORE
#undef H_COMPUTE
#undef H_STEP
}

template <class Epi>
DI void gemm256(const bf16_t* __restrict__ X, int ldx, const bf16_t* __restrict__ W, int ldw, int N, int K, int m0, int n0, char* smem, Epi epi) {
  constexpr int LDG = 32;
  constexpr int BUFE = 512 * LDG;
  bf16_t* sb = (bf16_t*)smem;
  const int tid = (int)ltid(), lane = tid & 63, wave = tid >> 6, wm = wave >> 2, wn = wave & 3;
  const int g = lane >> 4, l16 = lane & 15;
  f32x4 acc[4][8];
#pragma unroll
  for (int a = 0; a < 4; ++a)
#pragma unroll
    for (int b = 0; b < 8; ++b) acc[a][b] = f32x4{0.f, 0.f, 0.f, 0.f};
  const int lr = tid >> 2, lc = (tid & 3) * 8;
  const int lcs = ((tid & 3) ^ ((4 - ((lr >> 2) & 3)) & 3)) * 8;
  const int gs = (g ^ ((4 - (l16 >> 2)) & 3)) * 8;
  unsigned xoff[2], woff[2];
#pragma unroll
  for (int i = 0; i < 2; ++i) {
    xoff[i] = (unsigned)((m0 + lr + 128 * i) * ldx + lc);
    int n = n0 + lr + 128 * i; if (n > N - 1) n = N - 1;
    woff[i] = (unsigned)(n * ldw + lc);
  }
  const int nk = K >> 5;
  u32x4 rx[3][2], rw[3][2];
#define G_LOAD(S, KT) { const bf16_t* xb_ = X + (KT) * 32; const bf16_t* wb_ = W + (KT) * 32; \
    rx[S][0] = *(const u32x4*)(xb_ + xoff[0]); rx[S][1] = *(const u32x4*)(xb_ + xoff[1]); \
    rw[S][0] = *(const u32x4*)(wb_ + woff[0]); rw[S][1] = *(const u32x4*)(wb_ + woff[1]); }
#define G_STORE(S, B) { bf16_t* d_ = sb + (B) * BUFE + lr * LDG + lcs; \
    *(u32x4*)(d_) = rx[S][0]; *(u32x4*)(d_ + 128 * LDG) = rx[S][1]; \
    *(u32x4*)(d_ + 256 * LDG) = rw[S][0]; *(u32x4*)(d_ + 384 * LDG) = rw[S][1]; }
#define G_COMPUTE(B) { const bf16_t* bx_ = sb + (B) * BUFE; const bf16_t* bw_ = bx_ + 256 * LDG; \
    bf16x8 wf[4], xf[8]; \
    _Pragma("unroll") for (int i = 0; i < 4; ++i) wf[i] = *(const bf16x8*)(bw_ + (wn * 64 + i * 16 + l16) * LDG + gs); \
    _Pragma("unroll") for (int i = 0; i < 8; ++i) xf[i] = *(const bf16x8*)(bx_ + (wm * 128 + i * 16 + l16) * LDG + gs); \
    _Pragma("unroll") for (int ni = 0; ni < 4; ++ni) \
      _Pragma("unroll") for (int mi = 0; mi < 8; ++mi) acc[ni][mi] = MFMA16(wf[ni], xf[mi], acc[ni][mi]); }
#define G_STEP(KK, RL, RS) if ((KK) < nk) { \
    if ((KK) + 1 < nk) G_STORE(RS, ((KK) + 1) & 1) \
    if ((KK) + 3 < nk) G_LOAD(RL, (KK) + 3) \
    G_COMPUTE((KK) & 1) \
    __syncthreads(); }
  G_LOAD(0, 0) G_LOAD(1, 1) G_LOAD(2, 2)
  __syncthreads();
  G_STORE(0, 0)
  __syncthreads();
  for (int k0 = 0; k0 < nk; k0 += 3) {
    G_STEP(k0, 0, 1)
    G_STEP(k0 + 1, 1, 2)
    G_STEP(k0 + 2, 2, 0)
  }
#undef G_LOAD
#undef G_STORE
#undef G_COMPUTE
#undef G_STEP
#pragma unroll
  for (int ni = 0; ni < 4; ++ni) {
    const int n = n0 + wn * 64 + ni * 16 + g * 4;
    if (n < N) {
#pragma unroll
      for (int mi = 0; mi < 8; ++mi) epi(m0 + wm * 128 + mi * 16 + l16, n, acc[ni][mi]);
    }
  }
}

namespace pg8 {
#define PG8_LAS __attribute__((address_space(3)))
typedef unsigned short bf16_t;
typedef short bf16x8 __attribute__((ext_vector_type(8)));
typedef float f32x4 __attribute__((ext_vector_type(4)));
typedef unsigned u32x4 __attribute__((ext_vector_type(4)));
constexpr int BM = 256, BK = 64, HALF = 128, HTB = HALF * BK * 2  , STAGE_BYTES = 8 * HTB, NXCD = 8, WGM = 8;

__host__ __device__ __forceinline__ int lds_byte(int r, int c) { const int st = (r >> 4) * 2 + (c >> 5), rr = r & 15, cc = c & 31, ob = rr * 64 + cc * 2; return st * 1024 + (ob ^ (((ob >> 9) & 1) << 5)); }
__host__ __device__ __forceinline__ void stage_rc(int b, int& R, int& C) { const int st = b / 1024, sb = b % 1024, swz = sb ^ (((sb >> 9) & 1) << 5); R = (st >> 1) * 16 + swz / 64; C = (st & 1) * 32 + (swz % 64) / 2; }
__host__ __device__ __forceinline__ int perm32(int rho) { const int n = rho >> 4, i = rho & 15; return 8 * (i >> 2) + 4 * n + (i & 3); }

struct Unit { int pm, pn; };
struct Gemm { const bf16_t* A; const bf16_t* Bt; int M, N, K; };

struct StaticOrder {
    int nM, nN, nwg, G, c;
    __host__ __device__ void init(int M, int N, int G_, int c_) { nM = M / BM; nN = N / BM; nwg = nM * nN; G = G_; c = c_; }
    __host__ __device__ bool next(int i, Unit& u) const {
        const long L = (long)i * G + c; if (L >= nwg) return false;
        int wgid = (int)L; { const int q = nwg / NXCD, r = nwg % NXCD, xcd = wgid % NXCD, off = wgid / NXCD; wgid = (xcd < r ? xcd * (q + 1) : r * (q + 1) + (xcd - r) * q) + off; }
        const int nig = WGM * nN, gid = wgid / nig, fm = gid * WGM, gsz = (nM - fm) < WGM ? (nM - fm) : WGM;
        u.pm = fm + ((wgid % nig) % gsz); u.pn = (wgid % nig) / gsz; return true;
    }
    __device__ __forceinline__ void a_ready(const Unit&) const {}
    __device__ __forceinline__ void done(const Unit&) const {}
};
__device__ __forceinline__ unsigned cvt_pk_bf16(float lo, float hi) { unsigned r; asm volatile("v_cvt_pk_bf16_f32 %0, %1, %2" : "=v"(r) : "v"(lo), "v"(hi)); return r; }
template <class Epi, class Sched, bool STAMP = false>
__device__ __forceinline__ void gemm_phase(PG8_LAS unsigned char* lds, const Gemm g, const Sched& S, const Epi& E, unsigned long long* stamps) {
    const int tid = (int)ltid(), wid = __builtin_amdgcn_readfirstlane(tid >> 6), lane = tid & 63, wr = wid >> 2, wc = wid & 3, fr = lane & 15, fq = lane >> 4;
    const int K = g.K, nt = K / BK;
    int ts_lo = 0, ts_hi = 0, nts = 0; const unsigned long long rt_entry = STAMP ? (unsigned long long)wall_clock64() : 0ull;
#define PG8_STAMP() do { if (STAMP && wid == 0 && nts < 64) { const unsigned long long _c = (unsigned long long)clock64(); \
        ts_lo = (lane == nts) ? (int)(unsigned)_c : ts_lo; ts_hi = (lane == nts) ? (int)(unsigned)(_c >> 32) : ts_hi; ++nts; } } while (0)
    PG8_STAMP();
    unsigned voffA[2], voffB[2];
#pragma unroll
    for (int i = 0; i < 2; ++i) { int R, C; stage_rc(tid * 16 + i * 8192, R, C); const int Rb = Epi::PERM ? ((R & ~31) + perm32(R & 31)) : R;
        voffA[i] = (unsigned)(R * K + C) * 2u; voffB[i] = (unsigned)(Rb * K + C) * 2u; }
    const size_t kstep = (size_t)(BK * 2);
    const size_t hstep = (size_t)HALF * K * 2;
    const size_t tstep = 2 * hstep;
    const unsigned ldsw = (unsigned)wid * 1024u;
    const int aoff = lds_byte(wr * 64 + fr, fq * 8), boff = lds_byte(wc * 32 + fr, fq * 8);
#define PG8_SA(b, h) (((b) * 2 + (h)) * HTB)
#define PG8_SB(b, h) ((4 + (b) * 2 + (h)) * HTB)
#define PG8_STAGE(bufoff, gbase, voff) do { _Pragma("unroll") for (int _i = 0; _i < 2; ++_i) \
        __builtin_amdgcn_global_load_lds((const unsigned*)((const char*)(gbase) + (voff)[_i]), (PG8_LAS unsigned*)(lds + (bufoff) + ldsw + _i * 8192), 16, 0, 0); } while (0)
#define PG8_LDA(dst, b, h) do { _Pragma("unroll") for (int m = 0; m < 4; ++m) _Pragma("unroll") for (int k = 0; k < 2; ++k) dst[m][k] = *(const PG8_LAS bf16x8*)(lds + PG8_SA(b, h) + aoff + m * 2048 + k * 1024); } while (0)
#define PG8_LDB(dst, b, h) do { _Pragma("unroll") for (int n = 0; n < 2; ++n) _Pragma("unroll") for (int k = 0; k < 2; ++k) dst[n][k] = *(const PG8_LAS bf16x8*)(lds + PG8_SB(b, h) + boff + n * 2048 + k * 1024); } while (0)
#define PG8_MMA(ai, bj, At, Bt) do { __builtin_amdgcn_s_setprio(1); _Pragma("unroll") for (int m = 0; m < 4; ++m) _Pragma("unroll") for (int n = 0; n < 2; ++n) _Pragma("unroll") for (int k = 0; k < 2; ++k) \
        acc[ai][bj][m][n] = __builtin_amdgcn_mfma_f32_16x16x32_bf16(Bt[n][k], At[m][k], acc[ai][bj][m][n], 0, 0, 0); __builtin_amdgcn_s_setprio(0); } while (0)
#define PG8_WAIT_V(n) asm volatile("s_waitcnt vmcnt(" #n ")" ::: "memory")
#define PG8_WAIT_L(n) asm volatile("s_waitcnt lgkmcnt(" #n ")" ::: "memory")
#define PG8_BAR __builtin_amdgcn_s_barrier()
#define PG8_SCHED __builtin_amdgcn_sched_barrier(0)
    Unit cur, nxt; int ui = 0;
    if (!S.next(0, cur)) return;
    f32x4 acc[2][2][4][2];
#pragma unroll
    for (int a = 0; a < 2; ++a)
#pragma unroll
        for (int b = 0; b < 2; ++b)
#pragma unroll
            for (int m = 0; m < 4; ++m)
#pragma unroll
                for (int n = 0; n < 2; ++n) acc[a][b][m][n] = (f32x4){0.f, 0.f, 0.f, 0.f};
    bf16x8 At[4][2], B0[2][2], B1[2][2];
    const char* cA = (const char*)g.A + (size_t)cur.pm * tstep; const char* cB = (const char*)g.Bt + (size_t)cur.pn * tstep;
    S.a_ready(cur);
    PG8_STAGE(PG8_SB(0, 0), cB, voffB); PG8_STAGE(PG8_SA(0, 0), cA, voffA); PG8_STAGE(PG8_SB(0, 1), cB + hstep, voffB); PG8_STAGE(PG8_SA(0, 1), cA + hstep, voffA);
    if (wr == 1) PG8_BAR;
    PG8_WAIT_V(4); PG8_BAR;
    PG8_STAGE(PG8_SB(1, 0), cB + kstep, voffB); PG8_STAGE(PG8_SA(1, 0), cA + kstep, voffA); PG8_STAGE(PG8_SB(1, 1), cB + hstep + kstep, voffB);
    PG8_WAIT_V(6); PG8_BAR;
    PG8_STAMP();
    for (;;) {
        const bool has_next = S.next(ui + 1, nxt);
        const char* nA = has_next ? (const char*)g.A + (size_t)nxt.pm * tstep : cA; const char* nB = has_next ? (const char*)g.Bt + (size_t)nxt.pn * tstep : cB;
        for (int t = 0; t < nt; t += 2) {
            const bool last = (t == nt - 2);
            const char* a1 = cA + (size_t)(t + 1) * kstep;
            const char* a2 = last ? nA : cA + (size_t)(t + 2) * kstep; const char* b2 = last ? nB : cB + (size_t)(t + 2) * kstep;
            const char* a3 = a2 + kstep; const char* b3 = b2 + kstep;
            if (last && has_next) S.a_ready(nxt);
            PG8_LDB(B0, 0, 0); PG8_SCHED; PG8_LDA(At, 0, 0); PG8_STAGE(PG8_SA(1, 1), a1 + hstep, voffA);
            PG8_WAIT_L(8); PG8_BAR; PG8_WAIT_L(0); PG8_MMA(0, 0, At, B0); PG8_BAR; PG8_SCHED;
            PG8_LDB(B1, 0, 1); PG8_STAGE(PG8_SB(0, 0), b2, voffB);
            PG8_BAR; PG8_WAIT_L(0); PG8_MMA(0, 1, At, B1); PG8_BAR;
            PG8_LDA(At, 0, 1); PG8_STAGE(PG8_SA(0, 0), a2, voffA);
            PG8_BAR; PG8_WAIT_L(0); PG8_MMA(1, 0, At, B0); PG8_BAR; PG8_SCHED;
            PG8_STAGE(PG8_SB(0, 1), b2 + hstep, voffB);
            PG8_WAIT_V(6); PG8_BAR; PG8_MMA(1, 1, At, B1); PG8_BAR;
            PG8_LDB(B0, 1, 0); PG8_SCHED; PG8_LDA(At, 1, 0); PG8_STAGE(PG8_SA(0, 1), a2 + hstep, voffA);
            PG8_WAIT_L(8); PG8_BAR; PG8_WAIT_L(0); PG8_MMA(0, 0, At, B0); PG8_BAR; PG8_SCHED;
            PG8_LDB(B1, 1, 1); PG8_STAGE(PG8_SB(1, 0), b3, voffB);
            PG8_BAR; PG8_WAIT_L(0); PG8_MMA(0, 1, At, B1); PG8_BAR;
            PG8_LDA(At, 1, 1); PG8_STAGE(PG8_SA(1, 0), a3, voffA);
            PG8_BAR; PG8_WAIT_L(0); PG8_MMA(1, 0, At, B0); PG8_BAR; PG8_SCHED;
            PG8_STAGE(PG8_SB(1, 1), b3 + hstep, voffB);
            PG8_WAIT_V(6); PG8_BAR; PG8_MMA(1, 1, At, B1); PG8_BAR;
        }
        PG8_STAMP();
        if constexpr (!Epi::AFTER_DRAIN) { E(acc, cur, wr, wc, fr, fq); S.done(cur); }
        PG8_STAMP();
        if (!has_next) break;
#pragma unroll
        for (int a = 0; a < 2; ++a)
#pragma unroll
            for (int b = 0; b < 2; ++b)
#pragma unroll
                for (int m = 0; m < 4; ++m)
#pragma unroll
                    for (int n = 0; n < 2; ++n) acc[a][b][m][n] = (f32x4){0.f, 0.f, 0.f, 0.f};
        cur = nxt; cA = nA; cB = nB; ++ui;
    }
    PG8_WAIT_V(0);
    if (wr == 0) PG8_BAR;
    PG8_BAR;
    if constexpr (Epi::AFTER_DRAIN) { E.fused(acc, cur, wr, wc, fr, fq, lds, wid, lane); S.done(cur); }
    PG8_STAMP();
    if (STAMP && wid == 0) { stamps[lane] = lane < nts ? (((unsigned long long)(unsigned)ts_hi << 32) | (unsigned)ts_lo) : 0ull;
        if (lane == 62) stamps[62] = rt_entry; if (lane == 63) stamps[63] = (unsigned long long)wall_clock64(); }
#undef PG8_STAMP
#undef PG8_SA
#undef PG8_SB
#undef PG8_STAGE
#undef PG8_LDA
#undef PG8_LDB
#undef PG8_MMA
#undef PG8_WAIT_V
#undef PG8_WAIT_L
#undef PG8_BAR
#undef PG8_SCHED
}
}

struct EpiU {
  static constexpr bool PERM = true, AFTER_DRAIN = false;
  bf16_t* U; int ldu; int nvalid;
  float* aux;
  __device__ __forceinline__ void operator()(const f32x4 (&acc)[2][2][4][2], const pg8::Unit& u, int wr, int wc, int fr, int fq) const {
    const int row0 = u.pm * 256 + wr * 64 + fr, col0 = u.pn * 256 + wc * 32 + 8 * fq;
#pragma unroll
    for (int ai = 0; ai < 2; ++ai)
#pragma unroll
      for (int m = 0; m < 4; ++m) {
        bf16_t* rowp = U + (size_t)(row0 + ai * 128 + m * 16) * ldu;
#pragma unroll
        for (int bj = 0; bj < 2; ++bj) {
          const int col = col0 + bj * 128;
          if (col < nvalid) {
            const f32x4 v0 = acc[ai][bj][m][0], v1 = acc[ai][bj][m][1];
            u32x4 w;
            w[0] = pack2(v0[0], v0[1]); w[1] = pack2(v0[2], v0[3]); w[2] = pack2(v1[0], v1[1]); w[3] = pack2(v1[2], v1[3]);
            *(u32x4*)(rowp + col) = w;
            if (aux && col >= 3088 && col < 4112 && (row0 + ai * 128 + m * 16) < 4096) {
              float* ap = aux + (size_t)((col - 3088) >> 9) * 2097152 + (size_t)(row0 + ai * 128 + m * 16) * 512 + ((col - 3088) & 511);
              *(f32x4*)ap = v0; *(f32x4*)(ap + 4) = v1;
            }
          }
        }
      }
  }
};


struct EpiOut {
  static constexpr bool PERM = true, AFTER_DRAIN = false;
  const float* MOD; const float* x_prompt; const float* x_sample; bf16_t* X1B; int layer;
  __device__ __forceinline__ void operator()(const f32x4 (&acc)[2][2][4][2], const pg8::Unit& u, int wr, int wc, int fr, int fq) const {
    const int row0 = u.pm * 256 + wr * 64 + fr, col0 = u.pn * 256 + wc * 32 + 8 * fq;
#pragma unroll
    for (int ai = 0; ai < 2; ++ai)
#pragma unroll
      for (int m = 0; m < 4; ++m) {
        const int row = row0 + ai * 128 + m * 16;
        const float* gp = MOD + (layer * 3 + (row < 4096 ? 0 : 1 + ((row - 4096) >> 10))) * 3072 + 2048;
        const float* xr = row < 4096 ? x_prompt + (size_t)row * 1024 : x_sample + (size_t)(row - 4096) * 1024;
        bf16_t* xb = X1B + (size_t)row * 1024;
#pragma unroll
        for (int bj = 0; bj < 2; ++bj) {
          const int col = col0 + bj * 128;
          const f32x4 v0 = acc[ai][bj][m][0], v1 = acc[ai][bj][m][1];
          const float4 g0 = *(const float4*)(gp + col), g1 = *(const float4*)(gp + col + 4);
          float4 x0, x1;
          if (layer) {
            const uint4 w = *(const uint4*)(xb + col);
            x0 = make_float4(__uint_as_float(w.x << 16), __uint_as_float(w.x & 0xffff0000u), __uint_as_float(w.y << 16), __uint_as_float(w.y & 0xffff0000u));
            x1 = make_float4(__uint_as_float(w.z << 16), __uint_as_float(w.z & 0xffff0000u), __uint_as_float(w.w << 16), __uint_as_float(w.w & 0xffff0000u));
          } else { x0 = *(const float4*)(xr + col); x1 = *(const float4*)(xr + col + 4); }
          u32x4 o;
          o[0] = pack2(x0.x + g0.x * v0[0], x0.y + g0.y * v0[1]); o[1] = pack2(x0.z + g0.z * v0[2], x0.w + g0.w * v0[3]);
          o[2] = pack2(x1.x + g1.x * v1[0], x1.y + g1.y * v1[1]); o[3] = pack2(x1.z + g1.z * v1[2], x1.w + g1.w * v1[3]);
          *(u32x4*)(xb + col) = o;
        }
        asm volatile("" ::: "memory");
      }
  }
};

template <int W>
DI void stage_rows64(bf16_t* dst, int ldd, int coff, const bf16_t* src, int lds) {
  for (int c = TIDX; c < 64 * (W / 8); c += 256) {
    const int r = c / (W / 8), cc = (c % (W / 8)) * 8;
    *(uint4*)(dst + r * ldd + coff + cc) = *(const uint4*)(src + (size_t)r * lds + cc);
  }
}
template <int W>
DI void stage_T64(bf16_t* dst, const bf16_t* src, int lds, const float* rscale) {
  for (int c = TIDX; c < 64 * (W / 8); c += 256) {
    const int r = c & 63, cc = (c >> 6) * 8;
    uint4 v = *(const uint4*)(src + (size_t)r * lds + cc);
    unsigned w[4] = {v.x, v.y, v.z, v.w};
    if (rscale) {
      const float s = rscale[r];
#pragma unroll
      for (int i = 0; i < 4; ++i) {
        const unsigned pw = pack2(lo2f(w[i]) * s, hi2f(w[i]) * s);
        dst[(cc + 2 * i) * LDT + r] = (bf16_t)(pw & 0xffffu);
        dst[(cc + 2 * i + 1) * LDT + r] = (bf16_t)(pw >> 16);
      }
    } else {
#pragma unroll
      for (int i = 0; i < 4; ++i) {
        dst[(cc + 2 * i) * LDT + r] = (bf16_t)(w[i] & 0xffffu);
        dst[(cc + 2 * i + 1) * LDT + r] = (bf16_t)(w[i] >> 16);
      }
    }
  }
}

template <int DK, int DV, bool DUAL>
DI void attn_core(char* smem, const bf16_t* Qp, int ldq, const bf16_t* K1, int ldk1, const bf16_t* K2, int ldk2,
                  const bf16_t* V, int ldv, int T, float scale_log2, f32x4 (&o)[DUAL ? 2 : 1][DV / 16], float (&lsum)[DUAL ? 2 : 1], float (&mrun)[DUAL ? 2 : 1],
                  const float2* qrope = nullptr) {
  constexpr int NS = DUAL ? 2 : 1;
  constexpr int DKT = DUAL ? 2 * DK : DK;
  constexpr int W1 = (DK == 96) ? 64 : DKT;
  constexpr int LDK = DKT + 8;
  constexpr int NK1 = 64 * (W1 / 8) / 512;
  constexpr int NV = 64 * (DV / 8) / 512;
  constexpr int BUFE = 64 * DKT + DV * LDT;
  bf16_t* sbase = (bf16_t*)smem;
  const int tid = TIDX, lane = tid & 63, wave = tid >> 6, g = lane >> 4, l16 = lane & 15;
  const int st = (int)ltid();
  const int gsw = (g ^ ((4 - (l16 >> 2)) & 3)) * 8;
  bf16x8 qf[DKT / 32];
  const bf16_t* qrow = Qp + (size_t)(wave * 16 + l16) * ldq;
#pragma unroll
  for (int ks = 0; ks < DKT / 32; ++ks) qf[ks] = *(const bf16x8*)(qrow + ks * 32 + g * 8);
  if (DK == 96 && qrope) {
    const float2* rp = qrope + (wave * 16 + l16) * 16 + g * 4;
    const u32x4 w = __builtin_bit_cast(u32x4, qf[DKT / 32 - 1]);
    u32x4 r;
#pragma unroll
    for (int j = 0; j < 4; ++j) {
      const float2 cs = rp[j];
      const float x0 = lo2f(w[j]), x1 = hi2f(w[j]);
      r[j] = pack2(x0 * cs.x - x1 * cs.y, x0 * cs.y + x1 * cs.x);
    }
    qf[DKT / 32 - 1] = __builtin_bit_cast(bf16x8, r);
  }
#pragma unroll
  for (int n = 0; n < NS; ++n) {
#pragma unroll
    for (int i = 0; i < DV / 16; ++i) o[n][i] = f32x4{0.f, 0.f, 0.f, 0.f};
    mrun[n] = -INFINITY; lsum[n] = 0.f;
  }
  u32x4 pk[NK1], pk2, pv[NV];
  unsigned koff[NK1], voff[NV];
#pragma unroll
  for (int i = 0; i < NK1; ++i) { const int c = st + 512 * i, r = c / (W1 / 8), cc = (c % (W1 / 8)) * 8; koff[i] = (unsigned)(r * ldk1 + cc); }
#pragma unroll
  for (int i = 0; i < NV; ++i) { const int c = st + 512 * i, r = c & 63, cc = (c >> 6) * 8; voff[i] = (unsigned)(r * ldv + cc); }
  const unsigned k2off = (unsigned)(((st & 255) >> 2) * ldk2 + (st & 3) * 8);
#define A_LOAD(TN) { const bf16_t* kbase_ = K1 + (size_t)(TN) * ldk1; const bf16_t* vbase_ = V + (size_t)(TN) * ldv; \
    _Pragma("unroll") for (int i = 0; i < NK1; ++i) pk[i] = *(const u32x4*)(kbase_ + koff[i]); \
    if (DK == 96 && st < 256) pk2 = *(const u32x4*)(K2 + (size_t)(TN) * ldk2 + k2off); \
    _Pragma("unroll") for (int i = 0; i < NV; ++i) pv[i] = *(const u32x4*)(vbase_ + voff[i]); }
#define A_COMMIT(B) { bf16_t* sK_ = sbase + (B) * BUFE; bf16_t* sVT_ = sK_ + 64 * DKT; \
    _Pragma("unroll") for (int i = 0; i < NK1; ++i) { const int c = st + 512 * i, r = c / (W1 / 8), ch = c % (W1 / 8); *(u32x4*)(sK_ + (ch >> 2) * 2048 + r * 32 + (((ch & 3) ^ ((4 - ((r >> 2) & 3)) & 3)) * 8)) = pk[i]; } \
    if (DK == 96 && st < 256) { const int r = st >> 2, ch = st & 3; *(u32x4*)(sK_ + 2 * 2048 + r * 32 + ((ch ^ ((4 - ((r >> 2) & 3)) & 3)) * 8)) = pk2; } \
    _Pragma("unroll") for (int i = 0; i < NV; ++i) { const int c = st + 512 * i, r = c & 63, cc = (c >> 6) * 8; \
      _Pragma("unroll") for (int j = 0; j < 4; ++j) { sVT_[(cc + 2 * j) * LDT + r] = (bf16_t)(pv[i][j] & 0xffffu); sVT_[(cc + 2 * j + 1) * LDT + r] = (bf16_t)(pv[i][j] >> 16); } } }
  A_LOAD(0)
  __syncthreads();
  A_COMMIT(0)
  if (64 < T) A_LOAD(64)
  __syncthreads();
  int par = 0;
  for (int t0 = 0; t0 < T; t0 += 64, par ^= 1) {
    {
    {
    if (t0 + 64 < T) {
      A_COMMIT(par ^ 1)
      if (t0 + 128 < T) A_LOAD(t0 + 128)
    }
    const bf16_t* sK = sbase + par * BUFE;
    const bf16_t* sVT = sK + 64 * DKT;
    bf16x8 pf[NS][2];
#pragma unroll
    for (int n = 0; n < NS; ++n) {
      f32x4 s[4];
#pragma unroll
      for (int t = 0; t < 4; ++t) {
        s[t] = f32x4{0.f, 0.f, 0.f, 0.f};
#pragma unroll
        for (int ks = 0; ks < DK / 32; ++ks) {
          const bf16x8 kf = *(const bf16x8*)(sK + (n * (DK / 32) + ks) * 2048 + (t * 16 + l16) * 32 + gsw);
          s[t] = MFMA16(kf, qf[n * (DK / 32) + ks], s[t]);
        }
      }
      float mx = -INFINITY;
#pragma unroll
      for (int t = 0; t < 4; ++t)
#pragma unroll
        for (int j = 0; j < 4; ++j) mx = fmaxf(mx, s[t][j]);
      mx = xmax_16_32(mx);
      const float mnew = fmaxf(mrun[n], mx);
      const float alpha = __builtin_amdgcn_exp2f((mrun[n] - mnew) * scale_log2);
      mrun[n] = mnew;
      const float moff = -mnew * scale_log2;
      float ps = 0.f;
#pragma unroll
      for (int t = 0; t < 4; ++t)
#pragma unroll
        for (int j = 0; j < 4; ++j) { s[t][j] = __builtin_amdgcn_exp2f(fmaf(s[t][j], scale_log2, moff)); ps += s[t][j]; }
      lsum[n] = lsum[n] * alpha + ps;
#pragma unroll
      for (int i = 0; i < DV / 16; ++i) o[n][i] *= alpha;
#pragma unroll
      for (int kb = 0; kb < 2; ++kb)
      {
        u32x4 w;
        w[0] = pack2(s[2 * kb][0], s[2 * kb][1]); w[1] = pack2(s[2 * kb][2], s[2 * kb][3]);
        w[2] = pack2(s[2 * kb + 1][0], s[2 * kb + 1][1]); w[3] = pack2(s[2 * kb + 1][2], s[2 * kb + 1][3]);
        pf[n][kb] = __builtin_bit_cast(bf16x8, w);
      }
    }
#pragma unroll
    for (int kb = 0; kb < 2; ++kb) {
#pragma unroll
      for (int i = 0; i < DV / 16; ++i) {
        const bf16_t* vp = sVT + (i * 16 + l16) * LDT + kb * 32 + g * 4;
        const bf16x4 lo = *(const bf16x4*)(vp);
        const bf16x4 hi = *(const bf16x4*)(vp + 16);
        const bf16x8 vf = __builtin_shufflevector(lo, hi, 0, 1, 2, 3, 4, 5, 6, 7);
#pragma unroll
        for (int n = 0; n < NS; ++n) o[n][i] = MFMA16(vf, pf[n][kb], o[n][i]);
        if (DUAL && (i & 3) == 3) asm volatile("" ::: "memory");
      }
    }
    }
    }
    __syncthreads();
  }
#undef A_LOAD
#undef A_COMMIT
}

DI void transpose_w(const float* __restrict__ src, int K, int N, bf16_t* __restrict__ dst, int tile, float* sT, int sc_lo, int sc_hi, float sc) {
  const int ntn = (N + 63) >> 6;
  const int kt = tile / ntn, nt = tile % ntn, k0 = kt * 64, n0 = nt * 64;
  __syncthreads();
#pragma unroll
  for (int q = 0; q < 4; ++q) {
    const int i = TIDX + 256 * q;
    const int r = i >> 4, c = (i & 15) * 4, n = n0 + c;
    float4 v = make_float4(0.f, 0.f, 0.f, 0.f);
    if (n < N) v = *(const float4*)(src + (size_t)(k0 + r) * N + n);
    if (n >= sc_lo && n < sc_hi) { v.x *= sc; v.y *= sc; v.z *= sc; v.w *= sc; }
    float* d = sT + r * 65 + c;
    d[0] = v.x; d[1] = v.y; d[2] = v.z; d[3] = v.w;
  }
  __syncthreads();
#pragma unroll
  for (int q = 0; q < 2; ++q) {
    const int i = TIDX + 256 * q;
    const int c = i >> 3, kc = (i & 7) * 8, n = n0 + c;
    if (n < N) {
      const float* sp = sT + kc * 65 + c;
      uint4 o;
      o.x = pack2(sp[0], sp[65]); o.y = pack2(sp[130], sp[195]); o.z = pack2(sp[260], sp[325]); o.w = pack2(sp[390], sp[455]);
      *(uint4*)(dst + (size_t)n * K + k0 + kc) = o;
    }
  }
}

DI void phase0(const Params& p, char* smem) {
  const int tid = TIDX;
  for (int it = VBLK; it < 384; it += NVBLK) {
    const int l = it / 192, cb = (it % 192) * 16;
    const float* W = l ? p.o_ada_w : p.e_ada_w;
    const float* bias = l ? p.o_ada_b : p.e_ada_b;
    float* sc = (float*)smem;
    float* red = sc + 3072;
    __syncthreads();
    for (int i = tid; i < 3072; i += 256) {
      const int j = i >> 10, k = i & 1023;
      const float v = (j == 0) ? p.c_ctx[k] : p.c[(j - 1) * 1024 + k];
      sc[i] = siluf(v);
    }
    __syncthreads();
    const int col = cb + (tid & 15), kg = tid >> 4;
    float a0 = 0.f, a1 = 0.f, a2 = 0.f;
    for (int kb = kg * 64; kb < kg * 64 + 64; kb += 16) {
      float w[16];
#pragma unroll
      for (int u = 0; u < 16; ++u) w[u] = W[(size_t)(kb + u) * 3072 + col];
#pragma unroll
      for (int u = 0; u < 16; ++u) { a0 += sc[kb + u] * w[u]; a1 += sc[1024 + kb + u] * w[u]; a2 += sc[2048 + kb + u] * w[u]; }
    }
    red[(kg * 3 + 0) * 16 + (tid & 15)] = a0;
    red[(kg * 3 + 1) * 16 + (tid & 15)] = a1;
    red[(kg * 3 + 2) * 16 + (tid & 15)] = a2;
    __syncthreads();
    if (tid < 48) {
      const int j = tid >> 4, c = tid & 15;
      float s = 0.f;
      for (int q = 0; q < 16; ++q) s += red[(q * 3 + j) * 16 + c];
      p.MOD[(l * 3 + j) * 3072 + cb + c] = s + bias[cb + c];
    }
  }
}

DI void phase0b(const Params& p, char* smem) {
  const int tid = TIDX;
  if (VBLK == 0 && tid < 64) {
    float a = p.o_lam[tid] * p.o_lam[64 + tid];
    float b = p.o_lam[128 + tid] * p.o_lam[192 + tid];
    a = wave_sum(a); b = wave_sum(b);
    if (tid == 0) p.LAMV[0] = fexp(a) - fexp(b) + LAM_INIT;
  }
  for (int idx = VBLK * 256 + tid; idx < 1024 * 48; idx += NVBLK * 256) {
    const int pos = idx / 48, e = idx % 48;
    const float rr = (float)(pos >> 6), cc = (float)(pos & 63);
    if (e < 16) {
      const int j = e & 7;
      const float inv = 1.0f / powf(10000.0f, (float)(2 * j) / 16.0f);
      const float ang = ((e < 8) ? rr : cc) * inv;
      p.ROPE32[pos * 16 + e] = make_float2(cosf(ang), sinf(ang));
    } else {
      const int i = e - 16, j = i & 15;
      const float inv = 1.0f / powf(10000.0f, (float)(2 * j) / 32.0f);
      const float ang = ((i < 16) ? rr : cc) * inv;
      p.ROPE64[pos * 32 + i] = make_float2(cosf(ang), sinf(ang));
    }
  }
  float* sT = (float*)smem;
  for (int it = VBLK; it < 1016; it += NVBLK) {
    if (it < 624) transpose_w(p.e_w_in, 1024, EIN, p.WinE, it, sT, 0, 0, 1.f);
    else if (it < 696) transpose_w(p.e_w_uq, 384, 768, p.Wuq, it - 624, sT, 0, 0, 1.f);
    else if (it < 760) transpose_w(p.e_w_ukv, 256, 1024, p.Wukv, it - 696, sT, 0, 0, 1.f);
    else transpose_w(p.e_w_out, 1024, 1024, p.WoutE, it - 760, sT, 0, 0, 1.f);
  }
}

DI void late_weight_prep(const Params& p, char* smem, int first_group, int tile_lo, int tile_hi) {
  float* sT = (float*)smem;
  const int ng = NVBLK - first_group;
  if (ng <= 0 || VBLK < first_group) return;
  for (int it = tile_lo + VBLK - first_group; it < tile_hi; it += ng) {
    if (it < 1168) transpose_w(p.o_w_in, 1024, OIN, p.WinO, it, sT, 512, 1024, 0.08838834764831845f);
    else transpose_w(p.o_w_out, 1024, 1024, p.WoutO, it - 1168, sT, 0, 0, 1.f);
  }
}

DI void store_bf4(bf16_t* dst, f32x4 v) {
  uint2 o; o.x = pack2(v[0], v[1]); o.y = pack2(v[2], v[3]);
  *(uint2*)dst = o;
}
DI float4 load_bf4(const bf16_t* src) {
  const uint2 w = *(const uint2*)src;
  return make_float4(lo2f(w.x), hi2f(w.x), lo2f(w.y), hi2f(w.y));
}

DI void phase_norm(const Params& p, int layer) {
  const int tid = TIDX, lane = tid & 63, wave = tid >> 6;
  const float* g = layer ? p.o_norm_g : p.e_norm_g;
  for (int it = VBLK; it < NROW / 4; it += NVBLK) {
    const int row = it * 4 + wave;
    const float* x = xrow(p, row);
    const bf16_t* xb = p.X1B + (size_t)row * 1024;
    const float* md = p.MOD + (layer * 3 + cv_of_row(row)) * 3072;
    float4 v[4];
    float ss = 0.f;
#pragma unroll
    for (int i = 0; i < 4; ++i) {
      v[i] = layer ? load_bf4(xb + i * 256 + lane * 4) : *(const float4*)(x + i * 256 + lane * 4);
      ss += v[i].x * v[i].x + v[i].y * v[i].y + v[i].z * v[i].z + v[i].w * v[i].w;
    }
    ss = wave_sum(ss);
    const float r = rsqrtf(ss * (1.f / 1024.f) + EPSF);
#pragma unroll
    for (int i = 0; i < 4; ++i) {
      const int col = i * 256 + lane * 4;
      const float4 gg = *(const float4*)(g + col), sh = *(const float4*)(md + col), sc = *(const float4*)(md + 1024 + col);
      uint2 o;
      o.x = pack2(v[i].x * r * gg.x * (1.f + sc.x) + sh.x, v[i].y * r * gg.y * (1.f + sc.y) + sh.y);
      o.y = pack2(v[i].z * r * gg.z * (1.f + sc.z) + sh.z, v[i].w * r * gg.w * (1.f + sc.w) + sh.w);
      *(uint2*)(p.H + (size_t)row * 1024 + col) = o;
    }
  }
}


DI void phase_gemm_in(const Params& p, int layer, char* smem) {
  const int N = layer ? OIN : EIN;
  const int Npad = layer ? OIN_PAD : EIN_PAD;
  pg8::Gemm g;
  g.A = p.H; g.Bt = layer ? p.WinO : p.WinE; g.M = NROW; g.N = Npad; g.K = 1024;
  pg8::StaticOrder S;
  S.init(NROW, Npad, (int)gridDim.x, (int)blockIdx.x);
  EpiU E;
  E.U = layer ? p.U1 : p.U0; E.ldu = N; E.nvalid = N; E.aux = layer ? p.out + O_DK : nullptr;
  pg8::gemm_phase<EpiU, pg8::StaticOrder, false>((PG8_LAS unsigned char*)smem, g, S, E, nullptr);
}

DI void phase_gemm_out(const Params& p, int layer, char* smem) {
  const bf16_t* W = layer ? p.WoutO : p.WoutE;
  for (int it = VBLK; it < 48 * 8; it += NVBLK) {
    const int mt = it % 48, nt = it / 48;
    gemm_tile64(p.O, 1024, W, 1024, 1024, 1024, mt * 128, nt * 128, smem,
              [=](int m, int n, f32x4 v) {
                const float4 gt = *(const float4*)(p.MOD + (layer * 3 + cv_of_row(m)) * 3072 + 2048 + n);
                const float4 xv = layer ? load_bf4(p.X1B + (size_t)m * 1024 + n) : *(const float4*)(xrow(p, m) + n);
                f32x4 r;
                r[0] = xv.x + gt.x * v[0]; r[1] = xv.y + gt.y * v[1]; r[2] = xv.z + gt.z * v[2]; r[3] = xv.w + gt.w * v[3];
                store_bf4(p.X1B + (size_t)m * 1024 + n, r);
              });
  }
}

DI void phase_out_norm_fused(const Params& p, int layer, char* smem) {
  const int tid = TIDX, lane = tid & 63, wave = tid >> 6, wm = wave >> 1, wn = wave & 1, g = lane >> 4, l16 = lane & 15;
  float* sSS = (float*)(smem + 65536);
  float* sR = sSS + 256;
  for (int it = VBLK; it < 48 * 8; it += NVBLK) {
    const int mt = it % 48, nt = it / 48, m0 = mt * 128, n0 = nt * 128;
    f32x4 acc[4][4];
    gemm_tile64_acc(p.O, 1024, layer ? p.WoutO : p.WoutE, 1024, 1024, 1024, m0, n0, smem, acc);
    float* ssq_slots = p.SSQ + (size_t)layer * NROW * 8;
    unsigned* cnt_base = p.CNT + layer * 48 * 64;
    float ssq[4];
#pragma unroll
    for (int mi = 0; mi < 4; ++mi) {
      const int row = m0 + wm * 64 + mi * 16 + l16;
      const float* gp = p.MOD + (layer * 3 + cv_of_row(row)) * 3072 + 2048;
      ssq[mi] = 0.f;
#pragma unroll
      for (int ni = 0; ni < 4; ++ni) {
        const int n = n0 + wn * 64 + ni * 16 + g * 4;
        const float4 gt = *(const float4*)(gp + n);
        const float4 xv = layer ? load_bf4(p.X1B + (size_t)row * 1024 + n) : *(const float4*)(xrow(p, row) + n);
        f32x4 r;
        r[0] = xv.x + gt.x * acc[ni][mi][0]; r[1] = xv.y + gt.y * acc[ni][mi][1]; r[2] = xv.z + gt.z * acc[ni][mi][2]; r[3] = xv.w + gt.w * acc[ni][mi][3];
        acc[ni][mi] = r;
        if (!layer) store_bf4(p.X1B + (size_t)row * 1024 + n, r);
        ssq[mi] += r[0] * r[0] + r[1] * r[1] + r[2] * r[2] + r[3] * r[3];
      }
      ssq[mi] = xsum_16_32(ssq[mi]);
    }
    if (g == 0) {
#pragma unroll
      for (int mi = 0; mi < 4; ++mi) sSS[wn * 128 + wm * 64 + mi * 16 + l16] = ssq[mi];
    }
    __syncthreads();
    if (tid < 128) __hip_atomic_store(ssq_slots + (size_t)(m0 + tid) * 8 + nt, sSS[tid] + sSS[128 + tid], __ATOMIC_RELAXED, __HIP_MEMORY_SCOPE_AGENT);
    asm volatile("s_waitcnt vmcnt(0)" ::: "memory");
    __syncthreads();
    if (tid == 0) {
      unsigned* cnt = cnt_base + mt * 64;
      __hip_atomic_fetch_add(cnt, 1u, __ATOMIC_RELAXED, __HIP_MEMORY_SCOPE_AGENT);
      unsigned sp = 0;
      while (__hip_atomic_load(cnt, __ATOMIC_RELAXED, __HIP_MEMORY_SCOPE_AGENT) < 8u) {
        __builtin_amdgcn_s_sleep(1);
        if (++sp > (1u << 22)) break;
      }
      asm volatile("" ::: "memory");
    }
    __syncthreads();
    if (tid < 128) {
      const float* sl = ssq_slots + (size_t)(m0 + tid) * 8;
      float t = 0.f;
#pragma unroll
      for (int q = 0; q < 8; ++q) t += __hip_atomic_load(sl + q, __ATOMIC_RELAXED, __HIP_MEMORY_SCOPE_AGENT);
      sR[tid] = rsqrtf(t * (1.f / 1024.f) + EPSF);
    }
    __syncthreads();
#pragma unroll
    for (int mi = 0; mi < 4; ++mi) {
      const int rl = wm * 64 + mi * 16 + l16;
      const float r = sR[rl];
      float* op = p.out + O_Y + (size_t)(m0 + rl) * 1024;
      const float* md = p.MOD + (3 + cv_of_row(m0 + rl)) * 3072;
#pragma unroll
      for (int ni = 0; ni < 4; ++ni) {
        const int n = n0 + wn * 64 + ni * 16 + g * 4;
        if (layer) {
          const float4 gg = *(const float4*)(p.final_g + n);
          *(float4*)(op + n) = make_float4(acc[ni][mi][0] * r * gg.x, acc[ni][mi][1] * r * gg.y, acc[ni][mi][2] * r * gg.z, acc[ni][mi][3] * r * gg.w);
        } else {
          const float4 gg = *(const float4*)(p.o_norm_g + n), sh = *(const float4*)(md + n), sc = *(const float4*)(md + 1024 + n);
          f32x4 hv;
          hv[0] = acc[ni][mi][0] * r * gg.x * (1.f + sc.x) + sh.x; hv[1] = acc[ni][mi][1] * r * gg.y * (1.f + sc.y) + sh.y;
          hv[2] = acc[ni][mi][2] * r * gg.z * (1.f + sc.z) + sh.z; hv[3] = acc[ni][mi][3] * r * gg.w * (1.f + sc.w) + sh.w;
          store_bf4(p.H + (size_t)(m0 + rl) * 1024 + n, hv);
        }
      }
    }
  }
}

DI void phase_gemm_mla(const Params& p, char* smem) {
  const int G = (int)gridDim.x, bid = (int)blockIdx.x;
  const bool split = G >= 176;
  if (!split || bid < 72) {
    pg8::Gemm g;
    g.A = p.CQN; g.Bt = p.Wuq; g.M = NROW; g.N = 768; g.K = 384;
    pg8::StaticOrder S;
    S.init(NROW, 768, G, bid);
    EpiU E;
    E.U = p.Q; E.ldu = 768; E.nvalid = 768; E.aux = nullptr;
    pg8::gemm_phase<EpiU, pg8::StaticOrder, false>((PG8_LAS unsigned char*)smem, g, S, E, nullptr);
  }
  if (!split || bid >= 72) {
    pg8::Gemm g;
    g.A = p.CKVN; g.Bt = p.Wukv; g.M = NTROW; g.N = 1024; g.K = 256;
    pg8::StaticOrder S;
    S.init(NTROW, 1024, G, split ? bid - 72 : bid);
    EpiU E;
    E.U = p.KV; E.ldu = 1024; E.nvalid = 1024; E.aux = nullptr;
    pg8::gemm_phase<EpiU, pg8::StaticOrder, false>((PG8_LAS unsigned char*)smem, g, S, E, nullptr);
  }
}

struct TRow { int row, pos, cb, ct; bool cache, lat; };
DI TRow decode_trow(int trow) {
  TRow t; t.row = -1; t.pos = 0; t.cb = 0; t.ct = 0; t.cache = false; t.lat = false;
  if (trow < 4096) { t.row = trow; }
  else {
    const int r = trow - 4096; const int b = r / 1280, tt = r % 1280;
    t.lat = true;
    if (tt < 256) { t.cache = true; t.cb = b; t.ct = tt; }
    else { t.pos = tt - 256; t.row = 4096 + b * 1024 + t.pos; }
  }
  return t;
}
DI void cvt_store4(bf16_t* dst, const float* src) {
  const float4 v = *(const float4*)src;
  uint2 o; o.x = pack2(v.x, v.y); o.y = pack2(v.z, v.w);
  *(uint2*)dst = o;
}

DI void phase3(const Params& p) {
  const int tid = TIDX, lane = tid & 63, wave = tid >> 6;
  for (int it = VBLK; it < NTROW / 4; it += NVBLK) {
    const int trow = it * 4 + wave;
    const TRow t = decode_trow(trow);
    if (t.cache) {
      const size_t ci = (size_t)t.cb * 256 + t.ct;
      cvt_store4(p.CKVN + (size_t)trow * 256 + lane * 4, p.cache_ckv + ci * 256 + lane * 4);
      if (lane < 8) cvt_store4(p.KR + (size_t)trow * 32 + lane * 4, p.cache_kr + ci * 32 + lane * 4);
      if (lane < 32) {
        cvt_store4(p.KB + (size_t)trow * 128 + lane * 4, p.cache_gk + ci * 128 + lane * 4);
        cvt_store4(p.VB + (size_t)trow * 128 + lane * 4, p.cache_gv + ci * 128 + lane * 4);
      }
      continue;
    }
    const int row = t.row;
    const bf16_t* u = p.U0 + (size_t)row * EIN;
    {
      float x[6]; float ss = 0.f;
#pragma unroll
      for (int i = 0; i < 3; ++i) {
        const unsigned w = *(const unsigned*)(u + i * 128 + lane * 2);
        x[2 * i] = lo2f(w); x[2 * i + 1] = hi2f(w);
        ss += x[2 * i] * x[2 * i] + x[2 * i + 1] * x[2 * i + 1];
      }
      ss = wave_sum(ss);
      const float r = rsqrtf(ss * (1.f / 384.f) + EPSF);
#pragma unroll
      for (int i = 0; i < 3; ++i) {
        const int col = i * 128 + lane * 2;
        *(unsigned*)(p.CQN + (size_t)row * 384 + col) = pack2(x[2 * i] * r * p.e_qn_g[col], x[2 * i + 1] * r * p.e_qn_g[col + 1]);
      }
    }
    {
      const uint2 w = *(const uint2*)(u + 384 + lane * 4);
      float x0 = lo2f(w.x), x1 = hi2f(w.x), x2 = lo2f(w.y), x3 = hi2f(w.y);
      float ss = wave_sum(x0 * x0 + x1 * x1 + x2 * x2 + x3 * x3);
      const float r = rsqrtf(ss * (1.f / 256.f) + EPSF);
      const float4 gg = *(const float4*)(p.e_kvn_g + lane * 4);
      x0 *= r * gg.x; x1 *= r * gg.y; x2 *= r * gg.z; x3 *= r * gg.w;
      uint2 o; o.x = pack2(x0, x1); o.y = pack2(x2, x3);
      *(uint2*)(p.CKVN + (size_t)trow * 256 + lane * 4) = o;
      if (!t.lat) *(float4*)(p.out + O_CKV + (size_t)row * 256 + lane * 4) = make_float4(x0, x1, x2, x3);
    }
    if (lane < 16) {
      const unsigned w = *(const unsigned*)(u + 640 + lane * 2);
      float x0 = lo2f(w), x1 = hi2f(w);
      if (t.lat) {
        const float2 cs = p.ROPE32[t.pos * 16 + lane];
        const float y0 = x0 * cs.x - x1 * cs.y, y1 = x0 * cs.y + x1 * cs.x;
        x0 = y0; x1 = y1;
      } else {
        *(float2*)(p.out + O_KR + (size_t)row * 32 + lane * 2) = make_float2(x0, x1);
      }
      *(unsigned*)(p.KR + (size_t)trow * 32 + lane * 2) = pack2(x0, x1);
    }
#pragma unroll
    for (int which = 0; which < 2; ++which) {
      const int lsrc = which ? (lane & 15) : lane;
      const uint4 w = *(const uint4*)(u + (which ? 1696 : 1184) + lsrc * 8);
      float x[8] = {lo2f(w.x), hi2f(w.x), lo2f(w.y), hi2f(w.y), lo2f(w.z), hi2f(w.z), lo2f(w.w), hi2f(w.w)};
      float ss = 0.f;
#pragma unroll
      for (int j = 0; j < 8; ++j) ss += x[j] * x[j];
      ss += __shfl_xor(ss, 1); ss += __shfl_xor(ss, 2); ss += __shfl_xor(ss, 4);
      const float r = rsqrtf(ss * (1.f / 64.f) + EPSF);
      const float* gp = (which ? p.e_gk_g : p.e_gq_g) + (lane & 7) * 8;
#pragma unroll
      for (int j = 0; j < 8; ++j) x[j] *= r * gp[j];
      if (t.lat) {
#pragma unroll
        for (int jj = 0; jj < 4; ++jj) {
          const float2 cs = p.ROPE64[t.pos * 32 + (lane & 7) * 4 + jj];
          const float y0 = x[2 * jj] * cs.x - x[2 * jj + 1] * cs.y, y1 = x[2 * jj] * cs.y + x[2 * jj + 1] * cs.x;
          x[2 * jj] = y0; x[2 * jj + 1] = y1;
        }
      }
      uint4 o; o.x = pack2(x[0], x[1]); o.y = pack2(x[2], x[3]); o.z = pack2(x[4], x[5]); o.w = pack2(x[6], x[7]);
      if (which == 0) {
        *(uint4*)(p.QB + (size_t)row * 512 + lane * 8) = o;
      } else if (lane < 16) {
        *(uint4*)(p.KB + (size_t)trow * 128 + lane * 8) = o;
        if (!t.lat) {
          float* op = p.out + O_GK + (size_t)row * 128 + lane * 8;
          *(float4*)op = make_float4(x[0], x[1], x[2], x[3]);
          *(float4*)(op + 4) = make_float4(x[4], x[5], x[6], x[7]);
        }
      }
    }
    if (lane < 16) {
      const uint4 w = *(const uint4*)(u + 1824 + lane * 8);
      *(uint4*)(p.VB + (size_t)trow * 128 + lane * 8) = w;
      if (!t.lat) {
        float* op = p.out + O_GV + (size_t)row * 128 + lane * 8;
        *(float4*)op = make_float4(lo2f(w.x), hi2f(w.x), lo2f(w.y), hi2f(w.y));
        *(float4*)(op + 4) = make_float4(lo2f(w.z), hi2f(w.z), lo2f(w.w), hi2f(w.w));
      }
    }
  }
}

DI void phase_attn0(const Params& p, char* smem) {
  const int lane = TIDX & 63, wave = TIDX >> 6, g = lane >> 4, l16 = lane & 15;
  for (int it = vblk_xcd(); it < 1536; it += NVBLK) {
    int kind, b, h, qb, row0, trow0, T;
    if (it < 512) { const int i = it & 255; kind = it >> 8; b = i >> 7; h = (i >> 4) & 7; qb = i & 15; row0 = 4096 + b * 1024 + qb * 64; trow0 = 4096 + b * 1280; T = 1280; }
    else { const int i2 = it - 512; kind = i2 >> 9; const int i = i2 & 511; b = i >> 5; h = (i >> 2) & 7; qb = i & 3; row0 = b * 256 + qb * 64; trow0 = b * 256; T = 256; }
    f32x4 oo[1][4];
    float lss[1], mss[1];
    int gcol, ocol;
    const int row = row0 + wave * 16 + l16;
    uint2 gwv[4];
    {
      const int gc = kind == 0 ? 672 + h * 64 : 1952 + h * 64;
#pragma unroll
      for (int i = 0; i < 4; ++i) gwv[i] = *(const uint2*)(p.U0 + (size_t)row * EIN + gc + i * 16 + g * 4);
    }
    if (kind == 0) {
      attn_core<96, 64, false>(smem, p.Q + (size_t)row0 * 768 + h * 96, 768, p.KV + (size_t)trow0 * 1024 + h * 128, 1024,
                        p.KR + (size_t)trow0 * 32, 32, p.KV + (size_t)trow0 * 1024 + h * 128 + 64, 1024, T,
                        0.10206207261596575f * 1.4426950408889634f, oo, lss, mss,
                        it < 512 ? p.ROPE32 + (size_t)(qb * 64) * 16 : nullptr);
      gcol = 672 + h * 64; ocol = h * 64;
    } else {
      const int kvh = h >> 2;
      attn_core<64, 64, false>(smem, p.QB + (size_t)row0 * 512 + h * 64, 512, p.KB + (size_t)trow0 * 128 + kvh * 64, 128,
                        nullptr, 0, p.VB + (size_t)trow0 * 128 + kvh * 64, 128, T, 0.125f * 1.4426950408889634f, oo, lss, mss);
      gcol = 1952 + h * 64; ocol = 512 + h * 64;
    }
    float ls = lss[0];
    ls = xsum_16_32(ls);
    const float inv = 1.f / ls;
    f32x4 (&o)[4] = oo[0];
#pragma unroll
    for (int i = 0; i < 4; ++i) {
      const int dv = i * 16 + g * 4;
      const uint2 gw = gwv[i];
      f32x4 r;
      r[0] = o[i][0] * inv * siluf(lo2f(gw.x)); r[1] = o[i][1] * inv * siluf(hi2f(gw.x));
      r[2] = o[i][2] * inv * siluf(lo2f(gw.y)); r[3] = o[i][3] * inv * siluf(hi2f(gw.y));
      store_bf4(p.O + (size_t)row * 1024 + ocol + dv, r);
    }
  }
}

DI void mlstm_gates(const Params& p, int rowbase, int nc, int h, int dir, int j, int lane, float& ig, float& lf) {
  const int oc = dir ? nc - 1 - j : j;
  const int s = dir ? 63 - lane : lane;
  const int row = rowbase + oc * 64 + s;
  const bf16_t* up = p.U1 + (size_t)row * OIN + 2048;
  ig = bf2f(up[dir * 8 + h]) + p.o_gate_b[dir * 8 + h];
  lf = logsig(bf2f(up[dir * 8 + 4 + h]) + p.o_gate_b[dir * 8 + 4 + h]);
}
DI void mitem_decode(int it, int& sq, int& h, int& dir, int& j, int& nc, int& rowbase) {
  if (it < 512) { j = it & 3; dir = (it >> 2) & 1; h = (it >> 3) & 3; sq = it >> 5; nc = 4; rowbase = sq * 256; }
  else { const int i = it - 512; j = i & 15; dir = (i >> 4) & 1; h = (i >> 5) & 3; sq = 16 + (i >> 7); nc = 16; rowbase = 4096 + (sq - 16) * 1024; }
}
DI int mitem_id(int sq, int h, int dir, int j) {
  return sq < 16 ? (((sq * 4 + h) * 2 + dir) * 4 + j) : (512 + ((((sq - 16) * 4 + h) * 2 + dir) * 16 + j));
}

DI void phase9(const Params& p, char* smem) {
  const int tid = TIDX, lane = tid & 63, wave = tid >> 6, g = lane >> 4, l16 = lane & 15;
  for (int it = VBLK; it < NTROW / 4; it += NVBLK) {
    const int trow = it * 4 + wave;
    const TRow t = decode_trow(trow);
    if (t.cache) {
      const size_t ci = (size_t)t.cb * 256 + t.ct;
      cvt_store4(p.KD + (size_t)trow * 512 + lane * 8, p.cache_dk + ci * 512 + lane * 8);
      cvt_store4(p.KD + (size_t)trow * 512 + lane * 8 + 4, p.cache_dk + ci * 512 + lane * 8 + 4);
      cvt_store4(p.VD + (size_t)trow * 512 + lane * 8, p.cache_dv + ci * 512 + lane * 8);
      cvt_store4(p.VD + (size_t)trow * 512 + lane * 8 + 4, p.cache_dv + ci * 512 + lane * 8 + 4);
      continue;
    }
    if (!t.lat) continue;
    const int row = t.row;
    const bf16_t* u = p.U1 + (size_t)row * OIN;
#pragma unroll
    for (int which = 0; which < 2; ++which) {
      const uint4 w = *(const uint4*)(u + (which ? 3088 : 2576) + lane * 8);
      float x[8] = {lo2f(w.x), hi2f(w.x), lo2f(w.y), hi2f(w.y), lo2f(w.z), hi2f(w.z), lo2f(w.w), hi2f(w.w)};
      if (t.lat) {
#pragma unroll
        for (int jj = 0; jj < 4; ++jj) {
          const float2 cs = p.ROPE64[t.pos * 32 + (lane & 7) * 4 + jj];
          const float y0 = x[2 * jj] * cs.x - x[2 * jj + 1] * cs.y, y1 = x[2 * jj] * cs.y + x[2 * jj + 1] * cs.x;
          x[2 * jj] = y0; x[2 * jj + 1] = y1;
        }
      }
      uint4 o; o.x = pack2(x[0], x[1]); o.y = pack2(x[2], x[3]); o.z = pack2(x[4], x[5]); o.w = pack2(x[6], x[7]);
      if (which == 0) { if (t.lat) *(uint4*)(p.QD + (size_t)row * 512 + lane * 8) = o; }
      else {
        if (t.lat) *(uint4*)(p.KD + (size_t)trow * 512 + lane * 8) = o;
        if (!t.lat) {
          float* op = p.out + O_DK + (size_t)row * 512 + lane * 8;
          *(float4*)op = make_float4(x[0], x[1], x[2], x[3]);
          *(float4*)(op + 4) = make_float4(x[4], x[5], x[6], x[7]);
        }
      }
    }
    {
      const uint4 w = *(const uint4*)(u + 3600 + lane * 8);
      if (t.lat) *(uint4*)(p.VD + (size_t)trow * 512 + lane * 8) = w;
      if (!t.lat) {
        float* op = p.out + O_DV + (size_t)row * 512 + lane * 8;
        *(float4*)op = make_float4(lo2f(w.x), hi2f(w.x), lo2f(w.y), hi2f(w.y));
        *(float4*)(op + 4) = make_float4(lo2f(w.z), hi2f(w.z), lo2f(w.w), hi2f(w.w));
      }
    }
  }
  bf16_t* sKT = (bf16_t*)smem;
  bf16_t* sVT = sKT + 128 * LDT;
  float* swk = (float*)(sVT + 128 * LDT);
  for (int it = VBLK; it < 768; it += NVBLK) {
    int sq, h, dir, j, nc, rowbase;
    mitem_decode(it, sq, h, dir, j, nc, rowbase);
    float ig, lf;
    mlstm_gates(p, rowbase, nc, h, dir, j, lane, ig, lf);
    const float b = scan_add(lf, lane);
    const float bL = __shfl(b, 63);
    const float mx = wave_max(bL - b + ig);
    const float wk = fexp(bL - b + ig - mx);
    __syncthreads();
    if (wave == 0) {
      swk[dir ? 63 - lane : lane] = wk;
      if (lane == 0) { p.SC[it * 4 + 0] = bL; p.SC[it * 4 + 1] = mx; }
    }
    __syncthreads();
    const int oc = dir ? nc - 1 - j : j;
    const int row0 = rowbase + oc * 64;
    stage_T64<128>(sKT, p.U1 + (size_t)row0 * OIN + 512 + h * 128, OIN, nullptr);
    stage_T64<128>(sVT, p.U1 + (size_t)row0 * OIN + 1024 + h * 128, OIN, swk);
    __syncthreads();
    f32x4 acc[2][8];
#pragma unroll
    for (int a = 0; a < 2; ++a)
#pragma unroll
      for (int c = 0; c < 8; ++c) acc[a][c] = f32x4{0.f, 0.f, 0.f, 0.f};
#pragma unroll
    for (int ks = 0; ks < 2; ++ks) {
      bf16x8 vf[2];
#pragma unroll
      for (int a = 0; a < 2; ++a) vf[a] = *(const bf16x8*)(sVT + ((wave * 2 + a) * 16 + l16) * LDT + ks * 32 + g * 8);
#pragma unroll
      for (int kt = 0; kt < 8; ++kt) {
        const bf16x8 kf = *(const bf16x8*)(sKT + (kt * 16 + l16) * LDT + ks * 32 + g * 8);
#pragma unroll
        for (int a = 0; a < 2; ++a) acc[a][kt] = MFMA16(kf, vf[a], acc[a][kt]);
      }
    }
    bf16_t* uc = p.UC + (size_t)it * 16384;
#pragma unroll
    for (int a = 0; a < 2; ++a)
#pragma unroll
      for (int kt = 0; kt < 8; ++kt) {
        const int v = (wave * 2 + a) * 16 + l16, k = kt * 16 + g * 4;
        store_bf4(uc + v * 128 + k, acc[a][kt]);
      }
    if (tid < 128) {
      float s = 0.f;
#pragma unroll
      for (int c8 = 0; c8 < 8; ++c8) {
        const u32x4 kw = *(const u32x4*)(sKT + tid * LDT + c8 * 8);
        const float4 w0 = *(const float4*)(swk + c8 * 8), w1 = *(const float4*)(swk + c8 * 8 + 4);
        s += lo2f(kw[0]) * w0.x + hi2f(kw[0]) * w0.y + lo2f(kw[1]) * w0.z + hi2f(kw[1]) * w0.w
           + lo2f(kw[2]) * w1.x + hi2f(kw[2]) * w1.y + lo2f(kw[3]) * w1.z + hi2f(kw[3]) * w1.w;
      }
      p.NU[it * 128 + tid] = s;
    }
  }
}

DI void diff_finish(const Params& p, f32x4 (&o1)[8], f32x4 (&o2)[8], float l1, float l2, int row0, int hd) {
  const int lane = TIDX & 63, wave = TIDX >> 6, g = lane >> 4, l16 = lane & 15;
  l1 = xsum_16_32(l1);
  l2 = xsum_16_32(l2);
  const float i1 = 1.f / l1, i2 = p.LAMV[0] / l2;
  float ss = 0.f;
#pragma unroll
  for (int i = 0; i < 8; ++i)
#pragma unroll
    for (int j = 0; j < 4; ++j) { o1[i][j] = o1[i][j] * i1 - o2[i][j] * i2; ss += o1[i][j] * o1[i][j]; }
  ss = xsum_16_32(ss);
  const float r = rsqrtf(ss * (1.f / 128.f) + EPSF) * (1.f - LAM_INIT);
  const int row = row0 + wave * 16 + l16;
#pragma unroll
  for (int i = 0; i < 8; ++i) {
    const int dv = i * 16 + g * 4;
    const uint2 gw = *(const uint2*)(p.U1 + (size_t)row * OIN + 4112 + hd * 128 + dv);
    const float4 gn = *(const float4*)(p.o_dnorm_g + dv);
    f32x4 rr;
    rr[0] = o1[i][0] * r * gn.x * siluf(lo2f(gw.x)); rr[1] = o1[i][1] * r * gn.y * siluf(hi2f(gw.x));
    rr[2] = o1[i][2] * r * gn.z * siluf(lo2f(gw.y)); rr[3] = o1[i][3] * r * gn.w * siluf(hi2f(gw.y));
    store_bf4(p.O + (size_t)row * 1024 + 512 + hd * 128 + dv, rr);
  }
}

DI void phase10(const Params& p, char* smem) {
  const int tid = TIDX, lane = tid & 63, wave = tid >> 6, g = lane >> 4, l16 = lane & 15;
  for (int it = vblk_xcd(); it < 512; it += NVBLK) {
    int b, hd, qb, row0, trow0, T;
    const bool lat = it < 256;
    const int split = (it >> 1) & 1;
    const int li = ((it >> 7) * 4 + ((it >> 5) & 3)) * 16 + ((it >> 2) & 7) * 2 + (it & 1);
    if (lat) { b = li >> 6; hd = (li >> 4) & 3; qb = li & 15; row0 = 4096 + b * 1024 + qb * 64; trow0 = 4096 + b * 1280 + split * 640; T = 640; }
    else { const int i = it - 256; b = i >> 4; hd = (i >> 2) & 3; qb = i & 3; row0 = b * 256 + qb * 64; trow0 = b * 256; T = 256; }
    f32x4 od[2][8];
    float ld2[2], md2[2];
    const float sc = 0.125f * 1.4426950408889634f;
    const bf16_t* qp = lat ? p.QD + (size_t)row0 * 512 + hd * 128 : p.U1 + (size_t)row0 * OIN + 2576 + hd * 128;
    const bf16_t* kp = lat ? p.KD + (size_t)trow0 * 512 + hd * 128 : p.U1 + (size_t)trow0 * OIN + 3088 + hd * 128;
    const bf16_t* vp = lat ? p.VD + (size_t)trow0 * 512 + hd * 128 : p.U1 + (size_t)trow0 * OIN + 3600 + hd * 128;
    const int ldqkv = lat ? 512 : OIN;
    attn_core<64, 128, true>(smem, qp, ldqkv, kp, ldqkv, nullptr, 0, vp, ldqkv, T, sc, od, ld2, md2);
    if (lat) {
#pragma unroll
      for (int n = 0; n < 2; ++n) {
        const size_t base = (size_t)((li * 2 + split) * 2 + n) * 4 + wave;
#pragma unroll
        for (int i = 0; i < 8; ++i) store_bf4(p.OP + ((base * 8 + i) * 64 + lane) * 4, od[n][i]);
        *(float2*)(p.ML + (base * 64 + lane) * 2) = make_float2(md2[n], ld2[n]);
      }
    } else {
      diff_finish(p, od[0], od[1], ld2[0], ld2[1], row0, hd);
    }
  }
  const int vb = (vblk_xcd() + (NVBLK >> 1)) % NVBLK;
  for (int it = vb; it < 144 * 16; it += NVBLK) {
    const int chain = it < 256 ? 128 + (it >> 4) : ((it - 256) >> 4), eb = it & 15;
    const int sq = chain >> 3, h = (chain >> 1) & 3, dir = chain & 1;
    const int nc = sq < 16 ? 4 : 16;
    const int ib = mitem_id(sq, h, dir, 0);
    const int e = eb * 1024 + tid * 4;
    float4 C = make_float4(0.f, 0.f, 0.f, 0.f);
    if (sq >= 16) C = *(const float4*)(p.st_C + (size_t)(((sq - 16) * 2 + dir) * 4 + h) * 16384 + e);
    float4 uu[16];
    float dcs[16], scl[16], bLs[16], mxs[16];
#pragma unroll
    for (int j = 0; j < 16; ++j) {
      if (j < nc) { bLs[j] = p.SC[(ib + j) * 4 + 0]; mxs[j] = p.SC[(ib + j) * 4 + 1]; uu[j] = load_bf4(p.UC + (size_t)(ib + j) * 16384 + e); }
    }
    float mrun = 0.f;
    if (sq >= 16) mrun = p.st_m[((sq - 16) * 2 + dir) * 4 + h];
#pragma unroll
    for (int j = 0; j < 16; ++j) {
      if (j < nc) {
        const float mnext = fmaxf(bLs[j] + mrun, mxs[j]);
        dcs[j] = fexp(bLs[j] + mrun - mnext);
        scl[j] = fexp(mxs[j] - mnext);
        if (eb == 0 && tid == 0) p.SCM[ib + j] = mrun;
        mrun = mnext;
      }
    }
#pragma unroll
    for (int j = 0; j < 16; ++j) {
      if (j < nc) {
        uint2 o; o.x = pack2(C.x, C.y); o.y = pack2(C.z, C.w);
        *(uint2*)(p.CST + (size_t)(ib + j) * 16384 + e) = o;
        const float dc = dcs[j], sc = scl[j];
        C.x = dc * C.x + sc * uu[j].x; C.y = dc * C.y + sc * uu[j].y; C.z = dc * C.z + sc * uu[j].z; C.w = dc * C.w + sc * uu[j].w;
      }
    }
    if (sq < 16) *(float4*)(p.out + O_C + (size_t)((sq * 2 + dir) * 4 + h) * 16384 + e) = C;
    if (eb == 0 && tid < 128) {
      float n = 0.f;
      if (sq >= 16) n = p.st_n[(((sq - 16) * 2 + dir) * 4 + h) * 128 + tid];
#pragma unroll
      for (int j = 0; j < 16; ++j) {
        if (j < nc) {
          p.NST[(ib + j) * 128 + tid] = n;
          n = dcs[j] * n + scl[j] * p.NU[(ib + j) * 128 + tid];
        }
      }
      if (sq < 16) {
        p.out[O_N + ((sq * 2 + dir) * 4 + h) * 128 + tid] = n;
        if (tid == 0) p.out[O_M + (sq * 2 + dir) * 4 + h] = mrun;
      }
    }
  }
}

DI void phase11(const Params& p, char* smem) {
  const int tid = TIDX, lane = tid & 63, wave = tid >> 6, g = lane >> 4, l16 = lane & 15;
  bf16_t* sK = (bf16_t*)smem;
  bf16_t* sVT = sK + 64 * 128;
  float* sB = (float*)(sVT + 128 * LDT);
  float* sA = sB + 128;
  float* sMT = sA + 128;
  bf16_t* sC = (bf16_t*)(smem + 36352);
  for (int it = VBLK; it < 512; it += NVBLK) {
    if (it >= 384) {
    const int li = it - 384;
    const int b = li >> 6, hd = (li >> 4) & 3, qb = li & 15, row0 = 4096 + b * 1024 + qb * 64;
    f32x4 oc[2][8];
    float lc[2];
#pragma unroll
    for (int n = 0; n < 2; ++n) {
      const size_t b0 = (size_t)((li * 2 + 0) * 2 + n) * 4 + wave, b1 = (size_t)((li * 2 + 1) * 2 + n) * 4 + wave;
      const float2 ml0 = *(const float2*)(p.ML + (b0 * 64 + lane) * 2), ml1 = *(const float2*)(p.ML + (b1 * 64 + lane) * 2);
      const float m = fmaxf(ml0.x, ml1.x);
      const float f0 = __builtin_amdgcn_exp2f((ml0.x - m) * (0.125f * 1.4426950408889634f)), f1 = __builtin_amdgcn_exp2f((ml1.x - m) * (0.125f * 1.4426950408889634f));
      lc[n] = ml0.y * f0 + ml1.y * f1;
#pragma unroll
      for (int i = 0; i < 8; ++i) {
        const float4 a0 = load_bf4(p.OP + ((b0 * 8 + i) * 64 + lane) * 4), a1 = load_bf4(p.OP + ((b1 * 8 + i) * 64 + lane) * 4);
        oc[n][i] = f32x4{a0.x * f0 + a1.x * f1, a0.y * f0 + a1.y * f1, a0.z * f0 + a1.z * f1, a0.w * f0 + a1.w * f1};
      }
    }
    diff_finish(p, oc[0], oc[1], lc[0], lc[1], row0, hd);
    continue;
    }
    int sq, h, c, nc, rowbase;
    if (it < 128) { sq = 16 + (it >> 6); h = (it >> 4) & 3; c = it & 15; nc = 16; rowbase = 4096 + (sq - 16) * 1024; }
    else { const int i = it - 128; sq = i >> 4; h = (i >> 2) & 3; c = i & 3; nc = 4; rowbase = sq * 256; }
    const int row0 = rowbase + c * 64;
    float mst[2];
    int item[2];
    item[0] = mitem_id(sq, h, 0, c);
    item[1] = mitem_id(sq, h, 1, nc - 1 - c);
    u32x4 cr[8];
    {
      const bf16_t* cst0 = p.CST + (size_t)item[0] * 16384;
#pragma unroll
      for (int i = 0; i < 8; ++i) cr[i] = *(const u32x4*)(cst0 + (tid + 256 * i) * 8);
    }
    __syncthreads();
#pragma unroll
    for (int dir = 0; dir < 2; ++dir) {
      const int j = dir ? nc - 1 - c : c;
      mst[dir] = p.SCM[item[dir]];
      if (wave == 0) {
        float ig, lf;
        mlstm_gates(p, rowbase, nc, h, dir, j, lane, ig, lf);
        const float b = scan_add(lf, lane);
        const float a = ig - b;
        const float pm = scan_max(a, lane);
        const float mt = b + fmaxf(mst[dir], pm);
        const int so = dir ? 63 - lane : lane;
        sB[dir * 64 + so] = b; sA[dir * 64 + so] = a; sMT[dir * 64 + so] = mt;
      }
    }
    for (int c = tid; c < 64 * 16; c += 256) {
      const int r = c >> 4, ch = c & 15;
      *(uint4*)(sK + (ch >> 2) * 2048 + r * 32 + (((ch & 3) ^ ((4 - ((r >> 2) & 3)) & 3)) * 8)) = *(const uint4*)(p.U1 + (size_t)(row0 + r) * OIN + 512 + h * 128 + ch * 8);
    }
    stage_T64<128>(sVT, p.U1 + (size_t)row0 * OIN + 1024 + h * 128, OIN, nullptr);
#pragma unroll
    for (int i = 0; i < 8; ++i) {
      const int cc = tid + 256 * i, r = cc >> 4, ch = cc & 15;
      *(u32x4*)(sC + (ch >> 2) * 4096 + r * 32 + (((ch & 3) ^ ((4 - ((r >> 2) & 3)) & 3)) * 8)) = cr[i];
    }
    bf16x8 qf[4];
    const int tq = wave * 16 + l16;
    const int row = row0 + tq;
#pragma unroll
    for (int ks = 0; ks < 4; ++ks) qf[ks] = *(const bf16x8*)(p.U1 + (size_t)row * OIN + h * 128 + ks * 32 + g * 8);
    __syncthreads();
    f32x4 hsum[8];
#pragma unroll
    for (int i = 0; i < 8; ++i) hsum[i] = f32x4{0.f, 0.f, 0.f, 0.f};
#pragma unroll 1
    for (int dir = 0; dir < 2; ++dir) {
      const float bt = sB[dir * 64 + tq], mtt = sMT[dir * 64 + tq];
      const float mst_d = dir ? mst[1] : mst[0];
      const int item_d = dir ? item[1] : item[0];
      const float w_inter = fexp(bt + mst_d - mtt);
      const float et = bt - mtt;
      if (dir == 0) {
        const bf16_t* cst1 = p.CST + (size_t)item[1] * 16384;
#pragma unroll
        for (int i = 0; i < 8; ++i) cr[i] = *(const u32x4*)(cst1 + (tid + 256 * i) * 8);
      }
      f32x4 s[4];
      float dsum = 0.f;
#pragma unroll
      for (int t = 0; t < 4; ++t) {
        s[t] = f32x4{0.f, 0.f, 0.f, 0.f};
#pragma unroll
        for (int ks = 0; ks < 4; ++ks) {
          const bf16x8 kf = *(const bf16x8*)(sK + ks * 2048 + (t * 16 + l16) * 32 + ((g ^ ((4 - (l16 >> 2)) & 3)) * 8));
          s[t] = MFMA16(kf, qf[ks], s[t]);
        }
#pragma unroll
        for (int j = 0; j < 4; ++j) {
          const int sk = t * 16 + g * 4 + j;
          const bool ok = dir ? (sk >= tq) : (sk <= tq);
          const float w = ok ? fexp(et + sA[dir * 64 + sk]) : 0.f;
          s[t][j] *= w;
          dsum += s[t][j];
        }
      }
      dsum = xsum_16_32(dsum);
      f32x4 acc[8];
#pragma unroll
      for (int vt = 0; vt < 8; ++vt) {
        acc[vt] = f32x4{0.f, 0.f, 0.f, 0.f};
#pragma unroll
        for (int ks = 0; ks < 4; ++ks) {
          const bf16x8 cf = *(const bf16x8*)(sC + ks * 4096 + (vt * 16 + l16) * 32 + ((g ^ ((4 - (l16 >> 2)) & 3)) * 8));
          acc[vt] = MFMA16(cf, qf[ks], acc[vt]);
        }
        acc[vt] *= w_inter;
        if ((vt & 3) == 3) asm volatile("" ::: "memory");
      }
#pragma unroll
      for (int kb = 0; kb < 2; ++kb) {
        bf16x8 pf;
#pragma unroll
        for (int j = 0; j < 4; ++j) { pf[j] = (short)f2bf(s[2 * kb][j]); pf[4 + j] = (short)f2bf(s[2 * kb + 1][j]); }
#pragma unroll
        for (int vt = 0; vt < 8; ++vt) {
          const bf16_t* vp = sVT + (vt * 16 + l16) * LDT + kb * 32 + g * 4;
          const bf16x4 lo = *(const bf16x4*)(vp);
          const bf16x4 hi = *(const bf16x4*)(vp + 16);
          const bf16x8 vf = __builtin_shufflevector(lo, hi, 0, 1, 2, 3, 4, 5, 6, 7);
          acc[vt] = MFMA16(vf, pf, acc[vt]);
        }
      }
      float nq = 0.f;
      const float* nst = p.NST + (size_t)item_d * 128;
#pragma unroll
      for (int ks = 0; ks < 4; ++ks) {
        const float4 n0 = *(const float4*)(nst + ks * 32 + g * 8), n1 = *(const float4*)(nst + ks * 32 + g * 8 + 4);
        nq += n0.x * bf2f((bf16_t)qf[ks][0]) + n0.y * bf2f((bf16_t)qf[ks][1]) + n0.z * bf2f((bf16_t)qf[ks][2]) + n0.w * bf2f((bf16_t)qf[ks][3]);
        nq += n1.x * bf2f((bf16_t)qf[ks][4]) + n1.y * bf2f((bf16_t)qf[ks][5]) + n1.z * bf2f((bf16_t)qf[ks][6]) + n1.w * bf2f((bf16_t)qf[ks][7]);
      }
      nq = xsum_16_32(nq);
      const float den = w_inter * nq + dsum;
      const float dinv = 1.f / fmaxf(fabsf(den), fexp(-mtt));
#pragma unroll
      for (int vt = 0; vt < 8; ++vt) hsum[vt] += acc[vt] * dinv;
      if (dir == 0) {
        __syncthreads();
#pragma unroll
        for (int i = 0; i < 8; ++i) {
          const int cc = tid + 256 * i, r = cc >> 4, ch = cc & 15;
          *(u32x4*)(sC + (ch >> 2) * 4096 + r * 32 + (((ch & 3) ^ ((4 - ((r >> 2) & 3)) & 3)) * 8)) = cr[i];
        }
        __syncthreads();
      }
    }
    const bf16_t* u = p.U1 + (size_t)row * OIN;
    float ss = 0.f;
#pragma unroll
    for (int vt = 0; vt < 8; ++vt) {
      const uint2 ow = *(const uint2*)(u + 1536 + h * 128 + vt * 16 + g * 4);
      hsum[vt][0] *= sigmf(lo2f(ow.x)); hsum[vt][1] *= sigmf(hi2f(ow.x));
      hsum[vt][2] *= sigmf(lo2f(ow.y)); hsum[vt][3] *= sigmf(hi2f(ow.y));
#pragma unroll
      for (int j = 0; j < 4; ++j) ss += hsum[vt][j] * hsum[vt][j];
    }
    ss = xsum_16_32(ss);
    const float r = rsqrtf(ss * (1.f / 128.f) + EPSF);
#pragma unroll
    for (int vt = 0; vt < 8; ++vt) {
      const int v = h * 128 + vt * 16 + g * 4;
      const uint2 zw = *(const uint2*)(u + 2064 + v);
      const float4 gn = *(const float4*)(p.o_mnorm_g + v);
      f32x4 rr;
      rr[0] = hsum[vt][0] * r * gn.x * siluf(lo2f(zw.x)); rr[1] = hsum[vt][1] * r * gn.y * siluf(hi2f(zw.x));
      rr[2] = hsum[vt][2] * r * gn.z * siluf(lo2f(zw.y)); rr[3] = hsum[vt][3] * r * gn.w * siluf(hi2f(zw.y));
      store_bf4(p.O + (size_t)row * 1024 + v, rr);
    }
  }
}

DI void phase_final(const Params& p) {
  const int tid = TIDX, lane = tid & 63, wave = tid >> 6;
  for (int it = VBLK; it < NROW / 4; it += NVBLK) {
    const int row = it * 4 + wave;
    const bf16_t* x = p.X1B + (size_t)row * 1024;
    float4 v[4];
    float ss = 0.f;
#pragma unroll
    for (int i = 0; i < 4; ++i) {
      v[i] = load_bf4(x + i * 256 + lane * 4);
      ss += v[i].x * v[i].x + v[i].y * v[i].y + v[i].z * v[i].z + v[i].w * v[i].w;
    }
    ss = wave_sum(ss);
    const float r = rsqrtf(ss * (1.f / 1024.f) + EPSF);
#pragma unroll
    for (int i = 0; i < 4; ++i) {
      const int col = i * 256 + lane * 4;
      const float4 gg = *(const float4*)(p.final_g + col);
      *(float4*)(p.out + O_Y + (size_t)row * 1024 + col) = make_float4(v[i].x * r * gg.x, v[i].y * r * gg.y, v[i].z * r * gg.z, v[i].w * r * gg.w);
    }
  }
}


#define XB_TMO      128
#define XB_XCNT(j)  (256  + 64 * (j))
#define XB_XSUB(j)  (1280 + 64 * (j))
#define XB_XGEN(j)  (2304 + 64 * (j))
#define XB_TOP      3328
#define XB_TOPGEN   3392
#define XCD_BAR_WORDS 3456
#define XB_SPIN_CAP (1u << 18)
#define LAS __attribute__((address_space(3)))
DI unsigned xb_ld(unsigned* p) { return __hip_atomic_load(p, __ATOMIC_RELAXED, __HIP_MEMORY_SCOPE_AGENT); }
DI unsigned xb_add(unsigned* p, unsigned v) { return __hip_atomic_fetch_add(p, v, __ATOMIC_RELAXED, __HIP_MEMORY_SCOPE_AGENT); }
DI unsigned xb_xcc_id() { return (unsigned)__builtin_amdgcn_s_getreg((3 << 11) | 20) & 0xFu; }
#define XB_SPIN(cond, bar) do { unsigned _sp = 0; while (cond) { __builtin_amdgcn_s_sleep(1); \
    if ((++_sp & 255u) == 0u) { if (xb_ld(&(bar)[XB_TMO])) break; if (_sp > XB_SPIN_CAP) { atomicAdd(&(bar)[XB_TMO], 1u); break; } } } } while (0)
struct XcdBarrier { unsigned* bar; unsigned x; volatile LAS unsigned* st; };
DI XcdBarrier xcd_barrier_post(unsigned* bar, volatile LAS unsigned* st) {
  XcdBarrier b; b.bar = bar; b.x = xb_xcc_id(); b.st = st;
  if (threadIdx.x == 0) (void)xb_add(&bar[XB_XCNT(b.x)], 1u);
  return b;
}
DI void xcd_barrier_complete(unsigned* bar, unsigned x, unsigned& nloc, unsigned& nx) {
  const unsigned G = gridDim.x * gridDim.y * gridDim.z;
  unsigned sum, cnt, mine, sp = 0u;
  for (;;) {
    sum = 0u; cnt = 0u; mine = 0u;
#pragma unroll
    for (unsigned j = 0; j < 16; ++j) { const unsigned c = xb_ld(&bar[XB_XCNT(j)]); sum += c; cnt += (c > 0u) ? 1u : 0u; mine = (j == x) ? c : mine; }
    if (sum == G) break;
    __builtin_amdgcn_s_sleep(1);
    if ((++sp & 255u) == 0u) { if (xb_ld(&bar[XB_TMO])) break; if (sp > XB_SPIN_CAP) { atomicAdd(&bar[XB_TMO], 1u); break; } }
  }
  nloc = mine > 0u ? mine : 1u; nx = cnt > 0u ? cnt : 1u;
}
DI void xcd_barrier(const XcdBarrier& b) {
  asm volatile("s_waitcnt vmcnt(0)" ::: "memory");
  __syncthreads();
  if (threadIdx.x == 0) {
    unsigned* bar = b.bar;
    __builtin_amdgcn_s_waitcnt(0);
    unsigned nloc = b.st[0], nx = b.st[1];
    if (nloc == 0u) { xcd_barrier_complete(bar, b.x, nloc, nx); b.st[0] = nloc; b.st[1] = nx; }
    const unsigned old = xb_add(&bar[XB_XSUB(b.x)], 1u);
    const unsigned gen = old / nloc;
    if (old + 1u == (gen + 1u) * nloc) {
      __builtin_amdgcn_fence(__ATOMIC_RELEASE, "agent");
      asm volatile("s_waitcnt vmcnt(0)" ::: "memory");
      const unsigned og = xb_add(&bar[XB_TOP], 1u);
      const unsigned tg = og / nx;
      if (og + 1u == (tg + 1u) * nx) xb_add(&bar[XB_TOPGEN], 1u);
      else XB_SPIN(xb_ld(&bar[XB_TOPGEN]) == tg, bar);
      __builtin_amdgcn_fence(__ATOMIC_ACQUIRE, "agent");
      xb_add(&bar[XB_XGEN(b.x)], 1u);
      asm volatile("s_waitcnt vmcnt(0)" ::: "memory");
    } else {
      XB_SPIN(xb_ld(&bar[XB_XGEN(b.x)]) == gen, bar);
      __builtin_amdgcn_fence(__ATOMIC_ACQUIRE, "agent");
      asm volatile("s_waitcnt vmcnt(0)" ::: "memory");
    }
  }
  __syncthreads();
}

DI void run_phase(const Params& p, char* smem0, int ph) {
  char* smem = smem0 + (ltid() >> 8) * GRP_LDS;
  switch (ph) {
    case 0: phase0(p, smem); break;
    case 1: phase0b(p, smem); phase_norm(p, 0); break;
    case 2: phase_gemm_in(p, 0, smem0); break;
    case 3: phase3(p); break;
    case 4: phase_gemm_mla(p, smem0); if (NVBLK >= 512) late_weight_prep(p, smem, 352, 0, 800); else late_weight_prep(p, smem, 0, 0, 1424); break;
    case 5: phase_attn0(p, smem0); break;
    case 6: if (NVBLK >= 384) phase_out_norm_fused(p, 0, smem); else phase_gemm_out(p, 0, smem); if (NVBLK >= 512) late_weight_prep(p, smem, 384, 800, 1424); break;
    case 7: if (NVBLK < 384) phase_norm(p, 1); break;
    case 8: phase_gemm_in(p, 1, smem0); break;
    case 9: phase9(p, smem); break;
    case 10: phase10(p, smem0); break;
    case 11: phase11(p, smem); break;
    case 12: if (NVBLK >= 384) phase_out_norm_fused(p, 1, smem); else phase_gemm_out(p, 1, smem); break;
    case 13: if (NVBLK < 384) phase_final(p); break;
  }
}

__global__ void __launch_bounds__(512, 2) mk_fwd(Params p) {
#if SINGLE_LAUNCH
  extern __shared__ __attribute__((aligned(16))) char smem[];
  __shared__ uint4 xb_words;
  if (threadIdx.x == 0) xb_words = make_uint4(0u, 0u, 0u, 0u);
  __syncthreads();
  const XcdBarrier xb = xcd_barrier_post(p.BAR, (volatile LAS unsigned*)&xb_words);
  if (p.phase_hi == 12345) {
    const unsigned long long* ia = (const unsigned long long*)__builtin_amdgcn_implicitarg_ptr();
    p.BAR[XB_TMO] = (unsigned)ia[11];
  }
  run_phase(p, smem, 0); xcd_barrier(xb);
  run_phase(p, smem, 1); xcd_barrier(xb);
  run_phase(p, smem, 2); xcd_barrier(xb);
  run_phase(p, smem, 3); xcd_barrier(xb);
  run_phase(p, smem, 4); xcd_barrier(xb);
  run_phase(p, smem, 5); xcd_barrier(xb);
  run_phase(p, smem, 6); xcd_barrier(xb);
  if (NVBLK < 384) { run_phase(p, smem, 7); xcd_barrier(xb); }
  run_phase(p, smem, 8); xcd_barrier(xb);
  run_phase(p, smem, 9); xcd_barrier(xb);
  run_phase(p, smem, 10); xcd_barrier(xb);
  run_phase(p, smem, 11); xcd_barrier(xb);
  run_phase(p, smem, 12);
  if (NVBLK < 384) { xcd_barrier(xb); run_phase(p, smem, 13); }
#endif
}

template <int PH>
__global__ void __launch_bounds__(512, 2) mk_phase(Params p) {
  extern __shared__ __attribute__((aligned(16))) char smem[];
  run_phase(p, smem, PH);
}
template <int PH>
static void launch_phases(const Params& p, hipStream_t stream) {
  hipFuncSetAttribute((const void*)mk_phase<PH>, hipFuncAttributeMaxDynamicSharedMemorySize, LDS_BYTES);
  hipLaunchKernelGGL(mk_phase<PH>, dim3(256), dim3(512), LDS_BYTES, stream, p);
  if constexpr (PH + 1 < NPHASE) launch_phases<PH + 1>(p, stream);
}

extern "C" void kernel_launch(void* const* d_in, const int* in_sizes, int n_in, void* d_out, int out_size, void* d_ws, size_t ws_size, hipStream_t stream) {
  Params p{};
  const float** fp = (const float**)&p;
  for (int i = 0; i < 34; ++i) fp[i] = (const float*)d_in[i];
  p.out = (float*)d_out;
  char* w = (char*)d_ws;
  size_t off = 0;
  auto take = [&](size_t bytes) { char* r = w + off; off += (bytes + 255) & ~(size_t)255; return r; };
  p.BAR = (unsigned*)take(XCD_BAR_WORDS * 4);
  p.CNT = (unsigned*)take(2 * 48 * 64 * 4);
  p.SSQ = (float*)take((size_t)2 * NROW * 8 * 4);
  p.MOD = (float*)take(2 * 3 * 3072 * 4);
  p.LAMV = (float*)take(256);
  p.ROPE32 = (float2*)take(1024 * 16 * 8);
  p.ROPE64 = (float2*)take(1024 * 32 * 8);
  p.WinE = (bf16_t*)take((size_t)EIN_PAD * 1024 * 2);
  p.WinO = (bf16_t*)take((size_t)OIN_PAD * 1024 * 2);
  p.Wuq = (bf16_t*)take(768 * 384 * 2);
  p.Wukv = (bf16_t*)take(1024 * 256 * 2);
  p.WoutE = (bf16_t*)take(1024 * 1024 * 2);
  p.WoutO = (bf16_t*)take(1024 * 1024 * 2);
  p.H = (bf16_t*)take((size_t)NROW * 1024 * 2);
  p.O = (bf16_t*)take((size_t)NROW * 1024 * 2);
  p.X1 = (float*)take(256);
  p.X1B = (bf16_t*)take((size_t)NROW * 1024 * 2);
  p.SC = (float*)take(768 * 4 * 4);
  p.SCM = (float*)take(768 * 4);
  p.UC = (bf16_t*)take((size_t)768 * 16384 * 2);
  p.NU = (float*)take(768 * 128 * 4);
  p.NST = (float*)take(768 * 128 * 4);
  p.OP = (bf16_t*)take((size_t)128 * 2 * 2 * 4 * 8 * 64 * 8);
  p.ML = (float*)take((size_t)128 * 2 * 2 * 4 * 64 * 8);
  p.CST = (bf16_t*)take((size_t)768 * 16384 * 2);
  const size_t region = off;
  p.U0 = (bf16_t*)take((size_t)NROW * EIN * 2);
  p.CQN = (bf16_t*)take((size_t)NROW * 384 * 2);
  p.CKVN = (bf16_t*)take((size_t)NTROW * 256 * 2);
  p.KR = (bf16_t*)take((size_t)NTROW * 32 * 2);
  p.QB = (bf16_t*)take((size_t)NROW * 512 * 2);
  p.KB = (bf16_t*)take((size_t)NTROW * 128 * 2);
  p.VB = (bf16_t*)take((size_t)NTROW * 128 * 2);
  p.Q = (bf16_t*)take((size_t)NROW * 768 * 2);
  p.KV = (bf16_t*)take((size_t)NTROW * 1024 * 2);
  const size_t end0 = off;
  off = region;
  p.U1 = (bf16_t*)take((size_t)NROW * OIN * 2);
  p.QD = (bf16_t*)take((size_t)NROW * 512 * 2);
  p.KD = (bf16_t*)take((size_t)NTROW * 512 * 2);
  p.VD = (bf16_t*)take((size_t)NTROW * 512 * 2);
  const size_t end1 = off;
  const size_t need = end0 > end1 ? end0 : end1;
  if (need > ws_size) { fprintf(stderr, "workspace too small: need %zu have %zu\n", need, ws_size); return; }

#if SINGLE_LAUNCH
  static int grid_blocks = 0;
  if (!grid_blocks) {
    int dev = 0, cus = 0, per_cu = 0;
    hipGetDevice(&dev);
    hipDeviceGetAttribute(&cus, hipDeviceAttributeMultiprocessorCount, dev);
    hipFuncSetAttribute((const void*)mk_fwd, hipFuncAttributeMaxDynamicSharedMemorySize, LDS_BYTES);
    hipOccupancyMaxActiveBlocksPerMultiprocessor(&per_cu, mk_fwd, 512, LDS_BYTES);
    if (per_cu < 1) per_cu = 1;
    grid_blocks = cus;
  }
  p.phase_lo = 0; p.phase_hi = NPHASE;
  hipMemsetAsync(p.BAR, 0, (size_t)((char*)(p.CNT + 2 * 48 * 64) - (char*)p.BAR), stream);
  void* args[] = {&p};
  hipError_t e = hipLaunchCooperativeKernel((void*)mk_fwd, dim3(grid_blocks), dim3(512), args, LDS_BYTES, stream);
  if (e != hipSuccess) fprintf(stderr, "cooperative launch failed: %s (grid %d)\n", hipGetErrorString(e), grid_blocks);
#else
  launch_phases<0>(p, stream);
#endif
}
```

```cpp
#include <hip/hip_runtime.h>
#include <hip/hip_cooperative_groups.h>
#include <cstdio>
namespace cg = cooperative_groups;

typedef unsigned short bf16_t;
using bf16x8 = __attribute__((ext_vector_type(8))) short;
using bf16x4 = __attribute__((ext_vector_type(4))) short;
using f32x4  = __attribute__((ext_vector_type(4))) float;
using u32x4  = __attribute__((ext_vector_type(4))) unsigned;
#define DI __device__ __forceinline__
#define MFMA16(a, b, c) __builtin_amdgcn_mfma_f32_16x16x32_bf16((a), (b), (c), 0, 0, 0)

#ifndef SINGLE_LAUNCH
#define SINGLE_LAUNCH 1
#endif

__device__ __forceinline__ unsigned ltid() { unsigned t = threadIdx.x; asm volatile("" : "+v"(t)); return t; }
#define TIDX ((int)(ltid() & 255u))
#define VBLK ((int)(blockIdx.x * 2 + (ltid() >> 8)))
#define NVBLK ((int)(gridDim.x * 2))
DI int vblk_xcd() {
  const int b = blockIdx.x, nb = gridDim.x;
  if (nb & 7) return VBLK;
  return ((b & 7) * (nb >> 3) + (b >> 3)) * 2 + (int)(ltid() >> 8);
}
constexpr int EIN = 2464, OIN = 4624;
constexpr int EIN_PAD = 2560, OIN_PAD = 4864;
constexpr int NROW = 6144, NTROW = 6656;
constexpr int NPHASE = 14;
constexpr int LDS_BYTES = 139264;
constexpr int GRP_LDS = 69632;
constexpr int LDT = 72;
constexpr float EPSF = 1e-6f;
constexpr float LAM_INIT = 0.35550906759097f;
constexpr size_t O_Y = 0, O_CKV = 6291456, O_KR = 7340032, O_GK = 7471104, O_GV = 7995392, O_C = 8519680,
                 O_N = 10616832, O_M = 10633216, O_DK = 10633344, O_DV = 12730496;

struct Params {
  const float *x_prompt, *x_sample, *cache_ckv, *cache_kr, *cache_gk, *cache_gv, *st_C, *st_n, *st_m, *cache_dk, *cache_dv, *c, *c_ctx;
  const float *e_norm_g, *e_ada_w, *e_ada_b, *e_w_in, *e_qn_g, *e_w_uq, *e_kvn_g, *e_w_ukv, *e_gq_g, *e_gk_g, *e_w_out;
  const float *o_norm_g, *o_ada_w, *o_ada_b, *o_w_in, *o_gate_b, *o_mnorm_g, *o_lam, *o_dnorm_g, *o_w_out, *final_g;
  float* out;
  float *MOD, *LAMV;
  float2 *ROPE32, *ROPE64;
  bf16_t *WinE, *WinO, *Wuq, *Wukv, *WoutE, *WoutO;
  bf16_t *H, *U0, *U1, *CQN, *CKVN, *KR, *QB, *KB, *VB, *Q, *KV, *O, *QD, *KD, *VD, *CST;
  float *X1, *SC, *NU, *NST, *ML, *SCM;
  bf16_t *X1B, *UC, *OP;
  unsigned* BAR;
  unsigned* CNT;
  float* SSQ;
  int phase_lo, phase_hi;
};

DI bf16_t f2bf(float x) { unsigned u = __float_as_uint(x); u += 0x7fffu + ((u >> 16) & 1u); return (bf16_t)(u >> 16); }
DI float bf2f(bf16_t b) { return __uint_as_float(((unsigned)b) << 16); }
typedef __bf16 bf2_t __attribute__((ext_vector_type(2)));
typedef float f2_t __attribute__((ext_vector_type(2)));
DI unsigned pack2(float a, float b) { f2_t v = {a, b}; return __builtin_bit_cast(unsigned, __builtin_convertvector(v, bf2_t)); }
DI float lo2f(unsigned w) { return __uint_as_float(w << 16); }
DI float hi2f(unsigned w) { return __uint_as_float(w & 0xffff0000u); }
DI float xsum_16_32(float x) {
  auto a = __builtin_amdgcn_permlane16_swap(__float_as_uint(x), __float_as_uint(x), false, false);
  const float s = __uint_as_float(a[0]) + __uint_as_float(a[1]);
  auto b = __builtin_amdgcn_permlane32_swap(__float_as_uint(s), __float_as_uint(s), false, false);
  return __uint_as_float(b[0]) + __uint_as_float(b[1]);
}
DI float xmax_16_32(float x) {
  auto a = __builtin_amdgcn_permlane16_swap(__float_as_uint(x), __float_as_uint(x), false, false);
  const float s = fmaxf(__uint_as_float(a[0]), __uint_as_float(a[1]));
  auto b = __builtin_amdgcn_permlane32_swap(__float_as_uint(s), __float_as_uint(s), false, false);
  return fmaxf(__uint_as_float(b[0]), __uint_as_float(b[1]));
}
DI float wave_sum(float v) { v = xsum_16_32(v); for (int d = 8; d; d >>= 1) v += __shfl_xor(v, d); return v; }
DI float wave_max(float v) { v = xmax_16_32(v); for (int d = 8; d; d >>= 1) v = fmaxf(v, __shfl_xor(v, d)); return v; }
DI float scan_add(float v, int lane) { for (int d = 1; d < 64; d <<= 1) { float t = __shfl_up(v, d); if (lane >= d) v += t; } return v; }
DI float scan_max(float v, int lane) { for (int d = 1; d < 64; d <<= 1) { float t = __shfl_up(v, d); if (lane >= d) v = fmaxf(v, t); } return v; }
DI float fexp(float x) { return __builtin_amdgcn_exp2f(x * 1.4426950408889634f); }
DI float logsig(float x) { return fminf(x, 0.f) - log1pf(fexp(-fabsf(x))); }
DI float siluf(float x) { return x * __builtin_amdgcn_rcpf(1.f + fexp(-x)); }
DI float sigmf(float x) { return __builtin_amdgcn_rcpf(1.f + fexp(-x)); }
DI int cv_of_row(int row) { return row < 4096 ? 0 : 1 + ((row - 4096) >> 10); }
DI const float* xrow(const Params& p, int row) { return row < 4096 ? p.x_prompt + (size_t)row * 1024 : p.x_sample + (size_t)(row - 4096) * 1024; }

template <class Epi>
DI void gemm_tile(const bf16_t* __restrict__ X, int ldx, const bf16_t* __restrict__ W, int ldw, int N, int K, int m0, int n0, char* smem, Epi epi) {
  constexpr int LDG = 32;
  constexpr int BUFE = 256 * LDG;
  bf16_t* sb = (bf16_t*)smem;
  const int tid = TIDX, lane = tid & 63, wave = tid >> 6, wm = wave >> 1, wn = wave & 1;
  const int g = lane >> 4, l16 = lane & 15;
  f32x4 acc[4][4];
#pragma unroll
  for (int a = 0; a < 4; ++a)
#pragma unroll
    for (int b = 0; b < 4; ++b) acc[a][b] = f32x4{0.f, 0.f, 0.f, 0.f};
  const int lr = tid >> 2, lc = (tid & 3) * 8;
  const int lcs = ((tid & 3) ^ ((4 - ((lr >> 2) & 3)) & 3)) * 8;
  const int gs = (g ^ ((4 - (l16 >> 2)) & 3)) * 8;
  unsigned xoff[2], woff[2];
#pragma unroll
  for (int i = 0; i < 2; ++i) {
    xoff[i] = (unsigned)((m0 + lr + 64 * i) * ldx + lc);
    int n = n0 + lr + 64 * i; if (n > N - 1) n = N - 1;
    woff[i] = (unsigned)(n * ldw + lc);
  }
  const int nk = K >> 5;
  u32x4 rx[3][2], rw[3][2];
#define G_LOAD(S, KT) { const bf16_t* xb_ = X + (KT) * 32; const bf16_t* wb_ = W + (KT) * 32; \
    rx[S][0] = *(const u32x4*)(xb_ + xoff[0]); rx[S][1] = *(const u32x4*)(xb_ + xoff[1]); \
    rw[S][0] = *(const u32x4*)(wb_ + woff[0]); rw[S][1] = *(const u32x4*)(wb_ + woff[1]); }
#define G_STORE(S, B) { bf16_t* d_ = sb + (B) * BUFE + lr * LDG + lcs; \
    *(u32x4*)(d_) = rx[S][0]; *(u32x4*)(d_ + 64 * LDG) = rx[S][1]; \
    *(u32x4*)(d_ + 128 * LDG) = rw[S][0]; *(u32x4*)(d_ + 192 * LDG) = rw[S][1]; }
#define G_COMPUTE(B) { const bf16_t* bx_ = sb + (B) * BUFE; const bf16_t* bw_ = bx_ + 128 * LDG; \
    bf16x8 wf[4], xf[4]; \
    _Pragma("unroll") for (int i = 0; i < 4; ++i) { \
      wf[i] = *(const bf16x8*)(bw_ + (wn * 64 + i * 16 + l16) * LDG + gs); \
      xf[i] = *(const bf16x8*)(bx_ + (wm * 64 + i * 16 + l16) * LDG + gs); } \
    _Pragma("unroll") for (int ni = 0; ni < 4; ++ni) \
      _Pragma("unroll") for (int mi = 0; mi < 4; ++mi) acc[ni][mi] = MFMA16(wf[ni], xf[mi], acc[ni][mi]); }
#define G_STEP(KK, RL, RS) if ((KK) < nk) { \
    if ((KK) + 1 < nk) G_STORE(RS, ((KK) + 1) & 1) \
    if ((KK) + 3 < nk) G_LOAD(RL, (KK) + 3) \
    G_COMPUTE((KK) & 1) \
    __syncthreads(); }
  G_LOAD(0, 0) G_LOAD(1, 1) G_LOAD(2, 2)
  __syncthreads();
  G_STORE(0, 0)
  __syncthreads();
  for (int k0 = 0; k0 < nk; k0 += 3) {
    G_STEP(k0, 0, 1)
    G_STEP(k0 + 1, 1, 2)
    G_STEP(k0 + 2, 2, 0)
  }
#undef G_LOAD
#undef G_STORE
#undef G_COMPUTE
#undef G_STEP
#pragma unroll
  for (int ni = 0; ni < 4; ++ni) {
    const int n = n0 + wn * 64 + ni * 16 + g * 4;
    if (n < N) {
#pragma unroll
      for (int mi = 0; mi < 4; ++mi) epi(m0 + wm * 64 + mi * 16 + l16, n, acc[ni][mi]);
    }
  }
}

template <class Epi>
DI void gemm_tile64(const bf16_t* __restrict__ X, int ldx, const bf16_t* __restrict__ W, int ldw, int N, int K, int m0, int n0, char* smem, Epi epi) {
  constexpr int PANE = 256 * 32;
  constexpr int BUFE = 2 * PANE;
  bf16_t* sb = (bf16_t*)smem;
  const int tid = TIDX, lane = tid & 63, wave = tid >> 6, wm = wave >> 1, wn = wave & 1;
  const int g = lane >> 4, l16 = lane & 15;
  f32x4 acc[4][4];
#pragma unroll
  for (int a = 0; a < 4; ++a)
#pragma unroll
    for (int b = 0; b < 4; ++b) acc[a][b] = f32x4{0.f, 0.f, 0.f, 0.f};
  const int lr = tid >> 3, ch = tid & 7;
  const int soff = (ch >> 2) * PANE + lr * 32 + (((ch & 3) ^ ((4 - ((lr >> 2) & 3)) & 3)) * 8);
  const int gs = (g ^ ((4 - (l16 >> 2)) & 3)) * 8;
  unsigned xoff[4], woff[4];
#pragma unroll
  for (int i = 0; i < 4; ++i) {
    xoff[i] = (unsigned)((m0 + lr + 32 * i) * ldx + ch * 8);
    int n = n0 + lr + 32 * i; if (n > N - 1) n = N - 1;
    woff[i] = (unsigned)(n * ldw + ch * 8);
  }
  const int nk = K >> 6;
  u32x4 rx[2][4], rw[2][4];
#define H_LOAD(S, KT) { const bf16_t* xb_ = X + (KT) * 64; const bf16_t* wb_ = W + (KT) * 64; \
    _Pragma("unroll") for (int i = 0; i < 4; ++i) { rx[S][i] = *(const u32x4*)(xb_ + xoff[i]); rw[S][i] = *(const u32x4*)(wb_ + woff[i]); } }
#define H_STORE(S, B) { bf16_t* d_ = sb + (B) * BUFE + soff; \
    _Pragma("unroll") for (int i = 0; i < 4; ++i) { *(u32x4*)(d_ + (32 * i) * 32) = rx[S][i]; *(u32x4*)(d_ + (128 + 32 * i) * 32) = rw[S][i]; } }
#define H_COMPUTE(B) { _Pragma("unroll") for (int ks = 0; ks < 2; ++ks) { const bf16_t* bx_ = sb + (B) * BUFE + ks * PANE; const bf16_t* bw_ = bx_ + 128 * 32; \
    bf16x8 wf[4], xf[4]; \
    _Pragma("unroll") for (int i = 0; i < 4; ++i) { \
      wf[i] = *(const bf16x8*)(bw_ + (wn * 64 + i * 16 + l16) * 32 + gs); \
      xf[i] = *(const bf16x8*)(bx_ + (wm * 64 + i * 16 + l16) * 32 + gs); } \
    _Pragma("unroll") for (int ni = 0; ni < 4; ++ni) \
      _Pragma("unroll") for (int mi = 0; mi < 4; ++mi) acc[ni][mi] = MFMA16(wf[ni], xf[mi], acc[ni][mi]); } }
#define H_STEP(KK, SL) if ((KK) < nk) { \
    if ((KK) + 1 < nk) H_STORE((SL) ^ 1, ((KK) + 1) & 1) \
    if ((KK) + 2 < nk) H_LOAD(SL, (KK) + 2) \
    H_COMPUTE((KK) & 1) \
    __syncthreads(); }
  H_LOAD(0, 0)
  if (nk > 1) H_LOAD(1, 1)
  __syncthreads();
  H_STORE(0, 0)
  __syncthreads();
  for (int k0 = 0; k0 < nk; k0 += 2) {
    H_STEP(k0, 0)
    H_STEP(k0 + 1, 1)
  }
#undef H_LOAD
#undef H_STORE
#undef H_COMPUTE
#undef H_STEP
#pragma unroll
  for (int ni = 0; ni < 4; ++ni) {
    const int n = n0 + wn * 64 + ni * 16 + g * 4;
    if (n < N) {
#pragma unroll
      for (int mi = 0; mi < 4; ++mi) epi(m0 + wm * 64 + mi * 16 + l16, n, acc[ni][mi]);
    }
  }
}

DI void gemm_tile64_acc(const bf16_t* __restrict__ X, int ldx, const bf16_t* __restrict__ W, int ldw, int N, int K, int m0, int n0, char* smem, f32x4 (&acc)[4][4]) {
  constexpr int PANE = 256 * 32;
  constexpr int BUFE = 2 * PANE;
  bf16_t* sb = (bf16_t*)smem;
  const int tid = TIDX, lane = tid & 63, wave = tid >> 6, wm = wave >> 1, wn = wave & 1;
  const int g = lane >> 4, l16 = lane & 15;
#pragma unroll
  for (int a = 0; a < 4; ++a)
#pragma unroll
    for (int b = 0; b < 4; ++b) acc[a][b] = f32x4{0.f, 0.f, 0.f, 0.f};
  const int lr = tid >> 3, ch = tid & 7;
  const int soff = (ch >> 2) * PANE + lr * 32 + (((ch & 3) ^ ((4 - ((lr >> 2) & 3)) & 3)) * 8);
  const int gs = (g ^ ((4 - (l16 >> 2)) & 3)) * 8;
  unsigned xoff[4], woff[4];
#pragma unroll
  for (int i = 0; i < 4; ++i) {
    xoff[i] = (unsigned)((m0 + lr + 32 * i) * ldx + ch * 8);
    int n = n0 + lr + 32 * i; if (n > N - 1) n = N - 1;
    woff[i] = (unsigned)(n * ldw + ch * 8);
  }
  const int nk = K >> 6;
  u32x4 rx[2][4], rw[2][4];
#define H_LOAD(S, KT) { const bf16_t* xb_ = X + (KT) * 64; const bf16_t* wb_ = W + (KT) * 64; \
    _Pragma("unroll") for (int i = 0; i < 4; ++i) { rx[S][i] = *(const u32x4*)(xb_ + xoff[i]); rw[S][i] = *(const u32x4*)(wb_ + woff[i]); } }
#define H_STORE(S, B) { bf16_t* d_ = sb + (B) * BUFE + soff; \
    _Pragma("unroll") for (int i = 0; i < 4; ++i) { *(u32x4*)(d_ + (32 * i) * 32) = rx[S][i]; *(u32x4*)(d_ + (128 + 32 * i) * 32) = rw[S][i]; } }
#define H_COMPUTE(B) { _Pragma("unroll") for (int ks = 0; ks < 2; ++ks) { const bf16_t* bx_ = sb + (B) * BUFE + ks * PANE; const bf16_t* bw_ = bx_ + 128 * 32; \
    bf16x8 wf[4], xf[4]; \
    _Pragma("unroll") for (int i = 0; i < 4; ++i) { \
      wf[i] = *(const bf16x8*)(bw_ + (wn * 64 + i * 16 + l16) * 32 + gs); \
      xf[i] = *(const bf16x8*)(bx_ + (wm * 64 + i * 16 + l16) * 32 + gs); } \
    _Pragma("unroll") for (int ni = 0; ni < 4; ++ni) \
      _Pragma("unroll") for (int mi = 0; mi < 4; ++mi) acc[ni][mi] = MFMA16(wf[ni], xf[mi], acc[ni][mi]); } }
#define H_STEP(KK, SL) if ((KK) < nk) { \
    if ((KK) + 1 < nk) H_STORE((SL) ^ 1, ((KK) + 1) & 1) \
    if ((KK) + 2 < nk) H_LOAD(SL, (KK) + 2) \
    H_COMPUTE((KK) & 1) \
    __syncthreads(); }
  H_LOAD(0, 0)
  if (nk > 1) H_LOAD(1, 1)
  __syncthreads();
  H_STORE(0, 0)
  __syncthreads();
  for (int k0 = 0; k0 < nk; k0 += 2) {
    H_STEP(k0, 0)
    H_STEP(k0 + 1, 1)
  }
#undef H_LOAD
#undef H_STORE
#undef H_COMPUTE
#undef H_STEP
}

template <class Epi>
DI void gemm256(const bf16_t* __restrict__ X, int ldx, const bf16_t* __restrict__ W, int ldw, int N, int K, int m0, int n0, char* smem, Epi epi) {
  constexpr int LDG = 32;
  constexpr int BUFE = 512 * LDG;
  bf16_t* sb = (bf16_t*)smem;
  const int tid = (int)ltid(), lane = tid & 63, wave = tid >> 6, wm = wave >> 2, wn = wave & 3;
  const int g = lane >> 4, l16 = lane & 15;
  f32x4 acc[4][8];
#pragma unroll
  for (int a = 0; a < 4; ++a)
#pragma unroll
    for (int b = 0; b < 8; ++b) acc[a][b] = f32x4{0.f, 0.f, 0.f, 0.f};
  const int lr = tid >> 2, lc = (tid & 3) * 8;
  const int lcs = ((tid & 3) ^ ((4 - ((lr >> 2) & 3)) & 3)) * 8;
  const int gs = (g ^ ((4 - (l16 >> 2)) & 3)) * 8;
  unsigned xoff[2], woff[2];
#pragma unroll
  for (int i = 0; i < 2; ++i) {
    xoff[i] = (unsigned)((m0 + lr + 128 * i) * ldx + lc);
    int n = n0 + lr + 128 * i; if (n > N - 1) n = N - 1;
    woff[i] = (unsigned)(n * ldw + lc);
  }
  const int nk = K >> 5;
  u32x4 rx[3][2], rw[3][2];
#define G_LOAD(S, KT) { const bf16_t* xb_ = X + (KT) * 32; const bf16_t* wb_ = W + (KT) * 32; \
    rx[S][0] = *(const u32x4*)(xb_ + xoff[0]); rx[S][1] = *(const u32x4*)(xb_ + xoff[1]); \
    rw[S][0] = *(const u32x4*)(wb_ + woff[0]); rw[S][1] = *(const u32x4*)(wb_ + woff[1]); }
#define G_STORE(S, B) { bf16_t* d_ = sb + (B) * BUFE + lr * LDG + lcs; \
    *(u32x4*)(d_) = rx[S][0]; *(u32x4*)(d_ + 128 * LDG) = rx[S][1]; \
    *(u32x4*)(d_ + 256 * LDG) = rw[S][0]; *(u32x4*)(d_ + 384 * LDG) = rw[S][1]; }
#define G_COMPUTE(B) { const bf16_t* bx_ = sb + (B) * BUFE; const bf16_t* bw_ = bx_ + 256 * LDG; \
    bf16x8 wf[4], xf[8]; \
    _Pragma("unroll") for (int i = 0; i < 4; ++i) wf[i] = *(const bf16x8*)(bw_ + (wn * 64 + i * 16 + l16) * LDG + gs); \
    _Pragma("unroll") for (int i = 0; i < 8; ++i) xf[i] = *(const bf16x8*)(bx_ + (wm * 128 + i * 16 + l16) * LDG + gs); \
    _Pragma("unroll") for (int ni = 0; ni < 4; ++ni) \
      _Pragma("unroll") for (int mi = 0; mi < 8; ++mi) acc[ni][mi] = MFMA16(wf[ni], xf[mi], acc[ni][mi]); }
#define G_STEP(KK, RL, RS) if ((KK) < nk) { \
    if ((KK) + 1 < nk) G_STORE(RS, ((KK) + 1) & 1) \
    if ((KK) + 3 < nk) G_LOAD(RL, (KK) + 3) \
    G_COMPUTE((KK) & 1) \
    __syncthreads(); }
  G_LOAD(0, 0) G_LOAD(1, 1) G_LOAD(2, 2)
  __syncthreads();
  G_STORE(0, 0)
  __syncthreads();
  for (int k0 = 0; k0 < nk; k0 += 3) {
    G_STEP(k0, 0, 1)
    G_STEP(k0 + 1, 1, 2)
    G_STEP(k0 + 2, 2, 0)
  }
#undef G_LOAD
#undef G_STORE
#undef G_COMPUTE
#undef G_STEP
#pragma unroll
  for (int ni = 0; ni < 4; ++ni) {
    const int n = n0 + wn * 64 + ni * 16 + g * 4;
    if (n < N) {
#pragma unroll
      for (int mi = 0; mi < 8; ++mi) epi(m0 + wm * 128 + mi * 16 + l16, n, acc[ni][mi]);
    }
  }
}

namespace pg8 {
#define PG8_LAS __attribute__((address_space(3)))
typedef unsigned short bf16_t;
typedef short bf16x8 __attribute__((ext_vector_type(8)));
typedef float f32x4 __attribute__((ext_vector_type(4)));
typedef unsigned u32x4 __attribute__((ext_vector_type(4)));
constexpr int BM = 256, BK = 64, HALF = 128, HTB = HALF * BK * 2  , STAGE_BYTES = 8 * HTB, NXCD = 8, WGM = 8;

__host__ __device__ __forceinline__ int lds_byte(int r, int c) { const int st = (r >> 4) * 2 + (c >> 5), rr = r & 15, cc = c & 31, ob = rr * 64 + cc * 2; return st * 1024 + (ob ^ (((ob >> 9) & 1) << 5)); }
__host__ __device__ __forceinline__ void stage_rc(int b, int& R, int& C) { const int st = b / 1024, sb = b % 1024, swz = sb ^ (((sb >> 9) & 1) << 5); R = (st >> 1) * 16 + swz / 64; C = (st & 1) * 32 + (swz % 64) / 2; }
__host__ __device__ __forceinline__ int perm32(int rho) { const int n = rho >> 4, i = rho & 15; return 8 * (i >> 2) + 4 * n + (i & 3); }

struct Unit { int pm, pn; };
struct Gemm { const bf16_t* A; const bf16_t* Bt; int M, N, K; };

struct StaticOrder {
    int nM, nN, nwg, G, c;
    __host__ __device__ void init(int M, int N, int G_, int c_) { nM = M / BM; nN = N / BM; nwg = nM * nN; G = G_; c = c_; }
    __host__ __device__ bool next(int i, Unit& u) const {
        const long L = (long)i * G + c; if (L >= nwg) return false;
        int wgid = (int)L; { const int q = nwg / NXCD, r = nwg % NXCD, xcd = wgid % NXCD, off = wgid / NXCD; wgid = (xcd < r ? xcd * (q + 1) : r * (q + 1) + (xcd - r) * q) + off; }
        const int nig = WGM * nN, gid = wgid / nig, fm = gid * WGM, gsz = (nM - fm) < WGM ? (nM - fm) : WGM;
        u.pm = fm + ((wgid % nig) % gsz); u.pn = (wgid % nig) / gsz; return true;
    }
    __device__ __forceinline__ void a_ready(const Unit&) const {}
    __device__ __forceinline__ void done(const Unit&) const {}
};
__device__ __forceinline__ unsigned cvt_pk_bf16(float lo, float hi) { unsigned r; asm volatile("v_cvt_pk_bf16_f32 %0, %1, %2" : "=v"(r) : "v"(lo), "v"(hi)); return r; }
template <class Epi, class Sched, bool STAMP = false>
__device__ __forceinline__ void gemm_phase(PG8_LAS unsigned char* lds, const Gemm g, const Sched& S, const Epi& E, unsigned long long* stamps) {
    const int tid = (int)ltid(), wid = __builtin_amdgcn_readfirstlane(tid >> 6), lane = tid & 63, wr = wid >> 2, wc = wid & 3, fr = lane & 15, fq = lane >> 4;
    const int K = g.K, nt = K / BK;
    int ts_lo = 0, ts_hi = 0, nts = 0; const unsigned long long rt_entry = STAMP ? (unsigned long long)wall_clock64() : 0ull;
#define PG8_STAMP() do { if (STAMP && wid == 0 && nts < 64) { const unsigned long long _c = (unsigned long long)clock64(); \
        ts_lo = (lane == nts) ? (int)(unsigned)_c : ts_lo; ts_hi = (lane == nts) ? (int)(unsigned)(_c >> 32) : ts_hi; ++nts; } } while (0)
    PG8_STAMP();
    unsigned voffA[2], voffB[2];
#pragma unroll
    for (int i = 0; i < 2; ++i) { int R, C; stage_rc(tid * 16 + i * 8192, R, C); const int Rb = Epi::PERM ? ((R & ~31) + perm32(R & 31)) : R;
        voffA[i] = (unsigned)(R * K + C) * 2u; voffB[i] = (unsigned)(Rb * K + C) * 2u; }
    const size_t kstep = (size_t)(BK * 2);
    const size_t hstep = (size_t)HALF * K * 2;
    const size_t tstep = 2 * hstep;
    const unsigned ldsw = (unsigned)wid * 1024u;
    const int aoff = lds_byte(wr * 64 + fr, fq * 8), boff = lds_byte(wc * 32 + fr, fq * 8);
#define PG8_SA(b, h) (((b) * 2 + (h)) * HTB)
#define PG8_SB(b, h) ((4 + (b) * 2 + (h)) * HTB)
#define PG8_STAGE(bufoff, gbase, voff) do { _Pragma("unroll") for (int _i = 0; _i < 2; ++_i) \
        __builtin_amdgcn_global_load_lds((const unsigned*)((const char*)(gbase) + (voff)[_i]), (PG8_LAS unsigned*)(lds + (bufoff) + ldsw + _i * 8192), 16, 0, 0); } while (0)
#define PG8_LDA(dst, b, h) do { _Pragma("unroll") for (int m = 0; m < 4; ++m) _Pragma("unroll") for (int k = 0; k < 2; ++k) dst[m][k] = *(const PG8_LAS bf16x8*)(lds + PG8_SA(b, h) + aoff + m * 2048 + k * 1024); } while (0)
#define PG8_LDB(dst, b, h) do { _Pragma("unroll") for (int n = 0; n < 2; ++n) _Pragma("unroll") for (int k = 0; k < 2; ++k) dst[n][k] = *(const PG8_LAS bf16x8*)(lds + PG8_SB(b, h) + boff + n * 2048 + k * 1024); } while (0)
#define PG8_MMA(ai, bj, At, Bt) do { __builtin_amdgcn_s_setprio(1); _Pragma("unroll") for (int m = 0; m < 4; ++m) _Pragma("unroll") for (int n = 0; n < 2; ++n) _Pragma("unroll") for (int k = 0; k < 2; ++k) \
        acc[ai][bj][m][n] = __builtin_amdgcn_mfma_f32_16x16x32_bf16(Bt[n][k], At[m][k], acc[ai][bj][m][n], 0, 0, 0); __builtin_amdgcn_s_setprio(0); } while (0)
#define PG8_WAIT_V(n) asm volatile("s_waitcnt vmcnt(" #n ")" ::: "memory")
#define PG8_WAIT_L(n) asm volatile("s_waitcnt lgkmcnt(" #n ")" ::: "memory")
#define PG8_BAR __builtin_amdgcn_s_barrier()
#define PG8_SCHED __builtin_amdgcn_sched_barrier(0)
    Unit cur, nxt; int ui = 0;
    if (!S.next(0, cur)) return;
    f32x4 acc[2][2][4][2];
#pragma unroll
    for (int a = 0; a < 2; ++a)
#pragma unroll
        for (int b = 0; b < 2; ++b)
#pragma unroll
            for (int m = 0; m < 4; ++m)
#pragma unroll
                for (int n = 0; n < 2; ++n) acc[a][b][m][n] = (f32x4){0.f, 0.f, 0.f, 0.f};
    bf16x8 At[4][2], B0[2][2], B1[2][2];
    const char* cA = (const char*)g.A + (size_t)cur.pm * tstep; const char* cB = (const char*)g.Bt + (size_t)cur.pn * tstep;
    S.a_ready(cur);
    PG8_STAGE(PG8_SB(0, 0), cB, voffB); PG8_STAGE(PG8_SA(0, 0), cA, voffA); PG8_STAGE(PG8_SB(0, 1), cB + hstep, voffB); PG8_STAGE(PG8_SA(0, 1), cA + hstep, voffA);
    if (wr == 1) PG8_BAR;
    PG8_WAIT_V(4); PG8_BAR;
    PG8_STAGE(PG8_SB(1, 0), cB + kstep, voffB); PG8_STAGE(PG8_SA(1, 0), cA + kstep, voffA); PG8_STAGE(PG8_SB(1, 1), cB + hstep + kstep, voffB);
    PG8_WAIT_V(6); PG8_BAR;
    PG8_STAMP();
    for (;;) {
        const bool has_next = S.next(ui + 1, nxt);
        const char* nA = has_next ? (const char*)g.A + (size_t)nxt.pm * tstep : cA; const char* nB = has_next ? (const char*)g.Bt + (size_t)nxt.pn * tstep : cB;
        for (int t = 0; t < nt; t += 2) {
            const bool last = (t == nt - 2);
            const char* a1 = cA + (size_t)(t + 1) * kstep;
            const char* a2 = last ? nA : cA + (size_t)(t + 2) * kstep; const char* b2 = last ? nB : cB + (size_t)(t + 2) * kstep;
            const char* a3 = a2 + kstep; const char* b3 = b2 + kstep;
            if (last && has_next) S.a_ready(nxt);
            PG8_LDB(B0, 0, 0); PG8_SCHED; PG8_LDA(At, 0, 0); PG8_STAGE(PG8_SA(1, 1), a1 + hstep, voffA);
            PG8_WAIT_L(8); PG8_BAR; PG8_WAIT_L(0); PG8_MMA(0, 0, At, B0); PG8_BAR; PG8_SCHED;
            PG8_LDB(B1, 0, 1); PG8_STAGE(PG8_SB(0, 0), b2, voffB);
            PG8_BAR; PG8_WAIT_L(0); PG8_MMA(0, 1, At, B1); PG8_BAR;
            PG8_LDA(At, 0, 1); PG8_STAGE(PG8_SA(0, 0), a2, voffA);
            PG8_BAR; PG8_WAIT_L(0); PG8_MMA(1, 0, At, B0); PG8_BAR; PG8_SCHED;
            PG8_STAGE(PG8_SB(0, 1), b2 + hstep, voffB);
            PG8_WAIT_V(6); PG8_BAR; PG8_MMA(1, 1, At, B1); PG8_BAR;
            PG8_LDB(B0, 1, 0); PG8_SCHED; PG8_LDA(At, 1, 0); PG8_STAGE(PG8_SA(0, 1), a2 + hstep, voffA);
            PG8_WAIT_L(8); PG8_BAR; PG8_WAIT_L(0); PG8_MMA(0, 0, At, B0); PG8_BAR; PG8_SCHED;
            PG8_LDB(B1, 1, 1); PG8_STAGE(PG8_SB(1, 0), b3, voffB);
            PG8_BAR; PG8_WAIT_L(0); PG8_MMA(0, 1, At, B1); PG8_BAR;
            PG8_LDA(At, 1, 1); PG8_STAGE(PG8_SA(1, 0), a3, voffA);
            PG8_BAR; PG8_WAIT_L(0); PG8_MMA(1, 0, At, B0); PG8_BAR; PG8_SCHED;
            PG8_STAGE(PG8_SB(1, 1), b3 + hstep, voffB);
            PG8_WAIT_V(6); PG8_BAR; PG8_MMA(1, 1, At, B1); PG8_BAR;
        }
        PG8_STAMP();
        if constexpr (!Epi::AFTER_DRAIN) { E(acc, cur, wr, wc, fr, fq); S.done(cur); }
        PG8_STAMP();
        if (!has_next) break;
#pragma unroll
        for (int a = 0; a < 2; ++a)
#pragma unroll
            for (int b = 0; b < 2; ++b)
#pragma unroll
                for (int m = 0; m < 4; ++m)
#pragma unroll
                    for (int n = 0; n < 2; ++n) acc[a][b][m][n] = (f32x4){0.f, 0.f, 0.f, 0.f};
        cur = nxt; cA = nA; cB = nB; ++ui;
    }
    PG8_WAIT_V(0);
    if (wr == 0) PG8_BAR;
    PG8_BAR;
    if constexpr (Epi::AFTER_DRAIN) { E.fused(acc, cur, wr, wc, fr, fq, lds, wid, lane); S.done(cur); }
    PG8_STAMP();
    if (STAMP && wid == 0) { stamps[lane] = lane < nts ? (((unsigned long long)(unsigned)ts_hi << 32) | (unsigned)ts_lo) : 0ull;
        if (lane == 62) stamps[62] = rt_entry; if (lane == 63) stamps[63] = (unsigned long long)wall_clock64(); }
#undef PG8_STAMP
#undef PG8_SA
#undef PG8_SB
#undef PG8_STAGE
#undef PG8_LDA
#undef PG8_LDB
#undef PG8_MMA
#undef PG8_WAIT_V
#undef PG8_WAIT_L
#undef PG8_BAR
#undef PG8_SCHED
}
}

struct EpiU {
  static constexpr bool PERM = true, AFTER_DRAIN = false;
  bf16_t* U; int ldu; int nvalid;
  float* aux;
  __device__ __forceinline__ void operator()(const f32x4 (&acc)[2][2][4][2], const pg8::Unit& u, int wr, int wc, int fr, int fq) const {
    const int row0 = u.pm * 256 + wr * 64 + fr, col0 = u.pn * 256 + wc * 32 + 8 * fq;
#pragma unroll
    for (int ai = 0; ai < 2; ++ai)
#pragma unroll
      for (int m = 0; m < 4; ++m) {
        bf16_t* rowp = U + (size_t)(row0 + ai * 128 + m * 16) * ldu;
#pragma unroll
        for (int bj = 0; bj < 2; ++bj) {
          const int col = col0 + bj * 128;
          if (col < nvalid) {
            const f32x4 v0 = acc[ai][bj][m][0], v1 = acc[ai][bj][m][1];
            u32x4 w;
            w[0] = pack2(v0[0], v0[1]); w[1] = pack2(v0[2], v0[3]); w[2] = pack2(v1[0], v1[1]); w[3] = pack2(v1[2], v1[3]);
            *(u32x4*)(rowp + col) = w;
            if (aux && col >= 3088 && col < 4112 && (row0 + ai * 128 + m * 16) < 4096) {
              float* ap = aux + (size_t)((col - 3088) >> 9) * 2097152 + (size_t)(row0 + ai * 128 + m * 16) * 512 + ((col - 3088) & 511);
              *(f32x4*)ap = v0; *(f32x4*)(ap + 4) = v1;
            }
          }
        }
      }
  }
};


struct EpiOut {
  static constexpr bool PERM = true, AFTER_DRAIN = false;
  const float* MOD; const float* x_prompt; const float* x_sample; bf16_t* X1B; int layer;
  __device__ __forceinline__ void operator()(const f32x4 (&acc)[2][2][4][2], const pg8::Unit& u, int wr, int wc, int fr, int fq) const {
    const int row0 = u.pm * 256 + wr * 64 + fr, col0 = u.pn * 256 + wc * 32 + 8 * fq;
#pragma unroll
    for (int ai = 0; ai < 2; ++ai)
#pragma unroll
      for (int m = 0; m < 4; ++m) {
        const int row = row0 + ai * 128 + m * 16;
        const float* gp = MOD + (layer * 3 + (row < 4096 ? 0 : 1 + ((row - 4096) >> 10))) * 3072 + 2048;
        const float* xr = row < 4096 ? x_prompt + (size_t)row * 1024 : x_sample + (size_t)(row - 4096) * 1024;
        bf16_t* xb = X1B + (size_t)row * 1024;
#pragma unroll
        for (int bj = 0; bj < 2; ++bj) {
          const int col = col0 + bj * 128;
          const f32x4 v0 = acc[ai][bj][m][0], v1 = acc[ai][bj][m][1];
          const float4 g0 = *(const float4*)(gp + col), g1 = *(const float4*)(gp + col + 4);
          float4 x0, x1;
          if (layer) {
            const uint4 w = *(const uint4*)(xb + col);
            x0 = make_float4(__uint_as_float(w.x << 16), __uint_as_float(w.x & 0xffff0000u), __uint_as_float(w.y << 16), __uint_as_float(w.y & 0xffff0000u));
            x1 = make_float4(__uint_as_float(w.z << 16), __uint_as_float(w.z & 0xffff0000u), __uint_as_float(w.w << 16), __uint_as_float(w.w & 0xffff0000u));
          } else { x0 = *(const float4*)(xr + col); x1 = *(const float4*)(xr + col + 4); }
          u32x4 o;
          o[0] = pack2(x0.x + g0.x * v0[0], x0.y + g0.y * v0[1]); o[1] = pack2(x0.z + g0.z * v0[2], x0.w + g0.w * v0[3]);
          o[2] = pack2(x1.x + g1.x * v1[0], x1.y + g1.y * v1[1]); o[3] = pack2(x1.z + g1.z * v1[2], x1.w + g1.w * v1[3]);
          *(u32x4*)(xb + col) = o;
        }
        asm volatile("" ::: "memory");
      }
  }
};

template <int W>
DI void stage_rows64(bf16_t* dst, int ldd, int coff, const bf16_t* src, int lds) {
  for (int c = TIDX; c < 64 * (W / 8); c += 256) {
    const int r = c / (W / 8), cc = (c % (W / 8)) * 8;
    *(uint4*)(dst + r * ldd + coff + cc) = *(const uint4*)(src + (size_t)r * lds + cc);
  }
}
template <int W>
DI void stage_T64(bf16_t* dst, const bf16_t* src, int lds, const float* rscale) {
  for (int c = TIDX; c < 64 * (W / 8); c += 256) {
    const int r = c & 63, cc = (c >> 6) * 8;
    uint4 v = *(const uint4*)(src + (size_t)r * lds + cc);
    unsigned w[4] = {v.x, v.y, v.z, v.w};
    if (rscale) {
      const float s = rscale[r];
#pragma unroll
      for (int i = 0; i < 4; ++i) {
        const unsigned pw = pack2(lo2f(w[i]) * s, hi2f(w[i]) * s);
        dst[(cc + 2 * i) * LDT + r] = (bf16_t)(pw & 0xffffu);
        dst[(cc + 2 * i + 1) * LDT + r] = (bf16_t)(pw >> 16);
      }
    } else {
#pragma unroll
      for (int i = 0; i < 4; ++i) {
        dst[(cc + 2 * i) * LDT + r] = (bf16_t)(w[i] & 0xffffu);
        dst[(cc + 2 * i + 1) * LDT + r] = (bf16_t)(w[i] >> 16);
      }
    }
  }
}

template <int DK, int DV, bool DUAL>
DI void attn_core(char* smem, const bf16_t* Qp, int ldq, const bf16_t* K1, int ldk1, const bf16_t* K2, int ldk2,
                  const bf16_t* V, int ldv, int T, float scale_log2, f32x4 (&o)[DUAL ? 2 : 1][DV / 16], float (&lsum)[DUAL ? 2 : 1], float (&mrun)[DUAL ? 2 : 1],
                  const float2* qrope = nullptr) {
  constexpr int NS = DUAL ? 2 : 1;
  constexpr int DKT = DUAL ? 2 * DK : DK;
  constexpr int W1 = (DK == 96) ? 64 : DKT;
  constexpr int LDK = DKT + 8;
  constexpr int NK1 = 64 * (W1 / 8) / 512;
  constexpr int NV = 64 * (DV / 8) / 512;
  constexpr int BUFE = 64 * DKT + DV * LDT;
  bf16_t* sbase = (bf16_t*)smem;
  const int tid = TIDX, lane = tid & 63, wave = tid >> 6, g = lane >> 4, l16 = lane & 15;
  const int st = (int)ltid();
  const int gsw = (g ^ ((4 - (l16 >> 2)) & 3)) * 8;
  bf16x8 qf[DKT / 32];
  const bf16_t* qrow = Qp + (size_t)(wave * 16 + l16) * ldq;
#pragma unroll
  for (int ks = 0; ks < DKT / 32; ++ks) qf[ks] = *(const bf16x8*)(qrow + ks * 32 + g * 8);
  if (DK == 96 && qrope) {
    const float2* rp = qrope + (wave * 16 + l16) * 16 + g * 4;
    const u32x4 w = __builtin_bit_cast(u32x4, qf[DKT / 32 - 1]);
    u32x4 r;
#pragma unroll
    for (int j = 0; j < 4; ++j) {
      const float2 cs = rp[j];
      const float x0 = lo2f(w[j]), x1 = hi2f(w[j]);
      r[j] = pack2(x0 * cs.x - x1 * cs.y, x0 * cs.y + x1 * cs.x);
    }
    qf[DKT / 32 - 1] = __builtin_bit_cast(bf16x8, r);
  }
#pragma unroll
  for (int n = 0; n < NS; ++n) {
#pragma unroll
    for (int i = 0; i < DV / 16; ++i) o[n][i] = f32x4{0.f, 0.f, 0.f, 0.f};
    mrun[n] = -INFINITY; lsum[n] = 0.f;
  }
  u32x4 pk[NK1], pk2, pv[NV];
  unsigned koff[NK1], voff[NV];
#pragma unroll
  for (int i = 0; i < NK1; ++i) { const int c = st + 512 * i, r = c / (W1 / 8), cc = (c % (W1 / 8)) * 8; koff[i] = (unsigned)(r * ldk1 + cc); }
#pragma unroll
  for (int i = 0; i < NV; ++i) { const int c = st + 512 * i, r = c & 63, cc = (c >> 6) * 8; voff[i] = (unsigned)(r * ldv + cc); }
  const unsigned k2off = (unsigned)(((st & 255) >> 2) * ldk2 + (st & 3) * 8);
#define A_LOAD(TN) { const bf16_t* kbase_ = K1 + (size_t)(TN) * ldk1; const bf16_t* vbase_ = V + (size_t)(TN) * ldv; \
    _Pragma("unroll") for (int i = 0; i < NK1; ++i) pk[i] = *(const u32x4*)(kbase_ + koff[i]); \
    if (DK == 96 && st < 256) pk2 = *(const u32x4*)(K2 + (size_t)(TN) * ldk2 + k2off); \
    _Pragma("unroll") for (int i = 0; i < NV; ++i) pv[i] = *(const u32x4*)(vbase_ + voff[i]); }
#define A_COMMIT(B) { bf16_t* sK_ = sbase + (B) * BUFE; bf16_t* sVT_ = sK_ + 64 * DKT; \
    _Pragma("unroll") for (int i = 0; i < NK1; ++i) { const int c = st + 512 * i, r = c / (W1 / 8), ch = c % (W1 / 8); *(u32x4*)(sK_ + (ch >> 2) * 2048 + r * 32 + (((ch & 3) ^ ((4 - ((r >> 2) & 3)) & 3)) * 8)) = pk[i]; } \
    if (DK == 96 && st < 256) { const int r = st >> 2, ch = st & 3; *(u32x4*)(sK_ + 2 * 2048 + r * 32 + ((ch ^ ((4 - ((r >> 2) & 3)) & 3)) * 8)) = pk2; } \
    _Pragma("unroll") for (int i = 0; i < NV; ++i) { const int c = st + 512 * i, r = c & 63, cc = (c >> 6) * 8; \
      _Pragma("unroll") for (int j = 0; j < 4; ++j) { sVT_[(cc + 2 * j) * LDT + r] = (bf16_t)(pv[i][j] & 0xffffu); sVT_[(cc + 2 * j + 1) * LDT + r] = (bf16_t)(pv[i][j] >> 16); } } }
  A_LOAD(0)
  __syncthreads();
  A_COMMIT(0)
  if (64 < T) A_LOAD(64)
  __syncthreads();
  int par = 0;
  for (int t0 = 0; t0 < T; t0 += 64, par ^= 1) {
    {
    {
    if (t0 + 64 < T) {
      A_COMMIT(par ^ 1)
      if (t0 + 128 < T) A_LOAD(t0 + 128)
    }
    const bf16_t* sK = sbase + par * BUFE;
    const bf16_t* sVT = sK + 64 * DKT;
    bf16x8 pf[NS][2];
#pragma unroll
    for (int n = 0; n < NS; ++n) {
      f32x4 s[4];
#pragma unroll
      for (int t = 0; t < 4; ++t) {
        s[t] = f32x4{0.f, 0.f, 0.f, 0.f};
#pragma unroll
        for (int ks = 0; ks < DK / 32; ++ks) {
          const bf16x8 kf = *(const bf16x8*)(sK + (n * (DK / 32) + ks) * 2048 + (t * 16 + l16) * 32 + gsw);
          s[t] = MFMA16(kf, qf[n * (DK / 32) + ks], s[t]);
        }
      }
      float mx = -INFINITY;
#pragma unroll
      for (int t = 0; t < 4; ++t)
#pragma unroll
        for (int j = 0; j < 4; ++j) mx = fmaxf(mx, s[t][j]);
      mx = xmax_16_32(mx);
      const float mnew = fmaxf(mrun[n], mx);
      const float alpha = __builtin_amdgcn_exp2f((mrun[n] - mnew) * scale_log2);
      mrun[n] = mnew;
      const float moff = -mnew * scale_log2;
      float ps = 0.f;
#pragma unroll
      for (int t = 0; t < 4; ++t)
#pragma unroll
        for (int j = 0; j < 4; ++j) { s[t][j] = __builtin_amdgcn_exp2f(fmaf(s[t][j], scale_log2, moff)); ps += s[t][j]; }
      lsum[n] = lsum[n] * alpha + ps;
#pragma unroll
      for (int i = 0; i < DV / 16; ++i) o[n][i] *= alpha;
#pragma unroll
      for (int kb = 0; kb < 2; ++kb)
      {
        u32x4 w;
        w[0] = pack2(s[2 * kb][0], s[2 * kb][1]); w[1] = pack2(s[2 * kb][2], s[2 * kb][3]);
        w[2] = pack2(s[2 * kb + 1][0], s[2 * kb + 1][1]); w[3] = pack2(s[2 * kb + 1][2], s[2 * kb + 1][3]);
        pf[n][kb] = __builtin_bit_cast(bf16x8, w);
      }
    }
#pragma unroll
    for (int kb = 0; kb < 2; ++kb) {
#pragma unroll
      for (int i = 0; i < DV / 16; ++i) {
        const bf16_t* vp = sVT + (i * 16 + l16) * LDT + kb * 32 + g * 4;
        const bf16x4 lo = *(const bf16x4*)(vp);
        const bf16x4 hi = *(const bf16x4*)(vp + 16);
        const bf16x8 vf = __builtin_shufflevector(lo, hi, 0, 1, 2, 3, 4, 5, 6, 7);
#pragma unroll
        for (int n = 0; n < NS; ++n) o[n][i] = MFMA16(vf, pf[n][kb], o[n][i]);
        if (DUAL && (i & 3) == 3) asm volatile("" ::: "memory");
      }
    }
    }
    }
    __syncthreads();
  }
#undef A_LOAD
#undef A_COMMIT
}

DI void transpose_w(const float* __restrict__ src, int K, int N, bf16_t* __restrict__ dst, int tile, float* sT, int sc_lo, int sc_hi, float sc) {
  const int ntn = (N + 63) >> 6;
  const int kt = tile / ntn, nt = tile % ntn, k0 = kt * 64, n0 = nt * 64;
  __syncthreads();
#pragma unroll
  for (int q = 0; q < 4; ++q) {
    const int i = TIDX + 256 * q;
    const int r = i >> 4, c = (i & 15) * 4, n = n0 + c;
    float4 v = make_float4(0.f, 0.f, 0.f, 0.f);
    if (n < N) v = *(const float4*)(src + (size_t)(k0 + r) * N + n);
    if (n >= sc_lo && n < sc_hi) { v.x *= sc; v.y *= sc; v.z *= sc; v.w *= sc; }
    float* d = sT + r * 65 + c;
    d[0] = v.x; d[1] = v.y; d[2] = v.z; d[3] = v.w;
  }
  __syncthreads();
#pragma unroll
  for (int q = 0; q < 2; ++q) {
    const int i = TIDX + 256 * q;
    const int c = i >> 3, kc = (i & 7) * 8, n = n0 + c;
    if (n < N) {
      const float* sp = sT + kc * 65 + c;
      uint4 o;
      o.x = pack2(sp[0], sp[65]); o.y = pack2(sp[130], sp[195]); o.z = pack2(sp[260], sp[325]); o.w = pack2(sp[390], sp[455]);
      *(uint4*)(dst + (size_t)n * K + k0 + kc) = o;
    }
  }
}

DI void phase0(const Params& p, char* smem) {
  const int tid = TIDX;
  for (int it = VBLK; it < 384; it += NVBLK) {
    const int l = it / 192, cb = (it % 192) * 16;
    const float* W = l ? p.o_ada_w : p.e_ada_w;
    const float* bias = l ? p.o_ada_b : p.e_ada_b;
    float* sc = (float*)smem;
    float* red = sc + 3072;
    __syncthreads();
    for (int i = tid; i < 3072; i += 256) {
      const int j = i >> 10, k = i & 1023;
      const float v = (j == 0) ? p.c_ctx[k] : p.c[(j - 1) * 1024 + k];
      sc[i] = siluf(v);
    }
    __syncthreads();
    const int col = cb + (tid & 15), kg = tid >> 4;
    float a0 = 0.f, a1 = 0.f, a2 = 0.f;
    for (int kb = kg * 64; kb < kg * 64 + 64; kb += 16) {
      float w[16];
#pragma unroll
      for (int u = 0; u < 16; ++u) w[u] = W[(size_t)(kb + u) * 3072 + col];
#pragma unroll
      for (int u = 0; u < 16; ++u) { a0 += sc[kb + u] * w[u]; a1 += sc[1024 + kb + u] * w[u]; a2 += sc[2048 + kb + u] * w[u]; }
    }
    red[(kg * 3 + 0) * 16 + (tid & 15)] = a0;
    red[(kg * 3 + 1) * 16 + (tid & 15)] = a1;
    red[(kg * 3 + 2) * 16 + (tid & 15)] = a2;
    __syncthreads();
    if (tid < 48) {
      const int j = tid >> 4, c = tid & 15;
      float s = 0.f;
      for (int q = 0; q < 16; ++q) s += red[(q * 3 + j) * 16 + c];
      __hip_atomic_store(p.MOD + (l * 3 + j) * 3072 + cb + c, s + bias[cb + c], __ATOMIC_RELAXED, __HIP_MEMORY_SCOPE_AGENT);
    }
    asm volatile("s_waitcnt vmcnt(0)" ::: "memory");
    __syncthreads();
    if (tid == 0) __hip_atomic_fetch_add(p.CNT + 2 * 48 * 64, 1u, __ATOMIC_RELAXED, __HIP_MEMORY_SCOPE_AGENT);
  }
}

DI void wait_mod_ready(const Params& p) {
  if (TIDX == 0) {
    unsigned* cnt = p.CNT + 2 * 48 * 64;
    unsigned sp = 0;
    while (__hip_atomic_load(cnt, __ATOMIC_RELAXED, __HIP_MEMORY_SCOPE_AGENT) < 384u) {
      __builtin_amdgcn_s_sleep(1);
      if (++sp > (1u << 22)) break;
    }
    __builtin_amdgcn_fence(__ATOMIC_ACQUIRE, "agent");
    asm volatile("s_waitcnt vmcnt(0)" ::: "memory");
  }
  __syncthreads();
}

DI void phase0b(const Params& p, char* smem) {
  const int tid = TIDX;
  if (VBLK == 0 && tid < 64) {
    float a = p.o_lam[tid] * p.o_lam[64 + tid];
    float b = p.o_lam[128 + tid] * p.o_lam[192 + tid];
    a = wave_sum(a); b = wave_sum(b);
    if (tid == 0) p.LAMV[0] = fexp(a) - fexp(b) + LAM_INIT;
  }
  for (int idx = VBLK * 256 + tid; idx < 1024 * 48; idx += NVBLK * 256) {
    const int pos = idx / 48, e = idx % 48;
    const float rr = (float)(pos >> 6), cc = (float)(pos & 63);
    if (e < 16) {
      const int j = e & 7;
      const float inv = 1.0f / powf(10000.0f, (float)(2 * j) / 16.0f);
      const float ang = ((e < 8) ? rr : cc) * inv;
      p.ROPE32[pos * 16 + e] = make_float2(cosf(ang), sinf(ang));
    } else {
      const int i = e - 16, j = i & 15;
      const float inv = 1.0f / powf(10000.0f, (float)(2 * j) / 32.0f);
      const float ang = ((i < 16) ? rr : cc) * inv;
      p.ROPE64[pos * 32 + i] = make_float2(cosf(ang), sinf(ang));
    }
  }
  float* sT = (float*)smem;
  for (int it = VBLK; it < 1016; it += NVBLK) {
    if (it < 624) transpose_w(p.e_w_in, 1024, EIN, p.WinE, it, sT, 0, 0, 1.f);
    else if (it < 696) transpose_w(p.e_w_uq, 384, 768, p.Wuq, it - 624, sT, 0, 0, 1.f);
    else if (it < 760) transpose_w(p.e_w_ukv, 256, 1024, p.Wukv, it - 696, sT, 0, 0, 1.f);
    else transpose_w(p.e_w_out, 1024, 1024, p.WoutE, it - 760, sT, 0, 0, 1.f);
  }
}

DI void late_weight_prep(const Params& p, char* smem, int first_group, int tile_lo, int tile_hi) {
  float* sT = (float*)smem;
  const int ng = NVBLK - first_group;
  if (ng <= 0 || VBLK < first_group) return;
  for (int it = tile_lo + VBLK - first_group; it < tile_hi; it += ng) {
    if (it < 1168) transpose_w(p.o_w_in, 1024, OIN, p.WinO, it, sT, 512, 1024, 0.08838834764831845f);
    else transpose_w(p.o_w_out, 1024, 1024, p.WoutO, it - 1168, sT, 0, 0, 1.f);
  }
}

DI void store_bf4(bf16_t* dst, f32x4 v) {
  uint2 o; o.x = pack2(v[0], v[1]); o.y = pack2(v[2], v[3]);
  *(uint2*)dst = o;
}
DI float4 load_bf4(const bf16_t* src) {
  const uint2 w = *(const uint2*)src;
  return make_float4(lo2f(w.x), hi2f(w.x), lo2f(w.y), hi2f(w.y));
}

DI void phase_norm(const Params& p, int layer) {
  const int tid = TIDX, lane = tid & 63, wave = tid >> 6;
  const float* g = layer ? p.o_norm_g : p.e_norm_g;
  for (int it = VBLK; it < NROW / 4; it += NVBLK) {
    const int row = it * 4 + wave;
    const float* x = xrow(p, row);
    const bf16_t* xb = p.X1B + (size_t)row * 1024;
    const float* md = p.MOD + (layer * 3 + cv_of_row(row)) * 3072;
    float4 v[4];
    float ss = 0.f;
#pragma unroll
    for (int i = 0; i < 4; ++i) {
      v[i] = layer ? load_bf4(xb + i * 256 + lane * 4) : *(const float4*)(x + i * 256 + lane * 4);
      ss += v[i].x * v[i].x + v[i].y * v[i].y + v[i].z * v[i].z + v[i].w * v[i].w;
    }
    ss = wave_sum(ss);
    const float r = rsqrtf(ss * (1.f / 1024.f) + EPSF);
#pragma unroll
    for (int i = 0; i < 4; ++i) {
      const int col = i * 256 + lane * 4;
      const float4 gg = *(const float4*)(g + col), sh = *(const float4*)(md + col), sc = *(const float4*)(md + 1024 + col);
      uint2 o;
      o.x = pack2(v[i].x * r * gg.x * (1.f + sc.x) + sh.x, v[i].y * r * gg.y * (1.f + sc.y) + sh.y);
      o.y = pack2(v[i].z * r * gg.z * (1.f + sc.z) + sh.z, v[i].w * r * gg.w * (1.f + sc.w) + sh.w);
      *(uint2*)(p.H + (size_t)row * 1024 + col) = o;
    }
  }
}


DI void phase_gemm_in(const Params& p, int layer, char* smem) {
  const int N = layer ? OIN : EIN;
  const int Npad = layer ? OIN_PAD : EIN_PAD;
  pg8::Gemm g;
  g.A = p.H; g.Bt = layer ? p.WinO : p.WinE; g.M = NROW; g.N = Npad; g.K = 1024;
  pg8::StaticOrder S;
  S.init(NROW, Npad, (int)gridDim.x, (int)blockIdx.x);
  EpiU E;
  E.U = layer ? p.U1 : p.U0; E.ldu = N; E.nvalid = N; E.aux = layer ? p.out + O_DK : nullptr;
  pg8::gemm_phase<EpiU, pg8::StaticOrder, false>((PG8_LAS unsigned char*)smem, g, S, E, nullptr);
}

DI void phase_gemm_out(const Params& p, int layer, char* smem) {
  const bf16_t* W = layer ? p.WoutO : p.WoutE;
  for (int it = VBLK; it < 48 * 8; it += NVBLK) {
    const int mt = it % 48, nt = it / 48;
    gemm_tile64(p.O, 1024, W, 1024, 1024, 1024, mt * 128, nt * 128, smem,
              [=](int m, int n, f32x4 v) {
                const float4 gt = *(const float4*)(p.MOD + (layer * 3 + cv_of_row(m)) * 3072 + 2048 + n);
                const float4 xv = layer ? load_bf4(p.X1B + (size_t)m * 1024 + n) : *(const float4*)(xrow(p, m) + n);
                f32x4 r;
                r[0] = xv.x + gt.x * v[0]; r[1] = xv.y + gt.y * v[1]; r[2] = xv.z + gt.z * v[2]; r[3] = xv.w + gt.w * v[3];
                store_bf4(p.X1B + (size_t)m * 1024 + n, r);
              });
  }
}

DI void phase_out_norm_fused(const Params& p, int layer, char* smem) {
  const int tid = TIDX, lane = tid & 63, wave = tid >> 6, wm = wave >> 1, wn = wave & 1, g = lane >> 4, l16 = lane & 15;
  float* sSS = (float*)(smem + 65536);
  float* sR = sSS + 256;
  for (int it = VBLK; it < 48 * 8; it += NVBLK) {
    const int mt = it % 48, nt = it / 48, m0 = mt * 128, n0 = nt * 128;
    f32x4 acc[4][4];
    gemm_tile64_acc(p.O, 1024, layer ? p.WoutO : p.WoutE, 1024, 1024, 1024, m0, n0, smem, acc);
    float* ssq_slots = p.SSQ + (size_t)layer * NROW * 8;
    unsigned* cnt_base = p.CNT + layer * 48 * 64;
    float ssq[4];
#pragma unroll
    for (int mi = 0; mi < 4; ++mi) {
      const int row = m0 + wm * 64 + mi * 16 + l16;
      const float* gp = p.MOD + (layer * 3 + cv_of_row(row)) * 3072 + 2048;
      ssq[mi] = 0.f;
#pragma unroll
      for (int ni = 0; ni < 4; ++ni) {
        const int n = n0 + wn * 64 + ni * 16 + g * 4;
        const float4 gt = *(const float4*)(gp + n);
        const float4 xv = layer ? load_bf4(p.X1B + (size_t)row * 1024 + n) : *(const float4*)(xrow(p, row) + n);
        f32x4 r;
        r[0] = xv.x + gt.x * acc[ni][mi][0]; r[1] = xv.y + gt.y * acc[ni][mi][1]; r[2] = xv.z + gt.z * acc[ni][mi][2]; r[3] = xv.w + gt.w * acc[ni][mi][3];
        acc[ni][mi] = r;
        if (!layer) store_bf4(p.X1B + (size_t)row * 1024 + n, r);
        ssq[mi] += r[0] * r[0] + r[1] * r[1] + r[2] * r[2] + r[3] * r[3];
      }
      ssq[mi] = xsum_16_32(ssq[mi]);
    }
    if (g == 0) {
#pragma unroll
      for (int mi = 0; mi < 4; ++mi) sSS[wn * 128 + wm * 64 + mi * 16 + l16] = ssq[mi];
    }
    __syncthreads();
    if (tid < 128) __hip_atomic_store(ssq_slots + (size_t)(m0 + tid) * 8 + nt, sSS[tid] + sSS[128 + tid], __ATOMIC_RELAXED, __HIP_MEMORY_SCOPE_AGENT);
    asm volatile("s_waitcnt vmcnt(0)" ::: "memory");
    __syncthreads();
    if (tid == 0) {
      unsigned* cnt = cnt_base + mt * 64;
      __hip_atomic_fetch_add(cnt, 1u, __ATOMIC_RELAXED, __HIP_MEMORY_SCOPE_AGENT);
      unsigned sp = 0;
      while (__hip_atomic_load(cnt, __ATOMIC_RELAXED, __HIP_MEMORY_SCOPE_AGENT) < 8u) {
        __builtin_amdgcn_s_sleep(1);
        if (++sp > (1u << 22)) break;
      }
      asm volatile("" ::: "memory");
    }
    __syncthreads();
    if (tid < 128) {
      const float* sl = ssq_slots + (size_t)(m0 + tid) * 8;
      float t = 0.f;
#pragma unroll
      for (int q = 0; q < 8; ++q) t += __hip_atomic_load(sl + q, __ATOMIC_RELAXED, __HIP_MEMORY_SCOPE_AGENT);
      sR[tid] = rsqrtf(t * (1.f / 1024.f) + EPSF);
    }
    __syncthreads();
#pragma unroll
    for (int mi = 0; mi < 4; ++mi) {
      const int rl = wm * 64 + mi * 16 + l16;
      const float r = sR[rl];
      float* op = p.out + O_Y + (size_t)(m0 + rl) * 1024;
      const float* md = p.MOD + (3 + cv_of_row(m0 + rl)) * 3072;
#pragma unroll
      for (int ni = 0; ni < 4; ++ni) {
        const int n = n0 + wn * 64 + ni * 16 + g * 4;
        if (layer) {
          const float4 gg = *(const float4*)(p.final_g + n);
          *(float4*)(op + n) = make_float4(acc[ni][mi][0] * r * gg.x, acc[ni][mi][1] * r * gg.y, acc[ni][mi][2] * r * gg.z, acc[ni][mi][3] * r * gg.w);
        } else {
          const float4 gg = *(const float4*)(p.o_norm_g + n), sh = *(const float4*)(md + n), sc = *(const float4*)(md + 1024 + n);
          f32x4 hv;
          hv[0] = acc[ni][mi][0] * r * gg.x * (1.f + sc.x) + sh.x; hv[1] = acc[ni][mi][1] * r * gg.y * (1.f + sc.y) + sh.y;
          hv[2] = acc[ni][mi][2] * r * gg.z * (1.f + sc.z) + sh.z; hv[3] = acc[ni][mi][3] * r * gg.w * (1.f + sc.w) + sh.w;
          store_bf4(p.H + (size_t)(m0 + rl) * 1024 + n, hv);
        }
      }
    }
  }
}

DI void phase_gemm_mla(const Params& p, char* smem) {
  const int G = (int)gridDim.x, bid = (int)blockIdx.x;
  const bool split = G >= 176;
  if (!split || bid < 72) {
    pg8::Gemm g;
    g.A = p.CQN; g.Bt = p.Wuq; g.M = NROW; g.N = 768; g.K = 384;
    pg8::StaticOrder S;
    S.init(NROW, 768, G, bid);
    EpiU E;
    E.U = p.Q; E.ldu = 768; E.nvalid = 768; E.aux = nullptr;
    pg8::gemm_phase<EpiU, pg8::StaticOrder, false>((PG8_LAS unsigned char*)smem, g, S, E, nullptr);
  }
  if (!split || bid >= 72) {
    pg8::Gemm g;
    g.A = p.CKVN; g.Bt = p.Wukv; g.M = NTROW; g.N = 1024; g.K = 256;
    pg8::StaticOrder S;
    S.init(NTROW, 1024, G, split ? bid - 72 : bid);
    EpiU E;
    E.U = p.KV; E.ldu = 1024; E.nvalid = 1024; E.aux = nullptr;
    pg8::gemm_phase<EpiU, pg8::StaticOrder, false>((PG8_LAS unsigned char*)smem, g, S, E, nullptr);
  }
}

struct TRow { int row, pos, cb, ct; bool cache, lat; };
DI TRow decode_trow(int trow) {
  TRow t; t.row = -1; t.pos = 0; t.cb = 0; t.ct = 0; t.cache = false; t.lat = false;
  if (trow < 4096) { t.row = trow; }
  else {
    const int r = trow - 4096; const int b = r / 1280, tt = r % 1280;
    t.lat = true;
    if (tt < 256) { t.cache = true; t.cb = b; t.ct = tt; }
    else { t.pos = tt - 256; t.row = 4096 + b * 1024 + t.pos; }
  }
  return t;
}
DI void cvt_store4(bf16_t* dst, const float* src) {
  const float4 v = *(const float4*)src;
  uint2 o; o.x = pack2(v.x, v.y); o.y = pack2(v.z, v.w);
  *(uint2*)dst = o;
}

DI void phase3(const Params& p) {
  const int tid = TIDX, lane = tid & 63, wave = tid >> 6;
  for (int it = VBLK; it < NTROW / 4; it += NVBLK) {
    const int trow = it * 4 + wave;
    const TRow t = decode_trow(trow);
    if (t.cache) {
      const size_t ci = (size_t)t.cb * 256 + t.ct;
      cvt_store4(p.CKVN + (size_t)trow * 256 + lane * 4, p.cache_ckv + ci * 256 + lane * 4);
      if (lane < 8) cvt_store4(p.KR + (size_t)trow * 32 + lane * 4, p.cache_kr + ci * 32 + lane * 4);
      if (lane < 32) {
        cvt_store4(p.KB + (size_t)trow * 128 + lane * 4, p.cache_gk + ci * 128 + lane * 4);
        cvt_store4(p.VB + (size_t)trow * 128 + lane * 4, p.cache_gv + ci * 128 + lane * 4);
      }
      continue;
    }
    const int row = t.row;
    const bf16_t* u = p.U0 + (size_t)row * EIN;
    {
      float x[6]; float ss = 0.f;
#pragma unroll
      for (int i = 0; i < 3; ++i) {
        const unsigned w = *(const unsigned*)(u + i * 128 + lane * 2);
        x[2 * i] = lo2f(w); x[2 * i + 1] = hi2f(w);
        ss += x[2 * i] * x[2 * i] + x[2 * i + 1] * x[2 * i + 1];
      }
      ss = wave_sum(ss);
      const float r = rsqrtf(ss * (1.f / 384.f) + EPSF);
#pragma unroll
      for (int i = 0; i < 3; ++i) {
        const int col = i * 128 + lane * 2;
        *(unsigned*)(p.CQN + (size_t)row * 384 + col) = pack2(x[2 * i] * r * p.e_qn_g[col], x[2 * i + 1] * r * p.e_qn_g[col + 1]);
      }
    }
    {
      const uint2 w = *(const uint2*)(u + 384 + lane * 4);
      float x0 = lo2f(w.x), x1 = hi2f(w.x), x2 = lo2f(w.y), x3 = hi2f(w.y);
      float ss = wave_sum(x0 * x0 + x1 * x1 + x2 * x2 + x3 * x3);
      const float r = rsqrtf(ss * (1.f / 256.f) + EPSF);
      const float4 gg = *(const float4*)(p.e_kvn_g + lane * 4);
      x0 *= r * gg.x; x1 *= r * gg.y; x2 *= r * gg.z; x3 *= r * gg.w;
      uint2 o; o.x = pack2(x0, x1); o.y = pack2(x2, x3);
      *(uint2*)(p.CKVN + (size_t)trow * 256 + lane * 4) = o;
      if (!t.lat) *(float4*)(p.out + O_CKV + (size_t)row * 256 + lane * 4) = make_float4(x0, x1, x2, x3);
    }
    if (lane < 16) {
      const unsigned w = *(const unsigned*)(u + 640 + lane * 2);
      float x0 = lo2f(w), x1 = hi2f(w);
      if (t.lat) {
        const float2 cs = p.ROPE32[t.pos * 16 + lane];
        const float y0 = x0 * cs.x - x1 * cs.y, y1 = x0 * cs.y + x1 * cs.x;
        x0 = y0; x1 = y1;
      } else {
        *(float2*)(p.out + O_KR + (size_t)row * 32 + lane * 2) = make_float2(x0, x1);
      }
      *(unsigned*)(p.KR + (size_t)trow * 32 + lane * 2) = pack2(x0, x1);
    }
#pragma unroll
    for (int which = 0; which < 2; ++which) {
      const int lsrc = which ? (lane & 15) : lane;
      const uint4 w = *(const uint4*)(u + (which ? 1696 : 1184) + lsrc * 8);
      float x[8] = {lo2f(w.x), hi2f(w.x), lo2f(w.y), hi2f(w.y), lo2f(w.z), hi2f(w.z), lo2f(w.w), hi2f(w.w)};
      float ss = 0.f;
#pragma unroll
      for (int j = 0; j < 8; ++j) ss += x[j] * x[j];
      ss += __shfl_xor(ss, 1); ss += __shfl_xor(ss, 2); ss += __shfl_xor(ss, 4);
      const float r = rsqrtf(ss * (1.f / 64.f) + EPSF);
      const float* gp = (which ? p.e_gk_g : p.e_gq_g) + (lane & 7) * 8;
#pragma unroll
      for (int j = 0; j < 8; ++j) x[j] *= r * gp[j];
      if (t.lat) {
#pragma unroll
        for (int jj = 0; jj < 4; ++jj) {
          const float2 cs = p.ROPE64[t.pos * 32 + (lane & 7) * 4 + jj];
          const float y0 = x[2 * jj] * cs.x - x[2 * jj + 1] * cs.y, y1 = x[2 * jj] * cs.y + x[2 * jj + 1] * cs.x;
          x[2 * jj] = y0; x[2 * jj + 1] = y1;
        }
      }
      uint4 o; o.x = pack2(x[0], x[1]); o.y = pack2(x[2], x[3]); o.z = pack2(x[4], x[5]); o.w = pack2(x[6], x[7]);
      if (which == 0) {
        *(uint4*)(p.QB + (size_t)row * 512 + lane * 8) = o;
      } else if (lane < 16) {
        *(uint4*)(p.KB + (size_t)trow * 128 + lane * 8) = o;
        if (!t.lat) {
          float* op = p.out + O_GK + (size_t)row * 128 + lane * 8;
          *(float4*)op = make_float4(x[0], x[1], x[2], x[3]);
          *(float4*)(op + 4) = make_float4(x[4], x[5], x[6], x[7]);
        }
      }
    }
    if (lane < 16) {
      const uint4 w = *(const uint4*)(u + 1824 + lane * 8);
      *(uint4*)(p.VB + (size_t)trow * 128 + lane * 8) = w;
      if (!t.lat) {
        float* op = p.out + O_GV + (size_t)row * 128 + lane * 8;
        *(float4*)op = make_float4(lo2f(w.x), hi2f(w.x), lo2f(w.y), hi2f(w.y));
        *(float4*)(op + 4) = make_float4(lo2f(w.z), hi2f(w.z), lo2f(w.w), hi2f(w.w));
      }
    }
  }
}

DI void phase_attn0(const Params& p, char* smem) {
  const int lane = TIDX & 63, wave = TIDX >> 6, g = lane >> 4, l16 = lane & 15;
  for (int it = vblk_xcd(); it < 1536; it += NVBLK) {
    int kind, b, h, qb, row0, trow0, T;
    if (it < 512) { const int i = it & 255; kind = it >> 8; b = i >> 7; h = (i >> 4) & 7; qb = i & 15; row0 = 4096 + b * 1024 + qb * 64; trow0 = 4096 + b * 1280; T = 1280; }
    else { const int i2 = it - 512; kind = i2 >> 9; const int i = i2 & 511; b = i >> 5; h = (i >> 2) & 7; qb = i & 3; row0 = b * 256 + qb * 64; trow0 = b * 256; T = 256; }
    f32x4 oo[1][4];
    float lss[1], mss[1];
    int gcol, ocol;
    const int row = row0 + wave * 16 + l16;
    uint2 gwv[4];
    {
      const int gc = kind == 0 ? 672 + h * 64 : 1952 + h * 64;
#pragma unroll
      for (int i = 0; i < 4; ++i) gwv[i] = *(const uint2*)(p.U0 + (size_t)row * EIN + gc + i * 16 + g * 4);
    }
    if (kind == 0) {
      attn_core<96, 64, false>(smem, p.Q + (size_t)row0 * 768 + h * 96, 768, p.KV + (size_t)trow0 * 1024 + h * 128, 1024,
                        p.KR + (size_t)trow0 * 32, 32, p.KV + (size_t)trow0 * 1024 + h * 128 + 64, 1024, T,
                        0.10206207261596575f * 1.4426950408889634f, oo, lss, mss,
                        it < 512 ? p.ROPE32 + (size_t)(qb * 64) * 16 : nullptr);
      gcol = 672 + h * 64; ocol = h * 64;
    } else {
      const int kvh = h >> 2;
      attn_core<64, 64, false>(smem, p.QB + (size_t)row0 * 512 + h * 64, 512, p.KB + (size_t)trow0 * 128 + kvh * 64, 128,
                        nullptr, 0, p.VB + (size_t)trow0 * 128 + kvh * 64, 128, T, 0.125f * 1.4426950408889634f, oo, lss, mss);
      gcol = 1952 + h * 64; ocol = 512 + h * 64;
    }
    float ls = lss[0];
    ls = xsum_16_32(ls);
    const float inv = 1.f / ls;
    f32x4 (&o)[4] = oo[0];
#pragma unroll
    for (int i = 0; i < 4; ++i) {
      const int dv = i * 16 + g * 4;
      const uint2 gw = gwv[i];
      f32x4 r;
      r[0] = o[i][0] * inv * siluf(lo2f(gw.x)); r[1] = o[i][1] * inv * siluf(hi2f(gw.x));
      r[2] = o[i][2] * inv * siluf(lo2f(gw.y)); r[3] = o[i][3] * inv * siluf(hi2f(gw.y));
      store_bf4(p.O + (size_t)row * 1024 + ocol + dv, r);
    }
  }
}

DI void mlstm_gates(const Params& p, int rowbase, int nc, int h, int dir, int j, int lane, float& ig, float& lf) {
  const int oc = dir ? nc - 1 - j : j;
  const int s = dir ? 63 - lane : lane;
  const int row = rowbase + oc * 64 + s;
  const bf16_t* up = p.U1 + (size_t)row * OIN + 2048;
  ig = bf2f(up[dir * 8 + h]) + p.o_gate_b[dir * 8 + h];
  lf = logsig(bf2f(up[dir * 8 + 4 + h]) + p.o_gate_b[dir * 8 + 4 + h]);
}
DI void mitem_decode(int it, int& sq, int& h, int& dir, int& j, int& nc, int& rowbase) {
  if (it < 512) { j = it & 3; dir = (it >> 2) & 1; h = (it >> 3) & 3; sq = it >> 5; nc = 4; rowbase = sq * 256; }
  else { const int i = it - 512; j = i & 15; dir = (i >> 4) & 1; h = (i >> 5) & 3; sq = 16 + (i >> 7); nc = 16; rowbase = 4096 + (sq - 16) * 1024; }
}
DI int mitem_id(int sq, int h, int dir, int j) {
  return sq < 16 ? (((sq * 4 + h) * 2 + dir) * 4 + j) : (512 + ((((sq - 16) * 4 + h) * 2 + dir) * 16 + j));
}

DI void phase9(const Params& p, char* smem) {
  const int tid = TIDX, lane = tid & 63, wave = tid >> 6, g = lane >> 4, l16 = lane & 15;
  for (int it = VBLK; it < NTROW / 4; it += NVBLK) {
    const int trow = it * 4 + wave;
    const TRow t = decode_trow(trow);
    if (t.cache) {
      const size_t ci = (size_t)t.cb * 256 + t.ct;
      cvt_store4(p.KD + (size_t)trow * 512 + lane * 8, p.cache_dk + ci * 512 + lane * 8);
      cvt_store4(p.KD + (size_t)trow * 512 + lane * 8 + 4, p.cache_dk + ci * 512 + lane * 8 + 4);
      cvt_store4(p.VD + (size_t)trow * 512 + lane * 8, p.cache_dv + ci * 512 + lane * 8);
      cvt_store4(p.VD + (size_t)trow * 512 + lane * 8 + 4, p.cache_dv + ci * 512 + lane * 8 + 4);
      continue;
    }
    if (!t.lat) continue;
    const int row = t.row;
    const bf16_t* u = p.U1 + (size_t)row * OIN;
#pragma unroll
    for (int which = 0; which < 2; ++which) {
      const uint4 w = *(const uint4*)(u + (which ? 3088 : 2576) + lane * 8);
      float x[8] = {lo2f(w.x), hi2f(w.x), lo2f(w.y), hi2f(w.y), lo2f(w.z), hi2f(w.z), lo2f(w.w), hi2f(w.w)};
      if (t.lat) {
#pragma unroll
        for (int jj = 0; jj < 4; ++jj) {
          const float2 cs = p.ROPE64[t.pos * 32 + (lane & 7) * 4 + jj];
          const float y0 = x[2 * jj] * cs.x - x[2 * jj + 1] * cs.y, y1 = x[2 * jj] * cs.y + x[2 * jj + 1] * cs.x;
          x[2 * jj] = y0; x[2 * jj + 1] = y1;
        }
      }
      uint4 o; o.x = pack2(x[0], x[1]); o.y = pack2(x[2], x[3]); o.z = pack2(x[4], x[5]); o.w = pack2(x[6], x[7]);
      if (which == 0) { if (t.lat) *(uint4*)(p.QD + (size_t)row * 512 + lane * 8) = o; }
      else {
        if (t.lat) *(uint4*)(p.KD + (size_t)trow * 512 + lane * 8) = o;
        if (!t.lat) {
          float* op = p.out + O_DK + (size_t)row * 512 + lane * 8;
          *(float4*)op = make_float4(x[0], x[1], x[2], x[3]);
          *(float4*)(op + 4) = make_float4(x[4], x[5], x[6], x[7]);
        }
      }
    }
    {
      const uint4 w = *(const uint4*)(u + 3600 + lane * 8);
      if (t.lat) *(uint4*)(p.VD + (size_t)trow * 512 + lane * 8) = w;
      if (!t.lat) {
        float* op = p.out + O_DV + (size_t)row * 512 + lane * 8;
        *(float4*)op = make_float4(lo2f(w.x), hi2f(w.x), lo2f(w.y), hi2f(w.y));
        *(float4*)(op + 4) = make_float4(lo2f(w.z), hi2f(w.z), lo2f(w.w), hi2f(w.w));
      }
    }
  }
  bf16_t* sKT = (bf16_t*)smem;
  bf16_t* sVT = sKT + 128 * LDT;
  float* swk = (float*)(sVT + 128 * LDT);
  for (int it = VBLK; it < 768; it += NVBLK) {
    int sq, h, dir, j, nc, rowbase;
    mitem_decode(it, sq, h, dir, j, nc, rowbase);
    float ig, lf;
    mlstm_gates(p, rowbase, nc, h, dir, j, lane, ig, lf);
    const float b = scan_add(lf, lane);
    const float bL = __shfl(b, 63);
    const float mx = wave_max(bL - b + ig);
    const float wk = fexp(bL - b + ig - mx);
    __syncthreads();
    if (wave == 0) {
      swk[dir ? 63 - lane : lane] = wk;
      if (lane == 0) { p.SC[it * 4 + 0] = bL; p.SC[it * 4 + 1] = mx; }
    }
    __syncthreads();
    const int oc = dir ? nc - 1 - j : j;
    const int row0 = rowbase + oc * 64;
    stage_T64<128>(sKT, p.U1 + (size_t)row0 * OIN + 512 + h * 128, OIN, nullptr);
    stage_T64<128>(sVT, p.U1 + (size_t)row0 * OIN + 1024 + h * 128, OIN, swk);
    __syncthreads();
    f32x4 acc[2][8];
#pragma unroll
    for (int a = 0; a < 2; ++a)
#pragma unroll
      for (int c = 0; c < 8; ++c) acc[a][c] = f32x4{0.f, 0.f, 0.f, 0.f};
#pragma unroll
    for (int ks = 0; ks < 2; ++ks) {
      bf16x8 vf[2];
#pragma unroll
      for (int a = 0; a < 2; ++a) vf[a] = *(const bf16x8*)(sVT + ((wave * 2 + a) * 16 + l16) * LDT + ks * 32 + g * 8);
#pragma unroll
      for (int kt = 0; kt < 8; ++kt) {
        const bf16x8 kf = *(const bf16x8*)(sKT + (kt * 16 + l16) * LDT + ks * 32 + g * 8);
#pragma unroll
        for (int a = 0; a < 2; ++a) acc[a][kt] = MFMA16(kf, vf[a], acc[a][kt]);
      }
    }
    bf16_t* uc = p.UC + (size_t)it * 16384;
#pragma unroll
    for (int a = 0; a < 2; ++a)
#pragma unroll
      for (int kt = 0; kt < 8; ++kt) {
        const int v = (wave * 2 + a) * 16 + l16, k = kt * 16 + g * 4;
        store_bf4(uc + v * 128 + k, acc[a][kt]);
      }
    if (tid < 128) {
      float s = 0.f;
#pragma unroll
      for (int c8 = 0; c8 < 8; ++c8) {
        const u32x4 kw = *(const u32x4*)(sKT + tid * LDT + c8 * 8);
        const float4 w0 = *(const float4*)(swk + c8 * 8), w1 = *(const float4*)(swk + c8 * 8 + 4);
        s += lo2f(kw[0]) * w0.x + hi2f(kw[0]) * w0.y + lo2f(kw[1]) * w0.z + hi2f(kw[1]) * w0.w
           + lo2f(kw[2]) * w1.x + hi2f(kw[2]) * w1.y + lo2f(kw[3]) * w1.z + hi2f(kw[3]) * w1.w;
      }
      p.NU[it * 128 + tid] = s;
    }
  }
}

DI void diff_finish(const Params& p, f32x4 (&o1)[8], f32x4 (&o2)[8], float l1, float l2, int row0, int hd) {
  const int lane = TIDX & 63, wave = TIDX >> 6, g = lane >> 4, l16 = lane & 15;
  l1 = xsum_16_32(l1);
  l2 = xsum_16_32(l2);
  const float i1 = 1.f / l1, i2 = p.LAMV[0] / l2;
  float ss = 0.f;
#pragma unroll
  for (int i = 0; i < 8; ++i)
#pragma unroll
    for (int j = 0; j < 4; ++j) { o1[i][j] = o1[i][j] * i1 - o2[i][j] * i2; ss += o1[i][j] * o1[i][j]; }
  ss = xsum_16_32(ss);
  const float r = rsqrtf(ss * (1.f / 128.f) + EPSF) * (1.f - LAM_INIT);
  const int row = row0 + wave * 16 + l16;
#pragma unroll
  for (int i = 0; i < 8; ++i) {
    const int dv = i * 16 + g * 4;
    const uint2 gw = *(const uint2*)(p.U1 + (size_t)row * OIN + 4112 + hd * 128 + dv);
    const float4 gn = *(const float4*)(p.o_dnorm_g + dv);
    f32x4 rr;
    rr[0] = o1[i][0] * r * gn.x * siluf(lo2f(gw.x)); rr[1] = o1[i][1] * r * gn.y * siluf(hi2f(gw.x));
    rr[2] = o1[i][2] * r * gn.z * siluf(lo2f(gw.y)); rr[3] = o1[i][3] * r * gn.w * siluf(hi2f(gw.y));
    store_bf4(p.O + (size_t)row * 1024 + 512 + hd * 128 + dv, rr);
  }
}

DI void phase10(const Params& p, char* smem) {
  const int tid = TIDX, lane = tid & 63, wave = tid >> 6, g = lane >> 4, l16 = lane & 15;
  for (int it = vblk_xcd(); it < 512; it += NVBLK) {
    int b, hd, qb, row0, trow0, T;
    const bool lat = it < 256;
    const int split = (it >> 1) & 1;
    const int li = ((it >> 7) * 4 + ((it >> 5) & 3)) * 16 + ((it >> 2) & 7) * 2 + (it & 1);
    if (lat) { b = li >> 6; hd = (li >> 4) & 3; qb = li & 15; row0 = 4096 + b * 1024 + qb * 64; trow0 = 4096 + b * 1280 + split * 640; T = 640; }
    else { const int i = it - 256; b = i >> 4; hd = (i >> 2) & 3; qb = i & 3; row0 = b * 256 + qb * 64; trow0 = b * 256; T = 256; }
    f32x4 od[2][8];
    float ld2[2], md2[2];
    const float sc = 0.125f * 1.4426950408889634f;
    const bf16_t* qp = lat ? p.QD + (size_t)row0 * 512 + hd * 128 : p.U1 + (size_t)row0 * OIN + 2576 + hd * 128;
    const bf16_t* kp = lat ? p.KD + (size_t)trow0 * 512 + hd * 128 : p.U1 + (size_t)trow0 * OIN + 3088 + hd * 128;
    const bf16_t* vp = lat ? p.VD + (size_t)trow0 * 512 + hd * 128 : p.U1 + (size_t)trow0 * OIN + 3600 + hd * 128;
    const int ldqkv = lat ? 512 : OIN;
    attn_core<64, 128, true>(smem, qp, ldqkv, kp, ldqkv, nullptr, 0, vp, ldqkv, T, sc, od, ld2, md2);
    if (lat) {
#pragma unroll
      for (int n = 0; n < 2; ++n) {
        const size_t base = (size_t)((li * 2 + split) * 2 + n) * 4 + wave;
#pragma unroll
        for (int i = 0; i < 8; ++i) store_bf4(p.OP + ((base * 8 + i) * 64 + lane) * 4, od[n][i]);
        *(float2*)(p.ML + (base * 64 + lane) * 2) = make_float2(md2[n], ld2[n]);
      }
    } else {
      diff_finish(p, od[0], od[1], ld2[0], ld2[1], row0, hd);
    }
  }
  const int vb = (vblk_xcd() + (NVBLK >> 1)) % NVBLK;
  for (int it = vb; it < 144 * 16; it += NVBLK) {
    const int chain = it < 256 ? 128 + (it >> 4) : ((it - 256) >> 4), eb = it & 15;
    const int sq = chain >> 3, h = (chain >> 1) & 3, dir = chain & 1;
    const int nc = sq < 16 ? 4 : 16;
    const int ib = mitem_id(sq, h, dir, 0);
    const int e = eb * 1024 + tid * 4;
    float4 C = make_float4(0.f, 0.f, 0.f, 0.f);
    if (sq >= 16) C = *(const float4*)(p.st_C + (size_t)(((sq - 16) * 2 + dir) * 4 + h) * 16384 + e);
    float4 uu[16];
    float dcs[16], scl[16], bLs[16], mxs[16];
#pragma unroll
    for (int j = 0; j < 16; ++j) {
      if (j < nc) { bLs[j] = p.SC[(ib + j) * 4 + 0]; mxs[j] = p.SC[(ib + j) * 4 + 1]; uu[j] = load_bf4(p.UC + (size_t)(ib + j) * 16384 + e); }
    }
    float mrun = 0.f;
    if (sq >= 16) mrun = p.st_m[((sq - 16) * 2 + dir) * 4 + h];
#pragma unroll
    for (int j = 0; j < 16; ++j) {
      if (j < nc) {
        const float mnext = fmaxf(bLs[j] + mrun, mxs[j]);
        dcs[j] = fexp(bLs[j] + mrun - mnext);
        scl[j] = fexp(mxs[j] - mnext);
        if (eb == 0 && tid == 0) p.SCM[ib + j] = mrun;
        mrun = mnext;
      }
    }
#pragma unroll
    for (int j = 0; j < 16; ++j) {
      if (j < nc) {
        uint2 o; o.x = pack2(C.x, C.y); o.y = pack2(C.z, C.w);
        *(uint2*)(p.CST + (size_t)(ib + j) * 16384 + e) = o;
        const float dc = dcs[j], sc = scl[j];
        C.x = dc * C.x + sc * uu[j].x; C.y = dc * C.y + sc * uu[j].y; C.z = dc * C.z + sc * uu[j].z; C.w = dc * C.w + sc * uu[j].w;
      }
    }
    if (sq < 16) *(float4*)(p.out + O_C + (size_t)((sq * 2 + dir) * 4 + h) * 16384 + e) = C;
    if (eb == 0 && tid < 128) {
      float n = 0.f;
      if (sq >= 16) n = p.st_n[(((sq - 16) * 2 + dir) * 4 + h) * 128 + tid];
#pragma unroll
      for (int j = 0; j < 16; ++j) {
        if (j < nc) {
          p.NST[(ib + j) * 128 + tid] = n;
          n = dcs[j] * n + scl[j] * p.NU[(ib + j) * 128 + tid];
        }
      }
      if (sq < 16) {
        p.out[O_N + ((sq * 2 + dir) * 4 + h) * 128 + tid] = n;
        if (tid == 0) p.out[O_M + (sq * 2 + dir) * 4 + h] = mrun;
      }
    }
  }
}

DI void phase11(const Params& p, char* smem) {
  const int tid = TIDX, lane = tid & 63, wave = tid >> 6, g = lane >> 4, l16 = lane & 15;
  bf16_t* sK = (bf16_t*)smem;
  bf16_t* sVT = sK + 64 * 128;
  float* sB = (float*)(sVT + 128 * LDT);
  float* sA = sB + 128;
  float* sMT = sA + 128;
  bf16_t* sC = (bf16_t*)(smem + 36352);
  for (int it = VBLK; it < 512; it += NVBLK) {
    if (it >= 384) {
    const int li = it - 384;
    const int b = li >> 6, hd = (li >> 4) & 3, qb = li & 15, row0 = 4096 + b * 1024 + qb * 64;
    f32x4 oc[2][8];
    float lc[2];
#pragma unroll
    for (int n = 0; n < 2; ++n) {
      const size_t b0 = (size_t)((li * 2 + 0) * 2 + n) * 4 + wave, b1 = (size_t)((li * 2 + 1) * 2 + n) * 4 + wave;
      const float2 ml0 = *(const float2*)(p.ML + (b0 * 64 + lane) * 2), ml1 = *(const float2*)(p.ML + (b1 * 64 + lane) * 2);
      const float m = fmaxf(ml0.x, ml1.x);
      const float f0 = __builtin_amdgcn_exp2f((ml0.x - m) * (0.125f * 1.4426950408889634f)), f1 = __builtin_amdgcn_exp2f((ml1.x - m) * (0.125f * 1.4426950408889634f));
      lc[n] = ml0.y * f0 + ml1.y * f1;
#pragma unroll
      for (int i = 0; i < 8; ++i) {
        const float4 a0 = load_bf4(p.OP + ((b0 * 8 + i) * 64 + lane) * 4), a1 = load_bf4(p.OP + ((b1 * 8 + i) * 64 + lane) * 4);
        oc[n][i] = f32x4{a0.x * f0 + a1.x * f1, a0.y * f0 + a1.y * f1, a0.z * f0 + a1.z * f1, a0.w * f0 + a1.w * f1};
      }
    }
    diff_finish(p, oc[0], oc[1], lc[0], lc[1], row0, hd);
    continue;
    }
    int sq, h, c, nc, rowbase;
    if (it < 128) { sq = 16 + (it >> 6); h = (it >> 4) & 3; c = it & 15; nc = 16; rowbase = 4096 + (sq - 16) * 1024; }
    else { const int i = it - 128; sq = i >> 4; h = (i >> 2) & 3; c = i & 3; nc = 4; rowbase = sq * 256; }
    const int row0 = rowbase + c * 64;
    float mst[2];
    int item[2];
    item[0] = mitem_id(sq, h, 0, c);
    item[1] = mitem_id(sq, h, 1, nc - 1 - c);
    u32x4 cr[8];
    {
      const bf16_t* cst0 = p.CST + (size_t)item[0] * 16384;
#pragma unroll
      for (int i = 0; i < 8; ++i) cr[i] = *(const u32x4*)(cst0 + (tid + 256 * i) * 8);
    }
    __syncthreads();
#pragma unroll
    for (int dir = 0; dir < 2; ++dir) {
      const int j = dir ? nc - 1 - c : c;
      mst[dir] = p.SCM[item[dir]];
      if (wave == 0) {
        float ig, lf;
        mlstm_gates(p, rowbase, nc, h, dir, j, lane, ig, lf);
        const float b = scan_add(lf, lane);
        const float a = ig - b;
        const float pm = scan_max(a, lane);
        const float mt = b + fmaxf(mst[dir], pm);
        const int so = dir ? 63 - lane : lane;
        sB[dir * 64 + so] = b; sA[dir * 64 + so] = a; sMT[dir * 64 + so] = mt;
      }
    }
    for (int c = tid; c < 64 * 16; c += 256) {
      const int r = c >> 4, ch = c & 15;
      *(uint4*)(sK + (ch >> 2) * 2048 + r * 32 + (((ch & 3) ^ ((4 - ((r >> 2) & 3)) & 3)) * 8)) = *(const uint4*)(p.U1 + (size_t)(row0 + r) * OIN + 512 + h * 128 + ch * 8);
    }
    stage_T64<128>(sVT, p.U1 + (size_t)row0 * OIN + 1024 + h * 128, OIN, nullptr);
#pragma unroll
    for (int i = 0; i < 8; ++i) {
      const int cc = tid + 256 * i, r = cc >> 4, ch = cc & 15;
      *(u32x4*)(sC + (ch >> 2) * 4096 + r * 32 + (((ch & 3) ^ ((4 - ((r >> 2) & 3)) & 3)) * 8)) = cr[i];
    }
    bf16x8 qf[4];
    const int tq = wave * 16 + l16;
    const int row = row0 + tq;
#pragma unroll
    for (int ks = 0; ks < 4; ++ks) qf[ks] = *(const bf16x8*)(p.U1 + (size_t)row * OIN + h * 128 + ks * 32 + g * 8);
    __syncthreads();
    f32x4 hsum[8];
#pragma unroll
    for (int i = 0; i < 8; ++i) hsum[i] = f32x4{0.f, 0.f, 0.f, 0.f};
#pragma unroll 1
    for (int dir = 0; dir < 2; ++dir) {
      const float bt = sB[dir * 64 + tq], mtt = sMT[dir * 64 + tq];
      const float mst_d = dir ? mst[1] : mst[0];
      const int item_d = dir ? item[1] : item[0];
      const float w_inter = fexp(bt + mst_d - mtt);
      const float et = bt - mtt;
      if (dir == 0) {
        const bf16_t* cst1 = p.CST + (size_t)item[1] * 16384;
#pragma unroll
        for (int i = 0; i < 8; ++i) cr[i] = *(const u32x4*)(cst1 + (tid + 256 * i) * 8);
      }
      f32x4 s[4];
      float dsum = 0.f;
#pragma unroll
      for (int t = 0; t < 4; ++t) {
        s[t] = f32x4{0.f, 0.f, 0.f, 0.f};
#pragma unroll
        for (int ks = 0; ks < 4; ++ks) {
          const bf16x8 kf = *(const bf16x8*)(sK + ks * 2048 + (t * 16 + l16) * 32 + ((g ^ ((4 - (l16 >> 2)) & 3)) * 8));
          s[t] = MFMA16(kf, qf[ks], s[t]);
        }
#pragma unroll
        for (int j = 0; j < 4; ++j) {
          const int sk = t * 16 + g * 4 + j;
          const bool ok = dir ? (sk >= tq) : (sk <= tq);
          const float w = ok ? fexp(et + sA[dir * 64 + sk]) : 0.f;
          s[t][j] *= w;
          dsum += s[t][j];
        }
      }
      dsum = xsum_16_32(dsum);
      f32x4 acc[8];
#pragma unroll
      for (int vt = 0; vt < 8; ++vt) {
        acc[vt] = f32x4{0.f, 0.f, 0.f, 0.f};
#pragma unroll
        for (int ks = 0; ks < 4; ++ks) {
          const bf16x8 cf = *(const bf16x8*)(sC + ks * 4096 + (vt * 16 + l16) * 32 + ((g ^ ((4 - (l16 >> 2)) & 3)) * 8));
          acc[vt] = MFMA16(cf, qf[ks], acc[vt]);
        }
        acc[vt] *= w_inter;
        if ((vt & 3) == 3) asm volatile("" ::: "memory");
      }
#pragma unroll
      for (int kb = 0; kb < 2; ++kb) {
        bf16x8 pf;
#pragma unroll
        for (int j = 0; j < 4; ++j) { pf[j] = (short)f2bf(s[2 * kb][j]); pf[4 + j] = (short)f2bf(s[2 * kb + 1][j]); }
#pragma unroll
        for (int vt = 0; vt < 8; ++vt) {
          const bf16_t* vp = sVT + (vt * 16 + l16) * LDT + kb * 32 + g * 4;
          const bf16x4 lo = *(const bf16x4*)(vp);
          const bf16x4 hi = *(const bf16x4*)(vp + 16);
          const bf16x8 vf = __builtin_shufflevector(lo, hi, 0, 1, 2, 3, 4, 5, 6, 7);
          acc[vt] = MFMA16(vf, pf, acc[vt]);
        }
      }
      float nq = 0.f;
      const float* nst = p.NST + (size_t)item_d * 128;
#pragma unroll
      for (int ks = 0; ks < 4; ++ks) {
        const float4 n0 = *(const float4*)(nst + ks * 32 + g * 8), n1 = *(const float4*)(nst + ks * 32 + g * 8 + 4);
        nq += n0.x * bf2f((bf16_t)qf[ks][0]) + n0.y * bf2f((bf16_t)qf[ks][1]) + n0.z * bf2f((bf16_t)qf[ks][2]) + n0.w * bf2f((bf16_t)qf[ks][3]);
        nq += n1.x * bf2f((bf16_t)qf[ks][4]) + n1.y * bf2f((bf16_t)qf[ks][5]) + n1.z * bf2f((bf16_t)qf[ks][6]) + n1.w * bf2f((bf16_t)qf[ks][7]);
      }
      nq = xsum_16_32(nq);
      const float den = w_inter * nq + dsum;
      const float dinv = 1.f / fmaxf(fabsf(den), fexp(-mtt));
#pragma unroll
      for (int vt = 0; vt < 8; ++vt) hsum[vt] += acc[vt] * dinv;
      if (dir == 0) {
        __syncthreads();
#pragma unroll
        for (int i = 0; i < 8; ++i) {
          const int cc = tid + 256 * i, r = cc >> 4, ch = cc & 15;
          *(u32x4*)(sC + (ch >> 2) * 4096 + r * 32 + (((ch & 3) ^ ((4 - ((r >> 2) & 3)) & 3)) * 8)) = cr[i];
        }
        __syncthreads();
      }
    }
    const bf16_t* u = p.U1 + (size_t)row * OIN;
    float ss = 0.f;
#pragma unroll
    for (int vt = 0; vt < 8; ++vt) {
      const uint2 ow = *(const uint2*)(u + 1536 + h * 128 + vt * 16 + g * 4);
      hsum[vt][0] *= sigmf(lo2f(ow.x)); hsum[vt][1] *= sigmf(hi2f(ow.x));
      hsum[vt][2] *= sigmf(lo2f(ow.y)); hsum[vt][3] *= sigmf(hi2f(ow.y));
#pragma unroll
      for (int j = 0; j < 4; ++j) ss += hsum[vt][j] * hsum[vt][j];
    }
    ss = xsum_16_32(ss);
    const float r = rsqrtf(ss * (1.f / 128.f) + EPSF);
#pragma unroll
    for (int vt = 0; vt < 8; ++vt) {
      const int v = h * 128 + vt * 16 + g * 4;
      const uint2 zw = *(const uint2*)(u + 2064 + v);
      const float4 gn = *(const float4*)(p.o_mnorm_g + v);
      f32x4 rr;
      rr[0] = hsum[vt][0] * r * gn.x * siluf(lo2f(zw.x)); rr[1] = hsum[vt][1] * r * gn.y * siluf(hi2f(zw.x));
      rr[2] = hsum[vt][2] * r * gn.z * siluf(lo2f(zw.y)); rr[3] = hsum[vt][3] * r * gn.w * siluf(hi2f(zw.y));
      store_bf4(p.O + (size_t)row * 1024 + v, rr);
    }
  }
}

DI void phase_final(const Params& p) {
  const int tid = TIDX, lane = tid & 63, wave = tid >> 6;
  for (int it = VBLK; it < NROW / 4; it += NVBLK) {
    const int row = it * 4 + wave;
    const bf16_t* x = p.X1B + (size_t)row * 1024;
    float4 v[4];
    float ss = 0.f;
#pragma unroll
    for (int i = 0; i < 4; ++i) {
      v[i] = load_bf4(x + i * 256 + lane * 4);
      ss += v[i].x * v[i].x + v[i].y * v[i].y + v[i].z * v[i].z + v[i].w * v[i].w;
    }
    ss = wave_sum(ss);
    const float r = rsqrtf(ss * (1.f / 1024.f) + EPSF);
#pragma unroll
    for (int i = 0; i < 4; ++i) {
      const int col = i * 256 + lane * 4;
      const float4 gg = *(const float4*)(p.final_g + col);
      *(float4*)(p.out + O_Y + (size_t)row * 1024 + col) = make_float4(v[i].x * r * gg.x, v[i].y * r * gg.y, v[i].z * r * gg.z, v[i].w * r * gg.w);
    }
  }
}


#define XB_TMO      128
#define XB_XCNT(j)  (256  + 64 * (j))
#define XB_XSUB(j)  (1280 + 64 * (j))
#define XB_XGEN(j)  (2304 + 64 * (j))
#define XB_TOP      3328
#define XB_TOPGEN   3392
#define XCD_BAR_WORDS 3456
#define XB_SPIN_CAP (1u << 18)
#define LAS __attribute__((address_space(3)))
DI unsigned xb_ld(unsigned* p) { return __hip_atomic_load(p, __ATOMIC_RELAXED, __HIP_MEMORY_SCOPE_AGENT); }
DI unsigned xb_add(unsigned* p, unsigned v) { return __hip_atomic_fetch_add(p, v, __ATOMIC_RELAXED, __HIP_MEMORY_SCOPE_AGENT); }
DI unsigned xb_xcc_id() { return (unsigned)__builtin_amdgcn_s_getreg((3 << 11) | 20) & 0xFu; }
#define XB_SPIN(cond, bar) do { unsigned _sp = 0; while (cond) { __builtin_amdgcn_s_sleep(1); \
    if ((++_sp & 255u) == 0u) { if (xb_ld(&(bar)[XB_TMO])) break; if (_sp > XB_SPIN_CAP) { atomicAdd(&(bar)[XB_TMO], 1u); break; } } } } while (0)
struct XcdBarrier { unsigned* bar; unsigned x; volatile LAS unsigned* st; };
DI XcdBarrier xcd_barrier_post(unsigned* bar, volatile LAS unsigned* st) {
  XcdBarrier b; b.bar = bar; b.x = xb_xcc_id(); b.st = st;
  if (threadIdx.x == 0) (void)xb_add(&bar[XB_XCNT(b.x)], 1u);
  return b;
}
DI void xcd_barrier_complete(unsigned* bar, unsigned x, unsigned& nloc, unsigned& nx) {
  const unsigned G = gridDim.x * gridDim.y * gridDim.z;
  unsigned sum, cnt, mine, sp = 0u;
  for (;;) {
    sum = 0u; cnt = 0u; mine = 0u;
#pragma unroll
    for (unsigned j = 0; j < 16; ++j) { const unsigned c = xb_ld(&bar[XB_XCNT(j)]); sum += c; cnt += (c > 0u) ? 1u : 0u; mine = (j == x) ? c : mine; }
    if (sum == G) break;
    __builtin_amdgcn_s_sleep(1);
    if ((++sp & 255u) == 0u) { if (xb_ld(&bar[XB_TMO])) break; if (sp > XB_SPIN_CAP) { atomicAdd(&bar[XB_TMO], 1u); break; } }
  }
  nloc = mine > 0u ? mine : 1u; nx = cnt > 0u ? cnt : 1u;
}
DI void xcd_barrier(const XcdBarrier& b) {
  asm volatile("s_waitcnt vmcnt(0)" ::: "memory");
  __syncthreads();
  if (threadIdx.x == 0) {
    unsigned* bar = b.bar;
    __builtin_amdgcn_s_waitcnt(0);
    unsigned nloc = b.st[0], nx = b.st[1];
    if (nloc == 0u) { xcd_barrier_complete(bar, b.x, nloc, nx); b.st[0] = nloc; b.st[1] = nx; }
    const unsigned old = xb_add(&bar[XB_XSUB(b.x)], 1u);
    const unsigned gen = old / nloc;
    if (old + 1u == (gen + 1u) * nloc) {
      __builtin_amdgcn_fence(__ATOMIC_RELEASE, "agent");
      asm volatile("s_waitcnt vmcnt(0)" ::: "memory");
      const unsigned og = xb_add(&bar[XB_TOP], 1u);
      const unsigned tg = og / nx;
      if (og + 1u == (tg + 1u) * nx) xb_add(&bar[XB_TOPGEN], 1u);
      else XB_SPIN(xb_ld(&bar[XB_TOPGEN]) == tg, bar);
      __builtin_amdgcn_fence(__ATOMIC_ACQUIRE, "agent");
      xb_add(&bar[XB_XGEN(b.x)], 1u);
      asm volatile("s_waitcnt vmcnt(0)" ::: "memory");
    } else {
      XB_SPIN(xb_ld(&bar[XB_XGEN(b.x)]) == gen, bar);
      __builtin_amdgcn_fence(__ATOMIC_ACQUIRE, "agent");
      asm volatile("s_waitcnt vmcnt(0)" ::: "memory");
    }
  }
  __syncthreads();
}

DI void run_phase(const Params& p, char* smem0, int ph) {
  char* smem = smem0 + (ltid() >> 8) * GRP_LDS;
  switch (ph) {
    case 0: phase0(p, smem); break;
    case 1: phase0b(p, smem); wait_mod_ready(p); phase_norm(p, 0); break;
    case 2: phase_gemm_in(p, 0, smem0); break;
    case 3: phase3(p); break;
    case 4: phase_gemm_mla(p, smem0); if (NVBLK >= 512) late_weight_prep(p, smem, 352, 0, 800); else late_weight_prep(p, smem, 0, 0, 1424); break;
    case 5: phase_attn0(p, smem0); break;
    case 6: if (NVBLK >= 384) phase_out_norm_fused(p, 0, smem); else phase_gemm_out(p, 0, smem); if (NVBLK >= 512) late_weight_prep(p, smem, 384, 800, 1424); break;
    case 7: if (NVBLK < 384) phase_norm(p, 1); break;
    case 8: phase_gemm_in(p, 1, smem0); break;
    case 9: phase9(p, smem); break;
    case 10: phase10(p, smem0); break;
    case 11: phase11(p, smem); break;
    case 12: if (NVBLK >= 384) phase_out_norm_fused(p, 1, smem); else phase_gemm_out(p, 1, smem); break;
    case 13: if (NVBLK < 384) phase_final(p); break;
  }
}

__global__ void __launch_bounds__(512, 2) mk_fwd(Params p) {
#if SINGLE_LAUNCH
  extern __shared__ __attribute__((aligned(16))) char smem[];
  __shared__ uint4 xb_words;
  if (threadIdx.x == 0) xb_words = make_uint4(0u, 0u, 0u, 0u);
  __syncthreads();
  const XcdBarrier xb = xcd_barrier_post(p.BAR, (volatile LAS unsigned*)&xb_words);
  if (p.phase_hi == 12345) {
    const unsigned long long* ia = (const unsigned long long*)__builtin_amdgcn_implicitarg_ptr();
    p.BAR[XB_TMO] = (unsigned)ia[11];
  }
  run_phase(p, smem, 0);
  run_phase(p, smem, 1); xcd_barrier(xb);
  run_phase(p, smem, 2); xcd_barrier(xb);
  run_phase(p, smem, 3); xcd_barrier(xb);
  run_phase(p, smem, 4); xcd_barrier(xb);
  run_phase(p, smem, 5); xcd_barrier(xb);
  run_phase(p, smem, 6); xcd_barrier(xb);
  if (NVBLK < 384) { run_phase(p, smem, 7); xcd_barrier(xb); }
  run_phase(p, smem, 8); xcd_barrier(xb);
  run_phase(p, smem, 9); xcd_barrier(xb);
  run_phase(p, smem, 10); xcd_barrier(xb);
  run_phase(p, smem, 11); xcd_barrier(xb);
  run_phase(p, smem, 12);
  if (NVBLK < 384) { xcd_barrier(xb); run_phase(p, smem, 13); }
#endif
}

template <int PH>
__global__ void __launch_bounds__(512, 2) mk_phase(Params p) {
  extern __shared__ __attribute__((aligned(16))) char smem[];
  run_phase(p, smem, PH);
}
template <int PH>
static void launch_phases(const Params& p, hipStream_t stream) {
  hipFuncSetAttribute((const void*)mk_phase<PH>, hipFuncAttributeMaxDynamicSharedMemorySize, LDS_BYTES);
  hipLaunchKernelGGL(mk_phase<PH>, dim3(256), dim3(512), LDS_BYTES, stream, p);
  if constexpr (PH + 1 < NPHASE) launch_phases<PH + 1>(p, stream);
}

extern "C" void kernel_launch(void* const* d_in, const int* in_sizes, int n_in, void* d_out, int out_size, void* d_ws, size_t ws_size, hipStream_t stream) {
  Params p{};
  const float** fp = (const float**)&p;
  for (int i = 0; i < 34; ++i) fp[i] = (const float*)d_in[i];
  p.out = (float*)d_out;
  char* w = (char*)d_ws;
  size_t off = 0;
  auto take = [&](size_t bytes) { char* r = w + off; off += (bytes + 255) & ~(size_t)255; return r; };
  p.BAR = (unsigned*)take(XCD_BAR_WORDS * 4);
  p.CNT = (unsigned*)take((2 * 48 * 64 + 64) * 4);
  p.SSQ = (float*)take((size_t)2 * NROW * 8 * 4);
  p.MOD = (float*)take(2 * 3 * 3072 * 4);
  p.LAMV = (float*)take(256);
  p.ROPE32 = (float2*)take(1024 * 16 * 8);
  p.ROPE64 = (float2*)take(1024 * 32 * 8);
  p.WinE = (bf16_t*)take((size_t)EIN_PAD * 1024 * 2);
  p.WinO = (bf16_t*)take((size_t)OIN_PAD * 1024 * 2);
  p.Wuq = (bf16_t*)take(768 * 384 * 2);
  p.Wukv = (bf16_t*)take(1024 * 256 * 2);
  p.WoutE = (bf16_t*)take(1024 * 1024 * 2);
  p.WoutO = (bf16_t*)take(1024 * 1024 * 2);
  p.H = (bf16_t*)take((size_t)NROW * 1024 * 2);
  p.O = (bf16_t*)take((size_t)NROW * 1024 * 2);
  p.X1 = (float*)take(256);
  p.X1B = (bf16_t*)take((size_t)NROW * 1024 * 2);
  p.SC = (float*)take(768 * 4 * 4);
  p.SCM = (float*)take(768 * 4);
  p.UC = (bf16_t*)take((size_t)768 * 16384 * 2);
  p.NU = (float*)take(768 * 128 * 4);
  p.NST = (float*)take(768 * 128 * 4);
  p.OP = (bf16_t*)take((size_t)128 * 2 * 2 * 4 * 8 * 64 * 8);
  p.ML = (float*)take((size_t)128 * 2 * 2 * 4 * 64 * 8);
  p.CST = (bf16_t*)take((size_t)768 * 16384 * 2);
  const size_t region = off;
  p.U0 = (bf16_t*)take((size_t)NROW * EIN * 2);
  p.CQN = (bf16_t*)take((size_t)NROW * 384 * 2);
  p.CKVN = (bf16_t*)take((size_t)NTROW * 256 * 2);
  p.KR = (bf16_t*)take((size_t)NTROW * 32 * 2);
  p.QB = (bf16_t*)take((size_t)NROW * 512 * 2);
  p.KB = (bf16_t*)take((size_t)NTROW * 128 * 2);
  p.VB = (bf16_t*)take((size_t)NTROW * 128 * 2);
  p.Q = (bf16_t*)take((size_t)NROW * 768 * 2);
  p.KV = (bf16_t*)take((size_t)NTROW * 1024 * 2);
  const size_t end0 = off;
  off = region;
  p.U1 = (bf16_t*)take((size_t)NROW * OIN * 2);
  p.QD = (bf16_t*)take((size_t)NROW * 512 * 2);
  p.KD = (bf16_t*)take((size_t)NTROW * 512 * 2);
  p.VD = (bf16_t*)take((size_t)NTROW * 512 * 2);
  const size_t end1 = off;
  const size_t need = end0 > end1 ? end0 : end1;
  if (need > ws_size) { fprintf(stderr, "workspace too small: need %zu have %zu\n", need, ws_size); return; }

#if SINGLE_LAUNCH
  static int grid_blocks = 0;
  if (!grid_blocks) {
    int dev = 0, cus = 0, per_cu = 0;
    hipGetDevice(&dev);
    hipDeviceGetAttribute(&cus, hipDeviceAttributeMultiprocessorCount, dev);
    hipFuncSetAttribute((const void*)mk_fwd, hipFuncAttributeMaxDynamicSharedMemorySize, LDS_BYTES);
    hipOccupancyMaxActiveBlocksPerMultiprocessor(&per_cu, mk_fwd, 512, LDS_BYTES);
    if (per_cu < 1) per_cu = 1;
    grid_blocks = cus;
  }
  p.phase_lo = 0; p.phase_hi = NPHASE;
  hipMemsetAsync(p.BAR, 0, (size_t)((char*)(p.CNT + 2 * 48 * 64 + 64) - (char*)p.BAR), stream);
  void* args[] = {&p};
  hipError_t e = hipLaunchCooperativeKernel((void*)mk_fwd, dim3(grid_blocks), dim3(512), args, LDS_BYTES, stream);
  if (e != hipSuccess) fprintf(stderr, "cooperative launch failed: %s (grid %d)\n", hipGetErrorString(e), grid_blocks);
#else
  launch_phases<0>(p, stream);
#endif
}
```

```cpp
#include <hip/hip_runtime.h>
#include <hip/hip_cooperative_groups.h>
#include <cstdio>
namespace cg = cooperative_groups;

typedef unsigned short bf16_t;
using bf16x8 = __attribute__((ext_vector_type(8))) short;
using bf16x4 = __attribute__((ext_vector_type(4))) short;
using f32x4  = __attribute__((ext_vector_type(4))) float;
using u32x4  = __attribute__((ext_vector_type(4))) unsigned;
#define DI __device__ __forceinline__
#define MFMA16(a, b, c) __builtin_amdgcn_mfma_f32_16x16x32_bf16((a), (b), (c), 0, 0, 0)

#ifndef SINGLE_LAUNCH
#define SINGLE_LAUNCH 1
#endif

__device__ __forceinline__ unsigned ltid() { unsigned t = threadIdx.x; asm volatile("" : "+v"(t)); return t; }
#define TIDX ((int)(ltid() & 255u))
#define VBLK ((int)(blockIdx.x * 2 + (ltid() >> 8)))
#define NVBLK ((int)(gridDim.x * 2))
DI int vblk_xcd() {
  const int b = blockIdx.x, nb = gridDim.x;
  if (nb & 7) return VBLK;
  return ((b & 7) * (nb >> 3) + (b >> 3)) * 2 + (int)(ltid() >> 8);
}
constexpr int EIN = 2464, OIN = 4624;
constexpr int EIN_PAD = 2560, OIN_PAD = 4864;
constexpr int NROW = 6144, NTROW = 6656;
constexpr int NPHASE = 14;
constexpr int LDS_BYTES = 139264;
constexpr int GRP_LDS = 69632;
constexpr int LDT = 72;
constexpr float EPSF = 1e-6f;
constexpr float LAM_INIT = 0.35550906759097f;
constexpr size_t O_Y = 0, O_CKV = 6291456, O_KR = 7340032, O_GK = 7471104, O_GV = 7995392, O_C = 8519680,
                 O_N = 10616832, O_M = 10633216, O_DK = 10633344, O_DV = 12730496;

struct Params {
  const float *x_prompt, *x_sample, *cache_ckv, *cache_kr, *cache_gk, *cache_gv, *st_C, *st_n, *st_m, *cache_dk, *cache_dv, *c, *c_ctx;
  const float *e_norm_g, *e_ada_w, *e_ada_b, *e_w_in, *e_qn_g, *e_w_uq, *e_kvn_g, *e_w_ukv, *e_gq_g, *e_gk_g, *e_w_out;
  const float *o_norm_g, *o_ada_w, *o_ada_b, *o_w_in, *o_gate_b, *o_mnorm_g, *o_lam, *o_dnorm_g, *o_w_out, *final_g;
  float* out;
  float *MOD, *LAMV;
  float2 *ROPE32, *ROPE64;
  bf16_t *WinE, *WinO, *Wuq, *Wukv, *WoutE, *WoutO;
  bf16_t *H, *U0, *U1, *CQN, *CKVN, *KR, *QB, *KB, *VB, *Q, *KV, *O, *QD, *KD, *VD, *CST;
  float *X1, *SC, *NU, *NST, *ML, *SCM;
  bf16_t *X1B, *UC, *OP;
  unsigned* BAR;
  unsigned* CNT;
  float* SSQ;
  int phase_lo, phase_hi;
};

DI bf16_t f2bf(float x) { unsigned u = __float_as_uint(x); u += 0x7fffu + ((u >> 16) & 1u); return (bf16_t)(u >> 16); }
DI float bf2f(bf16_t b) { return __uint_as_float(((unsigned)b) << 16); }
typedef __bf16 bf2_t __attribute__((ext_vector_type(2)));
typedef float f2_t __attribute__((ext_vector_type(2)));
DI unsigned pack2(float a, float b) { f2_t v = {a, b}; return __builtin_bit_cast(unsigned, __builtin_convertvector(v, bf2_t)); }
DI float lo2f(unsigned w) { return __uint_as_float(w << 16); }
DI float hi2f(unsigned w) { return __uint_as_float(w & 0xffff0000u); }
DI float xsum_16_32(float x) {
  auto a = __builtin_amdgcn_permlane16_swap(__float_as_uint(x), __float_as_uint(x), false, false);
  const float s = __uint_as_float(a[0]) + __uint_as_float(a[1]);
  auto b = __builtin_amdgcn_permlane32_swap(__float_as_uint(s), __float_as_uint(s), false, false);
  return __uint_as_float(b[0]) + __uint_as_float(b[1]);
}
DI float xmax_16_32(float x) {
  auto a = __builtin_amdgcn_permlane16_swap(__float_as_uint(x), __float_as_uint(x), false, false);
  const float s = fmaxf(__uint_as_float(a[0]), __uint_as_float(a[1]));
  auto b = __builtin_amdgcn_permlane32_swap(__float_as_uint(s), __float_as_uint(s), false, false);
  return fmaxf(__uint_as_float(b[0]), __uint_as_float(b[1]));
}
#define DPPF(v, CTRL) __uint_as_float((unsigned)__builtin_amdgcn_mov_dpp((int)__float_as_uint(v), (CTRL), 0xF, 0xF, true))
DI float wave_sum(float v) {
  v += DPPF(v, 0xB1); v += DPPF(v, 0x4E); v += DPPF(v, 0x141); v += DPPF(v, 0x140);
  return xsum_16_32(v);
}
DI float wave_max(float v) {
  v = fmaxf(v, DPPF(v, 0xB1)); v = fmaxf(v, DPPF(v, 0x4E)); v = fmaxf(v, DPPF(v, 0x141)); v = fmaxf(v, DPPF(v, 0x140));
  return xmax_16_32(v);
}
DI float scan_add(float v, int lane) { for (int d = 1; d < 64; d <<= 1) { float t = __shfl_up(v, d); if (lane >= d) v += t; } return v; }
DI float scan_max(float v, int lane) { for (int d = 1; d < 64; d <<= 1) { float t = __shfl_up(v, d); if (lane >= d) v = fmaxf(v, t); } return v; }
DI float fexp(float x) { return __builtin_amdgcn_exp2f(x * 1.4426950408889634f); }
DI float logsig(float x) { return fminf(x, 0.f) - log1pf(fexp(-fabsf(x))); }
DI float siluf(float x) { return x * __builtin_amdgcn_rcpf(1.f + fexp(-x)); }
DI float sigmf(float x) { return __builtin_amdgcn_rcpf(1.f + fexp(-x)); }
DI int cv_of_row(int row) { return row < 4096 ? 0 : 1 + ((row - 4096) >> 10); }
DI const float* xrow(const Params& p, int row) { return row < 4096 ? p.x_prompt + (size_t)row * 1024 : p.x_sample + (size_t)(row - 4096) * 1024; }

template <class Epi>
DI void gemm_tile(const bf16_t* __restrict__ X, int ldx, const bf16_t* __restrict__ W, int ldw, int N, int K, int m0, int n0, char* smem, Epi epi) {
  constexpr int LDG = 32;
  constexpr int BUFE = 256 * LDG;
  bf16_t* sb = (bf16_t*)smem;
  const int tid = TIDX, lane = tid & 63, wave = tid >> 6, wm = wave >> 1, wn = wave & 1;
  const int g = lane >> 4, l16 = lane & 15;
  f32x4 acc[4][4];
#pragma unroll
  for (int a = 0; a < 4; ++a)
#pragma unroll
    for (int b = 0; b < 4; ++b) acc[a][b] = f32x4{0.f, 0.f, 0.f, 0.f};
  const int lr = tid >> 2, lc = (tid & 3) * 8;
  const int lcs = ((tid & 3) ^ ((4 - ((lr >> 2) & 3)) & 3)) * 8;
  const int gs = (g ^ ((4 - (l16 >> 2)) & 3)) * 8;
  unsigned xoff[2], woff[2];
#pragma unroll
  for (int i = 0; i < 2; ++i) {
    xoff[i] = (unsigned)((m0 + lr + 64 * i) * ldx + lc);
    int n = n0 + lr + 64 * i; if (n > N - 1) n = N - 1;
    woff[i] = (unsigned)(n * ldw + lc);
  }
  const int nk = K >> 5;
  u32x4 rx[3][2], rw[3][2];
#define G_LOAD(S, KT) { const bf16_t* xb_ = X + (KT) * 32; const bf16_t* wb_ = W + (KT) * 32; \
    rx[S][0] = *(const u32x4*)(xb_ + xoff[0]); rx[S][1] = *(const u32x4*)(xb_ + xoff[1]); \
    rw[S][0] = *(const u32x4*)(wb_ + woff[0]); rw[S][1] = *(const u32x4*)(wb_ + woff[1]); }
#define G_STORE(S, B) { bf16_t* d_ = sb + (B) * BUFE + lr * LDG + lcs; \
    *(u32x4*)(d_) = rx[S][0]; *(u32x4*)(d_ + 64 * LDG) = rx[S][1]; \
    *(u32x4*)(d_ + 128 * LDG) = rw[S][0]; *(u32x4*)(d_ + 192 * LDG) = rw[S][1]; }
#define G_COMPUTE(B) { const bf16_t* bx_ = sb + (B) * BUFE; const bf16_t* bw_ = bx_ + 128 * LDG; \
    bf16x8 wf[4], xf[4]; \
    _Pragma("unroll") for (int i = 0; i < 4; ++i) { \
      wf[i] = *(const bf16x8*)(bw_ + (wn * 64 + i * 16 + l16) * LDG + gs); \
      xf[i] = *(const bf16x8*)(bx_ + (wm * 64 + i * 16 + l16) * LDG + gs); } \
    _Pragma("unroll") for (int ni = 0; ni < 4; ++ni) \
      _Pragma("unroll") for (int mi = 0; mi < 4; ++mi) acc[ni][mi] = MFMA16(wf[ni], xf[mi], acc[ni][mi]); }
#define G_STEP(KK, RL, RS) if ((KK) < nk) { \
    if ((KK) + 1 < nk) G_STORE(RS, ((KK) + 1) & 1) \
    if ((KK) + 3 < nk) G_LOAD(RL, (KK) + 3) \
    G_COMPUTE((KK) & 1) \
    __syncthreads(); }
  G_LOAD(0, 0) G_LOAD(1, 1) G_LOAD(2, 2)
  __syncthreads();
  G_STORE(0, 0)
  __syncthreads();
  for (int k0 = 0; k0 < nk; k0 += 3) {
    G_STEP(k0, 0, 1)
    G_STEP(k0 + 1, 1, 2)
    G_STEP(k0 + 2, 2, 0)
  }
#undef G_LOAD
#undef G_STORE
#undef G_COMPUTE
#undef G_STEP
#pragma unroll
  for (int ni = 0; ni < 4; ++ni) {
    const int n = n0 + wn * 64 + ni * 16 + g * 4;
    if (n < N) {
#pragma unroll
      for (int mi = 0; mi < 4; ++mi) epi(m0 + wm * 64 + mi * 16 + l16, n, acc[ni][mi]);
    }
  }
}

template <class Epi>
DI void gemm_tile64(const bf16_t* __restrict__ X, int ldx, const bf16_t* __restrict__ W, int ldw, int N, int K, int m0, int n0, char* smem, Epi epi) {
  constexpr int PANE = 256 * 32;
  constexpr int BUFE = 2 * PANE;
  bf16_t* sb = (bf16_t*)smem;
  const int tid = TIDX, lane = tid & 63, wave = tid >> 6, wm = wave >> 1, wn = wave & 1;
  const int g = lane >> 4, l16 = lane & 15;
  f32x4 acc[4][4];
#pragma unroll
  for (int a = 0; a < 4; ++a)
#pragma unroll
    for (int b = 0; b < 4; ++b) acc[a][b] = f32x4{0.f, 0.f, 0.f, 0.f};
  const int lr = tid >> 3, ch = tid & 7;
  const int soff = (ch >> 2) * PANE + lr * 32 + (((ch & 3) ^ ((4 - ((lr >> 2) & 3)) & 3)) * 8);
  const int gs = (g ^ ((4 - (l16 >> 2)) & 3)) * 8;
  unsigned xoff[4], woff[4];
#pragma unroll
  for (int i = 0; i < 4; ++i) {
    xoff[i] = (unsigned)((m0 + lr + 32 * i) * ldx + ch * 8);
    int n = n0 + lr + 32 * i; if (n > N - 1) n = N - 1;
    woff[i] = (unsigned)(n * ldw + ch * 8);
  }
  const int nk = K >> 6;
  u32x4 rx[2][4], rw[2][4];
#define H_LOAD(S, KT) { const bf16_t* xb_ = X + (KT) * 64; const bf16_t* wb_ = W + (KT) * 64; \
    _Pragma("unroll") for (int i = 0; i < 4; ++i) { rx[S][i] = *(const u32x4*)(xb_ + xoff[i]); rw[S][i] = *(const u32x4*)(wb_ + woff[i]); } }
#define H_STORE(S, B) { bf16_t* d_ = sb + (B) * BUFE + soff; \
    _Pragma("unroll") for (int i = 0; i < 4; ++i) { *(u32x4*)(d_ + (32 * i) * 32) = rx[S][i]; *(u32x4*)(d_ + (128 + 32 * i) * 32) = rw[S][i]; } }
#define H_COMPUTE(B) { _Pragma("unroll") for (int ks = 0; ks < 2; ++ks) { const bf16_t* bx_ = sb + (B) * BUFE + ks * PANE; const bf16_t* bw_ = bx_ + 128 * 32; \
    bf16x8 wf[4], xf[4]; \
    _Pragma("unroll") for (int i = 0; i < 4; ++i) { \
      wf[i] = *(const bf16x8*)(bw_ + (wn * 64 + i * 16 + l16) * 32 + gs); \
      xf[i] = *(const bf16x8*)(bx_ + (wm * 64 + i * 16 + l16) * 32 + gs); } \
    _Pragma("unroll") for (int ni = 0; ni < 4; ++ni) \
      _Pragma("unroll") for (int mi = 0; mi < 4; ++mi) acc[ni][mi] = MFMA16(wf[ni], xf[mi], acc[ni][mi]); } }
#define H_STEP(KK, SL) if ((KK) < nk) { \
    if ((KK) + 1 < nk) H_STORE((SL) ^ 1, ((KK) + 1) & 1) \
    if ((KK) + 2 < nk) H_LOAD(SL, (KK) + 2) \
    H_COMPUTE((KK) & 1) \
    __syncthreads(); }
  H_LOAD(0, 0)
  if (nk > 1) H_LOAD(1, 1)
  __syncthreads();
  H_STORE(0, 0)
  __syncthreads();
  for (int k0 = 0; k0 < nk; k0 += 2) {
    H_STEP(k0, 0)
    H_STEP(k0 + 1, 1)
  }
#undef H_LOAD
#undef H_STORE
#undef H_COMPUTE
#undef H_STEP
#pragma unroll
  for (int ni = 0; ni < 4; ++ni) {
    const int n = n0 + wn * 64 + ni * 16 + g * 4;
    if (n < N) {
#pragma unroll
      for (int mi = 0; mi < 4; ++mi) epi(m0 + wm * 64 + mi * 16 + l16, n, acc[ni][mi]);
    }
  }
}

DI void gemm_tile64_acc(const bf16_t* __restrict__ X, int ldx, const bf16_t* __restrict__ W, int ldw, int N, int K, int m0, int n0, char* smem, f32x4 (&acc)[4][4]) {
  constexpr int PANE = 256 * 32;
  constexpr int BUFE = 2 * PANE;
  bf16_t* sb = (bf16_t*)smem;
  const int tid = TIDX, lane = tid & 63, wave = tid >> 6, wm = wave >> 1, wn = wave & 1;
  const int g = lane >> 4, l16 = lane & 15;
#pragma unroll
  for (int a = 0; a < 4; ++a)
#pragma unroll
    for (int b = 0; b < 4; ++b) acc[a][b] = f32x4{0.f, 0.f, 0.f, 0.f};
  const int lr = tid >> 3, ch = tid & 7;
  const int soff = (ch >> 2) * PANE + lr * 32 + (((ch & 3) ^ ((4 - ((lr >> 2) & 3)) & 3)) * 8);
  const int gs = (g ^ ((4 - (l16 >> 2)) & 3)) * 8;
  unsigned xoff[4], woff[4];
#pragma unroll
  for (int i = 0; i < 4; ++i) {
    xoff[i] = (unsigned)((m0 + lr + 32 * i) * ldx + ch * 8);
    int n = n0 + lr + 32 * i; if (n > N - 1) n = N - 1;
    woff[i] = (unsigned)(n * ldw + ch * 8);
  }
  const int nk = K >> 6;
  u32x4 rx[2][4], rw[2][4];
#define H_LOAD(S, KT) { const bf16_t* xb_ = X + (KT) * 64; const bf16_t* wb_ = W + (KT) * 64; \
    _Pragma("unroll") for (int i = 0; i < 4; ++i) { rx[S][i] = *(const u32x4*)(xb_ + xoff[i]); rw[S][i] = *(const u32x4*)(wb_ + woff[i]); } }
#define H_STORE(S, B) { bf16_t* d_ = sb + (B) * BUFE + soff; \
    _Pragma("unroll") for (int i = 0; i < 4; ++i) { *(u32x4*)(d_ + (32 * i) * 32) = rx[S][i]; *(u32x4*)(d_ + (128 + 32 * i) * 32) = rw[S][i]; } }
#define H_COMPUTE(B) { _Pragma("unroll") for (int ks = 0; ks < 2; ++ks) { const bf16_t* bx_ = sb + (B) * BUFE + ks * PANE; const bf16_t* bw_ = bx_ + 128 * 32; \
    bf16x8 wf[4], xf[4]; \
    _Pragma("unroll") for (int i = 0; i < 4; ++i) { \
      wf[i] = *(const bf16x8*)(bw_ + (wn * 64 + i * 16 + l16) * 32 + gs); \
      xf[i] = *(const bf16x8*)(bx_ + (wm * 64 + i * 16 + l16) * 32 + gs); } \
    _Pragma("unroll") for (int ni = 0; ni < 4; ++ni) \
      _Pragma("unroll") for (int mi = 0; mi < 4; ++mi) acc[ni][mi] = MFMA16(wf[ni], xf[mi], acc[ni][mi]); } }
#define H_STEP(KK, SL) if ((KK) < nk) { \
    if ((KK) + 1 < nk) H_STORE((SL) ^ 1, ((KK) + 1) & 1) \
    if ((KK) + 2 < nk) H_LOAD(SL, (KK) + 2) \
    H_COMPUTE((KK) & 1) \
    __syncthreads(); }
  H_LOAD(0, 0)
  if (nk > 1) H_LOAD(1, 1)
  __syncthreads();
  H_STORE(0, 0)
  __syncthreads();
  for (int k0 = 0; k0 < nk; k0 += 2) {
    H_STEP(k0, 0)
    H_STEP(k0 + 1, 1)
  }
#undef H_LOAD
#undef H_STORE
#undef H_COMPUTE
#undef H_STEP
}

template <class Epi>
DI void gemm256(const bf16_t* __restrict__ X, int ldx, const bf16_t* __restrict__ W, int ldw, int N, int K, int m0, int n0, char* smem, Epi epi) {
  constexpr int LDG = 32;
  constexpr int BUFE = 512 * LDG;
  bf16_t* sb = (bf16_t*)smem;
  const int tid = (int)ltid(), lane = tid & 63, wave = tid >> 6, wm = wave >> 2, wn = wave & 3;
  const int g = lane >> 4, l16 = lane & 15;
  f32x4 acc[4][8];
#pragma unroll
  for (int a = 0; a < 4; ++a)
#pragma unroll
    for (int b = 0; b < 8; ++b) acc[a][b] = f32x4{0.f, 0.f, 0.f, 0.f};
  const int lr = tid >> 2, lc = (tid & 3) * 8;
  const int lcs = ((tid & 3) ^ ((4 - ((lr >> 2) & 3)) & 3)) * 8;
  const int gs = (g ^ ((4 - (l16 >> 2)) & 3)) * 8;
  unsigned xoff[2], woff[2];
#pragma unroll
  for (int i = 0; i < 2; ++i) {
    xoff[i] = (unsigned)((m0 + lr + 128 * i) * ldx + lc);
    int n = n0 + lr + 128 * i; if (n > N - 1) n = N - 1;
    woff[i] = (unsigned)(n * ldw + lc);
  }
  const int nk = K >> 5;
  u32x4 rx[3][2], rw[3][2];
#define G_LOAD(S, KT) { const bf16_t* xb_ = X + (KT) * 32; const bf16_t* wb_ = W + (KT) * 32; \
    rx[S][0] = *(const u32x4*)(xb_ + xoff[0]); rx[S][1] = *(const u32x4*)(xb_ + xoff[1]); \
    rw[S][0] = *(const u32x4*)(wb_ + woff[0]); rw[S][1] = *(const u32x4*)(wb_ + woff[1]); }
#define G_STORE(S, B) { bf16_t* d_ = sb + (B) * BUFE + lr * LDG + lcs; \
    *(u32x4*)(d_) = rx[S][0]; *(u32x4*)(d_ + 128 * LDG) = rx[S][1]; \
    *(u32x4*)(d_ + 256 * LDG) = rw[S][0]; *(u32x4*)(d_ + 384 * LDG) = rw[S][1]; }
#define G_COMPUTE(B) { const bf16_t* bx_ = sb + (B) * BUFE; const bf16_t* bw_ = bx_ + 256 * LDG; \
    bf16x8 wf[4], xf[8]; \
    _Pragma("unroll") for (int i = 0; i < 4; ++i) wf[i] = *(const bf16x8*)(bw_ + (wn * 64 + i * 16 + l16) * LDG + gs); \
    _Pragma("unroll") for (int i = 0; i < 8; ++i) xf[i] = *(const bf16x8*)(bx_ + (wm * 128 + i * 16 + l16) * LDG + gs); \
    _Pragma("unroll") for (int ni = 0; ni < 4; ++ni) \
      _Pragma("unroll") for (int mi = 0; mi < 8; ++mi) acc[ni][mi] = MFMA16(wf[ni], xf[mi], acc[ni][mi]); }
#define G_STEP(KK, RL, RS) if ((KK) < nk) { \
    if ((KK) + 1 < nk) G_STORE(RS, ((KK) + 1) & 1) \
    if ((KK) + 3 < nk) G_LOAD(RL, (KK) + 3) \
    G_COMPUTE((KK) & 1) \
    __syncthreads(); }
  G_LOAD(0, 0) G_LOAD(1, 1) G_LOAD(2, 2)
  __syncthreads();
  G_STORE(0, 0)
  __syncthreads();
  for (int k0 = 0; k0 < nk; k0 += 3) {
    G_STEP(k0, 0, 1)
    G_STEP(k0 + 1, 1, 2)
    G_STEP(k0 + 2, 2, 0)
  }
#undef G_LOAD
#undef G_STORE
#undef G_COMPUTE
#undef G_STEP
#pragma unroll
  for (int ni = 0; ni < 4; ++ni) {
    const int n = n0 + wn * 64 + ni * 16 + g * 4;
    if (n < N) {
#pragma unroll
      for (int mi = 0; mi < 8; ++mi) epi(m0 + wm * 128 + mi * 16 + l16, n, acc[ni][mi]);
    }
  }
}

namespace pg8 {
#define PG8_LAS __attribute__((address_space(3)))
typedef unsigned short bf16_t;
typedef short bf16x8 __attribute__((ext_vector_type(8)));
typedef float f32x4 __attribute__((ext_vector_type(4)));
typedef unsigned u32x4 __attribute__((ext_vector_type(4)));
constexpr int BM = 256, BK = 64, HALF = 128, HTB = HALF * BK * 2  , STAGE_BYTES = 8 * HTB, NXCD = 8, WGM = 8;

__host__ __device__ __forceinline__ int lds_byte(int r, int c) { const int st = (r >> 4) * 2 + (c >> 5), rr = r & 15, cc = c & 31, ob = rr * 64 + cc * 2; return st * 1024 + (ob ^ (((ob >> 9) & 1) << 5)); }
__host__ __device__ __forceinline__ void stage_rc(int b, int& R, int& C) { const int st = b / 1024, sb = b % 1024, swz = sb ^ (((sb >> 9) & 1) << 5); R = (st >> 1) * 16 + swz / 64; C = (st & 1) * 32 + (swz % 64) / 2; }
__host__ __device__ __forceinline__ int perm32(int rho) { const int n = rho >> 4, i = rho & 15; return 8 * (i >> 2) + 4 * n + (i & 3); }

struct Unit { int pm, pn; };
struct Gemm { const bf16_t* A; const bf16_t* Bt; int M, N, K; };

struct StaticOrder {
    int nM, nN, nwg, G, c;
    __host__ __device__ void init(int M, int N, int G_, int c_) { nM = M / BM; nN = N / BM; nwg = nM * nN; G = G_; c = c_; }
    __host__ __device__ bool next(int i, Unit& u) const {
        const long L = (long)i * G + c; if (L >= nwg) return false;
        int wgid = (int)L; { const int q = nwg / NXCD, r = nwg % NXCD, xcd = wgid % NXCD, off = wgid / NXCD; wgid = (xcd < r ? xcd * (q + 1) : r * (q + 1) + (xcd - r) * q) + off; }
        const int nig = WGM * nN, gid = wgid / nig, fm = gid * WGM, gsz = (nM - fm) < WGM ? (nM - fm) : WGM;
        u.pm = fm + ((wgid % nig) % gsz); u.pn = (wgid % nig) / gsz; return true;
    }
    __device__ __forceinline__ void a_ready(const Unit&) const {}
    __device__ __forceinline__ void done(const Unit&) const {}
};
__device__ __forceinline__ unsigned cvt_pk_bf16(float lo, float hi) { unsigned r; asm volatile("v_cvt_pk_bf16_f32 %0, %1, %2" : "=v"(r) : "v"(lo), "v"(hi)); return r; }
template <class Epi, class Sched, bool STAMP = false>
__device__ __forceinline__ void gemm_phase(PG8_LAS unsigned char* lds, const Gemm g, const Sched& S, const Epi& E, unsigned long long* stamps) {
    const int tid = (int)ltid(), wid = __builtin_amdgcn_readfirstlane(tid >> 6), lane = tid & 63, wr = wid >> 2, wc = wid & 3, fr = lane & 15, fq = lane >> 4;
    const int K = g.K, nt = K / BK;
    int ts_lo = 0, ts_hi = 0, nts = 0; const unsigned long long rt_entry = STAMP ? (unsigned long long)wall_clock64() : 0ull;
#define PG8_STAMP() do { if (STAMP && wid == 0 && nts < 64) { const unsigned long long _c = (unsigned long long)clock64(); \
        ts_lo = (lane == nts) ? (int)(unsigned)_c : ts_lo; ts_hi = (lane == nts) ? (int)(unsigned)(_c >> 32) : ts_hi; ++nts; } } while (0)
    PG8_STAMP();
    unsigned voffA[2], voffB[2];
#pragma unroll
    for (int i = 0; i < 2; ++i) { int R, C; stage_rc(tid * 16 + i * 8192, R, C); const int Rb = Epi::PERM ? ((R & ~31) + perm32(R & 31)) : R;
        voffA[i] = (unsigned)(R * K + C) * 2u; voffB[i] = (unsigned)(Rb * K + C) * 2u; }
    const size_t kstep = (size_t)(BK * 2);
    const size_t hstep = (size_t)HALF * K * 2;
    const size_t tstep = 2 * hstep;
    const unsigned ldsw = (unsigned)wid * 1024u;
    const int aoff = lds_byte(wr * 64 + fr, fq * 8), boff = lds_byte(wc * 32 + fr, fq * 8);
#define PG8_SA(b, h) (((b) * 2 + (h)) * HTB)
#define PG8_SB(b, h) ((4 + (b) * 2 + (h)) * HTB)
#define PG8_STAGE(bufoff, gbase, voff) do { _Pragma("unroll") for (int _i = 0; _i < 2; ++_i) \
        __builtin_amdgcn_global_load_lds((const unsigned*)((const char*)(gbase) + (voff)[_i]), (PG8_LAS unsigned*)(lds + (bufoff) + ldsw + _i * 8192), 16, 0, 0); } while (0)
#define PG8_LDA(dst, b, h) do { _Pragma("unroll") for (int m = 0; m < 4; ++m) _Pragma("unroll") for (int k = 0; k < 2; ++k) dst[m][k] = *(const PG8_LAS bf16x8*)(lds + PG8_SA(b, h) + aoff + m * 2048 + k * 1024); } while (0)
#define PG8_LDB(dst, b, h) do { _Pragma("unroll") for (int n = 0; n < 2; ++n) _Pragma("unroll") for (int k = 0; k < 2; ++k) dst[n][k] = *(const PG8_LAS bf16x8*)(lds + PG8_SB(b, h) + boff + n * 2048 + k * 1024); } while (0)
#define PG8_MMA(ai, bj, At, Bt) do { __builtin_amdgcn_s_setprio(1); _Pragma("unroll") for (int m = 0; m < 4; ++m) _Pragma("unroll") for (int n = 0; n < 2; ++n) _Pragma("unroll") for (int k = 0; k < 2; ++k) \
        acc[ai][bj][m][n] = __builtin_amdgcn_mfma_f32_16x16x32_bf16(Bt[n][k], At[m][k], acc[ai][bj][m][n], 0, 0, 0); __builtin_amdgcn_s_setprio(0); } while (0)
#define PG8_WAIT_V(n) asm volatile("s_waitcnt vmcnt(" #n ")" ::: "memory")
#define PG8_WAIT_L(n) asm volatile("s_waitcnt lgkmcnt(" #n ")" ::: "memory")
#define PG8_BAR __builtin_amdgcn_s_barrier()
#define PG8_SCHED __builtin_amdgcn_sched_barrier(0)
    Unit cur, nxt; int ui = 0;
    if (!S.next(0, cur)) return;
    f32x4 acc[2][2][4][2];
#pragma unroll
    for (int a = 0; a < 2; ++a)
#pragma unroll
        for (int b = 0; b < 2; ++b)
#pragma unroll
            for (int m = 0; m < 4; ++m)
#pragma unroll
                for (int n = 0; n < 2; ++n) acc[a][b][m][n] = (f32x4){0.f, 0.f, 0.f, 0.f};
    bf16x8 At[4][2], B0[2][2], B1[2][2];
    const char* cA = (const char*)g.A + (size_t)cur.pm * tstep; const char* cB = (const char*)g.Bt + (size_t)cur.pn * tstep;
    S.a_ready(cur);
    PG8_STAGE(PG8_SB(0, 0), cB, voffB); PG8_STAGE(PG8_SA(0, 0), cA, voffA); PG8_STAGE(PG8_SB(0, 1), cB + hstep, voffB); PG8_STAGE(PG8_SA(0, 1), cA + hstep, voffA);
    if (wr == 1) PG8_BAR;
    PG8_WAIT_V(4); PG8_BAR;
    PG8_STAGE(PG8_SB(1, 0), cB + kstep, voffB); PG8_STAGE(PG8_SA(1, 0), cA + kstep, voffA); PG8_STAGE(PG8_SB(1, 1), cB + hstep + kstep, voffB);
    PG8_WAIT_V(6); PG8_BAR;
    PG8_STAMP();
    for (;;) {
        const bool has_next = S.next(ui + 1, nxt);
        const char* nA = has_next ? (const char*)g.A + (size_t)nxt.pm * tstep : cA; const char* nB = has_next ? (const char*)g.Bt + (size_t)nxt.pn * tstep : cB;
        for (int t = 0; t < nt; t += 2) {
            const bool last = (t == nt - 2);
            const char* a1 = cA + (size_t)(t + 1) * kstep;
            const char* a2 = last ? nA : cA + (size_t)(t + 2) * kstep; const char* b2 = last ? nB : cB + (size_t)(t + 2) * kstep;
            const char* a3 = a2 + kstep; const char* b3 = b2 + kstep;
            if (last && has_next) S.a_ready(nxt);
            PG8_LDB(B0, 0, 0); PG8_SCHED; PG8_LDA(At, 0, 0); PG8_STAGE(PG8_SA(1, 1), a1 + hstep, voffA);
            PG8_WAIT_L(8); PG8_BAR; PG8_WAIT_L(0); PG8_MMA(0, 0, At, B0); PG8_BAR; PG8_SCHED;
            PG8_LDB(B1, 0, 1); PG8_STAGE(PG8_SB(0, 0), b2, voffB);
            PG8_BAR; PG8_WAIT_L(0); PG8_MMA(0, 1, At, B1); PG8_BAR;
            PG8_LDA(At, 0, 1); PG8_STAGE(PG8_SA(0, 0), a2, voffA);
            PG8_BAR; PG8_WAIT_L(0); PG8_MMA(1, 0, At, B0); PG8_BAR; PG8_SCHED;
            PG8_STAGE(PG8_SB(0, 1), b2 + hstep, voffB);
            PG8_WAIT_V(6); PG8_BAR; PG8_MMA(1, 1, At, B1); PG8_BAR;
            PG8_LDB(B0, 1, 0); PG8_SCHED; PG8_LDA(At, 1, 0); PG8_STAGE(PG8_SA(0, 1), a2 + hstep, voffA);
            PG8_WAIT_L(8); PG8_BAR; PG8_WAIT_L(0); PG8_MMA(0, 0, At, B0); PG8_BAR; PG8_SCHED;
            PG8_LDB(B1, 1, 1); PG8_STAGE(PG8_SB(1, 0), b3, voffB);
            PG8_BAR; PG8_WAIT_L(0); PG8_MMA(0, 1, At, B1); PG8_BAR;
            PG8_LDA(At, 1, 1); PG8_STAGE(PG8_SA(1, 0), a3, voffA);
            PG8_BAR; PG8_WAIT_L(0); PG8_MMA(1, 0, At, B0); PG8_BAR; PG8_SCHED;
            PG8_STAGE(PG8_SB(1, 1), b3 + hstep, voffB);
            PG8_WAIT_V(6); PG8_BAR; PG8_MMA(1, 1, At, B1); PG8_BAR;
        }
        PG8_STAMP();
        if constexpr (!Epi::AFTER_DRAIN) { E(acc, cur, wr, wc, fr, fq); S.done(cur); }
        PG8_STAMP();
        if (!has_next) break;
#pragma unroll
        for (int a = 0; a < 2; ++a)
#pragma unroll
            for (int b = 0; b < 2; ++b)
#pragma unroll
                for (int m = 0; m < 4; ++m)
#pragma unroll
                    for (int n = 0; n < 2; ++n) acc[a][b][m][n] = (f32x4){0.f, 0.f, 0.f, 0.f};
        cur = nxt; cA = nA; cB = nB; ++ui;
    }
    PG8_WAIT_V(0);
    if (wr == 0) PG8_BAR;
    PG8_BAR;
    if constexpr (Epi::AFTER_DRAIN) { E.fused(acc, cur, wr, wc, fr, fq, lds, wid, lane); S.done(cur); }
    PG8_STAMP();
    if (STAMP && wid == 0) { stamps[lane] = lane < nts ? (((unsigned long long)(unsigned)ts_hi << 32) | (unsigned)ts_lo) : 0ull;
        if (lane == 62) stamps[62] = rt_entry; if (lane == 63) stamps[63] = (unsigned long long)wall_clock64(); }
#undef PG8_STAMP
#undef PG8_SA
#undef PG8_SB
#undef PG8_STAGE
#undef PG8_LDA
#undef PG8_LDB
#undef PG8_MMA
#undef PG8_WAIT_V
#undef PG8_WAIT_L
#undef PG8_BAR
#undef PG8_SCHED
}
}

struct EpiU {
  static constexpr bool PERM = true, AFTER_DRAIN = false;
  bf16_t* U; int ldu; int nvalid;
  float* aux;
  __device__ __forceinline__ void operator()(const f32x4 (&acc)[2][2][4][2], const pg8::Unit& u, int wr, int wc, int fr, int fq) const {
    const int row0 = u.pm * 256 + wr * 64 + fr, col0 = u.pn * 256 + wc * 32 + 8 * fq;
#pragma unroll
    for (int ai = 0; ai < 2; ++ai)
#pragma unroll
      for (int m = 0; m < 4; ++m) {
        bf16_t* rowp = U + (size_t)(row0 + ai * 128 + m * 16) * ldu;
#pragma unroll
        for (int bj = 0; bj < 2; ++bj) {
          const int col = col0 + bj * 128;
          if (col < nvalid) {
            const f32x4 v0 = acc[ai][bj][m][0], v1 = acc[ai][bj][m][1];
            u32x4 w;
            w[0] = pack2(v0[0], v0[1]); w[1] = pack2(v0[2], v0[3]); w[2] = pack2(v1[0], v1[1]); w[3] = pack2(v1[2], v1[3]);
            *(u32x4*)(rowp + col) = w;
            if (aux && col >= 3088 && col < 4112 && (row0 + ai * 128 + m * 16) < 4096) {
              float* ap = aux + (size_t)((col - 3088) >> 9) * 2097152 + (size_t)(row0 + ai * 128 + m * 16) * 512 + ((col - 3088) & 511);
              *(f32x4*)ap = v0; *(f32x4*)(ap + 4) = v1;
            }
          }
        }
      }
  }
};


struct EpiOut {
  static constexpr bool PERM = true, AFTER_DRAIN = false;
  const float* MOD; const float* x_prompt; const float* x_sample; bf16_t* X1B; int layer;
  __device__ __forceinline__ void operator()(const f32x4 (&acc)[2][2][4][2], const pg8::Unit& u, int wr, int wc, int fr, int fq) const {
    const int row0 = u.pm * 256 + wr * 64 + fr, col0 = u.pn * 256 + wc * 32 + 8 * fq;
#pragma unroll
    for (int ai = 0; ai < 2; ++ai)
#pragma unroll
      for (int m = 0; m < 4; ++m) {
        const int row = row0 + ai * 128 + m * 16;
        const float* gp = MOD + (layer * 3 + (row < 4096 ? 0 : 1 + ((row - 4096) >> 10))) * 3072 + 2048;
        const float* xr = row < 4096 ? x_prompt + (size_t)row * 1024 : x_sample + (size_t)(row - 4096) * 1024;
        bf16_t* xb = X1B + (size_t)row * 1024;
#pragma unroll
        for (int bj = 0; bj < 2; ++bj) {
          const int col = col0 + bj * 128;
          const f32x4 v0 = acc[ai][bj][m][0], v1 = acc[ai][bj][m][1];
          const float4 g0 = *(const float4*)(gp + col), g1 = *(const float4*)(gp + col + 4);
          float4 x0, x1;
          if (layer) {
            const uint4 w = *(const uint4*)(xb + col);
            x0 = make_float4(__uint_as_float(w.x << 16), __uint_as_float(w.x & 0xffff0000u), __uint_as_float(w.y << 16), __uint_as_float(w.y & 0xffff0000u));
            x1 = make_float4(__uint_as_float(w.z << 16), __uint_as_float(w.z & 0xffff0000u), __uint_as_float(w.w << 16), __uint_as_float(w.w & 0xffff0000u));
          } else { x0 = *(const float4*)(xr + col); x1 = *(const float4*)(xr + col + 4); }
          u32x4 o;
          o[0] = pack2(x0.x + g0.x * v0[0], x0.y + g0.y * v0[1]); o[1] = pack2(x0.z + g0.z * v0[2], x0.w + g0.w * v0[3]);
          o[2] = pack2(x1.x + g1.x * v1[0], x1.y + g1.y * v1[1]); o[3] = pack2(x1.z + g1.z * v1[2], x1.w + g1.w * v1[3]);
          *(u32x4*)(xb + col) = o;
        }
        asm volatile("" ::: "memory");
      }
  }
};

template <int W>
DI void stage_rows64(bf16_t* dst, int ldd, int coff, const bf16_t* src, int lds) {
  for (int c = TIDX; c < 64 * (W / 8); c += 256) {
    const int r = c / (W / 8), cc = (c % (W / 8)) * 8;
    *(uint4*)(dst + r * ldd + coff + cc) = *(const uint4*)(src + (size_t)r * lds + cc);
  }
}
template <int W>
DI void stage_T64(bf16_t* dst, const bf16_t* src, int lds, const float* rscale) {
  for (int c = TIDX; c < 64 * (W / 8); c += 256) {
    const int r = c & 63, cc = (c >> 6) * 8;
    uint4 v = *(const uint4*)(src + (size_t)r * lds + cc);
    unsigned w[4] = {v.x, v.y, v.z, v.w};
    if (rscale) {
      const float s = rscale[r];
#pragma unroll
      for (int i = 0; i < 4; ++i) {
        const unsigned pw = pack2(lo2f(w[i]) * s, hi2f(w[i]) * s);
        dst[(cc + 2 * i) * LDT + r] = (bf16_t)(pw & 0xffffu);
        dst[(cc + 2 * i + 1) * LDT + r] = (bf16_t)(pw >> 16);
      }
    } else {
#pragma unroll
      for (int i = 0; i < 4; ++i) {
        dst[(cc + 2 * i) * LDT + r] = (bf16_t)(w[i] & 0xffffu);
        dst[(cc + 2 * i + 1) * LDT + r] = (bf16_t)(w[i] >> 16);
      }
    }
  }
}

template <int DK, int DV, bool DUAL>
DI void attn_core(char* smem, const bf16_t* Qp, int ldq, const bf16_t* K1, int ldk1, const bf16_t* K2, int ldk2,
                  const bf16_t* V, int ldv, int T, float scale_log2, f32x4 (&o)[DUAL ? 2 : 1][DV / 16], float (&lsum)[DUAL ? 2 : 1], float (&mrun)[DUAL ? 2 : 1],
                  const float2* qrope = nullptr) {
  constexpr int NS = DUAL ? 2 : 1;
  constexpr int DKT = DUAL ? 2 * DK : DK;
  constexpr int W1 = (DK == 96) ? 64 : DKT;
  constexpr int LDK = DKT + 8;
  constexpr int NK1 = 64 * (W1 / 8) / 512;
  constexpr int NV = 64 * (DV / 8) / 512;
  constexpr int BUFE = 64 * DKT + DV * LDT;
  bf16_t* sbase = (bf16_t*)smem;
  const int tid = TIDX, lane = tid & 63, wave = tid >> 6, g = lane >> 4, l16 = lane & 15;
  const int st = (int)ltid();
  const int gsw = (g ^ ((4 - (l16 >> 2)) & 3)) * 8;
  bf16x8 qf[DKT / 32];
  const bf16_t* qrow = Qp + (size_t)(wave * 16 + l16) * ldq;
#pragma unroll
  for (int ks = 0; ks < DKT / 32; ++ks) qf[ks] = *(const bf16x8*)(qrow + ks * 32 + g * 8);
  if (DK == 96 && qrope) {
    const float2* rp = qrope + (wave * 16 + l16) * 16 + g * 4;
    const u32x4 w = __builtin_bit_cast(u32x4, qf[DKT / 32 - 1]);
    u32x4 r;
#pragma unroll
    for (int j = 0; j < 4; ++j) {
      const float2 cs = rp[j];
      const float x0 = lo2f(w[j]), x1 = hi2f(w[j]);
      r[j] = pack2(x0 * cs.x - x1 * cs.y, x0 * cs.y + x1 * cs.x);
    }
    qf[DKT / 32 - 1] = __builtin_bit_cast(bf16x8, r);
  }
#pragma unroll
  for (int n = 0; n < NS; ++n) {
#pragma unroll
    for (int i = 0; i < DV / 16; ++i) o[n][i] = f32x4{0.f, 0.f, 0.f, 0.f};
    mrun[n] = -INFINITY; lsum[n] = 0.f;
  }
  u32x4 pk[NK1], pk2, pv[NV];
  unsigned koff[NK1], voff[NV];
#pragma unroll
  for (int i = 0; i < NK1; ++i) { const int c = st + 512 * i, r = c / (W1 / 8), cc = (c % (W1 / 8)) * 8; koff[i] = (unsigned)(r * ldk1 + cc); }
#pragma unroll
  for (int i = 0; i < NV; ++i) { const int c = st + 512 * i, r = c & 63, cc = (c >> 6) * 8; voff[i] = (unsigned)(r * ldv + cc); }
  const unsigned k2off = (unsigned)(((st & 255) >> 2) * ldk2 + (st & 3) * 8);
#define A_LOAD(TN) { const bf16_t* kbase_ = K1 + (size_t)(TN) * ldk1; const bf16_t* vbase_ = V + (size_t)(TN) * ldv; \
    _Pragma("unroll") for (int i = 0; i < NK1; ++i) pk[i] = *(const u32x4*)(kbase_ + koff[i]); \
    if (DK == 96 && st < 256) pk2 = *(const u32x4*)(K2 + (size_t)(TN) * ldk2 + k2off); \
    _Pragma("unroll") for (int i = 0; i < NV; ++i) pv[i] = *(const u32x4*)(vbase_ + voff[i]); }
#define A_COMMIT(B) { bf16_t* sK_ = sbase + (B) * BUFE; bf16_t* sVT_ = sK_ + 64 * DKT; \
    _Pragma("unroll") for (int i = 0; i < NK1; ++i) { const int c = st + 512 * i, r = c / (W1 / 8), ch = c % (W1 / 8); *(u32x4*)(sK_ + (ch >> 2) * 2048 + r * 32 + (((ch & 3) ^ ((4 - ((r >> 2) & 3)) & 3)) * 8)) = pk[i]; } \
    if (DK == 96 && st < 256) { const int r = st >> 2, ch = st & 3; *(u32x4*)(sK_ + 2 * 2048 + r * 32 + ((ch ^ ((4 - ((r >> 2) & 3)) & 3)) * 8)) = pk2; } \
    _Pragma("unroll") for (int i = 0; i < NV; ++i) { const int c = st + 512 * i, r = c & 63, cc = (c >> 6) * 8; \
      _Pragma("unroll") for (int j = 0; j < 4; ++j) { sVT_[(cc + 2 * j) * LDT + r] = (bf16_t)(pv[i][j] & 0xffffu); sVT_[(cc + 2 * j + 1) * LDT + r] = (bf16_t)(pv[i][j] >> 16); } } }
  A_LOAD(0)
  __syncthreads();
  A_COMMIT(0)
  if (64 < T) A_LOAD(64)
  __syncthreads();
  int par = 0;
  for (int t0 = 0; t0 < T; t0 += 64, par ^= 1) {
    {
    {
    if (t0 + 64 < T) {
      A_COMMIT(par ^ 1)
      if (t0 + 128 < T) A_LOAD(t0 + 128)
    }
    const bf16_t* sK = sbase + par * BUFE;
    const bf16_t* sVT = sK + 64 * DKT;
    bf16x8 pf[NS][2];
#pragma unroll
    for (int n = 0; n < NS; ++n) {
      f32x4 s[4];
#pragma unroll
      for (int t = 0; t < 4; ++t) {
        s[t] = f32x4{0.f, 0.f, 0.f, 0.f};
#pragma unroll
        for (int ks = 0; ks < DK / 32; ++ks) {
          const bf16x8 kf = *(const bf16x8*)(sK + (n * (DK / 32) + ks) * 2048 + (t * 16 + l16) * 32 + gsw);
          s[t] = MFMA16(kf, qf[n * (DK / 32) + ks], s[t]);
        }
      }
      float mx = -INFINITY;
#pragma unroll
      for (int t = 0; t < 4; ++t)
#pragma unroll
        for (int j = 0; j < 4; ++j) mx = fmaxf(mx, s[t][j]);
      mx = xmax_16_32(mx);
      const float mnew = fmaxf(mrun[n], mx);
      const float alpha = __builtin_amdgcn_exp2f((mrun[n] - mnew) * scale_log2);
      mrun[n] = mnew;
      const float moff = -mnew * scale_log2;
      float ps = 0.f;
#pragma unroll
      for (int t = 0; t < 4; ++t)
#pragma unroll
        for (int j = 0; j < 4; ++j) { s[t][j] = __builtin_amdgcn_exp2f(fmaf(s[t][j], scale_log2, moff)); ps += s[t][j]; }
      lsum[n] = lsum[n] * alpha + ps;
#pragma unroll
      for (int i = 0; i < DV / 16; ++i) o[n][i] *= alpha;
#pragma unroll
      for (int kb = 0; kb < 2; ++kb)
      {
        u32x4 w;
        w[0] = pack2(s[2 * kb][0], s[2 * kb][1]); w[1] = pack2(s[2 * kb][2], s[2 * kb][3]);
        w[2] = pack2(s[2 * kb + 1][0], s[2 * kb + 1][1]); w[3] = pack2(s[2 * kb + 1][2], s[2 * kb + 1][3]);
        pf[n][kb] = __builtin_bit_cast(bf16x8, w);
      }
    }
#pragma unroll
    for (int kb = 0; kb < 2; ++kb) {
#pragma unroll
      for (int i = 0; i < DV / 16; ++i) {
        const bf16_t* vp = sVT + (i * 16 + l16) * LDT + kb * 32 + g * 4;
        const bf16x4 lo = *(const bf16x4*)(vp);
        const bf16x4 hi = *(const bf16x4*)(vp + 16);
        const bf16x8 vf = __builtin_shufflevector(lo, hi, 0, 1, 2, 3, 4, 5, 6, 7);
#pragma unroll
        for (int n = 0; n < NS; ++n) o[n][i] = MFMA16(vf, pf[n][kb], o[n][i]);
        if (DUAL && (i & 3) == 3) asm volatile("" ::: "memory");
      }
    }
    }
    }
    __syncthreads();
  }
#undef A_LOAD
#undef A_COMMIT
}

DI void transpose_w(const float* __restrict__ src, int K, int N, bf16_t* __restrict__ dst, int tile, float* sT, int sc_lo, int sc_hi, float sc) {
  const int ntn = (N + 63) >> 6;
  const int kt = tile / ntn, nt = tile % ntn, k0 = kt * 64, n0 = nt * 64;
  __syncthreads();
#pragma unroll
  for (int q = 0; q < 4; ++q) {
    const int i = TIDX + 256 * q;
    const int r = i >> 4, c = (i & 15) * 4, n = n0 + c;
    float4 v = make_float4(0.f, 0.f, 0.f, 0.f);
    if (n < N) v = *(const float4*)(src + (size_t)(k0 + r) * N + n);
    if (n >= sc_lo && n < sc_hi) { v.x *= sc; v.y *= sc; v.z *= sc; v.w *= sc; }
    float* d = sT + r * 65 + c;
    d[0] = v.x; d[1] = v.y; d[2] = v.z; d[3] = v.w;
  }
  __syncthreads();
#pragma unroll
  for (int q = 0; q < 2; ++q) {
    const int i = TIDX + 256 * q;
    const int c = i >> 3, kc = (i & 7) * 8, n = n0 + c;
    if (n < N) {
      const float* sp = sT + kc * 65 + c;
      uint4 o;
      o.x = pack2(sp[0], sp[65]); o.y = pack2(sp[130], sp[195]); o.z = pack2(sp[260], sp[325]); o.w = pack2(sp[390], sp[455]);
      *(uint4*)(dst + (size_t)n * K + k0 + kc) = o;
    }
  }
}

DI void phase0(const Params& p, char* smem) {
  const int tid = TIDX;
  for (int it = VBLK; it < 384; it += NVBLK) {
    const int l = it / 192, cb = (it % 192) * 16;
    const float* W = l ? p.o_ada_w : p.e_ada_w;
    const float* bias = l ? p.o_ada_b : p.e_ada_b;
    float* sc = (float*)smem;
    float* red = sc + 3072;
    __syncthreads();
    for (int i = tid; i < 3072; i += 256) {
      const int j = i >> 10, k = i & 1023;
      const float v = (j == 0) ? p.c_ctx[k] : p.c[(j - 1) * 1024 + k];
      sc[i] = siluf(v);
    }
    __syncthreads();
    const int col = cb + (tid & 15), kg = tid >> 4;
    float a0 = 0.f, a1 = 0.f, a2 = 0.f;
    for (int kb = kg * 64; kb < kg * 64 + 64; kb += 16) {
      float w[16];
#pragma unroll
      for (int u = 0; u < 16; ++u) w[u] = W[(size_t)(kb + u) * 3072 + col];
#pragma unroll
      for (int u = 0; u < 16; ++u) { a0 += sc[kb + u] * w[u]; a1 += sc[1024 + kb + u] * w[u]; a2 += sc[2048 + kb + u] * w[u]; }
    }
    red[(kg * 3 + 0) * 16 + (tid & 15)] = a0;
    red[(kg * 3 + 1) * 16 + (tid & 15)] = a1;
    red[(kg * 3 + 2) * 16 + (tid & 15)] = a2;
    __syncthreads();
    if (tid < 48) {
      const int j = tid >> 4, c = tid & 15;
      float s = 0.f;
      for (int q = 0; q < 16; ++q) s += red[(q * 3 + j) * 16 + c];
      __hip_atomic_store(p.MOD + (l * 3 + j) * 3072 + cb + c, s + bias[cb + c], __ATOMIC_RELAXED, __HIP_MEMORY_SCOPE_AGENT);
    }
    asm volatile("s_waitcnt vmcnt(0)" ::: "memory");
    __syncthreads();
    if (tid == 0) __hip_atomic_fetch_add(p.CNT + 2 * 48 * 64, 1u, __ATOMIC_RELAXED, __HIP_MEMORY_SCOPE_AGENT);
  }
}

DI void wait_mod_ready(const Params& p) {
  if (TIDX == 0) {
    unsigned* cnt = p.CNT + 2 * 48 * 64;
    unsigned sp = 0;
    while (__hip_atomic_load(cnt, __ATOMIC_RELAXED, __HIP_MEMORY_SCOPE_AGENT) < 384u) {
      __builtin_amdgcn_s_sleep(1);
      if (++sp > (1u << 22)) break;
    }
    __builtin_amdgcn_fence(__ATOMIC_ACQUIRE, "agent");
    asm volatile("s_waitcnt vmcnt(0)" ::: "memory");
  }
  __syncthreads();
}

DI void phase0b(const Params& p, char* smem) {
  const int tid = TIDX;
  if (VBLK == 0 && tid < 64) {
    float a = p.o_lam[tid] * p.o_lam[64 + tid];
    float b = p.o_lam[128 + tid] * p.o_lam[192 + tid];
    a = wave_sum(a); b = wave_sum(b);
    if (tid == 0) p.LAMV[0] = fexp(a) - fexp(b) + LAM_INIT;
  }
  for (int idx = VBLK * 256 + tid; idx < 1024 * 48; idx += NVBLK * 256) {
    const int pos = idx / 48, e = idx % 48;
    const float rr = (float)(pos >> 6), cc = (float)(pos & 63);
    if (e < 16) {
      const int j = e & 7;
      const float inv = 1.0f / powf(10000.0f, (float)(2 * j) / 16.0f);
      const float ang = ((e < 8) ? rr : cc) * inv;
      p.ROPE32[pos * 16 + e] = make_float2(cosf(ang), sinf(ang));
    } else {
      const int i = e - 16, j = i & 15;
      const float inv = 1.0f / powf(10000.0f, (float)(2 * j) / 32.0f);
      const float ang = ((i < 16) ? rr : cc) * inv;
      p.ROPE64[pos * 32 + i] = make_float2(cosf(ang), sinf(ang));
    }
  }
  float* sT = (float*)smem;
  for (int it = VBLK; it < 1016; it += NVBLK) {
    if (it < 624) transpose_w(p.e_w_in, 1024, EIN, p.WinE, it, sT, 0, 0, 1.f);
    else if (it < 696) transpose_w(p.e_w_uq, 384, 768, p.Wuq, it - 624, sT, 0, 0, 1.f);
    else if (it < 760) transpose_w(p.e_w_ukv, 256, 1024, p.Wukv, it - 696, sT, 0, 0, 1.f);
    else transpose_w(p.e_w_out, 1024, 1024, p.WoutE, it - 760, sT, 0, 0, 1.f);
  }
}

DI void late_weight_prep(const Params& p, char* smem, int first_group, int tile_lo, int tile_hi) {
  float* sT = (float*)smem;
  const int ng = NVBLK - first_group;
  if (ng <= 0 || VBLK < first_group) return;
  for (int it = tile_lo + VBLK - first_group; it < tile_hi; it += ng) {
    if (it < 1168) transpose_w(p.o_w_in, 1024, OIN, p.WinO, it, sT, 512, 1024, 0.08838834764831845f);
    else transpose_w(p.o_w_out, 1024, 1024, p.WoutO, it - 1168, sT, 0, 0, 1.f);
  }
}

DI void store_bf4(bf16_t* dst, f32x4 v) {
  uint2 o; o.x = pack2(v[0], v[1]); o.y = pack2(v[2], v[3]);
  *(uint2*)dst = o;
}
DI float4 load_bf4(const bf16_t* src) {
  const uint2 w = *(const uint2*)src;
  return make_float4(lo2f(w.x), hi2f(w.x), lo2f(w.y), hi2f(w.y));
}

DI void phase_norm(const Params& p, int layer) {
  const int tid = TIDX, lane = tid & 63, wave = tid >> 6;
  const float* g = layer ? p.o_norm_g : p.e_norm_g;
  for (int it = VBLK; it < NROW / 4; it += NVBLK) {
    const int row = it * 4 + wave;
    const float* x = xrow(p, row);
    const bf16_t* xb = p.X1B + (size_t)row * 1024;
    const float* md = p.MOD + (layer * 3 + cv_of_row(row)) * 3072;
    float4 v[4];
    float ss = 0.f;
#pragma unroll
    for (int i = 0; i < 4; ++i) {
      v[i] = layer ? load_bf4(xb + i * 256 + lane * 4) : *(const float4*)(x + i * 256 + lane * 4);
      ss += v[i].x * v[i].x + v[i].y * v[i].y + v[i].z * v[i].z + v[i].w * v[i].w;
    }
    ss = wave_sum(ss);
    const float r = rsqrtf(ss * (1.f / 1024.f) + EPSF);
#pragma unroll
    for (int i = 0; i < 4; ++i) {
      const int col = i * 256 + lane * 4;
      const float4 gg = *(const float4*)(g + col), sh = *(const float4*)(md + col), sc = *(const float4*)(md + 1024 + col);
      uint2 o;
      o.x = pack2(v[i].x * r * gg.x * (1.f + sc.x) + sh.x, v[i].y * r * gg.y * (1.f + sc.y) + sh.y);
      o.y = pack2(v[i].z * r * gg.z * (1.f + sc.z) + sh.z, v[i].w * r * gg.w * (1.f + sc.w) + sh.w);
      *(uint2*)(p.H + (size_t)row * 1024 + col) = o;
    }
  }
}


DI void phase_gemm_in(const Params& p, int layer, char* smem) {
  const int N = layer ? OIN : EIN;
  const int Npad = layer ? OIN_PAD : EIN_PAD;
  pg8::Gemm g;
  g.A = p.H; g.Bt = layer ? p.WinO : p.WinE; g.M = NROW; g.N = Npad; g.K = 1024;
  pg8::StaticOrder S;
  S.init(NROW, Npad, (int)gridDim.x, (int)blockIdx.x);
  EpiU E;
  E.U = layer ? p.U1 : p.U0; E.ldu = N; E.nvalid = N; E.aux = layer ? p.out + O_DK : nullptr;
  pg8::gemm_phase<EpiU, pg8::StaticOrder, false>((PG8_LAS unsigned char*)smem, g, S, E, nullptr);
}

DI void phase_gemm_out(const Params& p, int layer, char* smem) {
  const bf16_t* W = layer ? p.WoutO : p.WoutE;
  for (int it = VBLK; it < 48 * 8; it += NVBLK) {
    const int mt = it % 48, nt = it / 48;
    gemm_tile64(p.O, 1024, W, 1024, 1024, 1024, mt * 128, nt * 128, smem,
              [=](int m, int n, f32x4 v) {
                const float4 gt = *(const float4*)(p.MOD + (layer * 3 + cv_of_row(m)) * 3072 + 2048 + n);
                const float4 xv = layer ? load_bf4(p.X1B + (size_t)m * 1024 + n) : *(const float4*)(xrow(p, m) + n);
                f32x4 r;
                r[0] = xv.x + gt.x * v[0]; r[1] = xv.y + gt.y * v[1]; r[2] = xv.z + gt.z * v[2]; r[3] = xv.w + gt.w * v[3];
                store_bf4(p.X1B + (size_t)m * 1024 + n, r);
              });
  }
}

DI void phase_out_norm_fused(const Params& p, int layer, char* smem) {
  const int tid = TIDX, lane = tid & 63, wave = tid >> 6, wm = wave >> 1, wn = wave & 1, g = lane >> 4, l16 = lane & 15;
  float* sSS = (float*)(smem + 65536);
  float* sR = sSS + 256;
  for (int it = VBLK; it < 48 * 8; it += NVBLK) {
    const int mt = it % 48, nt = it / 48, m0 = mt * 128, n0 = nt * 128;
    f32x4 acc[4][4];
    gemm_tile64_acc(p.O, 1024, layer ? p.WoutO : p.WoutE, 1024, 1024, 1024, m0, n0, smem, acc);
    float* ssq_slots = p.SSQ + (size_t)layer * NROW * 8;
    unsigned* cnt_base = p.CNT + layer * 48 * 64;
    float ssq[4];
#pragma unroll
    for (int mi = 0; mi < 4; ++mi) {
      const int row = m0 + wm * 64 + mi * 16 + l16;
      const float* gp = p.MOD + (layer * 3 + cv_of_row(row)) * 3072 + 2048;
      ssq[mi] = 0.f;
#pragma unroll
      for (int ni = 0; ni < 4; ++ni) {
        const int n = n0 + wn * 64 + ni * 16 + g * 4;
        const float4 gt = *(const float4*)(gp + n);
        const float4 xv = layer ? load_bf4(p.X1B + (size_t)row * 1024 + n) : *(const float4*)(xrow(p, row) + n);
        f32x4 r;
        r[0] = xv.x + gt.x * acc[ni][mi][0]; r[1] = xv.y + gt.y * acc[ni][mi][1]; r[2] = xv.z + gt.z * acc[ni][mi][2]; r[3] = xv.w + gt.w * acc[ni][mi][3];
        acc[ni][mi] = r;
        if (!layer) store_bf4(p.X1B + (size_t)row * 1024 + n, r);
        ssq[mi] += r[0] * r[0] + r[1] * r[1] + r[2] * r[2] + r[3] * r[3];
      }
      ssq[mi] = xsum_16_32(ssq[mi]);
    }
    if (g == 0) {
#pragma unroll
      for (int mi = 0; mi < 4; ++mi) sSS[wn * 128 + wm * 64 + mi * 16 + l16] = ssq[mi];
    }
    __syncthreads();
    if (tid < 128) __hip_atomic_store(ssq_slots + (size_t)(m0 + tid) * 8 + nt, sSS[tid] + sSS[128 + tid], __ATOMIC_RELAXED, __HIP_MEMORY_SCOPE_AGENT);
    asm volatile("s_waitcnt vmcnt(0)" ::: "memory");
    __syncthreads();
    if (tid == 0) {
      unsigned* cnt = cnt_base + mt * 64;
      __hip_atomic_fetch_add(cnt, 1u, __ATOMIC_RELAXED, __HIP_MEMORY_SCOPE_AGENT);
      unsigned sp = 0;
      while (__hip_atomic_load(cnt, __ATOMIC_RELAXED, __HIP_MEMORY_SCOPE_AGENT) < 8u) {
        __builtin_amdgcn_s_sleep(1);
        if (++sp > (1u << 22)) break;
      }
      asm volatile("" ::: "memory");
    }
    __syncthreads();
    if (tid < 128) {
      const float* sl = ssq_slots + (size_t)(m0 + tid) * 8;
      float t = 0.f;
#pragma unroll
      for (int q = 0; q < 8; ++q) t += __hip_atomic_load(sl + q, __ATOMIC_RELAXED, __HIP_MEMORY_SCOPE_AGENT);
      sR[tid] = rsqrtf(t * (1.f / 1024.f) + EPSF);
    }
    __syncthreads();
#pragma unroll
    for (int mi = 0; mi < 4; ++mi) {
      const int rl = wm * 64 + mi * 16 + l16;
      const float r = sR[rl];
      float* op = p.out + O_Y + (size_t)(m0 + rl) * 1024;
      const float* md = p.MOD + (3 + cv_of_row(m0 + rl)) * 3072;
#pragma unroll
      for (int ni = 0; ni < 4; ++ni) {
        const int n = n0 + wn * 64 + ni * 16 + g * 4;
        if (layer) {
          const float4 gg = *(const float4*)(p.final_g + n);
          *(float4*)(op + n) = make_float4(acc[ni][mi][0] * r * gg.x, acc[ni][mi][1] * r * gg.y, acc[ni][mi][2] * r * gg.z, acc[ni][mi][3] * r * gg.w);
        } else {
          const float4 gg = *(const float4*)(p.o_norm_g + n), sh = *(const float4*)(md + n), sc = *(const float4*)(md + 1024 + n);
          f32x4 hv;
          hv[0] = acc[ni][mi][0] * r * gg.x * (1.f + sc.x) + sh.x; hv[1] = acc[ni][mi][1] * r * gg.y * (1.f + sc.y) + sh.y;
          hv[2] = acc[ni][mi][2] * r * gg.z * (1.f + sc.z) + sh.z; hv[3] = acc[ni][mi][3] * r * gg.w * (1.f + sc.w) + sh.w;
          store_bf4(p.H + (size_t)(m0 + rl) * 1024 + n, hv);
        }
      }
    }
  }
}

DI void phase_gemm_mla(const Params& p, char* smem) {
  const int G = (int)gridDim.x, bid = (int)blockIdx.x;
  const bool split = G >= 176;
  if (!split || bid < 72) {
    pg8::Gemm g;
    g.A = p.CQN; g.Bt = p.Wuq; g.M = NROW; g.N = 768; g.K = 384;
    pg8::StaticOrder S;
    S.init(NROW, 768, G, bid);
    EpiU E;
    E.U = p.Q; E.ldu = 768; E.nvalid = 768; E.aux = nullptr;
    pg8::gemm_phase<EpiU, pg8::StaticOrder, false>((PG8_LAS unsigned char*)smem, g, S, E, nullptr);
  }
  if (!split || bid >= 72) {
    pg8::Gemm g;
    g.A = p.CKVN; g.Bt = p.Wukv; g.M = NTROW; g.N = 1024; g.K = 256;
    pg8::StaticOrder S;
    S.init(NTROW, 1024, G, split ? bid - 72 : bid);
    EpiU E;
    E.U = p.KV; E.ldu = 1024; E.nvalid = 1024; E.aux = nullptr;
    pg8::gemm_phase<EpiU, pg8::StaticOrder, false>((PG8_LAS unsigned char*)smem, g, S, E, nullptr);
  }
}

struct TRow { int row, pos, cb, ct; bool cache, lat; };
DI TRow decode_trow(int trow) {
  TRow t; t.row = -1; t.pos = 0; t.cb = 0; t.ct = 0; t.cache = false; t.lat = false;
  if (trow < 4096) { t.row = trow; }
  else {
    const int r = trow - 4096; const int b = r / 1280, tt = r % 1280;
    t.lat = true;
    if (tt < 256) { t.cache = true; t.cb = b; t.ct = tt; }
    else { t.pos = tt - 256; t.row = 4096 + b * 1024 + t.pos; }
  }
  return t;
}
DI void cvt_store4(bf16_t* dst, const float* src) {
  const float4 v = *(const float4*)src;
  uint2 o; o.x = pack2(v.x, v.y); o.y = pack2(v.z, v.w);
  *(uint2*)dst = o;
}

DI void phase3(const Params& p) {
  const int tid = TIDX, lane = tid & 63, wave = tid >> 6;
  for (int it = VBLK; it < NTROW / 4; it += NVBLK) {
    const int trow = it * 4 + wave;
    const TRow t = decode_trow(trow);
    if (t.cache) {
      const size_t ci = (size_t)t.cb * 256 + t.ct;
      cvt_store4(p.CKVN + (size_t)trow * 256 + lane * 4, p.cache_ckv + ci * 256 + lane * 4);
      if (lane < 8) cvt_store4(p.KR + (size_t)trow * 32 + lane * 4, p.cache_kr + ci * 32 + lane * 4);
      if (lane < 32) {
        cvt_store4(p.KB + (size_t)trow * 128 + lane * 4, p.cache_gk + ci * 128 + lane * 4);
        cvt_store4(p.VB + (size_t)trow * 128 + lane * 4, p.cache_gv + ci * 128 + lane * 4);
      }
      continue;
    }
    const int row = t.row;
    const bf16_t* u = p.U0 + (size_t)row * EIN;
    {
      float x[6]; float ss = 0.f;
#pragma unroll
      for (int i = 0; i < 3; ++i) {
        const unsigned w = *(const unsigned*)(u + i * 128 + lane * 2);
        x[2 * i] = lo2f(w); x[2 * i + 1] = hi2f(w);
        ss += x[2 * i] * x[2 * i] + x[2 * i + 1] * x[2 * i + 1];
      }
      ss = wave_sum(ss);
      const float r = rsqrtf(ss * (1.f / 384.f) + EPSF);
#pragma unroll
      for (int i = 0; i < 3; ++i) {
        const int col = i * 128 + lane * 2;
        *(unsigned*)(p.CQN + (size_t)row * 384 + col) = pack2(x[2 * i] * r * p.e_qn_g[col], x[2 * i + 1] * r * p.e_qn_g[col + 1]);
      }
    }
    {
      const uint2 w = *(const uint2*)(u + 384 + lane * 4);
      float x0 = lo2f(w.x), x1 = hi2f(w.x), x2 = lo2f(w.y), x3 = hi2f(w.y);
      float ss = wave_sum(x0 * x0 + x1 * x1 + x2 * x2 + x3 * x3);
      const float r = rsqrtf(ss * (1.f / 256.f) + EPSF);
      const float4 gg = *(const float4*)(p.e_kvn_g + lane * 4);
      x0 *= r * gg.x; x1 *= r * gg.y; x2 *= r * gg.z; x3 *= r * gg.w;
      uint2 o; o.x = pack2(x0, x1); o.y = pack2(x2, x3);
      *(uint2*)(p.CKVN + (size_t)trow * 256 + lane * 4) = o;
      if (!t.lat) *(float4*)(p.out + O_CKV + (size_t)row * 256 + lane * 4) = make_float4(x0, x1, x2, x3);
    }
    if (lane < 16) {
      const unsigned w = *(const unsigned*)(u + 640 + lane * 2);
      float x0 = lo2f(w), x1 = hi2f(w);
      if (t.lat) {
        const float2 cs = p.ROPE32[t.pos * 16 + lane];
        const float y0 = x0 * cs.x - x1 * cs.y, y1 = x0 * cs.y + x1 * cs.x;
        x0 = y0; x1 = y1;
      } else {
        *(float2*)(p.out + O_KR + (size_t)row * 32 + lane * 2) = make_float2(x0, x1);
      }
      *(unsigned*)(p.KR + (size_t)trow * 32 + lane * 2) = pack2(x0, x1);
    }
#pragma unroll
    for (int which = 0; which < 2; ++which) {
      const int lsrc = which ? (lane & 15) : lane;
      const uint4 w = *(const uint4*)(u + (which ? 1696 : 1184) + lsrc * 8);
      float x[8] = {lo2f(w.x), hi2f(w.x), lo2f(w.y), hi2f(w.y), lo2f(w.z), hi2f(w.z), lo2f(w.w), hi2f(w.w)};
      float ss = 0.f;
#pragma unroll
      for (int j = 0; j < 8; ++j) ss += x[j] * x[j];
      ss += __shfl_xor(ss, 1); ss += __shfl_xor(ss, 2); ss += __shfl_xor(ss, 4);
      const float r = rsqrtf(ss * (1.f / 64.f) + EPSF);
      const float* gp = (which ? p.e_gk_g : p.e_gq_g) + (lane & 7) * 8;
#pragma unroll
      for (int j = 0; j < 8; ++j) x[j] *= r * gp[j];
      if (t.lat) {
#pragma unroll
        for (int jj = 0; jj < 4; ++jj) {
          const float2 cs = p.ROPE64[t.pos * 32 + (lane & 7) * 4 + jj];
          const float y0 = x[2 * jj] * cs.x - x[2 * jj + 1] * cs.y, y1 = x[2 * jj] * cs.y + x[2 * jj + 1] * cs.x;
          x[2 * jj] = y0; x[2 * jj + 1] = y1;
        }
      }
      uint4 o; o.x = pack2(x[0], x[1]); o.y = pack2(x[2], x[3]); o.z = pack2(x[4], x[5]); o.w = pack2(x[6], x[7]);
      if (which == 0) {
        *(uint4*)(p.QB + (size_t)row * 512 + lane * 8) = o;
      } else if (lane < 16) {
        *(uint4*)(p.KB + (size_t)trow * 128 + lane * 8) = o;
        if (!t.lat) {
          float* op = p.out + O_GK + (size_t)row * 128 + lane * 8;
          *(float4*)op = make_float4(x[0], x[1], x[2], x[3]);
          *(float4*)(op + 4) = make_float4(x[4], x[5], x[6], x[7]);
        }
      }
    }
    if (lane < 16) {
      const uint4 w = *(const uint4*)(u + 1824 + lane * 8);
      *(uint4*)(p.VB + (size_t)trow * 128 + lane * 8) = w;
      if (!t.lat) {
        float* op = p.out + O_GV + (size_t)row * 128 + lane * 8;
        *(float4*)op = make_float4(lo2f(w.x), hi2f(w.x), lo2f(w.y), hi2f(w.y));
        *(float4*)(op + 4) = make_float4(lo2f(w.z), hi2f(w.z), lo2f(w.w), hi2f(w.w));
      }
    }
  }
}

DI void phase_attn0(const Params& p, char* smem) {
  const int lane = TIDX & 63, wave = TIDX >> 6, g = lane >> 4, l16 = lane & 15;
  for (int it = vblk_xcd(); it < 1536; it += NVBLK) {
    int kind, b, h, qb, row0, trow0, T;
    if (it < 512) { const int i = it & 255; kind = it >> 8; b = i >> 7; h = (i >> 4) & 7; qb = i & 15; row0 = 4096 + b * 1024 + qb * 64; trow0 = 4096 + b * 1280; T = 1280; }
    else { const int i2 = it - 512; kind = i2 >> 9; const int i = i2 & 511; b = i >> 5; h = (i >> 2) & 7; qb = i & 3; row0 = b * 256 + qb * 64; trow0 = b * 256; T = 256; }
    f32x4 oo[1][4];
    float lss[1], mss[1];
    int gcol, ocol;
    const int row = row0 + wave * 16 + l16;
    uint2 gwv[4];
    {
      const int gc = kind == 0 ? 672 + h * 64 : 1952 + h * 64;
#pragma unroll
      for (int i = 0; i < 4; ++i) gwv[i] = *(const uint2*)(p.U0 + (size_t)row * EIN + gc + i * 16 + g * 4);
    }
    if (kind == 0) {
      attn_core<96, 64, false>(smem, p.Q + (size_t)row0 * 768 + h * 96, 768, p.KV + (size_t)trow0 * 1024 + h * 128, 1024,
                        p.KR + (size_t)trow0 * 32, 32, p.KV + (size_t)trow0 * 1024 + h * 128 + 64, 1024, T,
                        0.10206207261596575f * 1.4426950408889634f, oo, lss, mss,
                        it < 512 ? p.ROPE32 + (size_t)(qb * 64) * 16 : nullptr);
      gcol = 672 + h * 64; ocol = h * 64;
    } else {
      const int kvh = h >> 2;
      attn_core<64, 64, false>(smem, p.QB + (size_t)row0 * 512 + h * 64, 512, p.KB + (size_t)trow0 * 128 + kvh * 64, 128,
                        nullptr, 0, p.VB + (size_t)trow0 * 128 + kvh * 64, 128, T, 0.125f * 1.4426950408889634f, oo, lss, mss);
      gcol = 1952 + h * 64; ocol = 512 + h * 64;
    }
    float ls = lss[0];
    ls = xsum_16_32(ls);
    const float inv = 1.f / ls;
    f32x4 (&o)[4] = oo[0];
#pragma unroll
    for (int i = 0; i < 4; ++i) {
      const int dv = i * 16 + g * 4;
      const uint2 gw = gwv[i];
      f32x4 r;
      r[0] = o[i][0] * inv * siluf(lo2f(gw.x)); r[1] = o[i][1] * inv * siluf(hi2f(gw.x));
      r[2] = o[i][2] * inv * siluf(lo2f(gw.y)); r[3] = o[i][3] * inv * siluf(hi2f(gw.y));
      store_bf4(p.O + (size_t)row * 1024 + ocol + dv, r);
    }
  }
}

DI void mlstm_gates(const Params& p, int rowbase, int nc, int h, int dir, int j, int lane, float& ig, float& lf) {
  const int oc = dir ? nc - 1 - j : j;
  const int s = dir ? 63 - lane : lane;
  const int row = rowbase + oc * 64 + s;
  const bf16_t* up = p.U1 + (size_t)row * OIN + 2048;
  ig = bf2f(up[dir * 8 + h]) + p.o_gate_b[dir * 8 + h];
  lf = logsig(bf2f(up[dir * 8 + 4 + h]) + p.o_gate_b[dir * 8 + 4 + h]);
}
DI void mitem_decode(int it, int& sq, int& h, int& dir, int& j, int& nc, int& rowbase) {
  if (it < 512) { j = it & 3; dir = (it >> 2) & 1; h = (it >> 3) & 3; sq = it >> 5; nc = 4; rowbase = sq * 256; }
  else { const int i = it - 512; j = i & 15; dir = (i >> 4) & 1; h = (i >> 5) & 3; sq = 16 + (i >> 7); nc = 16; rowbase = 4096 + (sq - 16) * 1024; }
}
DI int mitem_id(int sq, int h, int dir, int j) {
  return sq < 16 ? (((sq * 4 + h) * 2 + dir) * 4 + j) : (512 + ((((sq - 16) * 4 + h) * 2 + dir) * 16 + j));
}

DI void phase9(const Params& p, char* smem) {
  const int tid = TIDX, lane = tid & 63, wave = tid >> 6, g = lane >> 4, l16 = lane & 15;
  for (int it = VBLK; it < NTROW / 4; it += NVBLK) {
    const int trow = it * 4 + wave;
    const TRow t = decode_trow(trow);
    if (t.cache) {
      const size_t ci = (size_t)t.cb * 256 + t.ct;
      cvt_store4(p.KD + (size_t)trow * 512 + lane * 8, p.cache_dk + ci * 512 + lane * 8);
      cvt_store4(p.KD + (size_t)trow * 512 + lane * 8 + 4, p.cache_dk + ci * 512 + lane * 8 + 4);
      cvt_store4(p.VD + (size_t)trow * 512 + lane * 8, p.cache_dv + ci * 512 + lane * 8);
      cvt_store4(p.VD + (size_t)trow * 512 + lane * 8 + 4, p.cache_dv + ci * 512 + lane * 8 + 4);
      continue;
    }
    if (!t.lat) continue;
    const int row = t.row;
    const bf16_t* u = p.U1 + (size_t)row * OIN;
#pragma unroll
    for (int which = 0; which < 2; ++which) {
      const uint4 w = *(const uint4*)(u + (which ? 3088 : 2576) + lane * 8);
      float x[8] = {lo2f(w.x), hi2f(w.x), lo2f(w.y), hi2f(w.y), lo2f(w.z), hi2f(w.z), lo2f(w.w), hi2f(w.w)};
      if (t.lat) {
#pragma unroll
        for (int jj = 0; jj < 4; ++jj) {
          const float2 cs = p.ROPE64[t.pos * 32 + (lane & 7) * 4 + jj];
          const float y0 = x[2 * jj] * cs.x - x[2 * jj + 1] * cs.y, y1 = x[2 * jj] * cs.y + x[2 * jj + 1] * cs.x;
          x[2 * jj] = y0; x[2 * jj + 1] = y1;
        }
      }
      uint4 o; o.x = pack2(x[0], x[1]); o.y = pack2(x[2], x[3]); o.z = pack2(x[4], x[5]); o.w = pack2(x[6], x[7]);
      if (which == 0) { if (t.lat) *(uint4*)(p.QD + (size_t)row * 512 + lane * 8) = o; }
      else {
        if (t.lat) *(uint4*)(p.KD + (size_t)trow * 512 + lane * 8) = o;
        if (!t.lat) {
          float* op = p.out + O_DK + (size_t)row * 512 + lane * 8;
          *(float4*)op = make_float4(x[0], x[1], x[2], x[3]);
          *(float4*)(op + 4) = make_float4(x[4], x[5], x[6], x[7]);
        }
      }
    }
    {
      const uint4 w = *(const uint4*)(u + 3600 + lane * 8);
      if (t.lat) *(uint4*)(p.VD + (size_t)trow * 512 + lane * 8) = w;
      if (!t.lat) {
        float* op = p.out + O_DV + (size_t)row * 512 + lane * 8;
        *(float4*)op = make_float4(lo2f(w.x), hi2f(w.x), lo2f(w.y), hi2f(w.y));
        *(float4*)(op + 4) = make_float4(lo2f(w.z), hi2f(w.z), lo2f(w.w), hi2f(w.w));
      }
    }
  }
  bf16_t* sKT = (bf16_t*)smem;
  bf16_t* sVT = sKT + 128 * LDT;
  float* swk = (float*)(sVT + 128 * LDT);
  for (int it = VBLK; it < 768; it += NVBLK) {
    int sq, h, dir, j, nc, rowbase;
    mitem_decode(it, sq, h, dir, j, nc, rowbase);
    float ig, lf;
    mlstm_gates(p, rowbase, nc, h, dir, j, lane, ig, lf);
    const float b = scan_add(lf, lane);
    const float bL = __shfl(b, 63);
    const float mx = wave_max(bL - b + ig);
    const float wk = fexp(bL - b + ig - mx);
    __syncthreads();
    if (wave == 0) {
      swk[dir ? 63 - lane : lane] = wk;
      if (lane == 0) { p.SC[it * 4 + 0] = bL; p.SC[it * 4 + 1] = mx; }
    }
    __syncthreads();
    const int oc = dir ? nc - 1 - j : j;
    const int row0 = rowbase + oc * 64;
    stage_T64<128>(sKT, p.U1 + (size_t)row0 * OIN + 512 + h * 128, OIN, nullptr);
    stage_T64<128>(sVT, p.U1 + (size_t)row0 * OIN + 1024 + h * 128, OIN, swk);
    __syncthreads();
    f32x4 acc[2][8];
#pragma unroll
    for (int a = 0; a < 2; ++a)
#pragma unroll
      for (int c = 0; c < 8; ++c) acc[a][c] = f32x4{0.f, 0.f, 0.f, 0.f};
#pragma unroll
    for (int ks = 0; ks < 2; ++ks) {
      bf16x8 vf[2];
#pragma unroll
      for (int a = 0; a < 2; ++a) vf[a] = *(const bf16x8*)(sVT + ((wave * 2 + a) * 16 + l16) * LDT + ks * 32 + g * 8);
#pragma unroll
      for (int kt = 0; kt < 8; ++kt) {
        const bf16x8 kf = *(const bf16x8*)(sKT + (kt * 16 + l16) * LDT + ks * 32 + g * 8);
#pragma unroll
        for (int a = 0; a < 2; ++a) acc[a][kt] = MFMA16(kf, vf[a], acc[a][kt]);
      }
    }
    bf16_t* uc = p.UC + (size_t)it * 16384;
#pragma unroll
    for (int a = 0; a < 2; ++a)
#pragma unroll
      for (int kt = 0; kt < 8; ++kt) {
        const int v = (wave * 2 + a) * 16 + l16, k = kt * 16 + g * 4;
        store_bf4(uc + v * 128 + k, acc[a][kt]);
      }
    if (tid < 128) {
      float s = 0.f;
#pragma unroll
      for (int c8 = 0; c8 < 8; ++c8) {
        const u32x4 kw = *(const u32x4*)(sKT + tid * LDT + c8 * 8);
        const float4 w0 = *(const float4*)(swk + c8 * 8), w1 = *(const float4*)(swk + c8 * 8 + 4);
        s += lo2f(kw[0]) * w0.x + hi2f(kw[0]) * w0.y + lo2f(kw[1]) * w0.z + hi2f(kw[1]) * w0.w
           + lo2f(kw[2]) * w1.x + hi2f(kw[2]) * w1.y + lo2f(kw[3]) * w1.z + hi2f(kw[3]) * w1.w;
      }
      p.NU[it * 128 + tid] = s;
    }
  }
}

DI void diff_finish(const Params& p, f32x4 (&o1)[8], f32x4 (&o2)[8], float l1, float l2, int row0, int hd) {
  const int lane = TIDX & 63, wave = TIDX >> 6, g = lane >> 4, l16 = lane & 15;
  l1 = xsum_16_32(l1);
  l2 = xsum_16_32(l2);
  const float i1 = 1.f / l1, i2 = p.LAMV[0] / l2;
  float ss = 0.f;
#pragma unroll
  for (int i = 0; i < 8; ++i)
#pragma unroll
    for (int j = 0; j < 4; ++j) { o1[i][j] = o1[i][j] * i1 - o2[i][j] * i2; ss += o1[i][j] * o1[i][j]; }
  ss = xsum_16_32(ss);
  const float r = rsqrtf(ss * (1.f / 128.f) + EPSF) * (1.f - LAM_INIT);
  const int row = row0 + wave * 16 + l16;
#pragma unroll
  for (int i = 0; i < 8; ++i) {
    const int dv = i * 16 + g * 4;
    const uint2 gw = *(const uint2*)(p.U1 + (size_t)row * OIN + 4112 + hd * 128 + dv);
    const float4 gn = *(const float4*)(p.o_dnorm_g + dv);
    f32x4 rr;
    rr[0] = o1[i][0] * r * gn.x * siluf(lo2f(gw.x)); rr[1] = o1[i][1] * r * gn.y * siluf(hi2f(gw.x));
    rr[2] = o1[i][2] * r * gn.z * siluf(lo2f(gw.y)); rr[3] = o1[i][3] * r * gn.w * siluf(hi2f(gw.y));
    store_bf4(p.O + (size_t)row * 1024 + 512 + hd * 128 + dv, rr);
  }
}

DI void phase10(const Params& p, char* smem) {
  const int tid = TIDX, lane = tid & 63, wave = tid >> 6, g = lane >> 4, l16 = lane & 15;
  for (int it = vblk_xcd(); it < 512; it += NVBLK) {
    int b, hd, qb, row0, trow0, T;
    const bool lat = it < 256;
    const int split = (it >> 1) & 1;
    const int li = ((it >> 7) * 4 + ((it >> 5) & 3)) * 16 + ((it >> 2) & 7) * 2 + (it & 1);
    if (lat) { b = li >> 6; hd = (li >> 4) & 3; qb = li & 15; row0 = 4096 + b * 1024 + qb * 64; trow0 = 4096 + b * 1280 + split * 640; T = 640; }
    else { const int i = it - 256; b = i >> 4; hd = (i >> 2) & 3; qb = i & 3; row0 = b * 256 + qb * 64; trow0 = b * 256; T = 256; }
    f32x4 od[2][8];
    float ld2[2], md2[2];
    const float sc = 0.125f * 1.4426950408889634f;
    const bf16_t* qp = lat ? p.QD + (size_t)row0 * 512 + hd * 128 : p.U1 + (size_t)row0 * OIN + 2576 + hd * 128;
    const bf16_t* kp = lat ? p.KD + (size_t)trow0 * 512 + hd * 128 : p.U1 + (size_t)trow0 * OIN + 3088 + hd * 128;
    const bf16_t* vp = lat ? p.VD + (size_t)trow0 * 512 + hd * 128 : p.U1 + (size_t)trow0 * OIN + 3600 + hd * 128;
    const int ldqkv = lat ? 512 : OIN;
    attn_core<64, 128, true>(smem, qp, ldqkv, kp, ldqkv, nullptr, 0, vp, ldqkv, T, sc, od, ld2, md2);
    if (lat) {
#pragma unroll
      for (int n = 0; n < 2; ++n) {
        const size_t base = (size_t)((li * 2 + split) * 2 + n) * 4 + wave;
#pragma unroll
        for (int i = 0; i < 8; ++i) store_bf4(p.OP + ((base * 8 + i) * 64 + lane) * 4, od[n][i]);
        *(float2*)(p.ML + (base * 64 + lane) * 2) = make_float2(md2[n], ld2[n]);
      }
    } else {
      diff_finish(p, od[0], od[1], ld2[0], ld2[1], row0, hd);
    }
  }
  const int vb = (vblk_xcd() + (NVBLK >> 1)) % NVBLK;
  for (int it = vb; it < 144 * 16; it += NVBLK) {
    const int chain = it < 256 ? 128 + (it >> 4) : ((it - 256) >> 4), eb = it & 15;
    const int sq = chain >> 3, h = (chain >> 1) & 3, dir = chain & 1;
    const int nc = sq < 16 ? 4 : 16;
    const int ib = mitem_id(sq, h, dir, 0);
    const int e = eb * 1024 + tid * 4;
    float4 C = make_float4(0.f, 0.f, 0.f, 0.f);
    if (sq >= 16) C = *(const float4*)(p.st_C + (size_t)(((sq - 16) * 2 + dir) * 4 + h) * 16384 + e);
    float4 uu[16];
    float dcs[16], scl[16], bLs[16], mxs[16];
#pragma unroll
    for (int j = 0; j < 16; ++j) {
      if (j < nc) { bLs[j] = p.SC[(ib + j) * 4 + 0]; mxs[j] = p.SC[(ib + j) * 4 + 1]; uu[j] = load_bf4(p.UC + (size_t)(ib + j) * 16384 + e); }
    }
    float mrun = 0.f;
    if (sq >= 16) mrun = p.st_m[((sq - 16) * 2 + dir) * 4 + h];
#pragma unroll
    for (int j = 0; j < 16; ++j) {
      if (j < nc) {
        const float mnext = fmaxf(bLs[j] + mrun, mxs[j]);
        dcs[j] = fexp(bLs[j] + mrun - mnext);
        scl[j] = fexp(mxs[j] - mnext);
        if (eb == 0 && tid == 0) p.SCM[ib + j] = mrun;
        mrun = mnext;
      }
    }
#pragma unroll
    for (int j = 0; j < 16; ++j) {
      if (j < nc) {
        uint2 o; o.x = pack2(C.x, C.y); o.y = pack2(C.z, C.w);
        *(uint2*)(p.CST + (size_t)(ib + j) * 16384 + e) = o;
        const float dc = dcs[j], sc = scl[j];
        C.x = dc * C.x + sc * uu[j].x; C.y = dc * C.y + sc * uu[j].y; C.z = dc * C.z + sc * uu[j].z; C.w = dc * C.w + sc * uu[j].w;
      }
    }
    if (sq < 16) *(float4*)(p.out + O_C + (size_t)((sq * 2 + dir) * 4 + h) * 16384 + e) = C;
    if (eb == 0 && tid < 128) {
      float n = 0.f;
      if (sq >= 16) n = p.st_n[(((sq - 16) * 2 + dir) * 4 + h) * 128 + tid];
#pragma unroll
      for (int j = 0; j < 16; ++j) {
        if (j < nc) {
          p.NST[(ib + j) * 128 + tid] = n;
          n = dcs[j] * n + scl[j] * p.NU[(ib + j) * 128 + tid];
        }
      }
      if (sq < 16) {
        p.out[O_N + ((sq * 2 + dir) * 4 + h) * 128 + tid] = n;
        if (tid == 0) p.out[O_M + (sq * 2 + dir) * 4 + h] = mrun;
      }
    }
  }
}

DI void phase11(const Params& p, char* smem) {
  const int tid = TIDX, lane = tid & 63, wave = tid >> 6, g = lane >> 4, l16 = lane & 15;
  bf16_t* sK = (bf16_t*)smem;
  bf16_t* sVT = sK + 64 * 128;
  float* sB = (float*)(sVT + 128 * LDT);
  float* sA = sB + 128;
  float* sMT = sA + 128;
  bf16_t* sC = (bf16_t*)(smem + 36352);
  for (int it = VBLK; it < 512; it += NVBLK) {
    if (it >= 384) {
    const int li = it - 384;
    const int b = li >> 6, hd = (li >> 4) & 3, qb = li & 15, row0 = 4096 + b * 1024 + qb * 64;
    f32x4 oc[2][8];
    float lc[2];
#pragma unroll
    for (int n = 0; n < 2; ++n) {
      const size_t b0 = (size_t)((li * 2 + 0) * 2 + n) * 4 + wave, b1 = (size_t)((li * 2 + 1) * 2 + n) * 4 + wave;
      const float2 ml0 = *(const float2*)(p.ML + (b0 * 64 + lane) * 2), ml1 = *(const float2*)(p.ML + (b1 * 64 + lane) * 2);
      const float m = fmaxf(ml0.x, ml1.x);
      const float f0 = __builtin_amdgcn_exp2f((ml0.x - m) * (0.125f * 1.4426950408889634f)), f1 = __builtin_amdgcn_exp2f((ml1.x - m) * (0.125f * 1.4426950408889634f));
      lc[n] = ml0.y * f0 + ml1.y * f1;
#pragma unroll
      for (int i = 0; i < 8; ++i) {
        const float4 a0 = load_bf4(p.OP + ((b0 * 8 + i) * 64 + lane) * 4), a1 = load_bf4(p.OP + ((b1 * 8 + i) * 64 + lane) * 4);
        oc[n][i] = f32x4{a0.x * f0 + a1.x * f1, a0.y * f0 + a1.y * f1, a0.z * f0 + a1.z * f1, a0.w * f0 + a1.w * f1};
      }
    }
    diff_finish(p, oc[0], oc[1], lc[0], lc[1], row0, hd);
    continue;
    }
    int sq, h, c, nc, rowbase;
    if (it < 128) { sq = 16 + (it >> 6); h = (it >> 4) & 3; c = it & 15; nc = 16; rowbase = 4096 + (sq - 16) * 1024; }
    else { const int i = it - 128; sq = i >> 4; h = (i >> 2) & 3; c = i & 3; nc = 4; rowbase = sq * 256; }
    const int row0 = rowbase + c * 64;
    float mst[2];
    int item[2];
    item[0] = mitem_id(sq, h, 0, c);
    item[1] = mitem_id(sq, h, 1, nc - 1 - c);
    u32x4 cr[8];
    {
      const bf16_t* cst0 = p.CST + (size_t)item[0] * 16384;
#pragma unroll
      for (int i = 0; i < 8; ++i) cr[i] = *(const u32x4*)(cst0 + (tid + 256 * i) * 8);
    }
    __syncthreads();
#pragma unroll
    for (int dir = 0; dir < 2; ++dir) {
      const int j = dir ? nc - 1 - c : c;
      mst[dir] = p.SCM[item[dir]];
      if (wave == 0) {
        float ig, lf;
        mlstm_gates(p, rowbase, nc, h, dir, j, lane, ig, lf);
        const float b = scan_add(lf, lane);
        const float a = ig - b;
        const float pm = scan_max(a, lane);
        const float mt = b + fmaxf(mst[dir], pm);
        const int so = dir ? 63 - lane : lane;
        sB[dir * 64 + so] = b; sA[dir * 64 + so] = a; sMT[dir * 64 + so] = mt;
      }
    }
    for (int c = tid; c < 64 * 16; c += 256) {
      const int r = c >> 4, ch = c & 15;
      *(uint4*)(sK + (ch >> 2) * 2048 + r * 32 + (((ch & 3) ^ ((4 - ((r >> 2) & 3)) & 3)) * 8)) = *(const uint4*)(p.U1 + (size_t)(row0 + r) * OIN + 512 + h * 128 + ch * 8);
    }
    stage_T64<128>(sVT, p.U1 + (size_t)row0 * OIN + 1024 + h * 128, OIN, nullptr);
#pragma unroll
    for (int i = 0; i < 8; ++i) {
      const int cc = tid + 256 * i, r = cc >> 4, ch = cc & 15;
      *(u32x4*)(sC + (ch >> 2) * 4096 + r * 32 + (((ch & 3) ^ ((4 - ((r >> 2) & 3)) & 3)) * 8)) = cr[i];
    }
    bf16x8 qf[4];
    const int tq = wave * 16 + l16;
    const int row = row0 + tq;
#pragma unroll
    for (int ks = 0; ks < 4; ++ks) qf[ks] = *(const bf16x8*)(p.U1 + (size_t)row * OIN + h * 128 + ks * 32 + g * 8);
    __syncthreads();
    f32x4 hsum[8];
#pragma unroll
    for (int i = 0; i < 8; ++i) hsum[i] = f32x4{0.f, 0.f, 0.f, 0.f};
#pragma unroll 1
    for (int dir = 0; dir < 2; ++dir) {
      const float bt = sB[dir * 64 + tq], mtt = sMT[dir * 64 + tq];
      const float mst_d = dir ? mst[1] : mst[0];
      const int item_d = dir ? item[1] : item[0];
      const float w_inter = fexp(bt + mst_d - mtt);
      const float et = bt - mtt;
      if (dir == 0) {
        const bf16_t* cst1 = p.CST + (size_t)item[1] * 16384;
#pragma unroll
        for (int i = 0; i < 8; ++i) cr[i] = *(const u32x4*)(cst1 + (tid + 256 * i) * 8);
      }
      f32x4 s[4];
      float dsum = 0.f;
#pragma unroll
      for (int t = 0; t < 4; ++t) {
        s[t] = f32x4{0.f, 0.f, 0.f, 0.f};
#pragma unroll
        for (int ks = 0; ks < 4; ++ks) {
          const bf16x8 kf = *(const bf16x8*)(sK + ks * 2048 + (t * 16 + l16) * 32 + ((g ^ ((4 - (l16 >> 2)) & 3)) * 8));
          s[t] = MFMA16(kf, qf[ks], s[t]);
        }
#pragma unroll
        for (int j = 0; j < 4; ++j) {
          const int sk = t * 16 + g * 4 + j;
          const bool ok = dir ? (sk >= tq) : (sk <= tq);
          const float w = ok ? fexp(et + sA[dir * 64 + sk]) : 0.f;
          s[t][j] *= w;
          dsum += s[t][j];
        }
      }
      dsum = xsum_16_32(dsum);
      f32x4 acc[8];
#pragma unroll
      for (int vt = 0; vt < 8; ++vt) {
        acc[vt] = f32x4{0.f, 0.f, 0.f, 0.f};
#pragma unroll
        for (int ks = 0; ks < 4; ++ks) {
          const bf16x8 cf = *(const bf16x8*)(sC + ks * 4096 + (vt * 16 + l16) * 32 + ((g ^ ((4 - (l16 >> 2)) & 3)) * 8));
          acc[vt] = MFMA16(cf, qf[ks], acc[vt]);
        }
        acc[vt] *= w_inter;
        if ((vt & 3) == 3) asm volatile("" ::: "memory");
      }
#pragma unroll
      for (int kb = 0; kb < 2; ++kb) {
        bf16x8 pf;
#pragma unroll
        for (int j = 0; j < 4; ++j) { pf[j] = (short)f2bf(s[2 * kb][j]); pf[4 + j] = (short)f2bf(s[2 * kb + 1][j]); }
#pragma unroll
        for (int vt = 0; vt < 8; ++vt) {
          const bf16_t* vp = sVT + (vt * 16 + l16) * LDT + kb * 32 + g * 4;
          const bf16x4 lo = *(const bf16x4*)(vp);
          const bf16x4 hi = *(const bf16x4*)(vp + 16);
          const bf16x8 vf = __builtin_shufflevector(lo, hi, 0, 1, 2, 3, 4, 5, 6, 7);
          acc[vt] = MFMA16(vf, pf, acc[vt]);
        }
      }
      float nq = 0.f;
      const float* nst = p.NST + (size_t)item_d * 128;
#pragma unroll
      for (int ks = 0; ks < 4; ++ks) {
        const float4 n0 = *(const float4*)(nst + ks * 32 + g * 8), n1 = *(const float4*)(nst + ks * 32 + g * 8 + 4);
        nq += n0.x * bf2f((bf16_t)qf[ks][0]) + n0.y * bf2f((bf16_t)qf[ks][1]) + n0.z * bf2f((bf16_t)qf[ks][2]) + n0.w * bf2f((bf16_t)qf[ks][3]);
        nq += n1.x * bf2f((bf16_t)qf[ks][4]) + n1.y * bf2f((bf16_t)qf[ks][5]) + n1.z * bf2f((bf16_t)qf[ks][6]) + n1.w * bf2f((bf16_t)qf[ks][7]);
      }
      nq = xsum_16_32(nq);
      const float den = w_inter * nq + dsum;
      const float dinv = 1.f / fmaxf(fabsf(den), fexp(-mtt));
#pragma unroll
      for (int vt = 0; vt < 8; ++vt) hsum[vt] += acc[vt] * dinv;
      if (dir == 0) {
        __syncthreads();
#pragma unroll
        for (int i = 0; i < 8; ++i) {
          const int cc = tid + 256 * i, r = cc >> 4, ch = cc & 15;
          *(u32x4*)(sC + (ch >> 2) * 4096 + r * 32 + (((ch & 3) ^ ((4 - ((r >> 2) & 3)) & 3)) * 8)) = cr[i];
        }
        __syncthreads();
      }
    }
    const bf16_t* u = p.U1 + (size_t)row * OIN;
    float ss = 0.f;
#pragma unroll
    for (int vt = 0; vt < 8; ++vt) {
      const uint2 ow = *(const uint2*)(u + 1536 + h * 128 + vt * 16 + g * 4);
      hsum[vt][0] *= sigmf(lo2f(ow.x)); hsum[vt][1] *= sigmf(hi2f(ow.x));
      hsum[vt][2] *= sigmf(lo2f(ow.y)); hsum[vt][3] *= sigmf(hi2f(ow.y));
#pragma unroll
      for (int j = 0; j < 4; ++j) ss += hsum[vt][j] * hsum[vt][j];
    }
    ss = xsum_16_32(ss);
    const float r = rsqrtf(ss * (1.f / 128.f) + EPSF);
#pragma unroll
    for (int vt = 0; vt < 8; ++vt) {
      const int v = h * 128 + vt * 16 + g * 4;
      const uint2 zw = *(const uint2*)(u + 2064 + v);
      const float4 gn = *(const float4*)(p.o_mnorm_g + v);
      f32x4 rr;
      rr[0] = hsum[vt][0] * r * gn.x * siluf(lo2f(zw.x)); rr[1] = hsum[vt][1] * r * gn.y * siluf(hi2f(zw.x));
      rr[2] = hsum[vt][2] * r * gn.z * siluf(lo2f(zw.y)); rr[3] = hsum[vt][3] * r * gn.w * siluf(hi2f(zw.y));
      store_bf4(p.O + (size_t)row * 1024 + v, rr);
    }
  }
}

DI void phase_final(const Params& p) {
  const int tid = TIDX, lane = tid & 63, wave = tid >> 6;
  for (int it = VBLK; it < NROW / 4; it += NVBLK) {
    const int row = it * 4 + wave;
    const bf16_t* x = p.X1B + (size_t)row * 1024;
    float4 v[4];
    float ss = 0.f;
#pragma unroll
    for (int i = 0; i < 4; ++i) {
      v[i] = load_bf4(x + i * 256 + lane * 4);
      ss += v[i].x * v[i].x + v[i].y * v[i].y + v[i].z * v[i].z + v[i].w * v[i].w;
    }
    ss = wave_sum(ss);
    const float r = rsqrtf(ss * (1.f / 1024.f) + EPSF);
#pragma unroll
    for (int i = 0; i < 4; ++i) {
      const int col = i * 256 + lane * 4;
      const float4 gg = *(const float4*)(p.final_g + col);
      *(float4*)(p.out + O_Y + (size_t)row * 1024 + col) = make_float4(v[i].x * r * gg.x, v[i].y * r * gg.y, v[i].z * r * gg.z, v[i].w * r * gg.w);
    }
  }
}


#define XB_TMO      128
#define XB_XCNT(j)  (256  + 64 * (j))
#define XB_XSUB(j)  (1280 + 64 * (j))
#define XB_XGEN(j)  (2304 + 64 * (j))
#define XB_TOP      3328
#define XB_TOPGEN   3392
#define XCD_BAR_WORDS 3456
#define XB_SPIN_CAP (1u << 18)
#define LAS __attribute__((address_space(3)))
DI unsigned xb_ld(unsigned* p) { return __hip_atomic_load(p, __ATOMIC_RELAXED, __HIP_MEMORY_SCOPE_AGENT); }
DI unsigned xb_add(unsigned* p, unsigned v) { return __hip_atomic_fetch_add(p, v, __ATOMIC_RELAXED, __HIP_MEMORY_SCOPE_AGENT); }
DI unsigned xb_xcc_id() { return (unsigned)__builtin_amdgcn_s_getreg((3 << 11) | 20) & 0xFu; }
#define XB_SPIN(cond, bar) do { unsigned _sp = 0; while (cond) { __builtin_amdgcn_s_sleep(1); \
    if ((++_sp & 255u) == 0u) { if (xb_ld(&(bar)[XB_TMO])) break; if (_sp > XB_SPIN_CAP) { atomicAdd(&(bar)[XB_TMO], 1u); break; } } } } while (0)
struct XcdBarrier { unsigned* bar; unsigned x; volatile LAS unsigned* st; };
DI XcdBarrier xcd_barrier_post(unsigned* bar, volatile LAS unsigned* st) {
  XcdBarrier b; b.bar = bar; b.x = xb_xcc_id(); b.st = st;
  if (threadIdx.x == 0) (void)xb_add(&bar[XB_XCNT(b.x)], 1u);
  return b;
}
DI void xcd_barrier_complete(unsigned* bar, unsigned x, unsigned& nloc, unsigned& nx) {
  const unsigned G = gridDim.x * gridDim.y * gridDim.z;
  unsigned sum, cnt, mine, sp = 0u;
  for (;;) {
    sum = 0u; cnt = 0u; mine = 0u;
#pragma unroll
    for (unsigned j = 0; j < 16; ++j) { const unsigned c = xb_ld(&bar[XB_XCNT(j)]); sum += c; cnt += (c > 0u) ? 1u : 0u; mine = (j == x) ? c : mine; }
    if (sum == G) break;
    __builtin_amdgcn_s_sleep(1);
    if ((++sp & 255u) == 0u) { if (xb_ld(&bar[XB_TMO])) break; if (sp > XB_SPIN_CAP) { atomicAdd(&bar[XB_TMO], 1u); break; } }
  }
  nloc = mine > 0u ? mine : 1u; nx = cnt > 0u ? cnt : 1u;
}
DI void xcd_barrier(const XcdBarrier& b) {
  asm volatile("s_waitcnt vmcnt(0)" ::: "memory");
  __syncthreads();
  if (threadIdx.x == 0) {
    unsigned* bar = b.bar;
    __builtin_amdgcn_s_waitcnt(0);
    unsigned nloc = b.st[0], nx = b.st[1];
    if (nloc == 0u) { xcd_barrier_complete(bar, b.x, nloc, nx); b.st[0] = nloc; b.st[1] = nx; }
    const unsigned old = xb_add(&bar[XB_XSUB(b.x)], 1u);
    const unsigned gen = old / nloc;
    if (old + 1u == (gen + 1u) * nloc) {
      __builtin_amdgcn_fence(__ATOMIC_RELEASE, "agent");
      asm volatile("s_waitcnt vmcnt(0)" ::: "memory");
      const unsigned og = xb_add(&bar[XB_TOP], 1u);
      const unsigned tg = og / nx;
      if (og + 1u == (tg + 1u) * nx) xb_add(&bar[XB_TOPGEN], 1u);
      else XB_SPIN(xb_ld(&bar[XB_TOPGEN]) == tg, bar);
      __builtin_amdgcn_fence(__ATOMIC_ACQUIRE, "agent");
      xb_add(&bar[XB_XGEN(b.x)], 1u);
      asm volatile("s_waitcnt vmcnt(0)" ::: "memory");
    } else {
      XB_SPIN(xb_ld(&bar[XB_XGEN(b.x)]) == gen, bar);
      __builtin_amdgcn_fence(__ATOMIC_ACQUIRE, "agent");
      asm volatile("s_waitcnt vmcnt(0)" ::: "memory");
    }
  }
  __syncthreads();
}

DI void run_phase(const Params& p, char* smem0, int ph) {
  char* smem = smem0 + (ltid() >> 8) * GRP_LDS;
  switch (ph) {
    case 0: phase0(p, smem); break;
    case 1: phase0b(p, smem); wait_mod_ready(p); phase_norm(p, 0); break;
    case 2: phase_gemm_in(p, 0, smem0); break;
    case 3: phase3(p); break;
    case 4: phase_gemm_mla(p, smem0); if (NVBLK >= 512) late_weight_prep(p, smem, 352, 0, 800); else late_weight_prep(p, smem, 0, 0, 1424); break;
    case 5: phase_attn0(p, smem0); break;
    case 6: if (NVBLK >= 384) phase_out_norm_fused(p, 0, smem); else phase_gemm_out(p, 0, smem); if (NVBLK >= 512) late_weight_prep(p, smem, 384, 800, 1424); break;
    case 7: if (NVBLK < 384) phase_norm(p, 1); break;
    case 8: phase_gemm_in(p, 1, smem0); break;
    case 9: phase9(p, smem); break;
    case 10: phase10(p, smem0); break;
    case 11: phase11(p, smem); break;
    case 12: if (NVBLK >= 384) phase_out_norm_fused(p, 1, smem); else phase_gemm_out(p, 1, smem); break;
    case 13: if (NVBLK < 384) phase_final(p); break;
  }
}

__global__ void __launch_bounds__(512, 2) mk_fwd(Params p) {
#if SINGLE_LAUNCH
  extern __shared__ __attribute__((aligned(16))) char smem[];
  __shared__ uint4 xb_words;
  if (threadIdx.x == 0) xb_words = make_uint4(0u, 0u, 0u, 0u);
  __syncthreads();
  const XcdBarrier xb = xcd_barrier_post(p.BAR, (volatile LAS unsigned*)&xb_words);
  if (p.phase_hi == 12345) {
    const unsigned long long* ia = (const unsigned long long*)__builtin_amdgcn_implicitarg_ptr();
    p.BAR[XB_TMO] = (unsigned)ia[11];
  }
  run_phase(p, smem, 0);
  run_phase(p, smem, 1); xcd_barrier(xb);
  run_phase(p, smem, 2); xcd_barrier(xb);
  run_phase(p, smem, 3); xcd_barrier(xb);
  run_phase(p, smem, 4); xcd_barrier(xb);
  run_phase(p, smem, 5); xcd_barrier(xb);
  run_phase(p, smem, 6); xcd_barrier(xb);
  if (NVBLK < 384) { run_phase(p, smem, 7); xcd_barrier(xb); }
  run_phase(p, smem, 8); xcd_barrier(xb);
  run_phase(p, smem, 9); xcd_barrier(xb);
  run_phase(p, smem, 10); xcd_barrier(xb);
  run_phase(p, smem, 11); xcd_barrier(xb);
  run_phase(p, smem, 12);
  if (NVBLK < 384) { xcd_barrier(xb); run_phase(p, smem, 13); }
#endif
}

template <int PH>
__global__ void __launch_bounds__(512, 2) mk_phase(Params p) {
  extern __shared__ __attribute__((aligned(16))) char smem[];
  run_phase(p, smem, PH);
}
template <int PH>
static void launch_phases(const Params& p, hipStream_t stream) {
  hipFuncSetAttribute((const void*)mk_phase<PH>, hipFuncAttributeMaxDynamicSharedMemorySize, LDS_BYTES);
  hipLaunchKernelGGL(mk_phase<PH>, dim3(256), dim3(512), LDS_BYTES, stream, p);
  if constexpr (PH + 1 < NPHASE) launch_phases<PH + 1>(p, stream);
}

extern "C" void kernel_launch(void* const* d_in, const int* in_sizes, int n_in, void* d_out, int out_size, void* d_ws, size_t ws_size, hipStream_t stream) {
  Params p{};
  const float** fp = (const float**)&p;
  for (int i = 0; i < 34; ++i) fp[i] = (const float*)d_in[i];
  p.out = (float*)d_out;
  char* w = (char*)d_ws;
  size_t off = 0;
  auto take = [&](size_t bytes) { char* r = w + off; off += (bytes + 255) & ~(size_t)255; return r; };
  p.BAR = (unsigned*)take(XCD_BAR_WORDS * 4);
  p.CNT = (unsigned*)take((2 * 48 * 64 + 64) * 4);
  p.SSQ = (float*)take((size_t)2 * NROW * 8 * 4);
  p.MOD = (float*)take(2 * 3 * 3072 * 4);
  p.LAMV = (float*)take(256);
  p.ROPE32 = (float2*)take(1024 * 16 * 8);
  p.ROPE64 = (float2*)take(1024 * 32 * 8);
  p.WinE = (bf16_t*)take((size_t)EIN_PAD * 1024 * 2);
  p.WinO = (bf16_t*)take((size_t)OIN_PAD * 1024 * 2);
  p.Wuq = (bf16_t*)take(768 * 384 * 2);
  p.Wukv = (bf16_t*)take(1024 * 256 * 2);
  p.WoutE = (bf16_t*)take(1024 * 1024 * 2);
  p.WoutO = (bf16_t*)take(1024 * 1024 * 2);
  p.H = (bf16_t*)take((size_t)NROW * 1024 * 2);
  p.O = (bf16_t*)take((size_t)NROW * 1024 * 2);
  p.X1 = (float*)take(256);
  p.X1B = (bf16_t*)take((size_t)NROW * 1024 * 2);
  p.SC = (float*)take(768 * 4 * 4);
  p.SCM = (float*)take(768 * 4);
  p.UC = (bf16_t*)take((size_t)768 * 16384 * 2);
  p.NU = (float*)take(768 * 128 * 4);
  p.NST = (float*)take(768 * 128 * 4);
  p.OP = (bf16_t*)take((size_t)128 * 2 * 2 * 4 * 8 * 64 * 8);
  p.ML = (float*)take((size_t)128 * 2 * 2 * 4 * 64 * 8);
  p.CST = (bf16_t*)take((size_t)768 * 16384 * 2);
  const size_t region = off;
  p.U0 = (bf16_t*)take((size_t)NROW * EIN * 2);
  p.CQN = (bf16_t*)take((size_t)NROW * 384 * 2);
  p.CKVN = (bf16_t*)take((size_t)NTROW * 256 * 2);
  p.KR = (bf16_t*)take((size_t)NTROW * 32 * 2);
  p.QB = (bf16_t*)take((size_t)NROW * 512 * 2);
  p.KB = (bf16_t*)take((size_t)NTROW * 128 * 2);
  p.VB = (bf16_t*)take((size_t)NTROW * 128 * 2);
  p.Q = (bf16_t*)take((size_t)NROW * 768 * 2);
  p.KV = (bf16_t*)take((size_t)NTROW * 1024 * 2);
  const size_t end0 = off;
  off = region;
  p.U1 = (bf16_t*)take((size_t)NROW * OIN * 2);
  p.QD = (bf16_t*)take((size_t)NROW * 512 * 2);
  p.KD = (bf16_t*)take((size_t)NTROW * 512 * 2);
  p.VD = (bf16_t*)take((size_t)NTROW * 512 * 2);
  const size_t end1 = off;
  const size_t need = end0 > end1 ? end0 : end1;
  if (need > ws_size) { fprintf(stderr, "workspace too small: need %zu have %zu\n", need, ws_size); return; }

#if SINGLE_LAUNCH
  static int grid_blocks = 0;
  if (!grid_blocks) {
    int dev = 0, cus = 0, per_cu = 0;
    hipGetDevice(&dev);
    hipDeviceGetAttribute(&cus, hipDeviceAttributeMultiprocessorCount, dev);
    hipFuncSetAttribute((const void*)mk_fwd, hipFuncAttributeMaxDynamicSharedMemorySize, LDS_BYTES);
    hipOccupancyMaxActiveBlocksPerMultiprocessor(&per_cu, mk_fwd, 512, LDS_BYTES);
    if (per_cu < 1) per_cu = 1;
    grid_blocks = cus;
  }
  p.phase_lo = 0; p.phase_hi = NPHASE;
  hipMemsetAsync(p.BAR, 0, (size_t)((char*)(p.CNT + 2 * 48 * 64 + 64) - (char*)p.BAR), stream);
  void* args[] = {&p};
  hipError_t e = hipLaunchCooperativeKernel((void*)mk_fwd, dim3(grid_blocks), dim3(512), args, LDS_BYTES, stream);
  if (e != hipSuccess) fprintf(stderr, "cooperative launch failed: %s (grid %d)\n", hipGetErrorString(e), grid_blocks);
#else
  launch_phases<0>(p, stream);
#endif
}
```

```cpp
#include <hip/hip_runtime.h>
#include <hip/hip_cooperative_groups.h>
#include <cstdio>
namespace cg = cooperative_groups;

typedef unsigned short bf16_t;
using bf16x8 = __attribute__((ext_vector_type(8))) short;
using bf16x4 = __attribute__((ext_vector_type(4))) short;
using f32x4  = __attribute__((ext_vector_type(4))) float;
using u32x4  = __attribute__((ext_vector_type(4))) unsigned;
#define DI __device__ __forceinline__
#define MFMA16(a, b, c) __builtin_amdgcn_mfma_f32_16x16x32_bf16((a), (b), (c), 0, 0, 0)

#ifndef SINGLE_LAUNCH
#define SINGLE_LAUNCH 1
#endif

__device__ __forceinline__ unsigned ltid() { unsigned t = threadIdx.x; asm volatile("" : "+v"(t)); return t; }
#define TIDX ((int)(ltid() & 255u))
#define VBLK ((int)(blockIdx.x * 2 + (ltid() >> 8)))
#define NVBLK ((int)(gridDim.x * 2))
DI int vblk_xcd() {
  const int b = blockIdx.x, nb = gridDim.x;
  if (nb & 7) return VBLK;
  return ((b & 7) * (nb >> 3) + (b >> 3)) * 2 + (int)(ltid() >> 8);
}
constexpr int EIN = 2464, OIN = 4624;
constexpr int EIN_PAD = 2560, OIN_PAD = 4864;
constexpr int NROW = 6144, NTROW = 6656;
constexpr int NPHASE = 14;
constexpr int LDS_BYTES = 139264;
constexpr int GRP_LDS = 69632;
constexpr int LDT = 72;
constexpr float EPSF = 1e-6f;
constexpr float LAM_INIT = 0.35550906759097f;
constexpr size_t O_Y = 0, O_CKV = 6291456, O_KR = 7340032, O_GK = 7471104, O_GV = 7995392, O_C = 8519680,
                 O_N = 10616832, O_M = 10633216, O_DK = 10633344, O_DV = 12730496;

struct Params {
  const float *x_prompt, *x_sample, *cache_ckv, *cache_kr, *cache_gk, *cache_gv, *st_C, *st_n, *st_m, *cache_dk, *cache_dv, *c, *c_ctx;
  const float *e_norm_g, *e_ada_w, *e_ada_b, *e_w_in, *e_qn_g, *e_w_uq, *e_kvn_g, *e_w_ukv, *e_gq_g, *e_gk_g, *e_w_out;
  const float *o_norm_g, *o_ada_w, *o_ada_b, *o_w_in, *o_gate_b, *o_mnorm_g, *o_lam, *o_dnorm_g, *o_w_out, *final_g;
  float* out;
  float *MOD, *LAMV;
  float2 *ROPE32, *ROPE64;
  bf16_t *WinE, *WinO, *Wuq, *Wukv, *WoutE, *WoutO;
  bf16_t *H, *U0, *U1, *CQN, *CKVN, *KR, *QB, *KB, *VB, *Q, *KV, *O, *QD, *KD, *VD, *CST;
  float *X1, *SC, *NU, *NST, *ML, *SCM;
  bf16_t *X1B, *UC, *OP;
  unsigned* BAR;
  unsigned* CNT;
  float* SSQ;
  int phase_lo, phase_hi;
};

DI bf16_t f2bf(float x) { unsigned u = __float_as_uint(x); u += 0x7fffu + ((u >> 16) & 1u); return (bf16_t)(u >> 16); }
DI float bf2f(bf16_t b) { return __uint_as_float(((unsigned)b) << 16); }
typedef __bf16 bf2_t __attribute__((ext_vector_type(2)));
typedef float f2_t __attribute__((ext_vector_type(2)));
DI unsigned pack2(float a, float b) { f2_t v = {a, b}; return __builtin_bit_cast(unsigned, __builtin_convertvector(v, bf2_t)); }
DI float lo2f(unsigned w) { return __uint_as_float(w << 16); }
DI float hi2f(unsigned w) { return __uint_as_float(w & 0xffff0000u); }
DI float xsum_16_32(float x) {
  auto a = __builtin_amdgcn_permlane16_swap(__float_as_uint(x), __float_as_uint(x), false, false);
  const float s = __uint_as_float(a[0]) + __uint_as_float(a[1]);
  auto b = __builtin_amdgcn_permlane32_swap(__float_as_uint(s), __float_as_uint(s), false, false);
  return __uint_as_float(b[0]) + __uint_as_float(b[1]);
}
DI float xmax_16_32(float x) {
  auto a = __builtin_amdgcn_permlane16_swap(__float_as_uint(x), __float_as_uint(x), false, false);
  const float s = fmaxf(__uint_as_float(a[0]), __uint_as_float(a[1]));
  auto b = __builtin_amdgcn_permlane32_swap(__float_as_uint(s), __float_as_uint(s), false, false);
  return fmaxf(__uint_as_float(b[0]), __uint_as_float(b[1]));
}
#define DPPF(v, CTRL) __uint_as_float((unsigned)__builtin_amdgcn_mov_dpp((int)__float_as_uint(v), (CTRL), 0xF, 0xF, true))
DI float wave_sum(float v) {
  v += DPPF(v, 0xB1); v += DPPF(v, 0x4E); v += DPPF(v, 0x141); v += DPPF(v, 0x140);
  return xsum_16_32(v);
}
DI float wave_max(float v) {
  v = fmaxf(v, DPPF(v, 0xB1)); v = fmaxf(v, DPPF(v, 0x4E)); v = fmaxf(v, DPPF(v, 0x141)); v = fmaxf(v, DPPF(v, 0x140));
  return xmax_16_32(v);
}
#define DPPU(IDENT, v, CTRL, RMASK) __uint_as_float((unsigned)__builtin_amdgcn_update_dpp((int)__float_as_uint(IDENT), (int)__float_as_uint(v), (CTRL), (RMASK), 0xF, false))
DI float scan_add(float v, int) {
  v += DPPU(0.f, v, 0x111, 0xF); v += DPPU(0.f, v, 0x112, 0xF); v += DPPU(0.f, v, 0x114, 0xF); v += DPPU(0.f, v, 0x118, 0xF);
  v += DPPU(0.f, v, 0x142, 0xA);
  v += DPPU(0.f, v, 0x143, 0xC);
  return v;
}
DI float scan_max(float v, int) {
  const float ninf = -INFINITY;
  v = fmaxf(v, DPPU(ninf, v, 0x111, 0xF)); v = fmaxf(v, DPPU(ninf, v, 0x112, 0xF)); v = fmaxf(v, DPPU(ninf, v, 0x114, 0xF)); v = fmaxf(v, DPPU(ninf, v, 0x118, 0xF));
  v = fmaxf(v, DPPU(ninf, v, 0x142, 0xA));
  v = fmaxf(v, DPPU(ninf, v, 0x143, 0xC));
  return v;
}
DI float fexp(float x) { return __builtin_amdgcn_exp2f(x * 1.4426950408889634f); }
DI float logsig(float x) { return fminf(x, 0.f) - log1pf(fexp(-fabsf(x))); }
DI float siluf(float x) { return x * __builtin_amdgcn_rcpf(1.f + fexp(-x)); }
DI float sigmf(float x) { return __builtin_amdgcn_rcpf(1.f + fexp(-x)); }
DI int cv_of_row(int row) { return row < 4096 ? 0 : 1 + ((row - 4096) >> 10); }
DI const float* xrow(const Params& p, int row) { return row < 4096 ? p.x_prompt + (size_t)row * 1024 : p.x_sample + (size_t)(row - 4096) * 1024; }

template <class Epi>
DI void gemm_tile(const bf16_t* __restrict__ X, int ldx, const bf16_t* __restrict__ W, int ldw, int N, int K, int m0, int n0, char* smem, Epi epi) {
  constexpr int LDG = 32;
  constexpr int BUFE = 256 * LDG;
  bf16_t* sb = (bf16_t*)smem;
  const int tid = TIDX, lane = tid & 63, wave = tid >> 6, wm = wave >> 1, wn = wave & 1;
  const int g = lane >> 4, l16 = lane & 15;
  f32x4 acc[4][4];
#pragma unroll
  for (int a = 0; a < 4; ++a)
#pragma unroll
    for (int b = 0; b < 4; ++b) acc[a][b] = f32x4{0.f, 0.f, 0.f, 0.f};
  const int lr = tid >> 2, lc = (tid & 3) * 8;
  const int lcs = ((tid & 3) ^ ((4 - ((lr >> 2) & 3)) & 3)) * 8;
  const int gs = (g ^ ((4 - (l16 >> 2)) & 3)) * 8;
  unsigned xoff[2], woff[2];
#pragma unroll
  for (int i = 0; i < 2; ++i) {
    xoff[i] = (unsigned)((m0 + lr + 64 * i) * ldx + lc);
    int n = n0 + lr + 64 * i; if (n > N - 1) n = N - 1;
    woff[i] = (unsigned)(n * ldw + lc);
  }
  const int nk = K >> 5;
  u32x4 rx[3][2], rw[3][2];
#define G_LOAD(S, KT) { const bf16_t* xb_ = X + (KT) * 32; const bf16_t* wb_ = W + (KT) * 32; \
    rx[S][0] = *(const u32x4*)(xb_ + xoff[0]); rx[S][1] = *(const u32x4*)(xb_ + xoff[1]); \
    rw[S][0] = *(const u32x4*)(wb_ + woff[0]); rw[S][1] = *(const u32x4*)(wb_ + woff[1]); }
#define G_STORE(S, B) { bf16_t* d_ = sb + (B) * BUFE + lr * LDG + lcs; \
    *(u32x4*)(d_) = rx[S][0]; *(u32x4*)(d_ + 64 * LDG) = rx[S][1]; \
    *(u32x4*)(d_ + 128 * LDG) = rw[S][0]; *(u32x4*)(d_ + 192 * LDG) = rw[S][1]; }
#define G_COMPUTE(B) { const bf16_t* bx_ = sb + (B) * BUFE; const bf16_t* bw_ = bx_ + 128 * LDG; \
    bf16x8 wf[4], xf[4]; \
    _Pragma("unroll") for (int i = 0; i < 4; ++i) { \
      wf[i] = *(const bf16x8*)(bw_ + (wn * 64 + i * 16 + l16) * LDG + gs); \
      xf[i] = *(const bf16x8*)(bx_ + (wm * 64 + i * 16 + l16) * LDG + gs); } \
    _Pragma("unroll") for (int ni = 0; ni < 4; ++ni) \
      _Pragma("unroll") for (int mi = 0; mi < 4; ++mi) acc[ni][mi] = MFMA16(wf[ni], xf[mi], acc[ni][mi]); }
#define G_STEP(KK, RL, RS) if ((KK) < nk) { \
    if ((KK) + 1 < nk) G_STORE(RS, ((KK) + 1) & 1) \
    if ((KK) + 3 < nk) G_LOAD(RL, (KK) + 3) \
    G_COMPUTE((KK) & 1) \
    __syncthreads(); }
  G_LOAD(0, 0) G_LOAD(1, 1) G_LOAD(2, 2)
  __syncthreads();
  G_STORE(0, 0)
  __syncthreads();
  for (int k0 = 0; k0 < nk; k0 += 3) {
    G_STEP(k0, 0, 1)
    G_STEP(k0 + 1, 1, 2)
    G_STEP(k0 + 2, 2, 0)
  }
#undef G_LOAD
#undef G_STORE
#undef G_COMPUTE
#undef G_STEP
#pragma unroll
  for (int ni = 0; ni < 4; ++ni) {
    const int n = n0 + wn * 64 + ni * 16 + g * 4;
    if (n < N) {
#pragma unroll
      for (int mi = 0; mi < 4; ++mi) epi(m0 + wm * 64 + mi * 16 + l16, n, acc[ni][mi]);
    }
  }
}

template <class Epi>
DI void gemm_tile64(const bf16_t* __restrict__ X, int ldx, const bf16_t* __restrict__ W, int ldw, int N, int K, int m0, int n0, char* smem, Epi epi) {
  constexpr int PANE = 256 * 32;
  constexpr int BUFE = 2 * PANE;
  bf16_t* sb = (bf16_t*)smem;
  const int tid = TIDX, lane = tid & 63, wave = tid >> 6, wm = wave >> 1, wn = wave & 1;
  const int g = lane >> 4, l16 = lane & 15;
  f32x4 acc[4][4];
#pragma unroll
  for (int a = 0; a < 4; ++a)
#pragma unroll
    for (int b = 0; b < 4; ++b) acc[a][b] = f32x4{0.f, 0.f, 0.f, 0.f};
  const int lr = tid >> 3, ch = tid & 7;
  const int soff = (ch >> 2) * PANE + lr * 32 + (((ch & 3) ^ ((4 - ((lr >> 2) & 3)) & 3)) * 8);
  const int gs = (g ^ ((4 - (l16 >> 2)) & 3)) * 8;
  unsigned xoff[4], woff[4];
#pragma unroll
  for (int i = 0; i < 4; ++i) {
    xoff[i] = (unsigned)((m0 + lr + 32 * i) * ldx + ch * 8);
    int n = n0 + lr + 32 * i; if (n > N - 1) n = N - 1;
    woff[i] = (unsigned)(n * ldw + ch * 8);
  }
  const int nk = K >> 6;
  u32x4 rx[2][4], rw[2][4];
#define H_LOAD(S, KT) { const bf16_t* xb_ = X + (KT) * 64; const bf16_t* wb_ = W + (KT) * 64; \
    _Pragma("unroll") for (int i = 0; i < 4; ++i) { rx[S][i] = *(const u32x4*)(xb_ + xoff[i]); rw[S][i] = *(const u32x4*)(wb_ + woff[i]); } }
#define H_STORE(S, B) { bf16_t* d_ = sb + (B) * BUFE + soff; \
    _Pragma("unroll") for (int i = 0; i < 4; ++i) { *(u32x4*)(d_ + (32 * i) * 32) = rx[S][i]; *(u32x4*)(d_ + (128 + 32 * i) * 32) = rw[S][i]; } }
#define H_COMPUTE(B) { _Pragma("unroll") for (int ks = 0; ks < 2; ++ks) { const bf16_t* bx_ = sb + (B) * BUFE + ks * PANE; const bf16_t* bw_ = bx_ + 128 * 32; \
    bf16x8 wf[4], xf[4]; \
    _Pragma("unroll") for (int i = 0; i < 4; ++i) { \
      wf[i] = *(const bf16x8*)(bw_ + (wn * 64 + i * 16 + l16) * 32 + gs); \
      xf[i] = *(const bf16x8*)(bx_ + (wm * 64 + i * 16 + l16) * 32 + gs); } \
    _Pragma("unroll") for (int ni = 0; ni < 4; ++ni) \
      _Pragma("unroll") for (int mi = 0; mi < 4; ++mi) acc[ni][mi] = MFMA16(wf[ni], xf[mi], acc[ni][mi]); } }
#define H_STEP(KK, SL) if ((KK) < nk) { \
    if ((KK) + 1 < nk) H_STORE((SL) ^ 1, ((KK) + 1) & 1) \
    if ((KK) + 2 < nk) H_LOAD(SL, (KK) + 2) \
    H_COMPUTE((KK) & 1) \
    __syncthreads(); }
  H_LOAD(0, 0)
  if (nk > 1) H_LOAD(1, 1)
  __syncthreads();
  H_STORE(0, 0)
  __syncthreads();
  for (int k0 = 0; k0 < nk; k0 += 2) {
    H_STEP(k0, 0)
    H_STEP(k0 + 1, 1)
  }
#undef H_LOAD
#undef H_STORE
#undef H_COMPUTE
#undef H_STEP
#pragma unroll
  for (int ni = 0; ni < 4; ++ni) {
    const int n = n0 + wn * 64 + ni * 16 + g * 4;
    if (n < N) {
#pragma unroll
      for (int mi = 0; mi < 4; ++mi) epi(m0 + wm * 64 + mi * 16 + l16, n, acc[ni][mi]);
    }
  }
}

DI void gemm_tile64_acc(const bf16_t* __restrict__ X, int ldx, const bf16_t* __restrict__ W, int ldw, int N, int K, int m0, int n0, char* smem, f32x4 (&acc)[4][4]) {
  constexpr int PANE = 256 * 32;
  constexpr int BUFE = 2 * PANE;
  bf16_t* sb = (bf16_t*)smem;
  const int tid = TIDX, lane = tid & 63, wave = tid >> 6, wm = wave >> 1, wn = wave & 1;
  const int g = lane >> 4, l16 = lane & 15;
#pragma unroll
  for (int a = 0; a < 4; ++a)
#pragma unroll
    for (int b = 0; b < 4; ++b) acc[a][b] = f32x4{0.f, 0.f, 0.f, 0.f};
  const int lr = tid >> 3, ch = tid & 7;
  const int soff = (ch >> 2) * PANE + lr * 32 + (((ch & 3) ^ ((4 - ((lr >> 2) & 3)) & 3)) * 8);
  const int gs = (g ^ ((4 - (l16 >> 2)) & 3)) * 8;
  unsigned xoff[4], woff[4];
#pragma unroll
  for (int i = 0; i < 4; ++i) {
    xoff[i] = (unsigned)((m0 + lr + 32 * i) * ldx + ch * 8);
    int n = n0 + lr + 32 * i; if (n > N - 1) n = N - 1;
    woff[i] = (unsigned)(n * ldw + ch * 8);
  }
  const int nk = K >> 6;
  u32x4 rx[2][4], rw[2][4];
#define H_LOAD(S, KT) { const bf16_t* xb_ = X + (KT) * 64; const bf16_t* wb_ = W + (KT) * 64; \
    _Pragma("unroll") for (int i = 0; i < 4; ++i) { rx[S][i] = *(const u32x4*)(xb_ + xoff[i]); rw[S][i] = *(const u32x4*)(wb_ + woff[i]); } }
#define H_STORE(S, B) { bf16_t* d_ = sb + (B) * BUFE + soff; \
    _Pragma("unroll") for (int i = 0; i < 4; ++i) { *(u32x4*)(d_ + (32 * i) * 32) = rx[S][i]; *(u32x4*)(d_ + (128 + 32 * i) * 32) = rw[S][i]; } }
#define H_COMPUTE(B) { _Pragma("unroll") for (int ks = 0; ks < 2; ++ks) { const bf16_t* bx_ = sb + (B) * BUFE + ks * PANE; const bf16_t* bw_ = bx_ + 128 * 32; \
    bf16x8 wf[4], xf[4]; \
    _Pragma("unroll") for (int i = 0; i < 4; ++i) { \
      wf[i] = *(const bf16x8*)(bw_ + (wn * 64 + i * 16 + l16) * 32 + gs); \
      xf[i] = *(const bf16x8*)(bx_ + (wm * 64 + i * 16 + l16) * 32 + gs); } \
    _Pragma("unroll") for (int ni = 0; ni < 4; ++ni) \
      _Pragma("unroll") for (int mi = 0; mi < 4; ++mi) acc[ni][mi] = MFMA16(wf[ni], xf[mi], acc[ni][mi]); } }
#define H_STEP(KK, SL) if ((KK) < nk) { \
    if ((KK) + 1 < nk) H_STORE((SL) ^ 1, ((KK) + 1) & 1) \
    if ((KK) + 2 < nk) H_LOAD(SL, (KK) + 2) \
    H_COMPUTE((KK) & 1) \
    __syncthreads(); }
  H_LOAD(0, 0)
  if (nk > 1) H_LOAD(1, 1)
  __syncthreads();
  H_STORE(0, 0)
  __syncthreads();
  for (int k0 = 0; k0 < nk; k0 += 2) {
    H_STEP(k0, 0)
    H_STEP(k0 + 1, 1)
  }
#undef H_LOAD
#undef H_STORE
#undef H_COMPUTE
#undef H_STEP
}

template <class Epi>
DI void gemm256(const bf16_t* __restrict__ X, int ldx, const bf16_t* __restrict__ W, int ldw, int N, int K, int m0, int n0, char* smem, Epi epi) {
  constexpr int LDG = 32;
  constexpr int BUFE = 512 * LDG;
  bf16_t* sb = (bf16_t*)smem;
  const int tid = (int)ltid(), lane = tid & 63, wave = tid >> 6, wm = wave >> 2, wn = wave & 3;
  const int g = lane >> 4, l16 = lane & 15;
  f32x4 acc[4][8];
#pragma unroll
  for (int a = 0; a < 4; ++a)
#pragma unroll
    for (int b = 0; b < 8; ++b) acc[a][b] = f32x4{0.f, 0.f, 0.f, 0.f};
  const int lr = tid >> 2, lc = (tid & 3) * 8;
  const int lcs = ((tid & 3) ^ ((4 - ((lr >> 2) & 3)) & 3)) * 8;
  const int gs = (g ^ ((4 - (l16 >> 2)) & 3)) * 8;
  unsigned xoff[2], woff[2];
#pragma unroll
  for (int i = 0; i < 2; ++i) {
    xoff[i] = (unsigned)((m0 + lr + 128 * i) * ldx + lc);
    int n = n0 + lr + 128 * i; if (n > N - 1) n = N - 1;
    woff[i] = (unsigned)(n * ldw + lc);
  }
  const int nk = K >> 5;
  u32x4 rx[3][2], rw[3][2];
#define G_LOAD(S, KT) { const bf16_t* xb_ = X + (KT) * 32; const bf16_t* wb_ = W + (KT) * 32; \
    rx[S][0] = *(const u32x4*)(xb_ + xoff[0]); rx[S][1] = *(const u32x4*)(xb_ + xoff[1]); \
    rw[S][0] = *(const u32x4*)(wb_ + woff[0]); rw[S][1] = *(const u32x4*)(wb_ + woff[1]); }
#define G_STORE(S, B) { bf16_t* d_ = sb + (B) * BUFE + lr * LDG + lcs; \
    *(u32x4*)(d_) = rx[S][0]; *(u32x4*)(d_ + 128 * LDG) = rx[S][1]; \
    *(u32x4*)(d_ + 256 * LDG) = rw[S][0]; *(u32x4*)(d_ + 384 * LDG) = rw[S][1]; }
#define G_COMPUTE(B) { const bf16_t* bx_ = sb + (B) * BUFE; const bf16_t* bw_ = bx_ + 256 * LDG; \
    bf16x8 wf[4], xf[8]; \
    _Pragma("unroll") for (int i = 0; i < 4; ++i) wf[i] = *(const bf16x8*)(bw_ + (wn * 64 + i * 16 + l16) * LDG + gs); \
    _Pragma("unroll") for (int i = 0; i < 8; ++i) xf[i] = *(const bf16x8*)(bx_ + (wm * 128 + i * 16 + l16) * LDG + gs); \
    _Pragma("unroll") for (int ni = 0; ni < 4; ++ni) \
      _Pragma("unroll") for (int mi = 0; mi < 8; ++mi) acc[ni][mi] = MFMA16(wf[ni], xf[mi], acc[ni][mi]); }
#define G_STEP(KK, RL, RS) if ((KK) < nk) { \
    if ((KK) + 1 < nk) G_STORE(RS, ((KK) + 1) & 1) \
    if ((KK) + 3 < nk) G_LOAD(RL, (KK) + 3) \
    G_COMPUTE((KK) & 1) \
    __syncthreads(); }
  G_LOAD(0, 0) G_LOAD(1, 1) G_LOAD(2, 2)
  __syncthreads();
  G_STORE(0, 0)
  __syncthreads();
  for (int k0 = 0; k0 < nk; k0 += 3) {
    G_STEP(k0, 0, 1)
    G_STEP(k0 + 1, 1, 2)
    G_STEP(k0 + 2, 2, 0)
  }
#undef G_LOAD
#undef G_STORE
#undef G_COMPUTE
#undef G_STEP
#pragma unroll
  for (int ni = 0; ni < 4; ++ni) {
    const int n = n0 + wn * 64 + ni * 16 + g * 4;
    if (n < N) {
#pragma unroll
      for (int mi = 0; mi < 8; ++mi) epi(m0 + wm * 128 + mi * 16 + l16, n, acc[ni][mi]);
    }
  }
}

namespace pg8 {
#define PG8_LAS __attribute__((address_space(3)))
typedef unsigned short bf16_t;
typedef short bf16x8 __attribute__((ext_vector_type(8)));
typedef float f32x4 __attribute__((ext_vector_type(4)));
typedef unsigned u32x4 __attribute__((ext_vector_type(4)));
constexpr int BM = 256, BK = 64, HALF = 128, HTB = HALF * BK * 2  , STAGE_BYTES = 8 * HTB, NXCD = 8, WGM = 8;

__host__ __device__ __forceinline__ int lds_byte(int r, int c) { const int st = (r >> 4) * 2 + (c >> 5), rr = r & 15, cc = c & 31, ob = rr * 64 + cc * 2; return st * 1024 + (ob ^ (((ob >> 9) & 1) << 5)); }
__host__ __device__ __forceinline__ void stage_rc(int b, int& R, int& C) { const int st = b / 1024, sb = b % 1024, swz = sb ^ (((sb >> 9) & 1) << 5); R = (st >> 1) * 16 + swz / 64; C = (st & 1) * 32 + (swz % 64) / 2; }
__host__ __device__ __forceinline__ int perm32(int rho) { const int n = rho >> 4, i = rho & 15; return 8 * (i >> 2) + 4 * n + (i & 3); }

struct Unit { int pm, pn; };
struct Gemm { const bf16_t* A; const bf16_t* Bt; int M, N, K; };

struct StaticOrder {
    int nM, nN, nwg, G, c;
    __host__ __device__ void init(int M, int N, int G_, int c_) { nM = M / BM; nN = N / BM; nwg = nM * nN; G = G_; c = c_; }
    __host__ __device__ bool next(int i, Unit& u) const {
        const long L = (long)i * G + c; if (L >= nwg) return false;
        int wgid = (int)L; { const int q = nwg / NXCD, r = nwg % NXCD, xcd = wgid % NXCD, off = wgid / NXCD; wgid = (xcd < r ? xcd * (q + 1) : r * (q + 1) + (xcd - r) * q) + off; }
        const int nig = WGM * nN, gid = wgid / nig, fm = gid * WGM, gsz = (nM - fm) < WGM ? (nM - fm) : WGM;
        u.pm = fm + ((wgid % nig) % gsz); u.pn = (wgid % nig) / gsz; return true;
    }
    __device__ __forceinline__ void a_ready(const Unit&) const {}
    __device__ __forceinline__ void done(const Unit&) const {}
};
__device__ __forceinline__ unsigned cvt_pk_bf16(float lo, float hi) { unsigned r; asm volatile("v_cvt_pk_bf16_f32 %0, %1, %2" : "=v"(r) : "v"(lo), "v"(hi)); return r; }
template <class Epi, class Sched, bool STAMP = false>
__device__ __forceinline__ void gemm_phase(PG8_LAS unsigned char* lds, const Gemm g, const Sched& S, const Epi& E, unsigned long long* stamps) {
    const int tid = (int)ltid(), wid = __builtin_amdgcn_readfirstlane(tid >> 6), lane = tid & 63, wr = wid >> 2, wc = wid & 3, fr = lane & 15, fq = lane >> 4;
    const int K = g.K, nt = K / BK;
    int ts_lo = 0, ts_hi = 0, nts = 0; const unsigned long long rt_entry = STAMP ? (unsigned long long)wall_clock64() : 0ull;
#define PG8_STAMP() do { if (STAMP && wid == 0 && nts < 64) { const unsigned long long _c = (unsigned long long)clock64(); \
        ts_lo = (lane == nts) ? (int)(unsigned)_c : ts_lo; ts_hi = (lane == nts) ? (int)(unsigned)(_c >> 32) : ts_hi; ++nts; } } while (0)
    PG8_STAMP();
    unsigned voffA[2], voffB[2];
#pragma unroll
    for (int i = 0; i < 2; ++i) { int R, C; stage_rc(tid * 16 + i * 8192, R, C); const int Rb = Epi::PERM ? ((R & ~31) + perm32(R & 31)) : R;
        voffA[i] = (unsigned)(R * K + C) * 2u; voffB[i] = (unsigned)(Rb * K + C) * 2u; }
    const size_t kstep = (size_t)(BK * 2);
    const size_t hstep = (size_t)HALF * K * 2;
    const size_t tstep = 2 * hstep;
    const unsigned ldsw = (unsigned)wid * 1024u;
    const int aoff = lds_byte(wr * 64 + fr, fq * 8), boff = lds_byte(wc * 32 + fr, fq * 8);
#define PG8_SA(b, h) (((b) * 2 + (h)) * HTB)
#define PG8_SB(b, h) ((4 + (b) * 2 + (h)) * HTB)
#define PG8_STAGE(bufoff, gbase, voff) do { _Pragma("unroll") for (int _i = 0; _i < 2; ++_i) \
        __builtin_amdgcn_global_load_lds((const unsigned*)((const char*)(gbase) + (voff)[_i]), (PG8_LAS unsigned*)(lds + (bufoff) + ldsw + _i * 8192), 16, 0, 0); } while (0)
#define PG8_LDA(dst, b, h) do { _Pragma("unroll") for (int m = 0; m < 4; ++m) _Pragma("unroll") for (int k = 0; k < 2; ++k) dst[m][k] = *(const PG8_LAS bf16x8*)(lds + PG8_SA(b, h) + aoff + m * 2048 + k * 1024); } while (0)
#define PG8_LDB(dst, b, h) do { _Pragma("unroll") for (int n = 0; n < 2; ++n) _Pragma("unroll") for (int k = 0; k < 2; ++k) dst[n][k] = *(const PG8_LAS bf16x8*)(lds + PG8_SB(b, h) + boff + n * 2048 + k * 1024); } while (0)
#define PG8_MMA(ai, bj, At, Bt) do { __builtin_amdgcn_s_setprio(1); _Pragma("unroll") for (int m = 0; m < 4; ++m) _Pragma("unroll") for (int n = 0; n < 2; ++n) _Pragma("unroll") for (int k = 0; k < 2; ++k) \
        acc[ai][bj][m][n] = __builtin_amdgcn_mfma_f32_16x16x32_bf16(Bt[n][k], At[m][k], acc[ai][bj][m][n], 0, 0, 0); __builtin_amdgcn_s_setprio(0); } while (0)
#define PG8_WAIT_V(n) asm volatile("s_waitcnt vmcnt(" #n ")" ::: "memory")
#define PG8_WAIT_L(n) asm volatile("s_waitcnt lgkmcnt(" #n ")" ::: "memory")
#define PG8_BAR __builtin_amdgcn_s_barrier()
#define PG8_SCHED __builtin_amdgcn_sched_barrier(0)
    Unit cur, nxt; int ui = 0;
    if (!S.next(0, cur)) return;
    f32x4 acc[2][2][4][2];
#pragma unroll
    for (int a = 0; a < 2; ++a)
#pragma unroll
        for (int b = 0; b < 2; ++b)
#pragma unroll
            for (int m = 0; m < 4; ++m)
#pragma unroll
                for (int n = 0; n < 2; ++n) acc[a][b][m][n] = (f32x4){0.f, 0.f, 0.f, 0.f};
    bf16x8 At[4][2], B0[2][2], B1[2][2];
    const char* cA = (const char*)g.A + (size_t)cur.pm * tstep; const char* cB = (const char*)g.Bt + (size_t)cur.pn * tstep;
    S.a_ready(cur);
    PG8_STAGE(PG8_SB(0, 0), cB, voffB); PG8_STAGE(PG8_SA(0, 0), cA, voffA); PG8_STAGE(PG8_SB(0, 1), cB + hstep, voffB); PG8_STAGE(PG8_SA(0, 1), cA + hstep, voffA);
    if (wr == 1) PG8_BAR;
    PG8_WAIT_V(4); PG8_BAR;
    PG8_STAGE(PG8_SB(1, 0), cB + kstep, voffB); PG8_STAGE(PG8_SA(1, 0), cA + kstep, voffA); PG8_STAGE(PG8_SB(1, 1), cB + hstep + kstep, voffB);
    PG8_WAIT_V(6); PG8_BAR;
    PG8_STAMP();
    for (;;) {
        const bool has_next = S.next(ui + 1, nxt);
        const char* nA = has_next ? (const char*)g.A + (size_t)nxt.pm * tstep : cA; const char* nB = has_next ? (const char*)g.Bt + (size_t)nxt.pn * tstep : cB;
        for (int t = 0; t < nt; t += 2) {
            const bool last = (t == nt - 2);
            const char* a1 = cA + (size_t)(t + 1) * kstep;
            const char* a2 = last ? nA : cA + (size_t)(t + 2) * kstep; const char* b2 = last ? nB : cB + (size_t)(t + 2) * kstep;
            const char* a3 = a2 + kstep; const char* b3 = b2 + kstep;
            if (last && has_next) S.a_ready(nxt);
            PG8_LDB(B0, 0, 0); PG8_SCHED; PG8_LDA(At, 0, 0); PG8_STAGE(PG8_SA(1, 1), a1 + hstep, voffA);
            PG8_WAIT_L(8); PG8_BAR; PG8_WAIT_L(0); PG8_MMA(0, 0, At, B0); PG8_BAR; PG8_SCHED;
            PG8_LDB(B1, 0, 1); PG8_STAGE(PG8_SB(0, 0), b2, voffB);
            PG8_BAR; PG8_WAIT_L(0); PG8_MMA(0, 1, At, B1); PG8_BAR;
            PG8_LDA(At, 0, 1); PG8_STAGE(PG8_SA(0, 0), a2, voffA);
            PG8_BAR; PG8_WAIT_L(0); PG8_MMA(1, 0, At, B0); PG8_BAR; PG8_SCHED;
            PG8_STAGE(PG8_SB(0, 1), b2 + hstep, voffB);
            PG8_WAIT_V(6); PG8_BAR; PG8_MMA(1, 1, At, B1); PG8_BAR;
            PG8_LDB(B0, 1, 0); PG8_SCHED; PG8_LDA(At, 1, 0); PG8_STAGE(PG8_SA(0, 1), a2 + hstep, voffA);
            PG8_WAIT_L(8); PG8_BAR; PG8_WAIT_L(0); PG8_MMA(0, 0, At, B0); PG8_BAR; PG8_SCHED;
            PG8_LDB(B1, 1, 1); PG8_STAGE(PG8_SB(1, 0), b3, voffB);
            PG8_BAR; PG8_WAIT_L(0); PG8_MMA(0, 1, At, B1); PG8_BAR;
            PG8_LDA(At, 1, 1); PG8_STAGE(PG8_SA(1, 0), a3, voffA);
            PG8_BAR; PG8_WAIT_L(0); PG8_MMA(1, 0, At, B0); PG8_BAR; PG8_SCHED;
            PG8_STAGE(PG8_SB(1, 1), b3 + hstep, voffB);
            PG8_WAIT_V(6); PG8_BAR; PG8_MMA(1, 1, At, B1); PG8_BAR;
        }
        PG8_STAMP();
        if constexpr (!Epi::AFTER_DRAIN) { E(acc, cur, wr, wc, fr, fq); S.done(cur); }
        PG8_STAMP();
        if (!has_next) break;
#pragma unroll
        for (int a = 0; a < 2; ++a)
#pragma unroll
            for (int b = 0; b < 2; ++b)
#pragma unroll
                for (int m = 0; m < 4; ++m)
#pragma unroll
                    for (int n = 0; n < 2; ++n) acc[a][b][m][n] = (f32x4){0.f, 0.f, 0.f, 0.f};
        cur = nxt; cA = nA; cB = nB; ++ui;
    }
    PG8_WAIT_V(0);
    if (wr == 0) PG8_BAR;
    PG8_BAR;
    if constexpr (Epi::AFTER_DRAIN) { E.fused(acc, cur, wr, wc, fr, fq, lds, wid, lane); S.done(cur); }
    PG8_STAMP();
    if (STAMP && wid == 0) { stamps[lane] = lane < nts ? (((unsigned long long)(unsigned)ts_hi << 32) | (unsigned)ts_lo) : 0ull;
        if (lane == 62) stamps[62] = rt_entry; if (lane == 63) stamps[63] = (unsigned long long)wall_clock64(); }
#undef PG8_STAMP
#undef PG8_SA
#undef PG8_SB
#undef PG8_STAGE
#undef PG8_LDA
#undef PG8_LDB
#undef PG8_MMA
#undef PG8_WAIT_V
#undef PG8_WAIT_L
#undef PG8_BAR
#undef PG8_SCHED
}
}

struct EpiU {
  static constexpr bool PERM = true, AFTER_DRAIN = false;
  bf16_t* U; int ldu; int nvalid;
  float* aux;
  __device__ __forceinline__ void operator()(const f32x4 (&acc)[2][2][4][2], const pg8::Unit& u, int wr, int wc, int fr, int fq) const {
    const int row0 = u.pm * 256 + wr * 64 + fr, col0 = u.pn * 256 + wc * 32 + 8 * fq;
#pragma unroll
    for (int ai = 0; ai < 2; ++ai)
#pragma unroll
      for (int m = 0; m < 4; ++m) {
        bf16_t* rowp = U + (size_t)(row0 + ai * 128 + m * 16) * ldu;
#pragma unroll
        for (int bj = 0; bj < 2; ++bj) {
          const int col = col0 + bj * 128;
          if (col < nvalid) {
            const f32x4 v0 = acc[ai][bj][m][0], v1 = acc[ai][bj][m][1];
            u32x4 w;
            w[0] = pack2(v0[0], v0[1]); w[1] = pack2(v0[2], v0[3]); w[2] = pack2(v1[0], v1[1]); w[3] = pack2(v1[2], v1[3]);
            *(u32x4*)(rowp + col) = w;
            if (aux && col >= 3088 && col < 4112 && (row0 + ai * 128 + m * 16) < 4096) {
              float* ap = aux + (size_t)((col - 3088) >> 9) * 2097152 + (size_t)(row0 + ai * 128 + m * 16) * 512 + ((col - 3088) & 511);
              *(f32x4*)ap = v0; *(f32x4*)(ap + 4) = v1;
            }
          }
        }
      }
  }
};


struct EpiOut {
  static constexpr bool PERM = true, AFTER_DRAIN = false;
  const float* MOD; const float* x_prompt; const float* x_sample; bf16_t* X1B; int layer;
  __device__ __forceinline__ void operator()(const f32x4 (&acc)[2][2][4][2], const pg8::Unit& u, int wr, int wc, int fr, int fq) const {
    const int row0 = u.pm * 256 + wr * 64 + fr, col0 = u.pn * 256 + wc * 32 + 8 * fq;
#pragma unroll
    for (int ai = 0; ai < 2; ++ai)
#pragma unroll
      for (int m = 0; m < 4; ++m) {
        const int row = row0 + ai * 128 + m * 16;
        const float* gp = MOD + (layer * 3 + (row < 4096 ? 0 : 1 + ((row - 4096) >> 10))) * 3072 + 2048;
        const float* xr = row < 4096 ? x_prompt + (size_t)row * 1024 : x_sample + (size_t)(row - 4096) * 1024;
        bf16_t* xb = X1B + (size_t)row * 1024;
#pragma unroll
        for (int bj = 0; bj < 2; ++bj) {
          const int col = col0 + bj * 128;
          const f32x4 v0 = acc[ai][bj][m][0], v1 = acc[ai][bj][m][1];
          const float4 g0 = *(const float4*)(gp + col), g1 = *(const float4*)(gp + col + 4);
          float4 x0, x1;
          if (layer) {
            const uint4 w = *(const uint4*)(xb + col);
            x0 = make_float4(__uint_as_float(w.x << 16), __uint_as_float(w.x & 0xffff0000u), __uint_as_float(w.y << 16), __uint_as_float(w.y & 0xffff0000u));
            x1 = make_float4(__uint_as_float(w.z << 16), __uint_as_float(w.z & 0xffff0000u), __uint_as_float(w.w << 16), __uint_as_float(w.w & 0xffff0000u));
          } else { x0 = *(const float4*)(xr + col); x1 = *(const float4*)(xr + col + 4); }
          u32x4 o;
          o[0] = pack2(x0.x + g0.x * v0[0], x0.y + g0.y * v0[1]); o[1] = pack2(x0.z + g0.z * v0[2], x0.w + g0.w * v0[3]);
          o[2] = pack2(x1.x + g1.x * v1[0], x1.y + g1.y * v1[1]); o[3] = pack2(x1.z + g1.z * v1[2], x1.w + g1.w * v1[3]);
          *(u32x4*)(xb + col) = o;
        }
        asm volatile("" ::: "memory");
      }
  }
};

template <int W>
DI void stage_rows64(bf16_t* dst, int ldd, int coff, const bf16_t* src, int lds) {
  for (int c = TIDX; c < 64 * (W / 8); c += 256) {
    const int r = c / (W / 8), cc = (c % (W / 8)) * 8;
    *(uint4*)(dst + r * ldd + coff + cc) = *(const uint4*)(src + (size_t)r * lds + cc);
  }
}
template <int W>
DI void stage_T64(bf16_t* dst, const bf16_t* src, int lds, const float* rscale) {
  for (int c = TIDX; c < 64 * (W / 8); c += 256) {
    const int r = c & 63, cc = (c >> 6) * 8;
    uint4 v = *(const uint4*)(src + (size_t)r * lds + cc);
    unsigned w[4] = {v.x, v.y, v.z, v.w};
    if (rscale) {
      const float s = rscale[r];
#pragma unroll
      for (int i = 0; i < 4; ++i) {
        const unsigned pw = pack2(lo2f(w[i]) * s, hi2f(w[i]) * s);
        dst[(cc + 2 * i) * LDT + r] = (bf16_t)(pw & 0xffffu);
        dst[(cc + 2 * i + 1) * LDT + r] = (bf16_t)(pw >> 16);
      }
    } else {
#pragma unroll
      for (int i = 0; i < 4; ++i) {
        dst[(cc + 2 * i) * LDT + r] = (bf16_t)(w[i] & 0xffffu);
        dst[(cc + 2 * i + 1) * LDT + r] = (bf16_t)(w[i] >> 16);
      }
    }
  }
}

template <int DK, int DV, bool DUAL>
DI void attn_core(char* smem, const bf16_t* Qp, int ldq, const bf16_t* K1, int ldk1, const bf16_t* K2, int ldk2,
                  const bf16_t* V, int ldv, int T, float scale_log2, f32x4 (&o)[DUAL ? 2 : 1][DV / 16], float (&lsum)[DUAL ? 2 : 1], float (&mrun)[DUAL ? 2 : 1],
                  const float2* qrope = nullptr) {
  constexpr int NS = DUAL ? 2 : 1;
  constexpr int DKT = DUAL ? 2 * DK : DK;
  constexpr int W1 = (DK == 96) ? 64 : DKT;
  constexpr int LDK = DKT + 8;
  constexpr int NK1 = 64 * (W1 / 8) / 512;
  constexpr int NV = 64 * (DV / 8) / 512;
  constexpr int BUFE = 64 * DKT + DV * LDT;
  bf16_t* sbase = (bf16_t*)smem;
  const int tid = TIDX, lane = tid & 63, wave = tid >> 6, g = lane >> 4, l16 = lane & 15;
  const int st = (int)ltid();
  const int gsw = (g ^ ((4 - (l16 >> 2)) & 3)) * 8;
  bf16x8 qf[DKT / 32];
  const bf16_t* qrow = Qp + (size_t)(wave * 16 + l16) * ldq;
#pragma unroll
  for (int ks = 0; ks < DKT / 32; ++ks) qf[ks] = *(const bf16x8*)(qrow + ks * 32 + g * 8);
  if (DK == 96 && qrope) {
    const float2* rp = qrope + (wave * 16 + l16) * 16 + g * 4;
    const u32x4 w = __builtin_bit_cast(u32x4, qf[DKT / 32 - 1]);
    u32x4 r;
#pragma unroll
    for (int j = 0; j < 4; ++j) {
      const float2 cs = rp[j];
      const float x0 = lo2f(w[j]), x1 = hi2f(w[j]);
      r[j] = pack2(x0 * cs.x - x1 * cs.y, x0 * cs.y + x1 * cs.x);
    }
    qf[DKT / 32 - 1] = __builtin_bit_cast(bf16x8, r);
  }
#pragma unroll
  for (int n = 0; n < NS; ++n) {
#pragma unroll
    for (int i = 0; i < DV / 16; ++i) o[n][i] = f32x4{0.f, 0.f, 0.f, 0.f};
    mrun[n] = -INFINITY; lsum[n] = 0.f;
  }
  u32x4 pk[NK1], pk2, pv[NV];
  unsigned koff[NK1], voff[NV];
#pragma unroll
  for (int i = 0; i < NK1; ++i) { const int c = st + 512 * i, r = c / (W1 / 8), cc = (c % (W1 / 8)) * 8; koff[i] = (unsigned)(r * ldk1 + cc); }
#pragma unroll
  for (int i = 0; i < NV; ++i) { const int c = st + 512 * i, r = c & 63, cc = (c >> 6) * 8; voff[i] = (unsigned)(r * ldv + cc); }
  const unsigned k2off = (unsigned)(((st & 255) >> 2) * ldk2 + (st & 3) * 8);
#define A_LOAD(TN) { const bf16_t* kbase_ = K1 + (size_t)(TN) * ldk1; const bf16_t* vbase_ = V + (size_t)(TN) * ldv; \
    _Pragma("unroll") for (int i = 0; i < NK1; ++i) pk[i] = *(const u32x4*)(kbase_ + koff[i]); \
    if (DK == 96 && st < 256) pk2 = *(const u32x4*)(K2 + (size_t)(TN) * ldk2 + k2off); \
    _Pragma("unroll") for (int i = 0; i < NV; ++i) pv[i] = *(const u32x4*)(vbase_ + voff[i]); }
#define A_COMMIT(B) { bf16_t* sK_ = sbase + (B) * BUFE; bf16_t* sVT_ = sK_ + 64 * DKT; \
    _Pragma("unroll") for (int i = 0; i < NK1; ++i) { const int c = st + 512 * i, r = c / (W1 / 8), ch = c % (W1 / 8); *(u32x4*)(sK_ + (ch >> 2) * 2048 + r * 32 + (((ch & 3) ^ ((4 - ((r >> 2) & 3)) & 3)) * 8)) = pk[i]; } \
    if (DK == 96 && st < 256) { const int r = st >> 2, ch = st & 3; *(u32x4*)(sK_ + 2 * 2048 + r * 32 + ((ch ^ ((4 - ((r >> 2) & 3)) & 3)) * 8)) = pk2; } \
    _Pragma("unroll") for (int i = 0; i < NV; ++i) { const int c = st + 512 * i, r = c & 63, cc = (c >> 6) * 8; \
      _Pragma("unroll") for (int j = 0; j < 4; ++j) { sVT_[(cc + 2 * j) * LDT + r] = (bf16_t)(pv[i][j] & 0xffffu); sVT_[(cc + 2 * j + 1) * LDT + r] = (bf16_t)(pv[i][j] >> 16); } } }
  A_LOAD(0)
  __syncthreads();
  A_COMMIT(0)
  if (64 < T) A_LOAD(64)
  __syncthreads();
  int par = 0;
  for (int t0 = 0; t0 < T; t0 += 64, par ^= 1) {
    {
    {
    if (t0 + 64 < T) {
      A_COMMIT(par ^ 1)
      if (t0 + 128 < T) A_LOAD(t0 + 128)
    }
    const bf16_t* sK = sbase + par * BUFE;
    const bf16_t* sVT = sK + 64 * DKT;
    bf16x8 pf[NS][2];
#pragma unroll
    for (int n = 0; n < NS; ++n) {
      f32x4 s[4];
#pragma unroll
      for (int t = 0; t < 4; ++t) {
        s[t] = f32x4{0.f, 0.f, 0.f, 0.f};
#pragma unroll
        for (int ks = 0; ks < DK / 32; ++ks) {
          const bf16x8 kf = *(const bf16x8*)(sK + (n * (DK / 32) + ks) * 2048 + (t * 16 + l16) * 32 + gsw);
          s[t] = MFMA16(kf, qf[n * (DK / 32) + ks], s[t]);
        }
      }
      float mx = -INFINITY;
#pragma unroll
      for (int t = 0; t < 4; ++t)
#pragma unroll
        for (int j = 0; j < 4; ++j) mx = fmaxf(mx, s[t][j]);
      mx = xmax_16_32(mx);
      const float mnew = fmaxf(mrun[n], mx);
      const float alpha = __builtin_amdgcn_exp2f((mrun[n] - mnew) * scale_log2);
      mrun[n] = mnew;
      const float moff = -mnew * scale_log2;
      float ps = 0.f;
#pragma unroll
      for (int t = 0; t < 4; ++t)
#pragma unroll
        for (int j = 0; j < 4; ++j) { s[t][j] = __builtin_amdgcn_exp2f(fmaf(s[t][j], scale_log2, moff)); ps += s[t][j]; }
      lsum[n] = lsum[n] * alpha + ps;
#pragma unroll
      for (int i = 0; i < DV / 16; ++i) o[n][i] *= alpha;
#pragma unroll
      for (int kb = 0; kb < 2; ++kb)
      {
        u32x4 w;
        w[0] = pack2(s[2 * kb][0], s[2 * kb][1]); w[1] = pack2(s[2 * kb][2], s[2 * kb][3]);
        w[2] = pack2(s[2 * kb + 1][0], s[2 * kb + 1][1]); w[3] = pack2(s[2 * kb + 1][2], s[2 * kb + 1][3]);
        pf[n][kb] = __builtin_bit_cast(bf16x8, w);
      }
    }
#pragma unroll
    for (int kb = 0; kb < 2; ++kb) {
#pragma unroll
      for (int i = 0; i < DV / 16; ++i) {
        const bf16_t* vp = sVT + (i * 16 + l16) * LDT + kb * 32 + g * 4;
        const bf16x4 lo = *(const bf16x4*)(vp);
        const bf16x4 hi = *(const bf16x4*)(vp + 16);
        const bf16x8 vf = __builtin_shufflevector(lo, hi, 0, 1, 2, 3, 4, 5, 6, 7);
#pragma unroll
        for (int n = 0; n < NS; ++n) o[n][i] = MFMA16(vf, pf[n][kb], o[n][i]);
        if (DUAL && (i & 3) == 3) asm volatile("" ::: "memory");
      }
    }
    }
    }
    __syncthreads();
  }
#undef A_LOAD
#undef A_COMMIT
}

DI void transpose_w(const float* __restrict__ src, int K, int N, bf16_t* __restrict__ dst, int tile, float* sT, int sc_lo, int sc_hi, float sc) {
  const int ntn = (N + 63) >> 6;
  const int kt = tile / ntn, nt = tile % ntn, k0 = kt * 64, n0 = nt * 64;
  __syncthreads();
#pragma unroll
  for (int q = 0; q < 4; ++q) {
    const int i = TIDX + 256 * q;
    const int r = i >> 4, c = (i & 15) * 4, n = n0 + c;
    float4 v = make_float4(0.f, 0.f, 0.f, 0.f);
    if (n < N) v = *(const float4*)(src + (size_t)(k0 + r) * N + n);
    if (n >= sc_lo && n < sc_hi) { v.x *= sc; v.y *= sc; v.z *= sc; v.w *= sc; }
    float* d = sT + r * 65 + c;
    d[0] = v.x; d[1] = v.y; d[2] = v.z; d[3] = v.w;
  }
  __syncthreads();
#pragma unroll
  for (int q = 0; q < 2; ++q) {
    const int i = TIDX + 256 * q;
    const int c = i >> 3, kc = (i & 7) * 8, n = n0 + c;
    if (n < N) {
      const float* sp = sT + kc * 65 + c;
      uint4 o;
      o.x = pack2(sp[0], sp[65]); o.y = pack2(sp[130], sp[195]); o.z = pack2(sp[260], sp[325]); o.w = pack2(sp[390], sp[455]);
      *(uint4*)(dst + (size_t)n * K + k0 + kc) = o;
    }
  }
}

DI void phase0(const Params& p, char* smem) {
  const int tid = TIDX;
  for (int it = VBLK; it < 384; it += NVBLK) {
    const int l = it / 192, cb = (it % 192) * 16;
    const float* W = l ? p.o_ada_w : p.e_ada_w;
    const float* bias = l ? p.o_ada_b : p.e_ada_b;
    float* sc = (float*)smem;
    float* red = sc + 3072;
    __syncthreads();
    for (int i = tid; i < 3072; i += 256) {
      const int j = i >> 10, k = i & 1023;
      const float v = (j == 0) ? p.c_ctx[k] : p.c[(j - 1) * 1024 + k];
      sc[i] = siluf(v);
    }
    __syncthreads();
    const int col = cb + (tid & 15), kg = tid >> 4;
    float a0 = 0.f, a1 = 0.f, a2 = 0.f;
    for (int kb = kg * 64; kb < kg * 64 + 64; kb += 16) {
      float w[16];
#pragma unroll
      for (int u = 0; u < 16; ++u) w[u] = W[(size_t)(kb + u) * 3072 + col];
#pragma unroll
      for (int u = 0; u < 16; ++u) { a0 += sc[kb + u] * w[u]; a1 += sc[1024 + kb + u] * w[u]; a2 += sc[2048 + kb + u] * w[u]; }
    }
    red[(kg * 3 + 0) * 16 + (tid & 15)] = a0;
    red[(kg * 3 + 1) * 16 + (tid & 15)] = a1;
    red[(kg * 3 + 2) * 16 + (tid & 15)] = a2;
    __syncthreads();
    if (tid < 48) {
      const int j = tid >> 4, c = tid & 15;
      float s = 0.f;
      for (int q = 0; q < 16; ++q) s += red[(q * 3 + j) * 16 + c];
      __hip_atomic_store(p.MOD + (l * 3 + j) * 3072 + cb + c, s + bias[cb + c], __ATOMIC_RELAXED, __HIP_MEMORY_SCOPE_AGENT);
    }
    asm volatile("s_waitcnt vmcnt(0)" ::: "memory");
    __syncthreads();
    if (tid == 0) __hip_atomic_fetch_add(p.CNT + 2 * 48 * 64, 1u, __ATOMIC_RELAXED, __HIP_MEMORY_SCOPE_AGENT);
  }
}

DI void wait_mod_ready(const Params& p) {
  if (TIDX == 0) {
    unsigned* cnt = p.CNT + 2 * 48 * 64;
    unsigned sp = 0;
    while (__hip_atomic_load(cnt, __ATOMIC_RELAXED, __HIP_MEMORY_SCOPE_AGENT) < 384u) {
      __builtin_amdgcn_s_sleep(1);
      if (++sp > (1u << 22)) break;
    }
    __builtin_amdgcn_fence(__ATOMIC_ACQUIRE, "agent");
    asm volatile("s_waitcnt vmcnt(0)" ::: "memory");
  }
  __syncthreads();
}

DI void phase0b(const Params& p, char* smem) {
  const int tid = TIDX;
  if (VBLK == 0 && tid < 64) {
    float a = p.o_lam[tid] * p.o_lam[64 + tid];
    float b = p.o_lam[128 + tid] * p.o_lam[192 + tid];
    a = wave_sum(a); b = wave_sum(b);
    if (tid == 0) p.LAMV[0] = fexp(a) - fexp(b) + LAM_INIT;
  }
  for (int idx = VBLK * 256 + tid; idx < 1024 * 48; idx += NVBLK * 256) {
    const int pos = idx / 48, e = idx % 48;
    const float rr = (float)(pos >> 6), cc = (float)(pos & 63);
    if (e < 16) {
      const int j = e & 7;
      const float inv = 1.0f / powf(10000.0f, (float)(2 * j) / 16.0f);
      const float ang = ((e < 8) ? rr : cc) * inv;
      p.ROPE32[pos * 16 + e] = make_float2(cosf(ang), sinf(ang));
    } else {
      const int i = e - 16, j = i & 15;
      const float inv = 1.0f / powf(10000.0f, (float)(2 * j) / 32.0f);
      const float ang = ((i < 16) ? rr : cc) * inv;
      p.ROPE64[pos * 32 + i] = make_float2(cosf(ang), sinf(ang));
    }
  }
  float* sT = (float*)smem;
  for (int it = VBLK; it < 1016; it += NVBLK) {
    if (it < 624) transpose_w(p.e_w_in, 1024, EIN, p.WinE, it, sT, 0, 0, 1.f);
    else if (it < 696) transpose_w(p.e_w_uq, 384, 768, p.Wuq, it - 624, sT, 0, 0, 1.f);
    else if (it < 760) transpose_w(p.e_w_ukv, 256, 1024, p.Wukv, it - 696, sT, 0, 0, 1.f);
    else transpose_w(p.e_w_out, 1024, 1024, p.WoutE, it - 760, sT, 0, 0, 1.f);
  }
}

DI void late_weight_prep(const Params& p, char* smem, int first_group, int tile_lo, int tile_hi) {
  float* sT = (float*)smem;
  const int ng = NVBLK - first_group;
  if (ng <= 0 || VBLK < first_group) return;
  for (int it = tile_lo + VBLK - first_group; it < tile_hi; it += ng) {
    if (it < 1168) transpose_w(p.o_w_in, 1024, OIN, p.WinO, it, sT, 512, 1024, 0.08838834764831845f);
    else transpose_w(p.o_w_out, 1024, 1024, p.WoutO, it - 1168, sT, 0, 0, 1.f);
  }
}

DI void store_bf4(bf16_t* dst, f32x4 v) {
  uint2 o; o.x = pack2(v[0], v[1]); o.y = pack2(v[2], v[3]);
  *(uint2*)dst = o;
}
DI float4 load_bf4(const bf16_t* src) {
  const uint2 w = *(const uint2*)src;
  return make_float4(lo2f(w.x), hi2f(w.x), lo2f(w.y), hi2f(w.y));
}

DI void phase_norm(const Params& p, int layer) {
  const int tid = TIDX, lane = tid & 63, wave = tid >> 6;
  const float* g = layer ? p.o_norm_g : p.e_norm_g;
  for (int it = VBLK; it < NROW / 4; it += NVBLK) {
    const int row = it * 4 + wave;
    const float* x = xrow(p, row);
    const bf16_t* xb = p.X1B + (size_t)row * 1024;
    const float* md = p.MOD + (layer * 3 + cv_of_row(row)) * 3072;
    float4 v[4];
    float ss = 0.f;
#pragma unroll
    for (int i = 0; i < 4; ++i) {
      v[i] = layer ? load_bf4(xb + i * 256 + lane * 4) : *(const float4*)(x + i * 256 + lane * 4);
      ss += v[i].x * v[i].x + v[i].y * v[i].y + v[i].z * v[i].z + v[i].w * v[i].w;
    }
    ss = wave_sum(ss);
    const float r = rsqrtf(ss * (1.f / 1024.f) + EPSF);
#pragma unroll
    for (int i = 0; i < 4; ++i) {
      const int col = i * 256 + lane * 4;
      const float4 gg = *(const float4*)(g + col), sh = *(const float4*)(md + col), sc = *(const float4*)(md + 1024 + col);
      uint2 o;
      o.x = pack2(v[i].x * r * gg.x * (1.f + sc.x) + sh.x, v[i].y * r * gg.y * (1.f + sc.y) + sh.y);
      o.y = pack2(v[i].z * r * gg.z * (1.f + sc.z) + sh.z, v[i].w * r * gg.w * (1.f + sc.w) + sh.w);
      *(uint2*)(p.H + (size_t)row * 1024 + col) = o;
    }
  }
}


DI void phase_gemm_in(const Params& p, int layer, char* smem) {
  const int N = layer ? OIN : EIN;
  const int Npad = layer ? OIN_PAD : EIN_PAD;
  pg8::Gemm g;
  g.A = p.H; g.Bt = layer ? p.WinO : p.WinE; g.M = NROW; g.N = Npad; g.K = 1024;
  pg8::StaticOrder S;
  S.init(NROW, Npad, (int)gridDim.x, (int)blockIdx.x);
  EpiU E;
  E.U = layer ? p.U1 : p.U0; E.ldu = N; E.nvalid = N; E.aux = layer ? p.out + O_DK : nullptr;
  pg8::gemm_phase<EpiU, pg8::StaticOrder, false>((PG8_LAS unsigned char*)smem, g, S, E, nullptr);
}

DI void phase_gemm_out(const Params& p, int layer, char* smem) {
  const bf16_t* W = layer ? p.WoutO : p.WoutE;
  for (int it = VBLK; it < 48 * 8; it += NVBLK) {
    const int mt = it % 48, nt = it / 48;
    gemm_tile64(p.O, 1024, W, 1024, 1024, 1024, mt * 128, nt * 128, smem,
              [=](int m, int n, f32x4 v) {
                const float4 gt = *(const float4*)(p.MOD + (layer * 3 + cv_of_row(m)) * 3072 + 2048 + n);
                const float4 xv = layer ? load_bf4(p.X1B + (size_t)m * 1024 + n) : *(const float4*)(xrow(p, m) + n);
                f32x4 r;
                r[0] = xv.x + gt.x * v[0]; r[1] = xv.y + gt.y * v[1]; r[2] = xv.z + gt.z * v[2]; r[3] = xv.w + gt.w * v[3];
                store_bf4(p.X1B + (size_t)m * 1024 + n, r);
              });
  }
}

DI void phase_out_norm_fused(const Params& p, int layer, char* smem) {
  const int tid = TIDX, lane = tid & 63, wave = tid >> 6, wm = wave >> 1, wn = wave & 1, g = lane >> 4, l16 = lane & 15;
  float* sSS = (float*)(smem + 65536);
  float* sR = sSS + 256;
  for (int it = VBLK; it < 48 * 8; it += NVBLK) {
    const int mt = it % 48, nt = it / 48, m0 = mt * 128, n0 = nt * 128;
    f32x4 acc[4][4];
    gemm_tile64_acc(p.O, 1024, layer ? p.WoutO : p.WoutE, 1024, 1024, 1024, m0, n0, smem, acc);
    float* ssq_slots = p.SSQ + (size_t)layer * NROW * 8;
    unsigned* cnt_base = p.CNT + layer * 48 * 64;
    float ssq[4];
#pragma unroll
    for (int mi = 0; mi < 4; ++mi) {
      const int row = m0 + wm * 64 + mi * 16 + l16;
      const float* gp = p.MOD + (layer * 3 + cv_of_row(row)) * 3072 + 2048;
      ssq[mi] = 0.f;
#pragma unroll
      for (int ni = 0; ni < 4; ++ni) {
        const int n = n0 + wn * 64 + ni * 16 + g * 4;
        const float4 gt = *(const float4*)(gp + n);
        const float4 xv = layer ? load_bf4(p.X1B + (size_t)row * 1024 + n) : *(const float4*)(xrow(p, row) + n);
        f32x4 r;
        r[0] = xv.x + gt.x * acc[ni][mi][0]; r[1] = xv.y + gt.y * acc[ni][mi][1]; r[2] = xv.z + gt.z * acc[ni][mi][2]; r[3] = xv.w + gt.w * acc[ni][mi][3];
        acc[ni][mi] = r;
        if (!layer) store_bf4(p.X1B + (size_t)row * 1024 + n, r);
        ssq[mi] += r[0] * r[0] + r[1] * r[1] + r[2] * r[2] + r[3] * r[3];
      }
      ssq[mi] = xsum_16_32(ssq[mi]);
    }
    if (g == 0) {
#pragma unroll
      for (int mi = 0; mi < 4; ++mi) sSS[wn * 128 + wm * 64 + mi * 16 + l16] = ssq[mi];
    }
    __syncthreads();
    if (tid < 128) __hip_atomic_store(ssq_slots + (size_t)(m0 + tid) * 8 + nt, sSS[tid] + sSS[128 + tid], __ATOMIC_RELAXED, __HIP_MEMORY_SCOPE_AGENT);
    asm volatile("s_waitcnt vmcnt(0)" ::: "memory");
    __syncthreads();
    if (tid == 0) {
      unsigned* cnt = cnt_base + mt * 64;
      __hip_atomic_fetch_add(cnt, 1u, __ATOMIC_RELAXED, __HIP_MEMORY_SCOPE_AGENT);
      unsigned sp = 0;
      while (__hip_atomic_load(cnt, __ATOMIC_RELAXED, __HIP_MEMORY_SCOPE_AGENT) < 8u) {
        __builtin_amdgcn_s_sleep(1);
        if (++sp > (1u << 22)) break;
      }
      asm volatile("" ::: "memory");
    }
    __syncthreads();
    if (tid < 128) {
      const float* sl = ssq_slots + (size_t)(m0 + tid) * 8;
      float t = 0.f;
#pragma unroll
      for (int q = 0; q < 8; ++q) t += __hip_atomic_load(sl + q, __ATOMIC_RELAXED, __HIP_MEMORY_SCOPE_AGENT);
      sR[tid] = rsqrtf(t * (1.f / 1024.f) + EPSF);
    }
    __syncthreads();
#pragma unroll
    for (int mi = 0; mi < 4; ++mi) {
      const int rl = wm * 64 + mi * 16 + l16;
      const float r = sR[rl];
      float* op = p.out + O_Y + (size_t)(m0 + rl) * 1024;
      const float* md = p.MOD + (3 + cv_of_row(m0 + rl)) * 3072;
#pragma unroll
      for (int ni = 0; ni < 4; ++ni) {
        const int n = n0 + wn * 64 + ni * 16 + g * 4;
        if (layer) {
          const float4 gg = *(const float4*)(p.final_g + n);
          *(float4*)(op + n) = make_float4(acc[ni][mi][0] * r * gg.x, acc[ni][mi][1] * r * gg.y, acc[ni][mi][2] * r * gg.z, acc[ni][mi][3] * r * gg.w);
        } else {
          const float4 gg = *(const float4*)(p.o_norm_g + n), sh = *(const float4*)(md + n), sc = *(const float4*)(md + 1024 + n);
          f32x4 hv;
          hv[0] = acc[ni][mi][0] * r * gg.x * (1.f + sc.x) + sh.x; hv[1] = acc[ni][mi][1] * r * gg.y * (1.f + sc.y) + sh.y;
          hv[2] = acc[ni][mi][2] * r * gg.z * (1.f + sc.z) + sh.z; hv[3] = acc[ni][mi][3] * r * gg.w * (1.f + sc.w) + sh.w;
          store_bf4(p.H + (size_t)(m0 + rl) * 1024 + n, hv);
        }
      }
    }
  }
}

DI void phase_gemm_mla(const Params& p, char* smem) {
  const int G = (int)gridDim.x, bid = (int)blockIdx.x;
  const bool split = G >= 176;
  if (!split || bid < 72) {
    pg8::Gemm g;
    g.A = p.CQN; g.Bt = p.Wuq; g.M = NROW; g.N = 768; g.K = 384;
    pg8::StaticOrder S;
    S.init(NROW, 768, G, bid);
    EpiU E;
    E.U = p.Q; E.ldu = 768; E.nvalid = 768; E.aux = nullptr;
    pg8::gemm_phase<EpiU, pg8::StaticOrder, false>((PG8_LAS unsigned char*)smem, g, S, E, nullptr);
  }
  if (!split || bid >= 72) {
    pg8::Gemm g;
    g.A = p.CKVN; g.Bt = p.Wukv; g.M = NTROW; g.N = 1024; g.K = 256;
    pg8::StaticOrder S;
    S.init(NTROW, 1024, G, split ? bid - 72 : bid);
    EpiU E;
    E.U = p.KV; E.ldu = 1024; E.nvalid = 1024; E.aux = nullptr;
    pg8::gemm_phase<EpiU, pg8::StaticOrder, false>((PG8_LAS unsigned char*)smem, g, S, E, nullptr);
  }
}

struct TRow { int row, pos, cb, ct; bool cache, lat; };
DI TRow decode_trow(int trow) {
  TRow t; t.row = -1; t.pos = 0; t.cb = 0; t.ct = 0; t.cache = false; t.lat = false;
  if (trow < 4096) { t.row = trow; }
  else {
    const int r = trow - 4096; const int b = r / 1280, tt = r % 1280;
    t.lat = true;
    if (tt < 256) { t.cache = true; t.cb = b; t.ct = tt; }
    else { t.pos = tt - 256; t.row = 4096 + b * 1024 + t.pos; }
  }
  return t;
}
DI void cvt_store4(bf16_t* dst, const float* src) {
  const float4 v = *(const float4*)src;
  uint2 o; o.x = pack2(v.x, v.y); o.y = pack2(v.z, v.w);
  *(uint2*)dst = o;
}

DI void phase3(const Params& p) {
  const int tid = TIDX, lane = tid & 63, wave = tid >> 6;
  for (int it = VBLK; it < NTROW / 4; it += NVBLK) {
    const int trow = it * 4 + wave;
    const TRow t = decode_trow(trow);
    if (t.cache) {
      const size_t ci = (size_t)t.cb * 256 + t.ct;
      cvt_store4(p.CKVN + (size_t)trow * 256 + lane * 4, p.cache_ckv + ci * 256 + lane * 4);
      if (lane < 8) cvt_store4(p.KR + (size_t)trow * 32 + lane * 4, p.cache_kr + ci * 32 + lane * 4);
      if (lane < 32) {
        cvt_store4(p.KB + (size_t)trow * 128 + lane * 4, p.cache_gk + ci * 128 + lane * 4);
        cvt_store4(p.VB + (size_t)trow * 128 + lane * 4, p.cache_gv + ci * 128 + lane * 4);
      }
      continue;
    }
    const int row = t.row;
    const bf16_t* u = p.U0 + (size_t)row * EIN;
    {
      float x[6]; float ss = 0.f;
#pragma unroll
      for (int i = 0; i < 3; ++i) {
        const unsigned w = *(const unsigned*)(u + i * 128 + lane * 2);
        x[2 * i] = lo2f(w); x[2 * i + 1] = hi2f(w);
        ss += x[2 * i] * x[2 * i] + x[2 * i + 1] * x[2 * i + 1];
      }
      ss = wave_sum(ss);
      const float r = rsqrtf(ss * (1.f / 384.f) + EPSF);
#pragma unroll
      for (int i = 0; i < 3; ++i) {
        const int col = i * 128 + lane * 2;
        *(unsigned*)(p.CQN + (size_t)row * 384 + col) = pack2(x[2 * i] * r * p.e_qn_g[col], x[2 * i + 1] * r * p.e_qn_g[col + 1]);
      }
    }
    {
      const uint2 w = *(const uint2*)(u + 384 + lane * 4);
      float x0 = lo2f(w.x), x1 = hi2f(w.x), x2 = lo2f(w.y), x3 = hi2f(w.y);
      float ss = wave_sum(x0 * x0 + x1 * x1 + x2 * x2 + x3 * x3);
      const float r = rsqrtf(ss * (1.f / 256.f) + EPSF);
      const float4 gg = *(const float4*)(p.e_kvn_g + lane * 4);
      x0 *= r * gg.x; x1 *= r * gg.y; x2 *= r * gg.z; x3 *= r * gg.w;
      uint2 o; o.x = pack2(x0, x1); o.y = pack2(x2, x3);
      *(uint2*)(p.CKVN + (size_t)trow * 256 + lane * 4) = o;
      if (!t.lat) *(float4*)(p.out + O_CKV + (size_t)row * 256 + lane * 4) = make_float4(x0, x1, x2, x3);
    }
    if (lane < 16) {
      const unsigned w = *(const unsigned*)(u + 640 + lane * 2);
      float x0 = lo2f(w), x1 = hi2f(w);
      if (t.lat) {
        const float2 cs = p.ROPE32[t.pos * 16 + lane];
        const float y0 = x0 * cs.x - x1 * cs.y, y1 = x0 * cs.y + x1 * cs.x;
        x0 = y0; x1 = y1;
      } else {
        *(float2*)(p.out + O_KR + (size_t)row * 32 + lane * 2) = make_float2(x0, x1);
      }
      *(unsigned*)(p.KR + (size_t)trow * 32 + lane * 2) = pack2(x0, x1);
    }
#pragma unroll
    for (int which = 0; which < 2; ++which) {
      const int lsrc = which ? (lane & 15) : lane;
      const uint4 w = *(const uint4*)(u + (which ? 1696 : 1184) + lsrc * 8);
      float x[8] = {lo2f(w.x), hi2f(w.x), lo2f(w.y), hi2f(w.y), lo2f(w.z), hi2f(w.z), lo2f(w.w), hi2f(w.w)};
      float ss = 0.f;
#pragma unroll
      for (int j = 0; j < 8; ++j) ss += x[j] * x[j];
      ss += DPPF(ss, 0xB1); ss += DPPF(ss, 0x4E); ss += DPPF(ss, 0x141);
      const float r = rsqrtf(ss * (1.f / 64.f) + EPSF);
      const float* gp = (which ? p.e_gk_g : p.e_gq_g) + (lane & 7) * 8;
#pragma unroll
      for (int j = 0; j < 8; ++j) x[j] *= r * gp[j];
      if (t.lat) {
#pragma unroll
        for (int jj = 0; jj < 4; ++jj) {
          const float2 cs = p.ROPE64[t.pos * 32 + (lane & 7) * 4 + jj];
          const float y0 = x[2 * jj] * cs.x - x[2 * jj + 1] * cs.y, y1 = x[2 * jj] * cs.y + x[2 * jj + 1] * cs.x;
          x[2 * jj] = y0; x[2 * jj + 1] = y1;
        }
      }
      uint4 o; o.x = pack2(x[0], x[1]); o.y = pack2(x[2], x[3]); o.z = pack2(x[4], x[5]); o.w = pack2(x[6], x[7]);
      if (which == 0) {
        *(uint4*)(p.QB + (size_t)row * 512 + lane * 8) = o;
      } else if (lane < 16) {
        *(uint4*)(p.KB + (size_t)trow * 128 + lane * 8) = o;
        if (!t.lat) {
          float* op = p.out + O_GK + (size_t)row * 128 + lane * 8;
          *(float4*)op = make_float4(x[0], x[1], x[2], x[3]);
          *(float4*)(op + 4) = make_float4(x[4], x[5], x[6], x[7]);
        }
      }
    }
    if (lane < 16) {
      const uint4 w = *(const uint4*)(u + 1824 + lane * 8);
      *(uint4*)(p.VB + (size_t)trow * 128 + lane * 8) = w;
      if (!t.lat) {
        float* op = p.out + O_GV + (size_t)row * 128 + lane * 8;
        *(float4*)op = make_float4(lo2f(w.x), hi2f(w.x), lo2f(w.y), hi2f(w.y));
        *(float4*)(op + 4) = make_float4(lo2f(w.z), hi2f(w.z), lo2f(w.w), hi2f(w.w));
      }
    }
  }
}

DI void phase_attn0(const Params& p, char* smem) {
  const int lane = TIDX & 63, wave = TIDX >> 6, g = lane >> 4, l16 = lane & 15;
  for (int it = vblk_xcd(); it < 1536; it += NVBLK) {
    int kind, b, h, qb, row0, trow0, T;
    if (it < 512) { const int i = it & 255; kind = it >> 8; b = i >> 7; h = (i >> 4) & 7; qb = i & 15; row0 = 4096 + b * 1024 + qb * 64; trow0 = 4096 + b * 1280; T = 1280; }
    else { const int i2 = it - 512; kind = i2 >> 9; const int i = i2 & 511; b = i >> 5; h = (i >> 2) & 7; qb = i & 3; row0 = b * 256 + qb * 64; trow0 = b * 256; T = 256; }
    f32x4 oo[1][4];
    float lss[1], mss[1];
    int gcol, ocol;
    const int row = row0 + wave * 16 + l16;
    uint2 gwv[4];
    {
      const int gc = kind == 0 ? 672 + h * 64 : 1952 + h * 64;
#pragma unroll
      for (int i = 0; i < 4; ++i) gwv[i] = *(const uint2*)(p.U0 + (size_t)row * EIN + gc + i * 16 + g * 4);
    }
    if (kind == 0) {
      attn_core<96, 64, false>(smem, p.Q + (size_t)row0 * 768 + h * 96, 768, p.KV + (size_t)trow0 * 1024 + h * 128, 1024,
                        p.KR + (size_t)trow0 * 32, 32, p.KV + (size_t)trow0 * 1024 + h * 128 + 64, 1024, T,
                        0.10206207261596575f * 1.4426950408889634f, oo, lss, mss,
                        it < 512 ? p.ROPE32 + (size_t)(qb * 64) * 16 : nullptr);
      gcol = 672 + h * 64; ocol = h * 64;
    } else {
      const int kvh = h >> 2;
      attn_core<64, 64, false>(smem, p.QB + (size_t)row0 * 512 + h * 64, 512, p.KB + (size_t)trow0 * 128 + kvh * 64, 128,
                        nullptr, 0, p.VB + (size_t)trow0 * 128 + kvh * 64, 128, T, 0.125f * 1.4426950408889634f, oo, lss, mss);
      gcol = 1952 + h * 64; ocol = 512 + h * 64;
    }
    float ls = lss[0];
    ls = xsum_16_32(ls);
    const float inv = 1.f / ls;
    f32x4 (&o)[4] = oo[0];
#pragma unroll
    for (int i = 0; i < 4; ++i) {
      const int dv = i * 16 + g * 4;
      const uint2 gw = gwv[i];
      f32x4 r;
      r[0] = o[i][0] * inv * siluf(lo2f(gw.x)); r[1] = o[i][1] * inv * siluf(hi2f(gw.x));
      r[2] = o[i][2] * inv * siluf(lo2f(gw.y)); r[3] = o[i][3] * inv * siluf(hi2f(gw.y));
      store_bf4(p.O + (size_t)row * 1024 + ocol + dv, r);
    }
  }
}

DI void mlstm_gates(const Params& p, int rowbase, int nc, int h, int dir, int j, int lane, float& ig, float& lf) {
  const int oc = dir ? nc - 1 - j : j;
  const int s = dir ? 63 - lane : lane;
  const int row = rowbase + oc * 64 + s;
  const bf16_t* up = p.U1 + (size_t)row * OIN + 2048;
  ig = bf2f(up[dir * 8 + h]) + p.o_gate_b[dir * 8 + h];
  lf = logsig(bf2f(up[dir * 8 + 4 + h]) + p.o_gate_b[dir * 8 + 4 + h]);
}
DI void mitem_decode(int it, int& sq, int& h, int& dir, int& j, int& nc, int& rowbase) {
  if (it < 512) { j = it & 3; dir = (it >> 2) & 1; h = (it >> 3) & 3; sq = it >> 5; nc = 4; rowbase = sq * 256; }
  else { const int i = it - 512; j = i & 15; dir = (i >> 4) & 1; h = (i >> 5) & 3; sq = 16 + (i >> 7); nc = 16; rowbase = 4096 + (sq - 16) * 1024; }
}
DI int mitem_id(int sq, int h, int dir, int j) {
  return sq < 16 ? (((sq * 4 + h) * 2 + dir) * 4 + j) : (512 + ((((sq - 16) * 4 + h) * 2 + dir) * 16 + j));
}

DI void phase9(const Params& p, char* smem) {
  const int tid = TIDX, lane = tid & 63, wave = tid >> 6, g = lane >> 4, l16 = lane & 15;
  for (int it = VBLK; it < NTROW / 4; it += NVBLK) {
    const int trow = it * 4 + wave;
    const TRow t = decode_trow(trow);
    if (t.cache) {
      const size_t ci = (size_t)t.cb * 256 + t.ct;
      cvt_store4(p.KD + (size_t)trow * 512 + lane * 8, p.cache_dk + ci * 512 + lane * 8);
      cvt_store4(p.KD + (size_t)trow * 512 + lane * 8 + 4, p.cache_dk + ci * 512 + lane * 8 + 4);
      cvt_store4(p.VD + (size_t)trow * 512 + lane * 8, p.cache_dv + ci * 512 + lane * 8);
      cvt_store4(p.VD + (size_t)trow * 512 + lane * 8 + 4, p.cache_dv + ci * 512 + lane * 8 + 4);
      continue;
    }
    if (!t.lat) continue;
    const int row = t.row;
    const bf16_t* u = p.U1 + (size_t)row * OIN;
#pragma unroll
    for (int which = 0; which < 2; ++which) {
      const uint4 w = *(const uint4*)(u + (which ? 3088 : 2576) + lane * 8);
      float x[8] = {lo2f(w.x), hi2f(w.x), lo2f(w.y), hi2f(w.y), lo2f(w.z), hi2f(w.z), lo2f(w.w), hi2f(w.w)};
      if (t.lat) {
#pragma unroll
        for (int jj = 0; jj < 4; ++jj) {
          const float2 cs = p.ROPE64[t.pos * 32 + (lane & 7) * 4 + jj];
          const float y0 = x[2 * jj] * cs.x - x[2 * jj + 1] * cs.y, y1 = x[2 * jj] * cs.y + x[2 * jj + 1] * cs.x;
          x[2 * jj] = y0; x[2 * jj + 1] = y1;
        }
      }
      uint4 o; o.x = pack2(x[0], x[1]); o.y = pack2(x[2], x[3]); o.z = pack2(x[4], x[5]); o.w = pack2(x[6], x[7]);
      if (which == 0) { if (t.lat) *(uint4*)(p.QD + (size_t)row * 512 + lane * 8) = o; }
      else {
        if (t.lat) *(uint4*)(p.KD + (size_t)trow * 512 + lane * 8) = o;
        if (!t.lat) {
          float* op = p.out + O_DK + (size_t)row * 512 + lane * 8;
          *(float4*)op = make_float4(x[0], x[1], x[2], x[3]);
          *(float4*)(op + 4) = make_float4(x[4], x[5], x[6], x[7]);
        }
      }
    }
    {
      const uint4 w = *(const uint4*)(u + 3600 + lane * 8);
      if (t.lat) *(uint4*)(p.VD + (size_t)trow * 512 + lane * 8) = w;
      if (!t.lat) {
        float* op = p.out + O_DV + (size_t)row * 512 + lane * 8;
        *(float4*)op = make_float4(lo2f(w.x), hi2f(w.x), lo2f(w.y), hi2f(w.y));
        *(float4*)(op + 4) = make_float4(lo2f(w.z), hi2f(w.z), lo2f(w.w), hi2f(w.w));
      }
    }
  }
  bf16_t* sKT = (bf16_t*)smem;
  bf16_t* sVT = sKT + 128 * LDT;
  float* swk = (float*)(sVT + 128 * LDT);
  for (int it = VBLK; it < 768; it += NVBLK) {
    int sq, h, dir, j, nc, rowbase;
    mitem_decode(it, sq, h, dir, j, nc, rowbase);
    float ig, lf;
    mlstm_gates(p, rowbase, nc, h, dir, j, lane, ig, lf);
    const float b = scan_add(lf, lane);
    const float bL = __shfl(b, 63);
    const float mx = wave_max(bL - b + ig);
    const float wk = fexp(bL - b + ig - mx);
    __syncthreads();
    if (wave == 0) {
      swk[dir ? 63 - lane : lane] = wk;
      if (lane == 0) { p.SC[it * 4 + 0] = bL; p.SC[it * 4 + 1] = mx; }
    }
    __syncthreads();
    const int oc = dir ? nc - 1 - j : j;
    const int row0 = rowbase + oc * 64;
    stage_T64<128>(sKT, p.U1 + (size_t)row0 * OIN + 512 + h * 128, OIN, nullptr);
    stage_T64<128>(sVT, p.U1 + (size_t)row0 * OIN + 1024 + h * 128, OIN, swk);
    __syncthreads();
    f32x4 acc[2][8];
#pragma unroll
    for (int a = 0; a < 2; ++a)
#pragma unroll
      for (int c = 0; c < 8; ++c) acc[a][c] = f32x4{0.f, 0.f, 0.f, 0.f};
#pragma unroll
    for (int ks = 0; ks < 2; ++ks) {
      bf16x8 vf[2];
#pragma unroll
      for (int a = 0; a < 2; ++a) vf[a] = *(const bf16x8*)(sVT + ((wave * 2 + a) * 16 + l16) * LDT + ks * 32 + g * 8);
#pragma unroll
      for (int kt = 0; kt < 8; ++kt) {
        const bf16x8 kf = *(const bf16x8*)(sKT + (kt * 16 + l16) * LDT + ks * 32 + g * 8);
#pragma unroll
        for (int a = 0; a < 2; ++a) acc[a][kt] = MFMA16(kf, vf[a], acc[a][kt]);
      }
    }
    bf16_t* uc = p.UC + (size_t)it * 16384;
#pragma unroll
    for (int a = 0; a < 2; ++a)
#pragma unroll
      for (int kt = 0; kt < 8; ++kt) {
        const int v = (wave * 2 + a) * 16 + l16, k = kt * 16 + g * 4;
        store_bf4(uc + v * 128 + k, acc[a][kt]);
      }
    if (tid < 128) {
      float s = 0.f;
#pragma unroll
      for (int c8 = 0; c8 < 8; ++c8) {
        const u32x4 kw = *(const u32x4*)(sKT + tid * LDT + c8 * 8);
        const float4 w0 = *(const float4*)(swk + c8 * 8), w1 = *(const float4*)(swk + c8 * 8 + 4);
        s += lo2f(kw[0]) * w0.x + hi2f(kw[0]) * w0.y + lo2f(kw[1]) * w0.z + hi2f(kw[1]) * w0.w
           + lo2f(kw[2]) * w1.x + hi2f(kw[2]) * w1.y + lo2f(kw[3]) * w1.z + hi2f(kw[3]) * w1.w;
      }
      p.NU[it * 128 + tid] = s;
    }
  }
}

DI void diff_finish(const Params& p, f32x4 (&o1)[8], f32x4 (&o2)[8], float l1, float l2, int row0, int hd) {
  const int lane = TIDX & 63, wave = TIDX >> 6, g = lane >> 4, l16 = lane & 15;
  l1 = xsum_16_32(l1);
  l2 = xsum_16_32(l2);
  const float i1 = 1.f / l1, i2 = p.LAMV[0] / l2;
  float ss = 0.f;
#pragma unroll
  for (int i = 0; i < 8; ++i)
#pragma unroll
    for (int j = 0; j < 4; ++j) { o1[i][j] = o1[i][j] * i1 - o2[i][j] * i2; ss += o1[i][j] * o1[i][j]; }
  ss = xsum_16_32(ss);
  const float r = rsqrtf(ss * (1.f / 128.f) + EPSF) * (1.f - LAM_INIT);
  const int row = row0 + wave * 16 + l16;
#pragma unroll
  for (int i = 0; i < 8; ++i) {
    const int dv = i * 16 + g * 4;
    const uint2 gw = *(const uint2*)(p.U1 + (size_t)row * OIN + 4112 + hd * 128 + dv);
    const float4 gn = *(const float4*)(p.o_dnorm_g + dv);
    f32x4 rr;
    rr[0] = o1[i][0] * r * gn.x * siluf(lo2f(gw.x)); rr[1] = o1[i][1] * r * gn.y * siluf(hi2f(gw.x));
    rr[2] = o1[i][2] * r * gn.z * siluf(lo2f(gw.y)); rr[3] = o1[i][3] * r * gn.w * siluf(hi2f(gw.y));
    store_bf4(p.O + (size_t)row * 1024 + 512 + hd * 128 + dv, rr);
  }
}

DI void phase10(const Params& p, char* smem) {
  const int tid = TIDX, lane = tid & 63, wave = tid >> 6, g = lane >> 4, l16 = lane & 15;
  for (int it = vblk_xcd(); it < 512; it += NVBLK) {
    int b, hd, qb, row0, trow0, T;
    const bool lat = it < 256;
    const int split = (it >> 1) & 1;
    const int li = ((it >> 7) * 4 + ((it >> 5) & 3)) * 16 + ((it >> 2) & 7) * 2 + (it & 1);
    if (lat) { b = li >> 6; hd = (li >> 4) & 3; qb = li & 15; row0 = 4096 + b * 1024 + qb * 64; trow0 = 4096 + b * 1280 + split * 640; T = 640; }
    else { const int i = it - 256; b = i >> 4; hd = (i >> 2) & 3; qb = i & 3; row0 = b * 256 + qb * 64; trow0 = b * 256; T = 256; }
    f32x4 od[2][8];
    float ld2[2], md2[2];
    const float sc = 0.125f * 1.4426950408889634f;
    const bf16_t* qp = lat ? p.QD + (size_t)row0 * 512 + hd * 128 : p.U1 + (size_t)row0 * OIN + 2576 + hd * 128;
    const bf16_t* kp = lat ? p.KD + (size_t)trow0 * 512 + hd * 128 : p.U1 + (size_t)trow0 * OIN + 3088 + hd * 128;
    const bf16_t* vp = lat ? p.VD + (size_t)trow0 * 512 + hd * 128 : p.U1 + (size_t)trow0 * OIN + 3600 + hd * 128;
    const int ldqkv = lat ? 512 : OIN;
    attn_core<64, 128, true>(smem, qp, ldqkv, kp, ldqkv, nullptr, 0, vp, ldqkv, T, sc, od, ld2, md2);
    if (lat) {
#pragma unroll
      for (int n = 0; n < 2; ++n) {
        const size_t base = (size_t)((li * 2 + split) * 2 + n) * 4 + wave;
#pragma unroll
        for (int i = 0; i < 8; ++i) store_bf4(p.OP + ((base * 8 + i) * 64 + lane) * 4, od[n][i]);
        *(float2*)(p.ML + (base * 64 + lane) * 2) = make_float2(md2[n], ld2[n]);
      }
    } else {
      diff_finish(p, od[0], od[1], ld2[0], ld2[1], row0, hd);
    }
  }
  const int vb = (vblk_xcd() + (NVBLK >> 1)) % NVBLK;
  for (int it = vb; it < 144 * 16; it += NVBLK) {
    const int chain = it < 256 ? 128 + (it >> 4) : ((it - 256) >> 4), eb = it & 15;
    const int sq = chain >> 3, h = (chain >> 1) & 3, dir = chain & 1;
    const int nc = sq < 16 ? 4 : 16;
    const int ib = mitem_id(sq, h, dir, 0);
    const int e = eb * 1024 + tid * 4;
    float4 C = make_float4(0.f, 0.f, 0.f, 0.f);
    if (sq >= 16) C = *(const float4*)(p.st_C + (size_t)(((sq - 16) * 2 + dir) * 4 + h) * 16384 + e);
    float4 uu[16];
    float dcs[16], scl[16], bLs[16], mxs[16];
#pragma unroll
    for (int j = 0; j < 16; ++j) {
      if (j < nc) { bLs[j] = p.SC[(ib + j) * 4 + 0]; mxs[j] = p.SC[(ib + j) * 4 + 1]; uu[j] = load_bf4(p.UC + (size_t)(ib + j) * 16384 + e); }
    }
    float mrun = 0.f;
    if (sq >= 16) mrun = p.st_m[((sq - 16) * 2 + dir) * 4 + h];
#pragma unroll
    for (int j = 0; j < 16; ++j) {
      if (j < nc) {
        const float mnext = fmaxf(bLs[j] + mrun, mxs[j]);
        dcs[j] = fexp(bLs[j] + mrun - mnext);
        scl[j] = fexp(mxs[j] - mnext);
        if (eb == 0 && tid == 0) p.SCM[ib + j] = mrun;
        mrun = mnext;
      }
    }
#pragma unroll
    for (int j = 0; j < 16; ++j) {
      if (j < nc) {
        uint2 o; o.x = pack2(C.x, C.y); o.y = pack2(C.z, C.w);
        *(uint2*)(p.CST + (size_t)(ib + j) * 16384 + e) = o;
        const float dc = dcs[j], sc = scl[j];
        C.x = dc * C.x + sc * uu[j].x; C.y = dc * C.y + sc * uu[j].y; C.z = dc * C.z + sc * uu[j].z; C.w = dc * C.w + sc * uu[j].w;
      }
    }
    if (sq < 16) *(float4*)(p.out + O_C + (size_t)((sq * 2 + dir) * 4 + h) * 16384 + e) = C;
    if (eb == 0 && tid < 128) {
      float n = 0.f;
      if (sq >= 16) n = p.st_n[(((sq - 16) * 2 + dir) * 4 + h) * 128 + tid];
#pragma unroll
      for (int j = 0; j < 16; ++j) {
        if (j < nc) {
          p.NST[(ib + j) * 128 + tid] = n;
          n = dcs[j] * n + scl[j] * p.NU[(ib + j) * 128 + tid];
        }
      }
      if (sq < 16) {
        p.out[O_N + ((sq * 2 + dir) * 4 + h) * 128 + tid] = n;
        if (tid == 0) p.out[O_M + (sq * 2 + dir) * 4 + h] = mrun;
      }
    }
  }
}

DI void phase11(const Params& p, char* smem) {
  const int tid = TIDX, lane = tid & 63, wave = tid >> 6, g = lane >> 4, l16 = lane & 15;
  bf16_t* sK = (bf16_t*)smem;
  bf16_t* sVT = sK + 64 * 128;
  float* sB = (float*)(sVT + 128 * LDT);
  float* sA = sB + 128;
  float* sMT = sA + 128;
  bf16_t* sC = (bf16_t*)(smem + 36352);
  for (int it = VBLK; it < 512; it += NVBLK) {
    if (it >= 384) {
    const int li = it - 384;
    const int b = li >> 6, hd = (li >> 4) & 3, qb = li & 15, row0 = 4096 + b * 1024 + qb * 64;
    f32x4 oc[2][8];
    float lc[2];
#pragma unroll
    for (int n = 0; n < 2; ++n) {
      const size_t b0 = (size_t)((li * 2 + 0) * 2 + n) * 4 + wave, b1 = (size_t)((li * 2 + 1) * 2 + n) * 4 + wave;
      const float2 ml0 = *(const float2*)(p.ML + (b0 * 64 + lane) * 2), ml1 = *(const float2*)(p.ML + (b1 * 64 + lane) * 2);
      const float m = fmaxf(ml0.x, ml1.x);
      const float f0 = __builtin_amdgcn_exp2f((ml0.x - m) * (0.125f * 1.4426950408889634f)), f1 = __builtin_amdgcn_exp2f((ml1.x - m) * (0.125f * 1.4426950408889634f));
      lc[n] = ml0.y * f0 + ml1.y * f1;
#pragma unroll
      for (int i = 0; i < 8; ++i) {
        const float4 a0 = load_bf4(p.OP + ((b0 * 8 + i) * 64 + lane) * 4), a1 = load_bf4(p.OP + ((b1 * 8 + i) * 64 + lane) * 4);
        oc[n][i] = f32x4{a0.x * f0 + a1.x * f1, a0.y * f0 + a1.y * f1, a0.z * f0 + a1.z * f1, a0.w * f0 + a1.w * f1};
      }
    }
    diff_finish(p, oc[0], oc[1], lc[0], lc[1], row0, hd);
    continue;
    }
    int sq, h, c, nc, rowbase;
    if (it < 128) { sq = 16 + (it >> 6); h = (it >> 4) & 3; c = it & 15; nc = 16; rowbase = 4096 + (sq - 16) * 1024; }
    else { const int i = it - 128; sq = i >> 4; h = (i >> 2) & 3; c = i & 3; nc = 4; rowbase = sq * 256; }
    const int row0 = rowbase + c * 64;
    float mst[2];
    int item[2];
    item[0] = mitem_id(sq, h, 0, c);
    item[1] = mitem_id(sq, h, 1, nc - 1 - c);
    u32x4 cr[8];
    {
      const bf16_t* cst0 = p.CST + (size_t)item[0] * 16384;
#pragma unroll
      for (int i = 0; i < 8; ++i) cr[i] = *(const u32x4*)(cst0 + (tid + 256 * i) * 8);
    }
    __syncthreads();
#pragma unroll
    for (int dir = 0; dir < 2; ++dir) {
      const int j = dir ? nc - 1 - c : c;
      mst[dir] = p.SCM[item[dir]];
      if (wave == 0) {
        float ig, lf;
        mlstm_gates(p, rowbase, nc, h, dir, j, lane, ig, lf);
        const float b = scan_add(lf, lane);
        const float a = ig - b;
        const float pm = scan_max(a, lane);
        const float mt = b + fmaxf(mst[dir], pm);
        const int so = dir ? 63 - lane : lane;
        sB[dir * 64 + so] = b; sA[dir * 64 + so] = a; sMT[dir * 64 + so] = mt;
      }
    }
    for (int c = tid; c < 64 * 16; c += 256) {
      const int r = c >> 4, ch = c & 15;
      *(uint4*)(sK + (ch >> 2) * 2048 + r * 32 + (((ch & 3) ^ ((4 - ((r >> 2) & 3)) & 3)) * 8)) = *(const uint4*)(p.U1 + (size_t)(row0 + r) * OIN + 512 + h * 128 + ch * 8);
    }
    stage_T64<128>(sVT, p.U1 + (size_t)row0 * OIN + 1024 + h * 128, OIN, nullptr);
#pragma unroll
    for (int i = 0; i < 8; ++i) {
      const int cc = tid + 256 * i, r = cc >> 4, ch = cc & 15;
      *(u32x4*)(sC + (ch >> 2) * 4096 + r * 32 + (((ch & 3) ^ ((4 - ((r >> 2) & 3)) & 3)) * 8)) = cr[i];
    }
    bf16x8 qf[4];
    const int tq = wave * 16 + l16;
    const int row = row0 + tq;
#pragma unroll
    for (int ks = 0; ks < 4; ++ks) qf[ks] = *(const bf16x8*)(p.U1 + (size_t)row * OIN + h * 128 + ks * 32 + g * 8);
    __syncthreads();
    f32x4 hsum[8];
#pragma unroll
    for (int i = 0; i < 8; ++i) hsum[i] = f32x4{0.f, 0.f, 0.f, 0.f};
#pragma unroll 1
    for (int dir = 0; dir < 2; ++dir) {
      const float bt = sB[dir * 64 + tq], mtt = sMT[dir * 64 + tq];
      const float mst_d = dir ? mst[1] : mst[0];
      const int item_d = dir ? item[1] : item[0];
      const float w_inter = fexp(bt + mst_d - mtt);
      const float et = bt - mtt;
      if (dir == 0) {
        const bf16_t* cst1 = p.CST + (size_t)item[1] * 16384;
#pragma unroll
        for (int i = 0; i < 8; ++i) cr[i] = *(const u32x4*)(cst1 + (tid + 256 * i) * 8);
      }
      f32x4 s[4];
      float dsum = 0.f;
#pragma unroll
      for (int t = 0; t < 4; ++t) {
        s[t] = f32x4{0.f, 0.f, 0.f, 0.f};
#pragma unroll
        for (int ks = 0; ks < 4; ++ks) {
          const bf16x8 kf = *(const bf16x8*)(sK + ks * 2048 + (t * 16 + l16) * 32 + ((g ^ ((4 - (l16 >> 2)) & 3)) * 8));
          s[t] = MFMA16(kf, qf[ks], s[t]);
        }
#pragma unroll
        for (int j = 0; j < 4; ++j) {
          const int sk = t * 16 + g * 4 + j;
          const bool ok = dir ? (sk >= tq) : (sk <= tq);
          const float w = ok ? fexp(et + sA[dir * 64 + sk]) : 0.f;
          s[t][j] *= w;
          dsum += s[t][j];
        }
      }
      dsum = xsum_16_32(dsum);
      f32x4 acc[8];
#pragma unroll
      for (int vt = 0; vt < 8; ++vt) {
        acc[vt] = f32x4{0.f, 0.f, 0.f, 0.f};
#pragma unroll
        for (int ks = 0; ks < 4; ++ks) {
          const bf16x8 cf = *(const bf16x8*)(sC + ks * 4096 + (vt * 16 + l16) * 32 + ((g ^ ((4 - (l16 >> 2)) & 3)) * 8));
          acc[vt] = MFMA16(cf, qf[ks], acc[vt]);
        }
        acc[vt] *= w_inter;
        if ((vt & 3) == 3) asm volatile("" ::: "memory");
      }
#pragma unroll
      for (int kb = 0; kb < 2; ++kb) {
        bf16x8 pf;
#pragma unroll
        for (int j = 0; j < 4; ++j) { pf[j] = (short)f2bf(s[2 * kb][j]); pf[4 + j] = (short)f2bf(s[2 * kb + 1][j]); }
#pragma unroll
        for (int vt = 0; vt < 8; ++vt) {
          const bf16_t* vp = sVT + (vt * 16 + l16) * LDT + kb * 32 + g * 4;
          const bf16x4 lo = *(const bf16x4*)(vp);
          const bf16x4 hi = *(const bf16x4*)(vp + 16);
          const bf16x8 vf = __builtin_shufflevector(lo, hi, 0, 1, 2, 3, 4, 5, 6, 7);
          acc[vt] = MFMA16(vf, pf, acc[vt]);
        }
      }
      float nq = 0.f;
      const float* nst = p.NST + (size_t)item_d * 128;
#pragma unroll
      for (int ks = 0; ks < 4; ++ks) {
        const float4 n0 = *(const float4*)(nst + ks * 32 + g * 8), n1 = *(const float4*)(nst + ks * 32 + g * 8 + 4);
        nq += n0.x * bf2f((bf16_t)qf[ks][0]) + n0.y * bf2f((bf16_t)qf[ks][1]) + n0.z * bf2f((bf16_t)qf[ks][2]) + n0.w * bf2f((bf16_t)qf[ks][3]);
        nq += n1.x * bf2f((bf16_t)qf[ks][4]) + n1.y * bf2f((bf16_t)qf[ks][5]) + n1.z * bf2f((bf16_t)qf[ks][6]) + n1.w * bf2f((bf16_t)qf[ks][7]);
      }
      nq = xsum_16_32(nq);
      const float den = w_inter * nq + dsum;
      const float dinv = 1.f / fmaxf(fabsf(den), fexp(-mtt));
#pragma unroll
      for (int vt = 0; vt < 8; ++vt) hsum[vt] += acc[vt] * dinv;
      if (dir == 0) {
        __syncthreads();
#pragma unroll
        for (int i = 0; i < 8; ++i) {
          const int cc = tid + 256 * i, r = cc >> 4, ch = cc & 15;
          *(u32x4*)(sC + (ch >> 2) * 4096 + r * 32 + (((ch & 3) ^ ((4 - ((r >> 2) & 3)) & 3)) * 8)) = cr[i];
        }
        __syncthreads();
      }
    }
    const bf16_t* u = p.U1 + (size_t)row * OIN;
    float ss = 0.f;
#pragma unroll
    for (int vt = 0; vt < 8; ++vt) {
      const uint2 ow = *(const uint2*)(u + 1536 + h * 128 + vt * 16 + g * 4);
      hsum[vt][0] *= sigmf(lo2f(ow.x)); hsum[vt][1] *= sigmf(hi2f(ow.x));
      hsum[vt][2] *= sigmf(lo2f(ow.y)); hsum[vt][3] *= sigmf(hi2f(ow.y));
#pragma unroll
      for (int j = 0; j < 4; ++j) ss += hsum[vt][j] * hsum[vt][j];
    }
    ss = xsum_16_32(ss);
    const float r = rsqrtf(ss * (1.f / 128.f) + EPSF);
#pragma unroll
    for (int vt = 0; vt < 8; ++vt) {
      const int v = h * 128 + vt * 16 + g * 4;
      const uint2 zw = *(const uint2*)(u + 2064 + v);
      const float4 gn = *(const float4*)(p.o_mnorm_g + v);
      f32x4 rr;
      rr[0] = hsum[vt][0] * r * gn.x * siluf(lo2f(zw.x)); rr[1] = hsum[vt][1] * r * gn.y * siluf(hi2f(zw.x));
      rr[2] = hsum[vt][2] * r * gn.z * siluf(lo2f(zw.y)); rr[3] = hsum[vt][3] * r * gn.w * siluf(hi2f(zw.y));
      store_bf4(p.O + (size_t)row * 1024 + v, rr);
    }
  }
}

DI void phase_final(const Params& p) {
  const int tid = TIDX, lane = tid & 63, wave = tid >> 6;
  for (int it = VBLK; it < NROW / 4; it += NVBLK) {
    const int row = it * 4 + wave;
    const bf16_t* x = p.X1B + (size_t)row * 1024;
    float4 v[4];
    float ss = 0.f;
#pragma unroll
    for (int i = 0; i < 4; ++i) {
      v[i] = load_bf4(x + i * 256 + lane * 4);
      ss += v[i].x * v[i].x + v[i].y * v[i].y + v[i].z * v[i].z + v[i].w * v[i].w;
    }
    ss = wave_sum(ss);
    const float r = rsqrtf(ss * (1.f / 1024.f) + EPSF);
#pragma unroll
    for (int i = 0; i < 4; ++i) {
      const int col = i * 256 + lane * 4;
      const float4 gg = *(const float4*)(p.final_g + col);
      *(float4*)(p.out + O_Y + (size_t)row * 1024 + col) = make_float4(v[i].x * r * gg.x, v[i].y * r * gg.y, v[i].z * r * gg.z, v[i].w * r * gg.w);
    }
  }
}


#define XB_TMO      128
#define XB_XCNT(j)  (256  + 64 * (j))
#define XB_XSUB(j)  (1280 + 64 * (j))
#define XB_XGEN(j)  (2304 + 64 * (j))
#define XB_TOP      3328
#define XB_TOPGEN   3392
#define XCD_BAR_WORDS 3456
#define XB_SPIN_CAP (1u << 18)
#define LAS __attribute__((address_space(3)))
DI unsigned xb_ld(unsigned* p) { return __hip_atomic_load(p, __ATOMIC_RELAXED, __HIP_MEMORY_SCOPE_AGENT); }
DI unsigned xb_add(unsigned* p, unsigned v) { return __hip_atomic_fetch_add(p, v, __ATOMIC_RELAXED, __HIP_MEMORY_SCOPE_AGENT); }
DI unsigned xb_xcc_id() { return (unsigned)__builtin_amdgcn_s_getreg((3 << 11) | 20) & 0xFu; }
#define XB_SPIN(cond, bar) do { unsigned _sp = 0; while (cond) { __builtin_amdgcn_s_sleep(1); \
    if ((++_sp & 255u) == 0u) { if (xb_ld(&(bar)[XB_TMO])) break; if (_sp > XB_SPIN_CAP) { atomicAdd(&(bar)[XB_TMO], 1u); break; } } } } while (0)
struct XcdBarrier { unsigned* bar; unsigned x; volatile LAS unsigned* st; };
DI XcdBarrier xcd_barrier_post(unsigned* bar, volatile LAS unsigned* st) {
  XcdBarrier b; b.bar = bar; b.x = xb_xcc_id(); b.st = st;
  if (threadIdx.x == 0) (void)xb_add(&bar[XB_XCNT(b.x)], 1u);
  return b;
}
DI void xcd_barrier_complete(unsigned* bar, unsigned x, unsigned& nloc, unsigned& nx) {
  const unsigned G = gridDim.x * gridDim.y * gridDim.z;
  unsigned sum, cnt, mine, sp = 0u;
  for (;;) {
    sum = 0u; cnt = 0u; mine = 0u;
#pragma unroll
    for (unsigned j = 0; j < 16; ++j) { const unsigned c = xb_ld(&bar[XB_XCNT(j)]); sum += c; cnt += (c > 0u) ? 1u : 0u; mine = (j == x) ? c : mine; }
    if (sum == G) break;
    __builtin_amdgcn_s_sleep(1);
    if ((++sp & 255u) == 0u) { if (xb_ld(&bar[XB_TMO])) break; if (sp > XB_SPIN_CAP) { atomicAdd(&bar[XB_TMO], 1u); break; } }
  }
  nloc = mine > 0u ? mine : 1u; nx = cnt > 0u ? cnt : 1u;
}
DI void xcd_barrier(const XcdBarrier& b) {
  asm volatile("s_waitcnt vmcnt(0)" ::: "memory");
  __syncthreads();
  if (threadIdx.x == 0) {
    unsigned* bar = b.bar;
    __builtin_amdgcn_s_waitcnt(0);
    unsigned nloc = b.st[0], nx = b.st[1];
    if (nloc == 0u) { xcd_barrier_complete(bar, b.x, nloc, nx); b.st[0] = nloc; b.st[1] = nx; }
    const unsigned old = xb_add(&bar[XB_XSUB(b.x)], 1u);
    const unsigned gen = old / nloc;
    if (old + 1u == (gen + 1u) * nloc) {
      __builtin_amdgcn_fence(__ATOMIC_RELEASE, "agent");
      asm volatile("s_waitcnt vmcnt(0)" ::: "memory");
      const unsigned og = xb_add(&bar[XB_TOP], 1u);
      const unsigned tg = og / nx;
      if (og + 1u == (tg + 1u) * nx) xb_add(&bar[XB_TOPGEN], 1u);
      else XB_SPIN(xb_ld(&bar[XB_TOPGEN]) == tg, bar);
      __builtin_amdgcn_fence(__ATOMIC_ACQUIRE, "agent");
      xb_add(&bar[XB_XGEN(b.x)], 1u);
      asm volatile("s_waitcnt vmcnt(0)" ::: "memory");
    } else {
      XB_SPIN(xb_ld(&bar[XB_XGEN(b.x)]) == gen, bar);
      __builtin_amdgcn_fence(__ATOMIC_ACQUIRE, "agent");
      asm volatile("s_waitcnt vmcnt(0)" ::: "memory");
    }
  }
  __syncthreads();
}

DI void run_phase(const Params& p, char* smem0, int ph) {
  char* smem = smem0 + (ltid() >> 8) * GRP_LDS;
  switch (ph) {
    case 0: phase0(p, smem); break;
    case 1: phase0b(p, smem); wait_mod_ready(p); phase_norm(p, 0); break;
    case 2: phase_gemm_in(p, 0, smem0); break;
    case 3: phase3(p); break;
    case 4: phase_gemm_mla(p, smem0); if (NVBLK >= 512) late_weight_prep(p, smem, 352, 0, 800); else late_weight_prep(p, smem, 0, 0, 1424); break;
    case 5: phase_attn0(p, smem0); break;
    case 6: if (NVBLK >= 384) phase_out_norm_fused(p, 0, smem); else phase_gemm_out(p, 0, smem); if (NVBLK >= 512) late_weight_prep(p, smem, 384, 800, 1424); break;
    case 7: if (NVBLK < 384) phase_norm(p, 1); break;
    case 8: phase_gemm_in(p, 1, smem0); break;
    case 9: phase9(p, smem); break;
    case 10: phase10(p, smem0); break;
    case 11: phase11(p, smem); break;
    case 12: if (NVBLK >= 384) phase_out_norm_fused(p, 1, smem); else phase_gemm_out(p, 1, smem); break;
    case 13: if (NVBLK < 384) phase_final(p); break;
  }
}

__global__ void __launch_bounds__(512, 2) mk_fwd(Params p) {
#if SINGLE_LAUNCH
  extern __shared__ __attribute__((aligned(16))) char smem[];
  __shared__ uint4 xb_words;
  if (threadIdx.x == 0) xb_words = make_uint4(0u, 0u, 0u, 0u);
  __syncthreads();
  const XcdBarrier xb = xcd_barrier_post(p.BAR, (volatile LAS unsigned*)&xb_words);
  if (p.phase_hi == 12345) {
    const unsigned long long* ia = (const unsigned long long*)__builtin_amdgcn_implicitarg_ptr();
    p.BAR[XB_TMO] = (unsigned)ia[11];
  }
  run_phase(p, smem, 0);
  run_phase(p, smem, 1); xcd_barrier(xb);
  run_phase(p, smem, 2); xcd_barrier(xb);
  run_phase(p, smem, 3); xcd_barrier(xb);
  run_phase(p, smem, 4); xcd_barrier(xb);
  run_phase(p, smem, 5); xcd_barrier(xb);
  run_phase(p, smem, 6); xcd_barrier(xb);
  if (NVBLK < 384) { run_phase(p, smem, 7); xcd_barrier(xb); }
  run_phase(p, smem, 8); xcd_barrier(xb);
  run_phase(p, smem, 9); xcd_barrier(xb);
  run_phase(p, smem, 10); xcd_barrier(xb);
  run_phase(p, smem, 11); xcd_barrier(xb);
  run_phase(p, smem, 12);
  if (NVBLK < 384) { xcd_barrier(xb); run_phase(p, smem, 13); }
#endif
}

template <int PH>
__global__ void __launch_bounds__(512, 2) mk_phase(Params p) {
  extern __shared__ __attribute__((aligned(16))) char smem[];
  run_phase(p, smem, PH);
}
template <int PH>
static void launch_phases(const Params& p, hipStream_t stream) {
  hipFuncSetAttribute((const void*)mk_phase<PH>, hipFuncAttributeMaxDynamicSharedMemorySize, LDS_BYTES);
  hipLaunchKernelGGL(mk_phase<PH>, dim3(256), dim3(512), LDS_BYTES, stream, p);
  if constexpr (PH + 1 < NPHASE) launch_phases<PH + 1>(p, stream);
}

extern "C" void kernel_launch(void* const* d_in, const int* in_sizes, int n_in, void* d_out, int out_size, void* d_ws, size_t ws_size, hipStream_t stream) {
  Params p{};
  const float** fp = (const float**)&p;
  for (int i = 0; i < 34; ++i) fp[i] = (const float*)d_in[i];
  p.out = (float*)d_out;
  char* w = (char*)d_ws;
  size_t off = 0;
  auto take = [&](size_t bytes) { char* r = w + off; off += (bytes + 255) & ~(size_t)255; return r; };
  p.BAR = (unsigned*)take(XCD_BAR_WORDS * 4);
  p.CNT = (unsigned*)take((2 * 48 * 64 + 64) * 4);
  p.SSQ = (float*)take((size_t)2 * NROW * 8 * 4);
  p.MOD = (float*)take(2 * 3 * 3072 * 4);
  p.LAMV = (float*)take(256);
  p.ROPE32 = (float2*)take(1024 * 16 * 8);
  p.ROPE64 = (float2*)take(1024 * 32 * 8);
  p.WinE = (bf16_t*)take((size_t)EIN_PAD * 1024 * 2);
  p.WinO = (bf16_t*)take((size_t)OIN_PAD * 1024 * 2);
  p.Wuq = (bf16_t*)take(768 * 384 * 2);
  p.Wukv = (bf16_t*)take(1024 * 256 * 2);
  p.WoutE = (bf16_t*)take(1024 * 1024 * 2);
  p.WoutO = (bf16_t*)take(1024 * 1024 * 2);
  p.H = (bf16_t*)take((size_t)NROW * 1024 * 2);
  p.O = (bf16_t*)take((size_t)NROW * 1024 * 2);
  p.X1 = (float*)take(256);
  p.X1B = (bf16_t*)take((size_t)NROW * 1024 * 2);
  p.SC = (float*)take(768 * 4 * 4);
  p.SCM = (float*)take(768 * 4);
  p.UC = (bf16_t*)take((size_t)768 * 16384 * 2);
  p.NU = (float*)take(768 * 128 * 4);
  p.NST = (float*)take(768 * 128 * 4);
  p.OP = (bf16_t*)take((size_t)128 * 2 * 2 * 4 * 8 * 64 * 8);
  p.ML = (float*)take((size_t)128 * 2 * 2 * 4 * 64 * 8);
  p.CST = (bf16_t*)take((size_t)768 * 16384 * 2);
  const size_t region = off;
  p.U0 = (bf16_t*)take((size_t)NROW * EIN * 2);
  p.CQN = (bf16_t*)take((size_t)NROW * 384 * 2);
  p.CKVN = (bf16_t*)take((size_t)NTROW * 256 * 2);
  p.KR = (bf16_t*)take((size_t)NTROW * 32 * 2);
  p.QB = (bf16_t*)take((size_t)NROW * 512 * 2);
  p.KB = (bf16_t*)take((size_t)NTROW * 128 * 2);
  p.VB = (bf16_t*)take((size_t)NTROW * 128 * 2);
  p.Q = (bf16_t*)take((size_t)NROW * 768 * 2);
  p.KV = (bf16_t*)take((size_t)NTROW * 1024 * 2);
  const size_t end0 = off;
  off = region;
  p.U1 = (bf16_t*)take((size_t)NROW * OIN * 2);
  p.QD = (bf16_t*)take((size_t)NROW * 512 * 2);
  p.KD = (bf16_t*)take((size_t)NTROW * 512 * 2);
  p.VD = (bf16_t*)take((size_t)NTROW * 512 * 2);
  const size_t end1 = off;
  const size_t need = end0 > end1 ? end0 : end1;
  if (need > ws_size) { fprintf(stderr, "workspace too small: need %zu have %zu\n", need, ws_size); return; }

#if SINGLE_LAUNCH
  static int grid_blocks = 0;
  if (!grid_blocks) {
    int dev = 0, cus = 0, per_cu = 0;
    hipGetDevice(&dev);
    hipDeviceGetAttribute(&cus, hipDeviceAttributeMultiprocessorCount, dev);
    hipFuncSetAttribute((const void*)mk_fwd, hipFuncAttributeMaxDynamicSharedMemorySize, LDS_BYTES);
    hipOccupancyMaxActiveBlocksPerMultiprocessor(&per_cu, mk_fwd, 512, LDS_BYTES);
    if (per_cu < 1) per_cu = 1;
    grid_blocks = cus;
  }
  p.phase_lo = 0; p.phase_hi = NPHASE;
  hipMemsetAsync(p.BAR, 0, (size_t)((char*)(p.CNT + 2 * 48 * 64 + 64) - (char*)p.BAR), stream);
  void* args[] = {&p};
  hipError_t e = hipLaunchCooperativeKernel((void*)mk_fwd, dim3(grid_blocks), dim3(512), args, LDS_BYTES, stream);
  if (e != hipSuccess) fprintf(stderr, "cooperative launch failed: %s (grid %d)\n", hipGetErrorString(e), grid_blocks);
#else
  launch_phases<0>(p, stream);
#endif
}
```

```cpp
#include <hip/hip_runtime.h>
#include <hip/hip_cooperative_groups.h>
#include <cstdio>
namespace cg = cooperative_groups;

typedef unsigned short bf16_t;
using bf16x8 = __attribute__((ext_vector_type(8))) short;
using bf16x4 = __attribute__((ext_vector_type(4))) short;
using f32x4  = __attribute__((ext_vector_type(4))) float;
using u32x4  = __attribute__((ext_vector_type(4))) unsigned;
#define DI __device__ __forceinline__
#define MFMA16(a, b, c) __builtin_amdgcn_mfma_f32_16x16x32_bf16((a), (b), (c), 0, 0, 0)

#ifndef SINGLE_LAUNCH
#define SINGLE_LAUNCH 1
#endif

__device__ __forceinline__ unsigned ltid() { unsigned t = threadIdx.x; asm volatile("" : "+v"(t)); return t; }
#define TIDX ((int)(ltid() & 255u))
#define VBLK ((int)(blockIdx.x * 2 + (ltid() >> 8)))
#define NVBLK ((int)(gridDim.x * 2))
DI int vblk_xcd() {
  const int b = blockIdx.x, nb = gridDim.x;
  if (nb & 7) return VBLK;
  return ((b & 7) * (nb >> 3) + (b >> 3)) * 2 + (int)(ltid() >> 8);
}
constexpr int EIN = 2464, OIN = 4624;
constexpr int EIN_PAD = 2560, OIN_PAD = 4864;
constexpr int NROW = 6144, NTROW = 6656;
constexpr int NPHASE = 14;
constexpr int LDS_BYTES = 139264;
constexpr int GRP_LDS = 69632;
constexpr int LDT = 72;
constexpr float EPSF = 1e-6f;
constexpr float LAM_INIT = 0.35550906759097f;
constexpr size_t O_Y = 0, O_CKV = 6291456, O_KR = 7340032, O_GK = 7471104, O_GV = 7995392, O_C = 8519680,
                 O_N = 10616832, O_M = 10633216, O_DK = 10633344, O_DV = 12730496;

struct Params {
  const float *x_prompt, *x_sample, *cache_ckv, *cache_kr, *cache_gk, *cache_gv, *st_C, *st_n, *st_m, *cache_dk, *cache_dv, *c, *c_ctx;
  const float *e_norm_g, *e_ada_w, *e_ada_b, *e_w_in, *e_qn_g, *e_w_uq, *e_kvn_g, *e_w_ukv, *e_gq_g, *e_gk_g, *e_w_out;
  const float *o_norm_g, *o_ada_w, *o_ada_b, *o_w_in, *o_gate_b, *o_mnorm_g, *o_lam, *o_dnorm_g, *o_w_out, *final_g;
  float* out;
  float *MOD, *LAMV;
  float2 *ROPE32, *ROPE64;
  bf16_t *WinE, *WinO, *Wuq, *Wukv, *WoutE, *WoutO;
  bf16_t *H, *U0, *U1, *CQN, *CKVN, *KR, *QB, *KB, *VB, *Q, *KV, *O, *QD, *KD, *VD, *CST;
  float *X1, *SC, *NU, *NST, *ML, *SCM;
  bf16_t *X1B, *UC, *OP;
  unsigned* BAR;
  unsigned* CNT;
  float* SSQ;
  int phase_lo, phase_hi;
};

DI bf16_t f2bf(float x) { unsigned u = __float_as_uint(x); u += 0x7fffu + ((u >> 16) & 1u); return (bf16_t)(u >> 16); }
DI float bf2f(bf16_t b) { return __uint_as_float(((unsigned)b) << 16); }
typedef __bf16 bf2_t __attribute__((ext_vector_type(2)));
typedef float f2_t __attribute__((ext_vector_type(2)));
DI unsigned pack2(float a, float b) { f2_t v = {a, b}; return __builtin_bit_cast(unsigned, __builtin_convertvector(v, bf2_t)); }
DI float lo2f(unsigned w) { return __uint_as_float(w << 16); }
DI float hi2f(unsigned w) { return __uint_as_float(w & 0xffff0000u); }
DI float xsum_16_32(float x) {
  auto a = __builtin_amdgcn_permlane16_swap(__float_as_uint(x), __float_as_uint(x), false, false);
  const float s = __uint_as_float(a[0]) + __uint_as_float(a[1]);
  auto b = __builtin_amdgcn_permlane32_swap(__float_as_uint(s), __float_as_uint(s), false, false);
  return __uint_as_float(b[0]) + __uint_as_float(b[1]);
}
DI float xmax_16_32(float x) {
  auto a = __builtin_amdgcn_permlane16_swap(__float_as_uint(x), __float_as_uint(x), false, false);
  const float s = fmaxf(__uint_as_float(a[0]), __uint_as_float(a[1]));
  auto b = __builtin_amdgcn_permlane32_swap(__float_as_uint(s), __float_as_uint(s), false, false);
  return fmaxf(__uint_as_float(b[0]), __uint_as_float(b[1]));
}
#define DPPF(v, CTRL) __uint_as_float((unsigned)__builtin_amdgcn_mov_dpp((int)__float_as_uint(v), (CTRL), 0xF, 0xF, true))
DI float wave_sum(float v) {
  v += DPPF(v, 0xB1); v += DPPF(v, 0x4E); v += DPPF(v, 0x141); v += DPPF(v, 0x140);
  return xsum_16_32(v);
}
DI float wave_max(float v) {
  v = fmaxf(v, DPPF(v, 0xB1)); v = fmaxf(v, DPPF(v, 0x4E)); v = fmaxf(v, DPPF(v, 0x141)); v = fmaxf(v, DPPF(v, 0x140));
  return xmax_16_32(v);
}
#define DPPU(IDENT, v, CTRL, RMASK) __uint_as_float((unsigned)__builtin_amdgcn_update_dpp((int)__float_as_uint(IDENT), (int)__float_as_uint(v), (CTRL), (RMASK), 0xF, false))
DI float scan_add(float v, int) {
  v += DPPU(0.f, v, 0x111, 0xF); v += DPPU(0.f, v, 0x112, 0xF); v += DPPU(0.f, v, 0x114, 0xF); v += DPPU(0.f, v, 0x118, 0xF);
  v += DPPU(0.f, v, 0x142, 0xA);
  v += DPPU(0.f, v, 0x143, 0xC);
  return v;
}
DI float scan_max(float v, int) {
  const float ninf = -INFINITY;
  v = fmaxf(v, DPPU(ninf, v, 0x111, 0xF)); v = fmaxf(v, DPPU(ninf, v, 0x112, 0xF)); v = fmaxf(v, DPPU(ninf, v, 0x114, 0xF)); v = fmaxf(v, DPPU(ninf, v, 0x118, 0xF));
  v = fmaxf(v, DPPU(ninf, v, 0x142, 0xA));
  v = fmaxf(v, DPPU(ninf, v, 0x143, 0xC));
  return v;
}
DI float fexp(float x) { return __builtin_amdgcn_exp2f(x * 1.4426950408889634f); }
DI float logsig(float x) { return fminf(x, 0.f) - __builtin_amdgcn_logf(1.f + fexp(-fabsf(x))) * 0.6931471805599453f; }
DI float siluf(float x) { return x * __builtin_amdgcn_rcpf(1.f + fexp(-x)); }
DI float sigmf(float x) { return __builtin_amdgcn_rcpf(1.f + fexp(-x)); }
DI int cv_of_row(int row) { return row < 4096 ? 0 : 1 + ((row - 4096) >> 10); }
DI const float* xrow(const Params& p, int row) { return row < 4096 ? p.x_prompt + (size_t)row * 1024 : p.x_sample + (size_t)(row - 4096) * 1024; }

template <class Epi>
DI void gemm_tile(const bf16_t* __restrict__ X, int ldx, const bf16_t* __restrict__ W, int ldw, int N, int K, int m0, int n0, char* smem, Epi epi) {
  constexpr int LDG = 32;
  constexpr int BUFE = 256 * LDG;
  bf16_t* sb = (bf16_t*)smem;
  const int tid = TIDX, lane = tid & 63, wave = tid >> 6, wm = wave >> 1, wn = wave & 1;
  const int g = lane >> 4, l16 = lane & 15;
  f32x4 acc[4][4];
#pragma unroll
  for (int a = 0; a < 4; ++a)
#pragma unroll
    for (int b = 0; b < 4; ++b) acc[a][b] = f32x4{0.f, 0.f, 0.f, 0.f};
  const int lr = tid >> 2, lc = (tid & 3) * 8;
  const int lcs = ((tid & 3) ^ ((4 - ((lr >> 2) & 3)) & 3)) * 8;
  const int gs = (g ^ ((4 - (l16 >> 2)) & 3)) * 8;
  unsigned xoff[2], woff[2];
#pragma unroll
  for (int i = 0; i < 2; ++i) {
    xoff[i] = (unsigned)((m0 + lr + 64 * i) * ldx + lc);
    int n = n0 + lr + 64 * i; if (n > N - 1) n = N - 1;
    woff[i] = (unsigned)(n * ldw + lc);
  }
  const int nk = K >> 5;
  u32x4 rx[3][2], rw[3][2];
#define G_LOAD(S, KT) { const bf16_t* xb_ = X + (KT) * 32; const bf16_t* wb_ = W + (KT) * 32; \
    rx[S][0] = *(const u32x4*)(xb_ + xoff[0]); rx[S][1] = *(const u32x4*)(xb_ + xoff[1]); \
    rw[S][0] = *(const u32x4*)(wb_ + woff[0]); rw[S][1] = *(const u32x4*)(wb_ + woff[1]); }
#define G_STORE(S, B) { bf16_t* d_ = sb + (B) * BUFE + lr * LDG + lcs; \
    *(u32x4*)(d_) = rx[S][0]; *(u32x4*)(d_ + 64 * LDG) = rx[S][1]; \
    *(u32x4*)(d_ + 128 * LDG) = rw[S][0]; *(u32x4*)(d_ + 192 * LDG) = rw[S][1]; }
#define G_COMPUTE(B) { const bf16_t* bx_ = sb + (B) * BUFE; const bf16_t* bw_ = bx_ + 128 * LDG; \
    bf16x8 wf[4], xf[4]; \
    _Pragma("unroll") for (int i = 0; i < 4; ++i) { \
      wf[i] = *(const bf16x8*)(bw_ + (wn * 64 + i * 16 + l16) * LDG + gs); \
      xf[i] = *(const bf16x8*)(bx_ + (wm * 64 + i * 16 + l16) * LDG + gs); } \
    _Pragma("unroll") for (int ni = 0; ni < 4; ++ni) \
      _Pragma("unroll") for (int mi = 0; mi < 4; ++mi) acc[ni][mi] = MFMA16(wf[ni], xf[mi], acc[ni][mi]); }
#define G_STEP(KK, RL, RS) if ((KK) < nk) { \
    if ((KK) + 1 < nk) G_STORE(RS, ((KK) + 1) & 1) \
    if ((KK) + 3 < nk) G_LOAD(RL, (KK) + 3) \
    G_COMPUTE((KK) & 1) \
    __syncthreads(); }
  G_LOAD(0, 0) G_LOAD(1, 1) G_LOAD(2, 2)
  __syncthreads();
  G_STORE(0, 0)
  __syncthreads();
  for (int k0 = 0; k0 < nk; k0 += 3) {
    G_STEP(k0, 0, 1)
    G_STEP(k0 + 1, 1, 2)
    G_STEP(k0 + 2, 2, 0)
  }
#undef G_LOAD
#undef G_STORE
#undef G_COMPUTE
#undef G_STEP
#pragma unroll
  for (int ni = 0; ni < 4; ++ni) {
    const int n = n0 + wn * 64 + ni * 16 + g * 4;
    if (n < N) {
#pragma unroll
      for (int mi = 0; mi < 4; ++mi) epi(m0 + wm * 64 + mi * 16 + l16, n, acc[ni][mi]);
    }
  }
}

template <class Epi>
DI void gemm_tile64(const bf16_t* __restrict__ X, int ldx, const bf16_t* __restrict__ W, int ldw, int N, int K, int m0, int n0, char* smem, Epi epi) {
  constexpr int PANE = 256 * 32;
  constexpr int BUFE = 2 * PANE;
  bf16_t* sb = (bf16_t*)smem;
  const int tid = TIDX, lane = tid & 63, wave = tid >> 6, wm = wave >> 1, wn = wave & 1;
  const int g = lane >> 4, l16 = lane & 15;
  f32x4 acc[4][4];
#pragma unroll
  for (int a = 0; a < 4; ++a)
#pragma unroll
    for (int b = 0; b < 4; ++b) acc[a][b] = f32x4{0.f, 0.f, 0.f, 0.f};
  const int lr = tid >> 3, ch = tid & 7;
  const int soff = (ch >> 2) * PANE + lr * 32 + (((ch & 3) ^ ((4 - ((lr >> 2) & 3)) & 3)) * 8);
  const int gs = (g ^ ((4 - (l16 >> 2)) & 3)) * 8;
  unsigned xoff[4], woff[4];
#pragma unroll
  for (int i = 0; i < 4; ++i) {
    xoff[i] = (unsigned)((m0 + lr + 32 * i) * ldx + ch * 8);
    int n = n0 + lr + 32 * i; if (n > N - 1) n = N - 1;
    woff[i] = (unsigned)(n * ldw + ch * 8);
  }
  const int nk = K >> 6;
  u32x4 rx[2][4], rw[2][4];
#define H_LOAD(S, KT) { const bf16_t* xb_ = X + (KT) * 64; const bf16_t* wb_ = W + (KT) * 64; \
    _Pragma("unroll") for (int i = 0; i < 4; ++i) { rx[S][i] = *(const u32x4*)(xb_ + xoff[i]); rw[S][i] = *(const u32x4*)(wb_ + woff[i]); } }
#define H_STORE(S, B) { bf16_t* d_ = sb + (B) * BUFE + soff; \
    _Pragma("unroll") for (int i = 0; i < 4; ++i) { *(u32x4*)(d_ + (32 * i) * 32) = rx[S][i]; *(u32x4*)(d_ + (128 + 32 * i) * 32) = rw[S][i]; } }
#define H_COMPUTE(B) { _Pragma("unroll") for (int ks = 0; ks < 2; ++ks) { const bf16_t* bx_ = sb + (B) * BUFE + ks * PANE; const bf16_t* bw_ = bx_ + 128 * 32; \
    bf16x8 wf[4], xf[4]; \
    _Pragma("unroll") for (int i = 0; i < 4; ++i) { \
      wf[i] = *(const bf16x8*)(bw_ + (wn * 64 + i * 16 + l16) * 32 + gs); \
      xf[i] = *(const bf16x8*)(bx_ + (wm * 64 + i * 16 + l16) * 32 + gs); } \
    _Pragma("unroll") for (int ni = 0; ni < 4; ++ni) \
      _Pragma("unroll") for (int mi = 0; mi < 4; ++mi) acc[ni][mi] = MFMA16(wf[ni], xf[mi], acc[ni][mi]); } }
#define H_STEP(KK, SL) if ((KK) < nk) { \
    if ((KK) + 1 < nk) H_STORE((SL) ^ 1, ((KK) + 1) & 1) \
    if ((KK) + 2 < nk) H_LOAD(SL, (KK) + 2) \
    H_COMPUTE((KK) & 1) \
    __syncthreads(); }
  H_LOAD(0, 0)
  if (nk > 1) H_LOAD(1, 1)
  __syncthreads();
  H_STORE(0, 0)
  __syncthreads();
  for (int k0 = 0; k0 < nk; k0 += 2) {
    H_STEP(k0, 0)
    H_STEP(k0 + 1, 1)
  }
#undef H_LOAD
#undef H_STORE
#undef H_COMPUTE
#undef H_STEP
#pragma unroll
  for (int ni = 0; ni < 4; ++ni) {
    const int n = n0 + wn * 64 + ni * 16 + g * 4;
    if (n < N) {
#pragma unroll
      for (int mi = 0; mi < 4; ++mi) epi(m0 + wm * 64 + mi * 16 + l16, n, acc[ni][mi]);
    }
  }
}

DI void gemm_tile64_acc(const bf16_t* __restrict__ X, int ldx, const bf16_t* __restrict__ W, int ldw, int N, int K, int m0, int n0, char* smem, f32x4 (&acc)[4][4]) {
  constexpr int PANE = 256 * 32;
  constexpr int BUFE = 2 * PANE;
  bf16_t* sb = (bf16_t*)smem;
  const int tid = TIDX, lane = tid & 63, wave = tid >> 6, wm = wave >> 1, wn = wave & 1;
  const int g = lane >> 4, l16 = lane & 15;
#pragma unroll
  for (int a = 0; a < 4; ++a)
#pragma unroll
    for (int b = 0; b < 4; ++b) acc[a][b] = f32x4{0.f, 0.f, 0.f, 0.f};
  const int lr = tid >> 3, ch = tid & 7;
  const int soff = (ch >> 2) * PANE + lr * 32 + (((ch & 3) ^ ((4 - ((lr >> 2) & 3)) & 3)) * 8);
  const int gs = (g ^ ((4 - (l16 >> 2)) & 3)) * 8;
  unsigned xoff[4], woff[4];
#pragma unroll
  for (int i = 0; i < 4; ++i) {
    xoff[i] = (unsigned)((m0 + lr + 32 * i) * ldx + ch * 8);
    int n = n0 + lr + 32 * i; if (n > N - 1) n = N - 1;
    woff[i] = (unsigned)(n * ldw + ch * 8);
  }
  const int nk = K >> 6;
  u32x4 rx[2][4], rw[2][4];
#define H_LOAD(S, KT) { const bf16_t* xb_ = X + (KT) * 64; const bf16_t* wb_ = W + (KT) * 64; \
    _Pragma("unroll") for (int i = 0; i < 4; ++i) { rx[S][i] = *(const u32x4*)(xb_ + xoff[i]); rw[S][i] = *(const u32x4*)(wb_ + woff[i]); } }
#define H_STORE(S, B) { bf16_t* d_ = sb + (B) * BUFE + soff; \
    _Pragma("unroll") for (int i = 0; i < 4; ++i) { *(u32x4*)(d_ + (32 * i) * 32) = rx[S][i]; *(u32x4*)(d_ + (128 + 32 * i) * 32) = rw[S][i]; } }
#define H_COMPUTE(B) { _Pragma("unroll") for (int ks = 0; ks < 2; ++ks) { const bf16_t* bx_ = sb + (B) * BUFE + ks * PANE; const bf16_t* bw_ = bx_ + 128 * 32; \
    bf16x8 wf[4], xf[4]; \
    _Pragma("unroll") for (int i = 0; i < 4; ++i) { \
      wf[i] = *(const bf16x8*)(bw_ + (wn * 64 + i * 16 + l16) * 32 + gs); \
      xf[i] = *(const bf16x8*)(bx_ + (wm * 64 + i * 16 + l16) * 32 + gs); } \
    _Pragma("unroll") for (int ni = 0; ni < 4; ++ni) \
      _Pragma("unroll") for (int mi = 0; mi < 4; ++mi) acc[ni][mi] = MFMA16(wf[ni], xf[mi], acc[ni][mi]); } }
#define H_STEP(KK, SL) if ((KK) < nk) { \
    if ((KK) + 1 < nk) H_STORE((SL) ^ 1, ((KK) + 1) & 1) \
    if ((KK) + 2 < nk) H_LOAD(SL, (KK) + 2) \
    H_COMPUTE((KK) & 1) \
    __syncthreads(); }
  H_LOAD(0, 0)
  if (nk > 1) H_LOAD(1, 1)
  __syncthreads();
  H_STORE(0, 0)
  __syncthreads();
  for (int k0 = 0; k0 < nk; k0 += 2) {
    H_STEP(k0, 0)
    H_STEP(k0 + 1, 1)
  }
#undef H_LOAD
#undef H_STORE
#undef H_COMPUTE
#undef H_STEP
}

template <class Epi>
DI void gemm256(const bf16_t* __restrict__ X, int ldx, const bf16_t* __restrict__ W, int ldw, int N, int K, int m0, int n0, char* smem, Epi epi) {
  constexpr int LDG = 32;
  constexpr int BUFE = 512 * LDG;
  bf16_t* sb = (bf16_t*)smem;
  const int tid = (int)ltid(), lane = tid & 63, wave = tid >> 6, wm = wave >> 2, wn = wave & 3;
  const int g = lane >> 4, l16 = lane & 15;
  f32x4 acc[4][8];
#pragma unroll
  for (int a = 0; a < 4; ++a)
#pragma unroll
    for (int b = 0; b < 8; ++b) acc[a][b] = f32x4{0.f, 0.f, 0.f, 0.f};
  const int lr = tid >> 2, lc = (tid & 3) * 8;
  const int lcs = ((tid & 3) ^ ((4 - ((lr >> 2) & 3)) & 3)) * 8;
  const int gs = (g ^ ((4 - (l16 >> 2)) & 3)) * 8;
  unsigned xoff[2], woff[2];
#pragma unroll
  for (int i = 0; i < 2; ++i) {
    xoff[i] = (unsigned)((m0 + lr + 128 * i) * ldx + lc);
    int n = n0 + lr + 128 * i; if (n > N - 1) n = N - 1;
    woff[i] = (unsigned)(n * ldw + lc);
  }
  const int nk = K >> 5;
  u32x4 rx[3][2], rw[3][2];
#define G_LOAD(S, KT) { const bf16_t* xb_ = X + (KT) * 32; const bf16_t* wb_ = W + (KT) * 32; \
    rx[S][0] = *(const u32x4*)(xb_ + xoff[0]); rx[S][1] = *(const u32x4*)(xb_ + xoff[1]); \
    rw[S][0] = *(const u32x4*)(wb_ + woff[0]); rw[S][1] = *(const u32x4*)(wb_ + woff[1]); }
#define G_STORE(S, B) { bf16_t* d_ = sb + (B) * BUFE + lr * LDG + lcs; \
    *(u32x4*)(d_) = rx[S][0]; *(u32x4*)(d_ + 128 * LDG) = rx[S][1]; \
    *(u32x4*)(d_ + 256 * LDG) = rw[S][0]; *(u32x4*)(d_ + 384 * LDG) = rw[S][1]; }
#define G_COMPUTE(B) { const bf16_t* bx_ = sb + (B) * BUFE; const bf16_t* bw_ = bx_ + 256 * LDG; \
    bf16x8 wf[4], xf[8]; \
    _Pragma("unroll") for (int i = 0; i < 4; ++i) wf[i] = *(const bf16x8*)(bw_ + (wn * 64 + i * 16 + l16) * LDG + gs); \
    _Pragma("unroll") for (int i = 0; i < 8; ++i) xf[i] = *(const bf16x8*)(bx_ + (wm * 128 + i * 16 + l16) * LDG + gs); \
    _Pragma("unroll") for (int ni = 0; ni < 4; ++ni) \
      _Pragma("unroll") for (int mi = 0; mi < 8; ++mi) acc[ni][mi] = MFMA16(wf[ni], xf[mi], acc[ni][mi]); }
#define G_STEP(KK, RL, RS) if ((KK) < nk) { \
    if ((KK) + 1 < nk) G_STORE(RS, ((KK) + 1) & 1) \
    if ((KK) + 3 < nk) G_LOAD(RL, (KK) + 3) \
    G_COMPUTE((KK) & 1) \
    __syncthreads(); }
  G_LOAD(0, 0) G_LOAD(1, 1) G_LOAD(2, 2)
  __syncthreads();
  G_STORE(0, 0)
  __syncthreads();
  for (int k0 = 0; k0 < nk; k0 += 3) {
    G_STEP(k0, 0, 1)
    G_STEP(k0 + 1, 1, 2)
    G_STEP(k0 + 2, 2, 0)
  }
#undef G_LOAD
#undef G_STORE
#undef G_COMPUTE
#undef G_STEP
#pragma unroll
  for (int ni = 0; ni < 4; ++ni) {
    const int n = n0 + wn * 64 + ni * 16 + g * 4;
    if (n < N) {
#pragma unroll
      for (int mi = 0; mi < 8; ++mi) epi(m0 + wm * 128 + mi * 16 + l16, n, acc[ni][mi]);
    }
  }
}

namespace pg8 {
#define PG8_LAS __attribute__((address_space(3)))
typedef unsigned short bf16_t;
typedef short bf16x8 __attribute__((ext_vector_type(8)));
typedef float f32x4 __attribute__((ext_vector_type(4)));
typedef unsigned u32x4 __attribute__((ext_vector_type(4)));
constexpr int BM = 256, BK = 64, HALF = 128, HTB = HALF * BK * 2  , STAGE_BYTES = 8 * HTB, NXCD = 8, WGM = 8;

__host__ __device__ __forceinline__ int lds_byte(int r, int c) { const int st = (r >> 4) * 2 + (c >> 5), rr = r & 15, cc = c & 31, ob = rr * 64 + cc * 2; return st * 1024 + (ob ^ (((ob >> 9) & 1) << 5)); }
__host__ __device__ __forceinline__ void stage_rc(int b, int& R, int& C) { const int st = b / 1024, sb = b % 1024, swz = sb ^ (((sb >> 9) & 1) << 5); R = (st >> 1) * 16 + swz / 64; C = (st & 1) * 32 + (swz % 64) / 2; }
__host__ __device__ __forceinline__ int perm32(int rho) { const int n = rho >> 4, i = rho & 15; return 8 * (i >> 2) + 4 * n + (i & 3); }

struct Unit { int pm, pn; };
struct Gemm { const bf16_t* A; const bf16_t* Bt; int M, N, K; };

struct StaticOrder {
    int nM, nN, nwg, G, c;
    __host__ __device__ void init(int M, int N, int G_, int c_) { nM = M / BM; nN = N / BM; nwg = nM * nN; G = G_; c = c_; }
    __host__ __device__ bool next(int i, Unit& u) const {
        const long L = (long)i * G + c; if (L >= nwg) return false;
        int wgid = (int)L; { const int q = nwg / NXCD, r = nwg % NXCD, xcd = wgid % NXCD, off = wgid / NXCD; wgid = (xcd < r ? xcd * (q + 1) : r * (q + 1) + (xcd - r) * q) + off; }
        const int nig = WGM * nN, gid = wgid / nig, fm = gid * WGM, gsz = (nM - fm) < WGM ? (nM - fm) : WGM;
        u.pm = fm + ((wgid % nig) % gsz); u.pn = (wgid % nig) / gsz; return true;
    }
    __device__ __forceinline__ void a_ready(const Unit&) const {}
    __device__ __forceinline__ void done(const Unit&) const {}
};
__device__ __forceinline__ unsigned cvt_pk_bf16(float lo, float hi) { unsigned r; asm volatile("v_cvt_pk_bf16_f32 %0, %1, %2" : "=v"(r) : "v"(lo), "v"(hi)); return r; }
template <class Epi, class Sched, bool STAMP = false>
__device__ __forceinline__ void gemm_phase(PG8_LAS unsigned char* lds, const Gemm g, const Sched& S, const Epi& E, unsigned long long* stamps) {
    const int tid = (int)ltid(), wid = __builtin_amdgcn_readfirstlane(tid >> 6), lane = tid & 63, wr = wid >> 2, wc = wid & 3, fr = lane & 15, fq = lane >> 4;
    const int K = g.K, nt = K / BK;
    int ts_lo = 0, ts_hi = 0, nts = 0; const unsigned long long rt_entry = STAMP ? (unsigned long long)wall_clock64() : 0ull;
#define PG8_STAMP() do { if (STAMP && wid == 0 && nts < 64) { const unsigned long long _c = (unsigned long long)clock64(); \
        ts_lo = (lane == nts) ? (int)(unsigned)_c : ts_lo; ts_hi = (lane == nts) ? (int)(unsigned)(_c >> 32) : ts_hi; ++nts; } } while (0)
    PG8_STAMP();
    unsigned voffA[2], voffB[2];
#pragma unroll
    for (int i = 0; i < 2; ++i) { int R, C; stage_rc(tid * 16 + i * 8192, R, C); const int Rb = Epi::PERM ? ((R & ~31) + perm32(R & 31)) : R;
        voffA[i] = (unsigned)(R * K + C) * 2u; voffB[i] = (unsigned)(Rb * K + C) * 2u; }
    const size_t kstep = (size_t)(BK * 2);
    const size_t hstep = (size_t)HALF * K * 2;
    const size_t tstep = 2 * hstep;
    const unsigned ldsw = (unsigned)wid * 1024u;
    const int aoff = lds_byte(wr * 64 + fr, fq * 8), boff = lds_byte(wc * 32 + fr, fq * 8);
#define PG8_SA(b, h) (((b) * 2 + (h)) * HTB)
#define PG8_SB(b, h) ((4 + (b) * 2 + (h)) * HTB)
#define PG8_STAGE(bufoff, gbase, voff) do { _Pragma("unroll") for (int _i = 0; _i < 2; ++_i) \
        __builtin_amdgcn_global_load_lds((const unsigned*)((const char*)(gbase) + (voff)[_i]), (PG8_LAS unsigned*)(lds + (bufoff) + ldsw + _i * 8192), 16, 0, 0); } while (0)
#define PG8_LDA(dst, b, h) do { _Pragma("unroll") for (int m = 0; m < 4; ++m) _Pragma("unroll") for (int k = 0; k < 2; ++k) dst[m][k] = *(const PG8_LAS bf16x8*)(lds + PG8_SA(b, h) + aoff + m * 2048 + k * 1024); } while (0)
#define PG8_LDB(dst, b, h) do { _Pragma("unroll") for (int n = 0; n < 2; ++n) _Pragma("unroll") for (int k = 0; k < 2; ++k) dst[n][k] = *(const PG8_LAS bf16x8*)(lds + PG8_SB(b, h) + boff + n * 2048 + k * 1024); } while (0)
#define PG8_MMA(ai, bj, At, Bt) do { __builtin_amdgcn_s_setprio(1); _Pragma("unroll") for (int m = 0; m < 4; ++m) _Pragma("unroll") for (int n = 0; n < 2; ++n) _Pragma("unroll") for (int k = 0; k < 2; ++k) \
        acc[ai][bj][m][n] = __builtin_amdgcn_mfma_f32_16x16x32_bf16(Bt[n][k], At[m][k], acc[ai][bj][m][n], 0, 0, 0); __builtin_amdgcn_s_setprio(0); } while (0)
#define PG8_WAIT_V(n) asm volatile("s_waitcnt vmcnt(" #n ")" ::: "memory")
#define PG8_WAIT_L(n) asm volatile("s_waitcnt lgkmcnt(" #n ")" ::: "memory")
#define PG8_BAR __builtin_amdgcn_s_barrier()
#define PG8_SCHED __builtin_amdgcn_sched_barrier(0)
    Unit cur, nxt; int ui = 0;
    if (!S.next(0, cur)) return;
    f32x4 acc[2][2][4][2];
#pragma unroll
    for (int a = 0; a < 2; ++a)
#pragma unroll
        for (int b = 0; b < 2; ++b)
#pragma unroll
            for (int m = 0; m < 4; ++m)
#pragma unroll
                for (int n = 0; n < 2; ++n) acc[a][b][m][n] = (f32x4){0.f, 0.f, 0.f, 0.f};
    bf16x8 At[4][2], B0[2][2], B1[2][2];
    const char* cA = (const char*)g.A + (size_t)cur.pm * tstep; const char* cB = (const char*)g.Bt + (size_t)cur.pn * tstep;
    S.a_ready(cur);
    PG8_STAGE(PG8_SB(0, 0), cB, voffB); PG8_STAGE(PG8_SA(0, 0), cA, voffA); PG8_STAGE(PG8_SB(0, 1), cB + hstep, voffB); PG8_STAGE(PG8_SA(0, 1), cA + hstep, voffA);
    if (wr == 1) PG8_BAR;
    PG8_WAIT_V(4); PG8_BAR;
    PG8_STAGE(PG8_SB(1, 0), cB + kstep, voffB); PG8_STAGE(PG8_SA(1, 0), cA + kstep, voffA); PG8_STAGE(PG8_SB(1, 1), cB + hstep + kstep, voffB);
    PG8_WAIT_V(6); PG8_BAR;
    PG8_STAMP();
    for (;;) {
        const bool has_next = S.next(ui + 1, nxt);
        const char* nA = has_next ? (const char*)g.A + (size_t)nxt.pm * tstep : cA; const char* nB = has_next ? (const char*)g.Bt + (size_t)nxt.pn * tstep : cB;
        for (int t = 0; t < nt; t += 2) {
            const bool last = (t == nt - 2);
            const char* a1 = cA + (size_t)(t + 1) * kstep;
            const char* a2 = last ? nA : cA + (size_t)(t + 2) * kstep; const char* b2 = last ? nB : cB + (size_t)(t + 2) * kstep;
            const char* a3 = a2 + kstep; const char* b3 = b2 + kstep;
            if (last && has_next) S.a_ready(nxt);
            PG8_LDB(B0, 0, 0); PG8_SCHED; PG8_LDA(At, 0, 0); PG8_STAGE(PG8_SA(1, 1), a1 + hstep, voffA);
            PG8_WAIT_L(8); PG8_BAR; PG8_WAIT_L(0); PG8_MMA(0, 0, At, B0); PG8_BAR; PG8_SCHED;
            PG8_LDB(B1, 0, 1); PG8_STAGE(PG8_SB(0, 0), b2, voffB);
            PG8_BAR; PG8_WAIT_L(0); PG8_MMA(0, 1, At, B1); PG8_BAR;
            PG8_LDA(At, 0, 1); PG8_STAGE(PG8_SA(0, 0), a2, voffA);
            PG8_BAR; PG8_WAIT_L(0); PG8_MMA(1, 0, At, B0); PG8_BAR; PG8_SCHED;
            PG8_STAGE(PG8_SB(0, 1), b2 + hstep, voffB);
            PG8_WAIT_V(6); PG8_BAR; PG8_MMA(1, 1, At, B1); PG8_BAR;
            PG8_LDB(B0, 1, 0); PG8_SCHED; PG8_LDA(At, 1, 0); PG8_STAGE(PG8_SA(0, 1), a2 + hstep, voffA);
            PG8_WAIT_L(8); PG8_BAR; PG8_WAIT_L(0); PG8_MMA(0, 0, At, B0); PG8_BAR; PG8_SCHED;
            PG8_LDB(B1, 1, 1); PG8_STAGE(PG8_SB(1, 0), b3, voffB);
            PG8_BAR; PG8_WAIT_L(0); PG8_MMA(0, 1, At, B1); PG8_BAR;
            PG8_LDA(At, 1, 1); PG8_STAGE(PG8_SA(1, 0), a3, voffA);
            PG8_BAR; PG8_WAIT_L(0); PG8_MMA(1, 0, At, B0); PG8_BAR; PG8_SCHED;
            PG8_STAGE(PG8_SB(1, 1), b3 + hstep, voffB);
            PG8_WAIT_V(6); PG8_BAR; PG8_MMA(1, 1, At, B1); PG8_BAR;
        }
        PG8_STAMP();
        if constexpr (!Epi::AFTER_DRAIN) { E(acc, cur, wr, wc, fr, fq); S.done(cur); }
        PG8_STAMP();
        if (!has_next) break;
#pragma unroll
        for (int a = 0; a < 2; ++a)
#pragma unroll
            for (int b = 0; b < 2; ++b)
#pragma unroll
                for (int m = 0; m < 4; ++m)
#pragma unroll
                    for (int n = 0; n < 2; ++n) acc[a][b][m][n] = (f32x4){0.f, 0.f, 0.f, 0.f};
        cur = nxt; cA = nA; cB = nB; ++ui;
    }
    PG8_WAIT_V(0);
    if (wr == 0) PG8_BAR;
    PG8_BAR;
    if constexpr (Epi::AFTER_DRAIN) { E.fused(acc, cur, wr, wc, fr, fq, lds, wid, lane); S.done(cur); }
    PG8_STAMP();
    if (STAMP && wid == 0) { stamps[lane] = lane < nts ? (((unsigned long long)(unsigned)ts_hi << 32) | (unsigned)ts_lo) : 0ull;
        if (lane == 62) stamps[62] = rt_entry; if (lane == 63) stamps[63] = (unsigned long long)wall_clock64(); }
#undef PG8_STAMP
#undef PG8_SA
#undef PG8_SB
#undef PG8_STAGE
#undef PG8_LDA
#undef PG8_LDB
#undef PG8_MMA
#undef PG8_WAIT_V
#undef PG8_WAIT_L
#undef PG8_BAR
#undef PG8_SCHED
}
}

struct EpiU {
  static constexpr bool PERM = true, AFTER_DRAIN = false;
  bf16_t* U; int ldu; int nvalid;
  float* aux;
  __device__ __forceinline__ void operator()(const f32x4 (&acc)[2][2][4][2], const pg8::Unit& u, int wr, int wc, int fr, int fq) const {
    const int row0 = u.pm * 256 + wr * 64 + fr, col0 = u.pn * 256 + wc * 32 + 8 * fq;
#pragma unroll
    for (int ai = 0; ai < 2; ++ai)
#pragma unroll
      for (int m = 0; m < 4; ++m) {
        bf16_t* rowp = U + (size_t)(row0 + ai * 128 + m * 16) * ldu;
#pragma unroll
        for (int bj = 0; bj < 2; ++bj) {
          const int col = col0 + bj * 128;
          if (col < nvalid) {
            const f32x4 v0 = acc[ai][bj][m][0], v1 = acc[ai][bj][m][1];
            u32x4 w;
            w[0] = pack2(v0[0], v0[1]); w[1] = pack2(v0[2], v0[3]); w[2] = pack2(v1[0], v1[1]); w[3] = pack2(v1[2], v1[3]);
            *(u32x4*)(rowp + col) = w;
            if (aux && col >= 3088 && col < 4112 && (row0 + ai * 128 + m * 16) < 4096) {
              float* ap = aux + (size_t)((col - 3088) >> 9) * 2097152 + (size_t)(row0 + ai * 128 + m * 16) * 512 + ((col - 3088) & 511);
              *(f32x4*)ap = v0; *(f32x4*)(ap + 4) = v1;
            }
          }
        }
      }
  }
};


struct EpiOut {
  static constexpr bool PERM = true, AFTER_DRAIN = false;
  const float* MOD; const float* x_prompt; const float* x_sample; bf16_t* X1B; int layer;
  __device__ __forceinline__ void operator()(const f32x4 (&acc)[2][2][4][2], const pg8::Unit& u, int wr, int wc, int fr, int fq) const {
    const int row0 = u.pm * 256 + wr * 64 + fr, col0 = u.pn * 256 + wc * 32 + 8 * fq;
#pragma unroll
    for (int ai = 0; ai < 2; ++ai)
#pragma unroll
      for (int m = 0; m < 4; ++m) {
        const int row = row0 + ai * 128 + m * 16;
        const float* gp = MOD + (layer * 3 + (row < 4096 ? 0 : 1 + ((row - 4096) >> 10))) * 3072 + 2048;
        const float* xr = row < 4096 ? x_prompt + (size_t)row * 1024 : x_sample + (size_t)(row - 4096) * 1024;
        bf16_t* xb = X1B + (size_t)row * 1024;
#pragma unroll
        for (int bj = 0; bj < 2; ++bj) {
          const int col = col0 + bj * 128;
          const f32x4 v0 = acc[ai][bj][m][0], v1 = acc[ai][bj][m][1];
          const float4 g0 = *(const float4*)(gp + col), g1 = *(const float4*)(gp + col + 4);
          float4 x0, x1;
          if (layer) {
            const uint4 w = *(const uint4*)(xb + col);
            x0 = make_float4(__uint_as_float(w.x << 16), __uint_as_float(w.x & 0xffff0000u), __uint_as_float(w.y << 16), __uint_as_float(w.y & 0xffff0000u));
            x1 = make_float4(__uint_as_float(w.z << 16), __uint_as_float(w.z & 0xffff0000u), __uint_as_float(w.w << 16), __uint_as_float(w.w & 0xffff0000u));
          } else { x0 = *(const float4*)(xr + col); x1 = *(const float4*)(xr + col + 4); }
          u32x4 o;
          o[0] = pack2(x0.x + g0.x * v0[0], x0.y + g0.y * v0[1]); o[1] = pack2(x0.z + g0.z * v0[2], x0.w + g0.w * v0[3]);
          o[2] = pack2(x1.x + g1.x * v1[0], x1.y + g1.y * v1[1]); o[3] = pack2(x1.z + g1.z * v1[2], x1.w + g1.w * v1[3]);
          *(u32x4*)(xb + col) = o;
        }
        asm volatile("" ::: "memory");
      }
  }
};

template <int W>
DI void stage_rows64(bf16_t* dst, int ldd, int coff, const bf16_t* src, int lds) {
  for (int c = TIDX; c < 64 * (W / 8); c += 256) {
    const int r = c / (W / 8), cc = (c % (W / 8)) * 8;
    *(uint4*)(dst + r * ldd + coff + cc) = *(const uint4*)(src + (size_t)r * lds + cc);
  }
}
template <int W>
DI void stage_T64(bf16_t* dst, const bf16_t* src, int lds, const float* rscale) {
  for (int c = TIDX; c < 64 * (W / 8); c += 256) {
    const int r = c & 63, cc = (c >> 6) * 8;
    uint4 v = *(const uint4*)(src + (size_t)r * lds + cc);
    unsigned w[4] = {v.x, v.y, v.z, v.w};
    if (rscale) {
      const float s = rscale[r];
#pragma unroll
      for (int i = 0; i < 4; ++i) {
        const unsigned pw = pack2(lo2f(w[i]) * s, hi2f(w[i]) * s);
        dst[(cc + 2 * i) * LDT + r] = (bf16_t)(pw & 0xffffu);
        dst[(cc + 2 * i + 1) * LDT + r] = (bf16_t)(pw >> 16);
      }
    } else {
#pragma unroll
      for (int i = 0; i < 4; ++i) {
        dst[(cc + 2 * i) * LDT + r] = (bf16_t)(w[i] & 0xffffu);
        dst[(cc + 2 * i + 1) * LDT + r] = (bf16_t)(w[i] >> 16);
      }
    }
  }
}

template <int DK, int DV, bool DUAL>
DI void attn_core(char* smem, const bf16_t* Qp, int ldq, const bf16_t* K1, int ldk1, const bf16_t* K2, int ldk2,
                  const bf16_t* V, int ldv, int T, float scale_log2, f32x4 (&o)[DUAL ? 2 : 1][DV / 16], float (&lsum)[DUAL ? 2 : 1], float (&mrun)[DUAL ? 2 : 1],
                  const float2* qrope = nullptr) {
  constexpr int NS = DUAL ? 2 : 1;
  constexpr int DKT = DUAL ? 2 * DK : DK;
  constexpr int W1 = (DK == 96) ? 64 : DKT;
  constexpr int LDK = DKT + 8;
  constexpr int NK1 = 64 * (W1 / 8) / 512;
  constexpr int NV = 64 * (DV / 8) / 512;
  constexpr int BUFE = 64 * DKT + DV * LDT;
  bf16_t* sbase = (bf16_t*)smem;
  const int tid = TIDX, lane = tid & 63, wave = tid >> 6, g = lane >> 4, l16 = lane & 15;
  const int st = (int)ltid();
  const int gsw = (g ^ ((4 - (l16 >> 2)) & 3)) * 8;
  bf16x8 qf[DKT / 32];
  const bf16_t* qrow = Qp + (size_t)(wave * 16 + l16) * ldq;
#pragma unroll
  for (int ks = 0; ks < DKT / 32; ++ks) qf[ks] = *(const bf16x8*)(qrow + ks * 32 + g * 8);
  if (DK == 96 && qrope) {
    const float2* rp = qrope + (wave * 16 + l16) * 16 + g * 4;
    const u32x4 w = __builtin_bit_cast(u32x4, qf[DKT / 32 - 1]);
    u32x4 r;
#pragma unroll
    for (int j = 0; j < 4; ++j) {
      const float2 cs = rp[j];
      const float x0 = lo2f(w[j]), x1 = hi2f(w[j]);
      r[j] = pack2(x0 * cs.x - x1 * cs.y, x0 * cs.y + x1 * cs.x);
    }
    qf[DKT / 32 - 1] = __builtin_bit_cast(bf16x8, r);
  }
#pragma unroll
  for (int n = 0; n < NS; ++n) {
#pragma unroll
    for (int i = 0; i < DV / 16; ++i) o[n][i] = f32x4{0.f, 0.f, 0.f, 0.f};
    mrun[n] = -INFINITY; lsum[n] = 0.f;
  }
  u32x4 pk[NK1], pk2, pv[NV];
  unsigned koff[NK1], voff[NV];
#pragma unroll
  for (int i = 0; i < NK1; ++i) { const int c = st + 512 * i, r = c / (W1 / 8), cc = (c % (W1 / 8)) * 8; koff[i] = (unsigned)(r * ldk1 + cc); }
#pragma unroll
  for (int i = 0; i < NV; ++i) { const int c = st + 512 * i, r = c & 63, cc = (c >> 6) * 8; voff[i] = (unsigned)(r * ldv + cc); }
  const unsigned k2off = (unsigned)(((st & 255) >> 2) * ldk2 + (st & 3) * 8);
#define A_LOAD(TN) { const bf16_t* kbase_ = K1 + (size_t)(TN) * ldk1; const bf16_t* vbase_ = V + (size_t)(TN) * ldv; \
    _Pragma("unroll") for (int i = 0; i < NK1; ++i) pk[i] = *(const u32x4*)(kbase_ + koff[i]); \
    if (DK == 96 && st < 256) pk2 = *(const u32x4*)(K2 + (size_t)(TN) * ldk2 + k2off); \
    _Pragma("unroll") for (int i = 0; i < NV; ++i) pv[i] = *(const u32x4*)(vbase_ + voff[i]); }
#define A_COMMIT(B) { bf16_t* sK_ = sbase + (B) * BUFE; bf16_t* sVT_ = sK_ + 64 * DKT; \
    _Pragma("unroll") for (int i = 0; i < NK1; ++i) { const int c = st + 512 * i, r = c / (W1 / 8), ch = c % (W1 / 8); *(u32x4*)(sK_ + (ch >> 2) * 2048 + r * 32 + (((ch & 3) ^ ((4 - ((r >> 2) & 3)) & 3)) * 8)) = pk[i]; } \
    if (DK == 96 && st < 256) { const int r = st >> 2, ch = st & 3; *(u32x4*)(sK_ + 2 * 2048 + r * 32 + ((ch ^ ((4 - ((r >> 2) & 3)) & 3)) * 8)) = pk2; } \
    _Pragma("unroll") for (int i = 0; i < NV; ++i) { const int c = st + 512 * i, r = c & 63, cc = (c >> 6) * 8; \
      _Pragma("unroll") for (int j = 0; j < 4; ++j) { sVT_[(cc + 2 * j) * LDT + r] = (bf16_t)(pv[i][j] & 0xffffu); sVT_[(cc + 2 * j + 1) * LDT + r] = (bf16_t)(pv[i][j] >> 16); } } }
  A_LOAD(0)
  __syncthreads();
  A_COMMIT(0)
  if (64 < T) A_LOAD(64)
  __syncthreads();
  int par = 0;
  for (int t0 = 0; t0 < T; t0 += 64, par ^= 1) {
    {
    {
    if (t0 + 64 < T) {
      A_COMMIT(par ^ 1)
      if (t0 + 128 < T) A_LOAD(t0 + 128)
    }
    const bf16_t* sK = sbase + par * BUFE;
    const bf16_t* sVT = sK + 64 * DKT;
    bf16x8 pf[NS][2];
#pragma unroll
    for (int n = 0; n < NS; ++n) {
      f32x4 s[4];
#pragma unroll
      for (int t = 0; t < 4; ++t) {
        s[t] = f32x4{0.f, 0.f, 0.f, 0.f};
#pragma unroll
        for (int ks = 0; ks < DK / 32; ++ks) {
          const bf16x8 kf = *(const bf16x8*)(sK + (n * (DK / 32) + ks) * 2048 + (t * 16 + l16) * 32 + gsw);
          s[t] = MFMA16(kf, qf[n * (DK / 32) + ks], s[t]);
        }
      }
      float mx = -INFINITY;
#pragma unroll
      for (int t = 0; t < 4; ++t)
#pragma unroll
        for (int j = 0; j < 4; ++j) mx = fmaxf(mx, s[t][j]);
      mx = xmax_16_32(mx);
      const float mnew = fmaxf(mrun[n], mx);
      const float alpha = __builtin_amdgcn_exp2f((mrun[n] - mnew) * scale_log2);
      mrun[n] = mnew;
      const float moff = -mnew * scale_log2;
      float ps = 0.f;
#pragma unroll
      for (int t = 0; t < 4; ++t)
#pragma unroll
        for (int j = 0; j < 4; ++j) { s[t][j] = __builtin_amdgcn_exp2f(fmaf(s[t][j], scale_log2, moff)); ps += s[t][j]; }
      lsum[n] = lsum[n] * alpha + ps;
#pragma unroll
      for (int i = 0; i < DV / 16; ++i) o[n][i] *= alpha;
#pragma unroll
      for (int kb = 0; kb < 2; ++kb)
      {
        u32x4 w;
        w[0] = pack2(s[2 * kb][0], s[2 * kb][1]); w[1] = pack2(s[2 * kb][2], s[2 * kb][3]);
        w[2] = pack2(s[2 * kb + 1][0], s[2 * kb + 1][1]); w[3] = pack2(s[2 * kb + 1][2], s[2 * kb + 1][3]);
        pf[n][kb] = __builtin_bit_cast(bf16x8, w);
      }
    }
#pragma unroll
    for (int kb = 0; kb < 2; ++kb) {
#pragma unroll
      for (int i = 0; i < DV / 16; ++i) {
        const bf16_t* vp = sVT + (i * 16 + l16) * LDT + kb * 32 + g * 4;
        const bf16x4 lo = *(const bf16x4*)(vp);
        const bf16x4 hi = *(const bf16x4*)(vp + 16);
        const bf16x8 vf = __builtin_shufflevector(lo, hi, 0, 1, 2, 3, 4, 5, 6, 7);
#pragma unroll
        for (int n = 0; n < NS; ++n) o[n][i] = MFMA16(vf, pf[n][kb], o[n][i]);
        if (DUAL && (i & 3) == 3) asm volatile("" ::: "memory");
      }
    }
    }
    }
    __syncthreads();
  }
#undef A_LOAD
#undef A_COMMIT
}

DI void transpose_w(const float* __restrict__ src, int K, int N, bf16_t* __restrict__ dst, int tile, float* sT, int sc_lo, int sc_hi, float sc) {
  const int ntn = (N + 63) >> 6;
  const int kt = tile / ntn, nt = tile % ntn, k0 = kt * 64, n0 = nt * 64;
  __syncthreads();
#pragma unroll
  for (int q = 0; q < 4; ++q) {
    const int i = TIDX + 256 * q;
    const int r = i >> 4, c = (i & 15) * 4, n = n0 + c;
    float4 v = make_float4(0.f, 0.f, 0.f, 0.f);
    if (n < N) v = *(const float4*)(src + (size_t)(k0 + r) * N + n);
    if (n >= sc_lo && n < sc_hi) { v.x *= sc; v.y *= sc; v.z *= sc; v.w *= sc; }
    float* d = sT + r * 65 + c;
    d[0] = v.x; d[1] = v.y; d[2] = v.z; d[3] = v.w;
  }
  __syncthreads();
#pragma unroll
  for (int q = 0; q < 2; ++q) {
    const int i = TIDX + 256 * q;
    const int c = i >> 3, kc = (i & 7) * 8, n = n0 + c;
    if (n < N) {
      const float* sp = sT + kc * 65 + c;
      uint4 o;
      o.x = pack2(sp[0], sp[65]); o.y = pack2(sp[130], sp[195]); o.z = pack2(sp[260], sp[325]); o.w = pack2(sp[390], sp[455]);
      *(uint4*)(dst + (size_t)n * K + k0 + kc) = o;
    }
  }
}

DI void phase0(const Params& p, char* smem) {
  const int tid = TIDX;
  for (int it = VBLK; it < 384; it += NVBLK) {
    const int l = it / 192, cb = (it % 192) * 16;
    const float* W = l ? p.o_ada_w : p.e_ada_w;
    const float* bias = l ? p.o_ada_b : p.e_ada_b;
    float* sc = (float*)smem;
    float* red = sc + 3072;
    __syncthreads();
    for (int i = tid; i < 3072; i += 256) {
      const int j = i >> 10, k = i & 1023;
      const float v = (j == 0) ? p.c_ctx[k] : p.c[(j - 1) * 1024 + k];
      sc[i] = siluf(v);
    }
    __syncthreads();
    const int col = cb + (tid & 15), kg = tid >> 4;
    float a0 = 0.f, a1 = 0.f, a2 = 0.f;
    for (int kb = kg * 64; kb < kg * 64 + 64; kb += 16) {
      float w[16];
#pragma unroll
      for (int u = 0; u < 16; ++u) w[u] = W[(size_t)(kb + u) * 3072 + col];
#pragma unroll
      for (int u = 0; u < 16; ++u) { a0 += sc[kb + u] * w[u]; a1 += sc[1024 + kb + u] * w[u]; a2 += sc[2048 + kb + u] * w[u]; }
    }
    red[(kg * 3 + 0) * 16 + (tid & 15)] = a0;
    red[(kg * 3 + 1) * 16 + (tid & 15)] = a1;
    red[(kg * 3 + 2) * 16 + (tid & 15)] = a2;
    __syncthreads();
    if (tid < 48) {
      const int j = tid >> 4, c = tid & 15;
      float s = 0.f;
      for (int q = 0; q < 16; ++q) s += red[(q * 3 + j) * 16 + c];
      __hip_atomic_store(p.MOD + (l * 3 + j) * 3072 + cb + c, s + bias[cb + c], __ATOMIC_RELAXED, __HIP_MEMORY_SCOPE_AGENT);
    }
    asm volatile("s_waitcnt vmcnt(0)" ::: "memory");
    __syncthreads();
    if (tid == 0) __hip_atomic_fetch_add(p.CNT + 2 * 48 * 64, 1u, __ATOMIC_RELAXED, __HIP_MEMORY_SCOPE_AGENT);
  }
}

DI void wait_mod_ready(const Params& p) {
  if (TIDX == 0) {
    unsigned* cnt = p.CNT + 2 * 48 * 64;
    unsigned sp = 0;
    while (__hip_atomic_load(cnt, __ATOMIC_RELAXED, __HIP_MEMORY_SCOPE_AGENT) < 384u) {
      __builtin_amdgcn_s_sleep(1);
      if (++sp > (1u << 22)) break;
    }
    __builtin_amdgcn_fence(__ATOMIC_ACQUIRE, "agent");
    asm volatile("s_waitcnt vmcnt(0)" ::: "memory");
  }
  __syncthreads();
}

DI void phase0b(const Params& p, char* smem) {
  const int tid = TIDX;
  if (VBLK == 0 && tid < 64) {
    float a = p.o_lam[tid] * p.o_lam[64 + tid];
    float b = p.o_lam[128 + tid] * p.o_lam[192 + tid];
    a = wave_sum(a); b = wave_sum(b);
    if (tid == 0) p.LAMV[0] = fexp(a) - fexp(b) + LAM_INIT;
  }
  for (int idx = VBLK * 256 + tid; idx < 1024 * 48; idx += NVBLK * 256) {
    const int pos = idx / 48, e = idx % 48;
    const float rr = (float)(pos >> 6), cc = (float)(pos & 63);
    if (e < 16) {
      const int j = e & 7;
      const float inv = 1.0f / powf(10000.0f, (float)(2 * j) / 16.0f);
      const float ang = ((e < 8) ? rr : cc) * inv;
      p.ROPE32[pos * 16 + e] = make_float2(cosf(ang), sinf(ang));
    } else {
      const int i = e - 16, j = i & 15;
      const float inv = 1.0f / powf(10000.0f, (float)(2 * j) / 32.0f);
      const float ang = ((i < 16) ? rr : cc) * inv;
      p.ROPE64[pos * 32 + i] = make_float2(cosf(ang), sinf(ang));
    }
  }
  float* sT = (float*)smem;
  for (int it = VBLK; it < 1016; it += NVBLK) {
    if (it < 624) transpose_w(p.e_w_in, 1024, EIN, p.WinE, it, sT, 0, 0, 1.f);
    else if (it < 696) transpose_w(p.e_w_uq, 384, 768, p.Wuq, it - 624, sT, 0, 0, 1.f);
    else if (it < 760) transpose_w(p.e_w_ukv, 256, 1024, p.Wukv, it - 696, sT, 0, 0, 1.f);
    else transpose_w(p.e_w_out, 1024, 1024, p.WoutE, it - 760, sT, 0, 0, 1.f);
  }
}

DI void late_weight_prep(const Params& p, char* smem, int first_group, int tile_lo, int tile_hi) {
  float* sT = (float*)smem;
  const int ng = NVBLK - first_group;
  if (ng <= 0 || VBLK < first_group) return;
  for (int it = tile_lo + VBLK - first_group; it < tile_hi; it += ng) {
    if (it < 1168) transpose_w(p.o_w_in, 1024, OIN, p.WinO, it, sT, 512, 1024, 0.08838834764831845f);
    else transpose_w(p.o_w_out, 1024, 1024, p.WoutO, it - 1168, sT, 0, 0, 1.f);
  }
}

DI void store_bf4(bf16_t* dst, f32x4 v) {
  uint2 o; o.x = pack2(v[0], v[1]); o.y = pack2(v[2], v[3]);
  *(uint2*)dst = o;
}
DI float4 load_bf4(const bf16_t* src) {
  const uint2 w = *(const uint2*)src;
  return make_float4(lo2f(w.x), hi2f(w.x), lo2f(w.y), hi2f(w.y));
}

DI void phase_norm(const Params& p, int layer) {
  const int tid = TIDX, lane = tid & 63, wave = tid >> 6;
  const float* g = layer ? p.o_norm_g : p.e_norm_g;
  for (int it = VBLK; it < NROW / 4; it += NVBLK) {
    const int row = it * 4 + wave;
    const float* x = xrow(p, row);
    const bf16_t* xb = p.X1B + (size_t)row * 1024;
    const float* md = p.MOD + (layer * 3 + cv_of_row(row)) * 3072;
    float4 v[4];
    float ss = 0.f;
#pragma unroll
    for (int i = 0; i < 4; ++i) {
      v[i] = layer ? load_bf4(xb + i * 256 + lane * 4) : *(const float4*)(x + i * 256 + lane * 4);
      ss += v[i].x * v[i].x + v[i].y * v[i].y + v[i].z * v[i].z + v[i].w * v[i].w;
    }
    ss = wave_sum(ss);
    const float r = rsqrtf(ss * (1.f / 1024.f) + EPSF);
#pragma unroll
    for (int i = 0; i < 4; ++i) {
      const int col = i * 256 + lane * 4;
      const float4 gg = *(const float4*)(g + col), sh = *(const float4*)(md + col), sc = *(const float4*)(md + 1024 + col);
      uint2 o;
      o.x = pack2(v[i].x * r * gg.x * (1.f + sc.x) + sh.x, v[i].y * r * gg.y * (1.f + sc.y) + sh.y);
      o.y = pack2(v[i].z * r * gg.z * (1.f + sc.z) + sh.z, v[i].w * r * gg.w * (1.f + sc.w) + sh.w);
      *(uint2*)(p.H + (size_t)row * 1024 + col) = o;
    }
  }
}


DI void phase_gemm_in(const Params& p, int layer, char* smem) {
  const int N = layer ? OIN : EIN;
  const int Npad = layer ? OIN_PAD : EIN_PAD;
  pg8::Gemm g;
  g.A = p.H; g.Bt = layer ? p.WinO : p.WinE; g.M = NROW; g.N = Npad; g.K = 1024;
  pg8::StaticOrder S;
  S.init(NROW, Npad, (int)gridDim.x, (int)blockIdx.x);
  EpiU E;
  E.U = layer ? p.U1 : p.U0; E.ldu = N; E.nvalid = N; E.aux = layer ? p.out + O_DK : nullptr;
  pg8::gemm_phase<EpiU, pg8::StaticOrder, false>((PG8_LAS unsigned char*)smem, g, S, E, nullptr);
}

DI void phase_gemm_out(const Params& p, int layer, char* smem) {
  const bf16_t* W = layer ? p.WoutO : p.WoutE;
  for (int it = VBLK; it < 48 * 8; it += NVBLK) {
    const int mt = it % 48, nt = it / 48;
    gemm_tile64(p.O, 1024, W, 1024, 1024, 1024, mt * 128, nt * 128, smem,
              [=](int m, int n, f32x4 v) {
                const float4 gt = *(const float4*)(p.MOD + (layer * 3 + cv_of_row(m)) * 3072 + 2048 + n);
                const float4 xv = layer ? load_bf4(p.X1B + (size_t)m * 1024 + n) : *(const float4*)(xrow(p, m) + n);
                f32x4 r;
                r[0] = xv.x + gt.x * v[0]; r[1] = xv.y + gt.y * v[1]; r[2] = xv.z + gt.z * v[2]; r[3] = xv.w + gt.w * v[3];
                store_bf4(p.X1B + (size_t)m * 1024 + n, r);
              });
  }
}

DI void phase_out_norm_fused(const Params& p, int layer, char* smem) {
  const int tid = TIDX, lane = tid & 63, wave = tid >> 6, wm = wave >> 1, wn = wave & 1, g = lane >> 4, l16 = lane & 15;
  float* sSS = (float*)(smem + 65536);
  float* sR = sSS + 256;
  for (int it = VBLK; it < 48 * 8; it += NVBLK) {
    const int mt = it % 48, nt = it / 48, m0 = mt * 128, n0 = nt * 128;
    f32x4 acc[4][4];
    gemm_tile64_acc(p.O, 1024, layer ? p.WoutO : p.WoutE, 1024, 1024, 1024, m0, n0, smem, acc);
    float* ssq_slots = p.SSQ + (size_t)layer * NROW * 8;
    unsigned* cnt_base = p.CNT + layer * 48 * 64;
    float ssq[4];
#pragma unroll
    for (int mi = 0; mi < 4; ++mi) {
      const int row = m0 + wm * 64 + mi * 16 + l16;
      const float* gp = p.MOD + (layer * 3 + cv_of_row(row)) * 3072 + 2048;
      ssq[mi] = 0.f;
#pragma unroll
      for (int ni = 0; ni < 4; ++ni) {
        const int n = n0 + wn * 64 + ni * 16 + g * 4;
        const float4 gt = *(const float4*)(gp + n);
        const float4 xv = layer ? load_bf4(p.X1B + (size_t)row * 1024 + n) : *(const float4*)(xrow(p, row) + n);
        f32x4 r;
        r[0] = xv.x + gt.x * acc[ni][mi][0]; r[1] = xv.y + gt.y * acc[ni][mi][1]; r[2] = xv.z + gt.z * acc[ni][mi][2]; r[3] = xv.w + gt.w * acc[ni][mi][3];
        acc[ni][mi] = r;
        if (!layer) store_bf4(p.X1B + (size_t)row * 1024 + n, r);
        ssq[mi] += r[0] * r[0] + r[1] * r[1] + r[2] * r[2] + r[3] * r[3];
      }
      ssq[mi] = xsum_16_32(ssq[mi]);
    }
    if (g == 0) {
#pragma unroll
      for (int mi = 0; mi < 4; ++mi) sSS[wn * 128 + wm * 64 + mi * 16 + l16] = ssq[mi];
    }
    __syncthreads();
    if (tid < 128) __hip_atomic_store(ssq_slots + (size_t)(m0 + tid) * 8 + nt, sSS[tid] + sSS[128 + tid], __ATOMIC_RELAXED, __HIP_MEMORY_SCOPE_AGENT);
    asm volatile("s_waitcnt vmcnt(0)" ::: "memory");
    __syncthreads();
    if (tid == 0) {
      unsigned* cnt = cnt_base + mt * 64;
      __hip_atomic_fetch_add(cnt, 1u, __ATOMIC_RELAXED, __HIP_MEMORY_SCOPE_AGENT);
      unsigned sp = 0;
      while (__hip_atomic_load(cnt, __ATOMIC_RELAXED, __HIP_MEMORY_SCOPE_AGENT) < 8u) {
        __builtin_amdgcn_s_sleep(1);
        if (++sp > (1u << 22)) break;
      }
      asm volatile("" ::: "memory");
    }
    __syncthreads();
    if (tid < 128) {
      const float* sl = ssq_slots + (size_t)(m0 + tid) * 8;
      float t = 0.f;
#pragma unroll
      for (int q = 0; q < 8; ++q) t += __hip_atomic_load(sl + q, __ATOMIC_RELAXED, __HIP_MEMORY_SCOPE_AGENT);
      sR[tid] = rsqrtf(t * (1.f / 1024.f) + EPSF);
    }
    __syncthreads();
#pragma unroll
    for (int mi = 0; mi < 4; ++mi) {
      const int rl = wm * 64 + mi * 16 + l16;
      const float r = sR[rl];
      float* op = p.out + O_Y + (size_t)(m0 + rl) * 1024;
      const float* md = p.MOD + (3 + cv_of_row(m0 + rl)) * 3072;
#pragma unroll
      for (int ni = 0; ni < 4; ++ni) {
        const int n = n0 + wn * 64 + ni * 16 + g * 4;
        if (layer) {
          const float4 gg = *(const float4*)(p.final_g + n);
          *(float4*)(op + n) = make_float4(acc[ni][mi][0] * r * gg.x, acc[ni][mi][1] * r * gg.y, acc[ni][mi][2] * r * gg.z, acc[ni][mi][3] * r * gg.w);
        } else {
          const float4 gg = *(const float4*)(p.o_norm_g + n), sh = *(const float4*)(md + n), sc = *(const float4*)(md + 1024 + n);
          f32x4 hv;
          hv[0] = acc[ni][mi][0] * r * gg.x * (1.f + sc.x) + sh.x; hv[1] = acc[ni][mi][1] * r * gg.y * (1.f + sc.y) + sh.y;
          hv[2] = acc[ni][mi][2] * r * gg.z * (1.f + sc.z) + sh.z; hv[3] = acc[ni][mi][3] * r * gg.w * (1.f + sc.w) + sh.w;
          store_bf4(p.H + (size_t)(m0 + rl) * 1024 + n, hv);
        }
      }
    }
  }
}

DI void phase_gemm_mla(const Params& p, char* smem) {
  const int G = (int)gridDim.x, bid = (int)blockIdx.x;
  const bool split = G >= 176;
  if (!split || bid < 72) {
    pg8::Gemm g;
    g.A = p.CQN; g.Bt = p.Wuq; g.M = NROW; g.N = 768; g.K = 384;
    pg8::StaticOrder S;
    S.init(NROW, 768, G, bid);
    EpiU E;
    E.U = p.Q; E.ldu = 768; E.nvalid = 768; E.aux = nullptr;
    pg8::gemm_phase<EpiU, pg8::StaticOrder, false>((PG8_LAS unsigned char*)smem, g, S, E, nullptr);
  }
  if (!split || bid >= 72) {
    pg8::Gemm g;
    g.A = p.CKVN; g.Bt = p.Wukv; g.M = NTROW; g.N = 1024; g.K = 256;
    pg8::StaticOrder S;
    S.init(NTROW, 1024, G, split ? bid - 72 : bid);
    EpiU E;
    E.U = p.KV; E.ldu = 1024; E.nvalid = 1024; E.aux = nullptr;
    pg8::gemm_phase<EpiU, pg8::StaticOrder, false>((PG8_LAS unsigned char*)smem, g, S, E, nullptr);
  }
}

struct TRow { int row, pos, cb, ct; bool cache, lat; };
DI TRow decode_trow(int trow) {
  TRow t; t.row = -1; t.pos = 0; t.cb = 0; t.ct = 0; t.cache = false; t.lat = false;
  if (trow < 4096) { t.row = trow; }
  else {
    const int r = trow - 4096; const int b = r / 1280, tt = r % 1280;
    t.lat = true;
    if (tt < 256) { t.cache = true; t.cb = b; t.ct = tt; }
    else { t.pos = tt - 256; t.row = 4096 + b * 1024 + t.pos; }
  }
  return t;
}
DI void cvt_store4(bf16_t* dst, const float* src) {
  const float4 v = *(const float4*)src;
  uint2 o; o.x = pack2(v.x, v.y); o.y = pack2(v.z, v.w);
  *(uint2*)dst = o;
}

DI void phase3(const Params& p) {
  const int tid = TIDX, lane = tid & 63, wave = tid >> 6;
  for (int it = VBLK; it < NTROW / 4; it += NVBLK) {
    const int trow = it * 4 + wave;
    const TRow t = decode_trow(trow);
    if (t.cache) {
      const size_t ci = (size_t)t.cb * 256 + t.ct;
      cvt_store4(p.CKVN + (size_t)trow * 256 + lane * 4, p.cache_ckv + ci * 256 + lane * 4);
      if (lane < 8) cvt_store4(p.KR + (size_t)trow * 32 + lane * 4, p.cache_kr + ci * 32 + lane * 4);
      if (lane < 32) {
        cvt_store4(p.KB + (size_t)trow * 128 + lane * 4, p.cache_gk + ci * 128 + lane * 4);
        cvt_store4(p.VB + (size_t)trow * 128 + lane * 4, p.cache_gv + ci * 128 + lane * 4);
      }
      continue;
    }
    const int row = t.row;
    const bf16_t* u = p.U0 + (size_t)row * EIN;
    {
      float x[6]; float ss = 0.f;
#pragma unroll
      for (int i = 0; i < 3; ++i) {
        const unsigned w = *(const unsigned*)(u + i * 128 + lane * 2);
        x[2 * i] = lo2f(w); x[2 * i + 1] = hi2f(w);
        ss += x[2 * i] * x[2 * i] + x[2 * i + 1] * x[2 * i + 1];
      }
      ss = wave_sum(ss);
      const float r = rsqrtf(ss * (1.f / 384.f) + EPSF);
#pragma unroll
      for (int i = 0; i < 3; ++i) {
        const int col = i * 128 + lane * 2;
        *(unsigned*)(p.CQN + (size_t)row * 384 + col) = pack2(x[2 * i] * r * p.e_qn_g[col], x[2 * i + 1] * r * p.e_qn_g[col + 1]);
      }
    }
    {
      const uint2 w = *(const uint2*)(u + 384 + lane * 4);
      float x0 = lo2f(w.x), x1 = hi2f(w.x), x2 = lo2f(w.y), x3 = hi2f(w.y);
      float ss = wave_sum(x0 * x0 + x1 * x1 + x2 * x2 + x3 * x3);
      const float r = rsqrtf(ss * (1.f / 256.f) + EPSF);
      const float4 gg = *(const float4*)(p.e_kvn_g + lane * 4);
      x0 *= r * gg.x; x1 *= r * gg.y; x2 *= r * gg.z; x3 *= r * gg.w;
      uint2 o; o.x = pack2(x0, x1); o.y = pack2(x2, x3);
      *(uint2*)(p.CKVN + (size_t)trow * 256 + lane * 4) = o;
      if (!t.lat) *(float4*)(p.out + O_CKV + (size_t)row * 256 + lane * 4) = make_float4(x0, x1, x2, x3);
    }
    if (lane < 16) {
      const unsigned w = *(const unsigned*)(u + 640 + lane * 2);
      float x0 = lo2f(w), x1 = hi2f(w);
      if (t.lat) {
        const float2 cs = p.ROPE32[t.pos * 16 + lane];
        const float y0 = x0 * cs.x - x1 * cs.y, y1 = x0 * cs.y + x1 * cs.x;
        x0 = y0; x1 = y1;
      } else {
        *(float2*)(p.out + O_KR + (size_t)row * 32 + lane * 2) = make_float2(x0, x1);
      }
      *(unsigned*)(p.KR + (size_t)trow * 32 + lane * 2) = pack2(x0, x1);
    }
#pragma unroll
    for (int which = 0; which < 2; ++which) {
      const int lsrc = which ? (lane & 15) : lane;
      const uint4 w = *(const uint4*)(u + (which ? 1696 : 1184) + lsrc * 8);
      float x[8] = {lo2f(w.x), hi2f(w.x), lo2f(w.y), hi2f(w.y), lo2f(w.z), hi2f(w.z), lo2f(w.w), hi2f(w.w)};
      float ss = 0.f;
#pragma unroll
      for (int j = 0; j < 8; ++j) ss += x[j] * x[j];
      ss += DPPF(ss, 0xB1); ss += DPPF(ss, 0x4E); ss += DPPF(ss, 0x141);
      const float r = rsqrtf(ss * (1.f / 64.f) + EPSF);
      const float* gp = (which ? p.e_gk_g : p.e_gq_g) + (lane & 7) * 8;
#pragma unroll
      for (int j = 0; j < 8; ++j) x[j] *= r * gp[j];
      if (t.lat) {
#pragma unroll
        for (int jj = 0; jj < 4; ++jj) {
          const float2 cs = p.ROPE64[t.pos * 32 + (lane & 7) * 4 + jj];
          const float y0 = x[2 * jj] * cs.x - x[2 * jj + 1] * cs.y, y1 = x[2 * jj] * cs.y + x[2 * jj + 1] * cs.x;
          x[2 * jj] = y0; x[2 * jj + 1] = y1;
        }
      }
      uint4 o; o.x = pack2(x[0], x[1]); o.y = pack2(x[2], x[3]); o.z = pack2(x[4], x[5]); o.w = pack2(x[6], x[7]);
      if (which == 0) {
        *(uint4*)(p.QB + (size_t)row * 512 + lane * 8) = o;
      } else if (lane < 16) {
        *(uint4*)(p.KB + (size_t)trow * 128 + lane * 8) = o;
        if (!t.lat) {
          float* op = p.out + O_GK + (size_t)row * 128 + lane * 8;
          *(float4*)op = make_float4(x[0], x[1], x[2], x[3]);
          *(float4*)(op + 4) = make_float4(x[4], x[5], x[6], x[7]);
        }
      }
    }
    if (lane < 16) {
      const uint4 w = *(const uint4*)(u + 1824 + lane * 8);
      *(uint4*)(p.VB + (size_t)trow * 128 + lane * 8) = w;
      if (!t.lat) {
        float* op = p.out + O_GV + (size_t)row * 128 + lane * 8;
        *(float4*)op = make_float4(lo2f(w.x), hi2f(w.x), lo2f(w.y), hi2f(w.y));
        *(float4*)(op + 4) = make_float4(lo2f(w.z), hi2f(w.z), lo2f(w.w), hi2f(w.w));
      }
    }
  }
}

DI void phase_attn0(const Params& p, char* smem) {
  const int lane = TIDX & 63, wave = TIDX >> 6, g = lane >> 4, l16 = lane & 15;
  for (int it = vblk_xcd(); it < 1536; it += NVBLK) {
    int kind, b, h, qb, row0, trow0, T;
    if (it < 512) { const int i = it & 255; kind = it >> 8; b = i >> 7; h = (i >> 4) & 7; qb = i & 15; row0 = 4096 + b * 1024 + qb * 64; trow0 = 4096 + b * 1280; T = 1280; }
    else { const int i2 = it - 512; kind = i2 >> 9; const int i = i2 & 511; b = i >> 5; h = (i >> 2) & 7; qb = i & 3; row0 = b * 256 + qb * 64; trow0 = b * 256; T = 256; }
    f32x4 oo[1][4];
    float lss[1], mss[1];
    int gcol, ocol;
    const int row = row0 + wave * 16 + l16;
    uint2 gwv[4];
    {
      const int gc = kind == 0 ? 672 + h * 64 : 1952 + h * 64;
#pragma unroll
      for (int i = 0; i < 4; ++i) gwv[i] = *(const uint2*)(p.U0 + (size_t)row * EIN + gc + i * 16 + g * 4);
    }
    if (kind == 0) {
      attn_core<96, 64, false>(smem, p.Q + (size_t)row0 * 768 + h * 96, 768, p.KV + (size_t)trow0 * 1024 + h * 128, 1024,
                        p.KR + (size_t)trow0 * 32, 32, p.KV + (size_t)trow0 * 1024 + h * 128 + 64, 1024, T,
                        0.10206207261596575f * 1.4426950408889634f, oo, lss, mss,
                        it < 512 ? p.ROPE32 + (size_t)(qb * 64) * 16 : nullptr);
      gcol = 672 + h * 64; ocol = h * 64;
    } else {
      const int kvh = h >> 2;
      attn_core<64, 64, false>(smem, p.QB + (size_t)row0 * 512 + h * 64, 512, p.KB + (size_t)trow0 * 128 + kvh * 64, 128,
                        nullptr, 0, p.VB + (size_t)trow0 * 128 + kvh * 64, 128, T, 0.125f * 1.4426950408889634f, oo, lss, mss);
      gcol = 1952 + h * 64; ocol = 512 + h * 64;
    }
    float ls = lss[0];
    ls = xsum_16_32(ls);
    const float inv = 1.f / ls;
    f32x4 (&o)[4] = oo[0];
#pragma unroll
    for (int i = 0; i < 4; ++i) {
      const int dv = i * 16 + g * 4;
      const uint2 gw = gwv[i];
      f32x4 r;
      r[0] = o[i][0] * inv * siluf(lo2f(gw.x)); r[1] = o[i][1] * inv * siluf(hi2f(gw.x));
      r[2] = o[i][2] * inv * siluf(lo2f(gw.y)); r[3] = o[i][3] * inv * siluf(hi2f(gw.y));
      store_bf4(p.O + (size_t)row * 1024 + ocol + dv, r);
    }
  }
}

DI void mlstm_gates(const Params& p, int rowbase, int nc, int h, int dir, int j, int lane, float& ig, float& lf) {
  const int oc = dir ? nc - 1 - j : j;
  const int s = dir ? 63 - lane : lane;
  const int row = rowbase + oc * 64 + s;
  const bf16_t* up = p.U1 + (size_t)row * OIN + 2048;
  ig = bf2f(up[dir * 8 + h]) + p.o_gate_b[dir * 8 + h];
  lf = logsig(bf2f(up[dir * 8 + 4 + h]) + p.o_gate_b[dir * 8 + 4 + h]);
}
DI void mitem_decode(int it, int& sq, int& h, int& dir, int& j, int& nc, int& rowbase) {
  if (it < 512) { j = it & 3; dir = (it >> 2) & 1; h = (it >> 3) & 3; sq = it >> 5; nc = 4; rowbase = sq * 256; }
  else { const int i = it - 512; j = i & 15; dir = (i >> 4) & 1; h = (i >> 5) & 3; sq = 16 + (i >> 7); nc = 16; rowbase = 4096 + (sq - 16) * 1024; }
}
DI int mitem_id(int sq, int h, int dir, int j) {
  return sq < 16 ? (((sq * 4 + h) * 2 + dir) * 4 + j) : (512 + ((((sq - 16) * 4 + h) * 2 + dir) * 16 + j));
}

DI void phase9(const Params& p, char* smem) {
  const int tid = TIDX, lane = tid & 63, wave = tid >> 6, g = lane >> 4, l16 = lane & 15;
  for (int it = VBLK; it < NTROW / 4; it += NVBLK) {
    const int trow = it * 4 + wave;
    const TRow t = decode_trow(trow);
    if (t.cache) {
      const size_t ci = (size_t)t.cb * 256 + t.ct;
      cvt_store4(p.KD + (size_t)trow * 512 + lane * 8, p.cache_dk + ci * 512 + lane * 8);
      cvt_store4(p.KD + (size_t)trow * 512 + lane * 8 + 4, p.cache_dk + ci * 512 + lane * 8 + 4);
      cvt_store4(p.VD + (size_t)trow * 512 + lane * 8, p.cache_dv + ci * 512 + lane * 8);
      cvt_store4(p.VD + (size_t)trow * 512 + lane * 8 + 4, p.cache_dv + ci * 512 + lane * 8 + 4);
      continue;
    }
    if (!t.lat) continue;
    const int row = t.row;
    const bf16_t* u = p.U1 + (size_t)row * OIN;
#pragma unroll
    for (int which = 0; which < 2; ++which) {
      const uint4 w = *(const uint4*)(u + (which ? 3088 : 2576) + lane * 8);
      float x[8] = {lo2f(w.x), hi2f(w.x), lo2f(w.y), hi2f(w.y), lo2f(w.z), hi2f(w.z), lo2f(w.w), hi2f(w.w)};
      if (t.lat) {
#pragma unroll
        for (int jj = 0; jj < 4; ++jj) {
          const float2 cs = p.ROPE64[t.pos * 32 + (lane & 7) * 4 + jj];
          const float y0 = x[2 * jj] * cs.x - x[2 * jj + 1] * cs.y, y1 = x[2 * jj] * cs.y + x[2 * jj + 1] * cs.x;
          x[2 * jj] = y0; x[2 * jj + 1] = y1;
        }
      }
      uint4 o; o.x = pack2(x[0], x[1]); o.y = pack2(x[2], x[3]); o.z = pack2(x[4], x[5]); o.w = pack2(x[6], x[7]);
      if (which == 0) { if (t.lat) *(uint4*)(p.QD + (size_t)row * 512 + lane * 8) = o; }
      else {
        if (t.lat) *(uint4*)(p.KD + (size_t)trow * 512 + lane * 8) = o;
        if (!t.lat) {
          float* op = p.out + O_DK + (size_t)row * 512 + lane * 8;
          *(float4*)op = make_float4(x[0], x[1], x[2], x[3]);
          *(float4*)(op + 4) = make_float4(x[4], x[5], x[6], x[7]);
        }
      }
    }
    {
      const uint4 w = *(const uint4*)(u + 3600 + lane * 8);
      if (t.lat) *(uint4*)(p.VD + (size_t)trow * 512 + lane * 8) = w;
      if (!t.lat) {
        float* op = p.out + O_DV + (size_t)row * 512 + lane * 8;
        *(float4*)op = make_float4(lo2f(w.x), hi2f(w.x), lo2f(w.y), hi2f(w.y));
        *(float4*)(op + 4) = make_float4(lo2f(w.z), hi2f(w.z), lo2f(w.w), hi2f(w.w));
      }
    }
  }
  bf16_t* sKT = (bf16_t*)smem;
  bf16_t* sVT = sKT + 128 * LDT;
  float* swk = (float*)(sVT + 128 * LDT);
  for (int it = VBLK; it < 768; it += NVBLK) {
    int sq, h, dir, j, nc, rowbase;
    mitem_decode(it, sq, h, dir, j, nc, rowbase);
    float ig, lf;
    mlstm_gates(p, rowbase, nc, h, dir, j, lane, ig, lf);
    const float b = scan_add(lf, lane);
    const float bL = __uint_as_float((unsigned)__builtin_amdgcn_readlane((int)__float_as_uint(b), 63));
    const float mx = wave_max(bL - b + ig);
    const float wk = fexp(bL - b + ig - mx);
    __syncthreads();
    if (wave == 0) {
      swk[dir ? 63 - lane : lane] = wk;
      if (lane == 0) { p.SC[it * 4 + 0] = bL; p.SC[it * 4 + 1] = mx; }
    }
    __syncthreads();
    const int oc = dir ? nc - 1 - j : j;
    const int row0 = rowbase + oc * 64;
    stage_T64<128>(sKT, p.U1 + (size_t)row0 * OIN + 512 + h * 128, OIN, nullptr);
    stage_T64<128>(sVT, p.U1 + (size_t)row0 * OIN + 1024 + h * 128, OIN, swk);
    __syncthreads();
    f32x4 acc[2][8];
#pragma unroll
    for (int a = 0; a < 2; ++a)
#pragma unroll
      for (int c = 0; c < 8; ++c) acc[a][c] = f32x4{0.f, 0.f, 0.f, 0.f};
#pragma unroll
    for (int ks = 0; ks < 2; ++ks) {
      bf16x8 vf[2];
#pragma unroll
      for (int a = 0; a < 2; ++a) vf[a] = *(const bf16x8*)(sVT + ((wave * 2 + a) * 16 + l16) * LDT + ks * 32 + g * 8);
#pragma unroll
      for (int kt = 0; kt < 8; ++kt) {
        const bf16x8 kf = *(const bf16x8*)(sKT + (kt * 16 + l16) * LDT + ks * 32 + g * 8);
#pragma unroll
        for (int a = 0; a < 2; ++a) acc[a][kt] = MFMA16(kf, vf[a], acc[a][kt]);
      }
    }
    bf16_t* uc = p.UC + (size_t)it * 16384;
#pragma unroll
    for (int a = 0; a < 2; ++a)
#pragma unroll
      for (int kt = 0; kt < 8; ++kt) {
        const int v = (wave * 2 + a) * 16 + l16, k = kt * 16 + g * 4;
        store_bf4(uc + v * 128 + k, acc[a][kt]);
      }
    if (tid < 128) {
      float s = 0.f;
#pragma unroll
      for (int c8 = 0; c8 < 8; ++c8) {
        const u32x4 kw = *(const u32x4*)(sKT + tid * LDT + c8 * 8);
        const float4 w0 = *(const float4*)(swk + c8 * 8), w1 = *(const float4*)(swk + c8 * 8 + 4);
        s += lo2f(kw[0]) * w0.x + hi2f(kw[0]) * w0.y + lo2f(kw[1]) * w0.z + hi2f(kw[1]) * w0.w
           + lo2f(kw[2]) * w1.x + hi2f(kw[2]) * w1.y + lo2f(kw[3]) * w1.z + hi2f(kw[3]) * w1.w;
      }
      p.NU[it * 128 + tid] = s;
    }
  }
}

DI void diff_finish(const Params& p, f32x4 (&o1)[8], f32x4 (&o2)[8], float l1, float l2, int row0, int hd) {
  const int lane = TIDX & 63, wave = TIDX >> 6, g = lane >> 4, l16 = lane & 15;
  l1 = xsum_16_32(l1);
  l2 = xsum_16_32(l2);
  const float i1 = 1.f / l1, i2 = p.LAMV[0] / l2;
  float ss = 0.f;
#pragma unroll
  for (int i = 0; i < 8; ++i)
#pragma unroll
    for (int j = 0; j < 4; ++j) { o1[i][j] = o1[i][j] * i1 - o2[i][j] * i2; ss += o1[i][j] * o1[i][j]; }
  ss = xsum_16_32(ss);
  const float r = rsqrtf(ss * (1.f / 128.f) + EPSF) * (1.f - LAM_INIT);
  const int row = row0 + wave * 16 + l16;
#pragma unroll
  for (int i = 0; i < 8; ++i) {
    const int dv = i * 16 + g * 4;
    const uint2 gw = *(const uint2*)(p.U1 + (size_t)row * OIN + 4112 + hd * 128 + dv);
    const float4 gn = *(const float4*)(p.o_dnorm_g + dv);
    f32x4 rr;
    rr[0] = o1[i][0] * r * gn.x * siluf(lo2f(gw.x)); rr[1] = o1[i][1] * r * gn.y * siluf(hi2f(gw.x));
    rr[2] = o1[i][2] * r * gn.z * siluf(lo2f(gw.y)); rr[3] = o1[i][3] * r * gn.w * siluf(hi2f(gw.y));
    store_bf4(p.O + (size_t)row * 1024 + 512 + hd * 128 + dv, rr);
  }
}

DI void phase10(const Params& p, char* smem) {
  const int tid = TIDX, lane = tid & 63, wave = tid >> 6, g = lane >> 4, l16 = lane & 15;
  for (int it = vblk_xcd(); it < 512; it += NVBLK) {
    int b, hd, qb, row0, trow0, T;
    const bool lat = it < 256;
    const int split = (it >> 1) & 1;
    const int li = ((it >> 7) * 4 + ((it >> 5) & 3)) * 16 + ((it >> 2) & 7) * 2 + (it & 1);
    if (lat) { b = li >> 6; hd = (li >> 4) & 3; qb = li & 15; row0 = 4096 + b * 1024 + qb * 64; trow0 = 4096 + b * 1280 + split * 640; T = 640; }
    else { const int i = it - 256; b = i >> 4; hd = (i >> 2) & 3; qb = i & 3; row0 = b * 256 + qb * 64; trow0 = b * 256; T = 256; }
    f32x4 od[2][8];
    float ld2[2], md2[2];
    const float sc = 0.125f * 1.4426950408889634f;
    const bf16_t* qp = lat ? p.QD + (size_t)row0 * 512 + hd * 128 : p.U1 + (size_t)row0 * OIN + 2576 + hd * 128;
    const bf16_t* kp = lat ? p.KD + (size_t)trow0 * 512 + hd * 128 : p.U1 + (size_t)trow0 * OIN + 3088 + hd * 128;
    const bf16_t* vp = lat ? p.VD + (size_t)trow0 * 512 + hd * 128 : p.U1 + (size_t)trow0 * OIN + 3600 + hd * 128;
    const int ldqkv = lat ? 512 : OIN;
    attn_core<64, 128, true>(smem, qp, ldqkv, kp, ldqkv, nullptr, 0, vp, ldqkv, T, sc, od, ld2, md2);
    if (lat) {
#pragma unroll
      for (int n = 0; n < 2; ++n) {
        const size_t base = (size_t)((li * 2 + split) * 2 + n) * 4 + wave;
#pragma unroll
        for (int i = 0; i < 8; ++i) store_bf4(p.OP + ((base * 8 + i) * 64 + lane) * 4, od[n][i]);
        *(float2*)(p.ML + (base * 64 + lane) * 2) = make_float2(md2[n], ld2[n]);
      }
    } else {
      diff_finish(p, od[0], od[1], ld2[0], ld2[1], row0, hd);
    }
  }
  const int vb = (vblk_xcd() + (NVBLK >> 1)) % NVBLK;
  for (int it = vb; it < 144 * 16; it += NVBLK) {
    const int chain = it < 256 ? 128 + (it >> 4) : ((it - 256) >> 4), eb = it & 15;
    const int sq = chain >> 3, h = (chain >> 1) & 3, dir = chain & 1;
    const int nc = sq < 16 ? 4 : 16;
    const int ib = mitem_id(sq, h, dir, 0);
    const int e = eb * 1024 + tid * 4;
    float4 C = make_float4(0.f, 0.f, 0.f, 0.f);
    if (sq >= 16) C = *(const float4*)(p.st_C + (size_t)(((sq - 16) * 2 + dir) * 4 + h) * 16384 + e);
    float4 uu[16];
    float dcs[16], scl[16], bLs[16], mxs[16];
#pragma unroll
    for (int j = 0; j < 16; ++j) {
      if (j < nc) { bLs[j] = p.SC[(ib + j) * 4 + 0]; mxs[j] = p.SC[(ib + j) * 4 + 1]; uu[j] = load_bf4(p.UC + (size_t)(ib + j) * 16384 + e); }
    }
    float mrun = 0.f;
    if (sq >= 16) mrun = p.st_m[((sq - 16) * 2 + dir) * 4 + h];
#pragma unroll
    for (int j = 0; j < 16; ++j) {
      if (j < nc) {
        const float mnext = fmaxf(bLs[j] + mrun, mxs[j]);
        dcs[j] = fexp(bLs[j] + mrun - mnext);
        scl[j] = fexp(mxs[j] - mnext);
        if (eb == 0 && tid == 0) p.SCM[ib + j] = mrun;
        mrun = mnext;
      }
    }
#pragma unroll
    for (int j = 0; j < 16; ++j) {
      if (j < nc) {
        uint2 o; o.x = pack2(C.x, C.y); o.y = pack2(C.z, C.w);
        *(uint2*)(p.CST + (size_t)(ib + j) * 16384 + e) = o;
        const float dc = dcs[j], sc = scl[j];
        C.x = dc * C.x + sc * uu[j].x; C.y = dc * C.y + sc * uu[j].y; C.z = dc * C.z + sc * uu[j].z; C.w = dc * C.w + sc * uu[j].w;
      }
    }
    if (sq < 16) *(float4*)(p.out + O_C + (size_t)((sq * 2 + dir) * 4 + h) * 16384 + e) = C;
    if (eb == 0 && tid < 128) {
      float n = 0.f;
      if (sq >= 16) n = p.st_n[(((sq - 16) * 2 + dir) * 4 + h) * 128 + tid];
#pragma unroll
      for (int j = 0; j < 16; ++j) {
        if (j < nc) {
          p.NST[(ib + j) * 128 + tid] = n;
          n = dcs[j] * n + scl[j] * p.NU[(ib + j) * 128 + tid];
        }
      }
      if (sq < 16) {
        p.out[O_N + ((sq * 2 + dir) * 4 + h) * 128 + tid] = n;
        if (tid == 0) p.out[O_M + (sq * 2 + dir) * 4 + h] = mrun;
      }
    }
  }
}

DI void phase11(const Params& p, char* smem) {
  const int tid = TIDX, lane = tid & 63, wave = tid >> 6, g = lane >> 4, l16 = lane & 15;
  bf16_t* sK = (bf16_t*)smem;
  bf16_t* sVT = sK + 64 * 128;
  float* sB = (float*)(sVT + 128 * LDT);
  float* sA = sB + 128;
  float* sMT = sA + 128;
  bf16_t* sC = (bf16_t*)(smem + 36352);
  for (int it = VBLK; it < 512; it += NVBLK) {
    if (it >= 384) {
    const int li = it - 384;
    const int b = li >> 6, hd = (li >> 4) & 3, qb = li & 15, row0 = 4096 + b * 1024 + qb * 64;
    f32x4 oc[2][8];
    float lc[2];
#pragma unroll
    for (int n = 0; n < 2; ++n) {
      const size_t b0 = (size_t)((li * 2 + 0) * 2 + n) * 4 + wave, b1 = (size_t)((li * 2 + 1) * 2 + n) * 4 + wave;
      const float2 ml0 = *(const float2*)(p.ML + (b0 * 64 + lane) * 2), ml1 = *(const float2*)(p.ML + (b1 * 64 + lane) * 2);
      const float m = fmaxf(ml0.x, ml1.x);
      const float f0 = __builtin_amdgcn_exp2f((ml0.x - m) * (0.125f * 1.4426950408889634f)), f1 = __builtin_amdgcn_exp2f((ml1.x - m) * (0.125f * 1.4426950408889634f));
      lc[n] = ml0.y * f0 + ml1.y * f1;
#pragma unroll
      for (int i = 0; i < 8; ++i) {
        const float4 a0 = load_bf4(p.OP + ((b0 * 8 + i) * 64 + lane) * 4), a1 = load_bf4(p.OP + ((b1 * 8 + i) * 64 + lane) * 4);
        oc[n][i] = f32x4{a0.x * f0 + a1.x * f1, a0.y * f0 + a1.y * f1, a0.z * f0 + a1.z * f1, a0.w * f0 + a1.w * f1};
      }
    }
    diff_finish(p, oc[0], oc[1], lc[0], lc[1], row0, hd);
    continue;
    }
    int sq, h, c, nc, rowbase;
    if (it < 128) { sq = 16 + (it >> 6); h = (it >> 4) & 3; c = it & 15; nc = 16; rowbase = 4096 + (sq - 16) * 1024; }
    else { const int i = it - 128; sq = i >> 4; h = (i >> 2) & 3; c = i & 3; nc = 4; rowbase = sq * 256; }
    const int row0 = rowbase + c * 64;
    float mst[2];
    int item[2];
    item[0] = mitem_id(sq, h, 0, c);
    item[1] = mitem_id(sq, h, 1, nc - 1 - c);
    u32x4 cr[8];
    {
      const bf16_t* cst0 = p.CST + (size_t)item[0] * 16384;
#pragma unroll
      for (int i = 0; i < 8; ++i) cr[i] = *(const u32x4*)(cst0 + (tid + 256 * i) * 8);
    }
    __syncthreads();
#pragma unroll
    for (int dir = 0; dir < 2; ++dir) {
      const int j = dir ? nc - 1 - c : c;
      mst[dir] = p.SCM[item[dir]];
      if (wave == 0) {
        float ig, lf;
        mlstm_gates(p, rowbase, nc, h, dir, j, lane, ig, lf);
        const float b = scan_add(lf, lane);
        const float a = ig - b;
        const float pm = scan_max(a, lane);
        const float mt = b + fmaxf(mst[dir], pm);
        const int so = dir ? 63 - lane : lane;
        sB[dir * 64 + so] = b; sA[dir * 64 + so] = a; sMT[dir * 64 + so] = mt;
      }
    }
    for (int c = tid; c < 64 * 16; c += 256) {
      const int r = c >> 4, ch = c & 15;
      *(uint4*)(sK + (ch >> 2) * 2048 + r * 32 + (((ch & 3) ^ ((4 - ((r >> 2) & 3)) & 3)) * 8)) = *(const uint4*)(p.U1 + (size_t)(row0 + r) * OIN + 512 + h * 128 + ch * 8);
    }
    stage_T64<128>(sVT, p.U1 + (size_t)row0 * OIN + 1024 + h * 128, OIN, nullptr);
#pragma unroll
    for (int i = 0; i < 8; ++i) {
      const int cc = tid + 256 * i, r = cc >> 4, ch = cc & 15;
      *(u32x4*)(sC + (ch >> 2) * 4096 + r * 32 + (((ch & 3) ^ ((4 - ((r >> 2) & 3)) & 3)) * 8)) = cr[i];
    }
    bf16x8 qf[4];
    const int tq = wave * 16 + l16;
    const int row = row0 + tq;
#pragma unroll
    for (int ks = 0; ks < 4; ++ks) qf[ks] = *(const bf16x8*)(p.U1 + (size_t)row * OIN + h * 128 + ks * 32 + g * 8);
    __syncthreads();
    f32x4 hsum[8];
#pragma unroll
    for (int i = 0; i < 8; ++i) hsum[i] = f32x4{0.f, 0.f, 0.f, 0.f};
#pragma unroll 1
    for (int dir = 0; dir < 2; ++dir) {
      const float bt = sB[dir * 64 + tq], mtt = sMT[dir * 64 + tq];
      const float mst_d = dir ? mst[1] : mst[0];
      const int item_d = dir ? item[1] : item[0];
      const float w_inter = fexp(bt + mst_d - mtt);
      const float et = bt - mtt;
      if (dir == 0) {
        const bf16_t* cst1 = p.CST + (size_t)item[1] * 16384;
#pragma unroll
        for (int i = 0; i < 8; ++i) cr[i] = *(const u32x4*)(cst1 + (tid + 256 * i) * 8);
      }
      f32x4 s[4];
      float dsum = 0.f;
#pragma unroll
      for (int t = 0; t < 4; ++t) {
        s[t] = f32x4{0.f, 0.f, 0.f, 0.f};
#pragma unroll
        for (int ks = 0; ks < 4; ++ks) {
          const bf16x8 kf = *(const bf16x8*)(sK + ks * 2048 + (t * 16 + l16) * 32 + ((g ^ ((4 - (l16 >> 2)) & 3)) * 8));
          s[t] = MFMA16(kf, qf[ks], s[t]);
        }
#pragma unroll
        for (int j = 0; j < 4; ++j) {
          const int sk = t * 16 + g * 4 + j;
          const bool ok = dir ? (sk >= tq) : (sk <= tq);
          const float w = ok ? fexp(et + sA[dir * 64 + sk]) : 0.f;
          s[t][j] *= w;
          dsum += s[t][j];
        }
      }
      dsum = xsum_16_32(dsum);
      f32x4 acc[8];
#pragma unroll
      for (int vt = 0; vt < 8; ++vt) {
        acc[vt] = f32x4{0.f, 0.f, 0.f, 0.f};
#pragma unroll
        for (int ks = 0; ks < 4; ++ks) {
          const bf16x8 cf = *(const bf16x8*)(sC + ks * 4096 + (vt * 16 + l16) * 32 + ((g ^ ((4 - (l16 >> 2)) & 3)) * 8));
          acc[vt] = MFMA16(cf, qf[ks], acc[vt]);
        }
        acc[vt] *= w_inter;
        if ((vt & 3) == 3) asm volatile("" ::: "memory");
      }
#pragma unroll
      for (int kb = 0; kb < 2; ++kb) {
        bf16x8 pf;
#pragma unroll
        for (int j = 0; j < 4; ++j) { pf[j] = (short)f2bf(s[2 * kb][j]); pf[4 + j] = (short)f2bf(s[2 * kb + 1][j]); }
#pragma unroll
        for (int vt = 0; vt < 8; ++vt) {
          const bf16_t* vp = sVT + (vt * 16 + l16) * LDT + kb * 32 + g * 4;
          const bf16x4 lo = *(const bf16x4*)(vp);
          const bf16x4 hi = *(const bf16x4*)(vp + 16);
          const bf16x8 vf = __builtin_shufflevector(lo, hi, 0, 1, 2, 3, 4, 5, 6, 7);
          acc[vt] = MFMA16(vf, pf, acc[vt]);
        }
      }
      float nq = 0.f;
      const float* nst = p.NST + (size_t)item_d * 128;
#pragma unroll
      for (int ks = 0; ks < 4; ++ks) {
        const float4 n0 = *(const float4*)(nst + ks * 32 + g * 8), n1 = *(const float4*)(nst + ks * 32 + g * 8 + 4);
        nq += n0.x * bf2f((bf16_t)qf[ks][0]) + n0.y * bf2f((bf16_t)qf[ks][1]) + n0.z * bf2f((bf16_t)qf[ks][2]) + n0.w * bf2f((bf16_t)qf[ks][3]);
        nq += n1.x * bf2f((bf16_t)qf[ks][4]) + n1.y * bf2f((bf16_t)qf[ks][5]) + n1.z * bf2f((bf16_t)qf[ks][6]) + n1.w * bf2f((bf16_t)qf[ks][7]);
      }
      nq = xsum_16_32(nq);
      const float den = w_inter * nq + dsum;
      const float dinv = 1.f / fmaxf(fabsf(den), fexp(-mtt));
#pragma unroll
      for (int vt = 0; vt < 8; ++vt) hsum[vt] += acc[vt] * dinv;
      if (dir == 0) {
        __syncthreads();
#pragma unroll
        for (int i = 0; i < 8; ++i) {
          const int cc = tid + 256 * i, r = cc >> 4, ch = cc & 15;
          *(u32x4*)(sC + (ch >> 2) * 4096 + r * 32 + (((ch & 3) ^ ((4 - ((r >> 2) & 3)) & 3)) * 8)) = cr[i];
        }
        __syncthreads();
      }
    }
    const bf16_t* u = p.U1 + (size_t)row * OIN;
    float ss = 0.f;
#pragma unroll
    for (int vt = 0; vt < 8; ++vt) {
      const uint2 ow = *(const uint2*)(u + 1536 + h * 128 + vt * 16 + g * 4);
      hsum[vt][0] *= sigmf(lo2f(ow.x)); hsum[vt][1] *= sigmf(hi2f(ow.x));
      hsum[vt][2] *= sigmf(lo2f(ow.y)); hsum[vt][3] *= sigmf(hi2f(ow.y));
#pragma unroll
      for (int j = 0; j < 4; ++j) ss += hsum[vt][j] * hsum[vt][j];
    }
    ss = xsum_16_32(ss);
    const float r = rsqrtf(ss * (1.f / 128.f) + EPSF);
#pragma unroll
    for (int vt = 0; vt < 8; ++vt) {
      const int v = h * 128 + vt * 16 + g * 4;
      const uint2 zw = *(const uint2*)(u + 2064 + v);
      const float4 gn = *(const float4*)(p.o_mnorm_g + v);
      f32x4 rr;
      rr[0] = hsum[vt][0] * r * gn.x * siluf(lo2f(zw.x)); rr[1] = hsum[vt][1] * r * gn.y * siluf(hi2f(zw.x));
      rr[2] = hsum[vt][2] * r * gn.z * siluf(lo2f(zw.y)); rr[3] = hsum[vt][3] * r * gn.w * siluf(hi2f(zw.y));
      store_bf4(p.O + (size_t)row * 1024 + v, rr);
    }
  }
}

DI void phase_final(const Params& p) {
  const int tid = TIDX, lane = tid & 63, wave = tid >> 6;
  for (int it = VBLK; it < NROW / 4; it += NVBLK) {
    const int row = it * 4 + wave;
    const bf16_t* x = p.X1B + (size_t)row * 1024;
    float4 v[4];
    float ss = 0.f;
#pragma unroll
    for (int i = 0; i < 4; ++i) {
      v[i] = load_bf4(x + i * 256 + lane * 4);
      ss += v[i].x * v[i].x + v[i].y * v[i].y + v[i].z * v[i].z + v[i].w * v[i].w;
    }
    ss = wave_sum(ss);
    const float r = rsqrtf(ss * (1.f / 1024.f) + EPSF);
#pragma unroll
    for (int i = 0; i < 4; ++i) {
      const int col = i * 256 + lane * 4;
      const float4 gg = *(const float4*)(p.final_g + col);
      *(float4*)(p.out + O_Y + (size_t)row * 1024 + col) = make_float4(v[i].x * r * gg.x, v[i].y * r * gg.y, v[i].z * r * gg.z, v[i].w * r * gg.w);
    }
  }
}


#define XB_TMO      128
#define XB_XCNT(j)  (256  + 64 * (j))
#define XB_XSUB(j)  (1280 + 64 * (j))
#define XB_XGEN(j)  (2304 + 64 * (j))
#define XB_TOP      3328
#define XB_TOPGEN   3392
#define XCD_BAR_WORDS 3456
#define XB_SPIN_CAP (1u << 18)
#define LAS __attribute__((address_space(3)))
DI unsigned xb_ld(unsigned* p) { return __hip_atomic_load(p, __ATOMIC_RELAXED, __HIP_MEMORY_SCOPE_AGENT); }
DI unsigned xb_add(unsigned* p, unsigned v) { return __hip_atomic_fetch_add(p, v, __ATOMIC_RELAXED, __HIP_MEMORY_SCOPE_AGENT); }
DI unsigned xb_xcc_id() { return (unsigned)__builtin_amdgcn_s_getreg((3 << 11) | 20) & 0xFu; }
#define XB_SPIN(cond, bar) do { unsigned _sp = 0; while (cond) { __builtin_amdgcn_s_sleep(1); \
    if ((++_sp & 255u) == 0u) { if (xb_ld(&(bar)[XB_TMO])) break; if (_sp > XB_SPIN_CAP) { atomicAdd(&(bar)[XB_TMO], 1u); break; } } } } while (0)
struct XcdBarrier { unsigned* bar; unsigned x; volatile LAS unsigned* st; };
DI XcdBarrier xcd_barrier_post(unsigned* bar, volatile LAS unsigned* st) {
  XcdBarrier b; b.bar = bar; b.x = xb_xcc_id(); b.st = st;
  if (threadIdx.x == 0) (void)xb_add(&bar[XB_XCNT(b.x)], 1u);
  return b;
}
DI void xcd_barrier_complete(unsigned* bar, unsigned x, unsigned& nloc, unsigned& nx) {
  const unsigned G = gridDim.x * gridDim.y * gridDim.z;
  unsigned sum, cnt, mine, sp = 0u;
  for (;;) {
    sum = 0u; cnt = 0u; mine = 0u;
#pragma unroll
    for (unsigned j = 0; j < 16; ++j) { const unsigned c = xb_ld(&bar[XB_XCNT(j)]); sum += c; cnt += (c > 0u) ? 1u : 0u; mine = (j == x) ? c : mine; }
    if (sum == G) break;
    __builtin_amdgcn_s_sleep(1);
    if ((++sp & 255u) == 0u) { if (xb_ld(&bar[XB_TMO])) break; if (sp > XB_SPIN_CAP) { atomicAdd(&bar[XB_TMO], 1u); break; } }
  }
  nloc = mine > 0u ? mine : 1u; nx = cnt > 0u ? cnt : 1u;
}
DI void xcd_barrier(const XcdBarrier& b) {
  asm volatile("s_waitcnt vmcnt(0)" ::: "memory");
  __syncthreads();
  if (threadIdx.x == 0) {
    unsigned* bar = b.bar;
    __builtin_amdgcn_s_waitcnt(0);
    unsigned nloc = b.st[0], nx = b.st[1];
    if (nloc == 0u) { xcd_barrier_complete(bar, b.x, nloc, nx); b.st[0] = nloc; b.st[1] = nx; }
    const unsigned old = xb_add(&bar[XB_XSUB(b.x)], 1u);
    const unsigned gen = old / nloc;
    if (old + 1u == (gen + 1u) * nloc) {
      __builtin_amdgcn_fence(__ATOMIC_RELEASE, "agent");
      asm volatile("s_waitcnt vmcnt(0)" ::: "memory");
      const unsigned og = xb_add(&bar[XB_TOP], 1u);
      const unsigned tg = og / nx;
      if (og + 1u == (tg + 1u) * nx) xb_add(&bar[XB_TOPGEN], 1u);
      else XB_SPIN(xb_ld(&bar[XB_TOPGEN]) == tg, bar);
      __builtin_amdgcn_fence(__ATOMIC_ACQUIRE, "agent");
      xb_add(&bar[XB_XGEN(b.x)], 1u);
      asm volatile("s_waitcnt vmcnt(0)" ::: "memory");
    } else {
      XB_SPIN(xb_ld(&bar[XB_XGEN(b.x)]) == gen, bar);
      __builtin_amdgcn_fence(__ATOMIC_ACQUIRE, "agent");
      asm volatile("s_waitcnt vmcnt(0)" ::: "memory");
    }
  }
  __syncthreads();
}

DI void run_phase(const Params& p, char* smem0, int ph) {
  char* smem = smem0 + (ltid() >> 8) * GRP_LDS;
  switch (ph) {
    case 0: phase0(p, smem); break;
    case 1: phase0b(p, smem); wait_mod_ready(p); phase_norm(p, 0); break;
    case 2: phase_gemm_in(p, 0, smem0); break;
    case 3: phase3(p); break;
    case 4: phase_gemm_mla(p, smem0); if (NVBLK >= 512) late_weight_prep(p, smem, 352, 0, 800); else late_weight_prep(p, smem, 0, 0, 1424); break;
    case 5: phase_attn0(p, smem0); break;
    case 6: if (NVBLK >= 384) phase_out_norm_fused(p, 0, smem); else phase_gemm_out(p, 0, smem); if (NVBLK >= 512) late_weight_prep(p, smem, 384, 800, 1424); break;
    case 7: if (NVBLK < 384) phase_norm(p, 1); break;
    case 8: phase_gemm_in(p, 1, smem0); break;
    case 9: phase9(p, smem); break;
    case 10: phase10(p, smem0); break;
    case 11: phase11(p, smem); break;
    case 12: if (NVBLK >= 384) phase_out_norm_fused(p, 1, smem); else phase_gemm_out(p, 1, smem); break;
    case 13: if (NVBLK < 384) phase_final(p); break;
  }
}

__global__ void __launch_bounds__(512, 2) mk_fwd(Params p) {
#if SINGLE_LAUNCH
  extern __shared__ __attribute__((aligned(16))) char smem[];
  __shared__ uint4 xb_words;
  if (threadIdx.x == 0) xb_words = make_uint4(0u, 0u, 0u, 0u);
  __syncthreads();
  const XcdBarrier xb = xcd_barrier_post(p.BAR, (volatile LAS unsigned*)&xb_words);
  if (p.phase_hi == 12345) {
    const unsigned long long* ia = (const unsigned long long*)__builtin_amdgcn_implicitarg_ptr();
    p.BAR[XB_TMO] = (unsigned)ia[11];
  }
  run_phase(p, smem, 0);
  run_phase(p, smem, 1); xcd_barrier(xb);
  run_phase(p, smem, 2); xcd_barrier(xb);
  run_phase(p, smem, 3); xcd_barrier(xb);
  run_phase(p, smem, 4); xcd_barrier(xb);
  run_phase(p, smem, 5); xcd_barrier(xb);
  run_phase(p, smem, 6); xcd_barrier(xb);
  if (NVBLK < 384) { run_phase(p, smem, 7); xcd_barrier(xb); }
  run_phase(p, smem, 8); xcd_barrier(xb);
  run_phase(p, smem, 9); xcd_barrier(xb);
  run_phase(p, smem, 10); xcd_barrier(xb);
  run_phase(p, smem, 11); xcd_barrier(xb);
  run_phase(p, smem, 12);
  if (NVBLK < 384) { xcd_barrier(xb); run_phase(p, smem, 13); }
#endif
}

template <int PH>
__global__ void __launch_bounds__(512, 2) mk_phase(Params p) {
  extern __shared__ __attribute__((aligned(16))) char smem[];
  run_phase(p, smem, PH);
}
template <int PH>
static void launch_phases(const Params& p, hipStream_t stream) {
  hipFuncSetAttribute((const void*)mk_phase<PH>, hipFuncAttributeMaxDynamicSharedMemorySize, LDS_BYTES);
  hipLaunchKernelGGL(mk_phase<PH>, dim3(256), dim3(512), LDS_BYTES, stream, p);
  if constexpr (PH + 1 < NPHASE) launch_phases<PH + 1>(p, stream);
}

extern "C" void kernel_launch(void* const* d_in, const int* in_sizes, int n_in, void* d_out, int out_size, void* d_ws, size_t ws_size, hipStream_t stream) {
  Params p{};
  const float** fp = (const float**)&p;
  for (int i = 0; i < 34; ++i) fp[i] = (const float*)d_in[i];
  p.out = (float*)d_out;
  char* w = (char*)d_ws;
  size_t off = 0;
  auto take = [&](size_t bytes) { char* r = w + off; off += (bytes + 255) & ~(size_t)255; return r; };
  p.BAR = (unsigned*)take(XCD_BAR_WORDS * 4);
  p.CNT = (unsigned*)take((2 * 48 * 64 + 64) * 4);
  p.SSQ = (float*)take((size_t)2 * NROW * 8 * 4);
  p.MOD = (float*)take(2 * 3 * 3072 * 4);
  p.LAMV = (float*)take(256);
  p.ROPE32 = (float2*)take(1024 * 16 * 8);
  p.ROPE64 = (float2*)take(1024 * 32 * 8);
  p.WinE = (bf16_t*)take((size_t)EIN_PAD * 1024 * 2);
  p.WinO = (bf16_t*)take((size_t)OIN_PAD * 1024 * 2);
  p.Wuq = (bf16_t*)take(768 * 384 * 2);
  p.Wukv = (bf16_t*)take(1024 * 256 * 2);
  p.WoutE = (bf16_t*)take(1024 * 1024 * 2);
  p.WoutO = (bf16_t*)take(1024 * 1024 * 2);
  p.H = (bf16_t*)take((size_t)NROW * 1024 * 2);
  p.O = (bf16_t*)take((size_t)NROW * 1024 * 2);
  p.X1 = (float*)take(256);
  p.X1B = (bf16_t*)take((size_t)NROW * 1024 * 2);
  p.SC = (float*)take(768 * 4 * 4);
  p.SCM = (float*)take(768 * 4);
  p.UC = (bf16_t*)take((size_t)768 * 16384 * 2);
  p.NU = (float*)take(768 * 128 * 4);
  p.NST = (float*)take(768 * 128 * 4);
  p.OP = (bf16_t*)take((size_t)128 * 2 * 2 * 4 * 8 * 64 * 8);
  p.ML = (float*)take((size_t)128 * 2 * 2 * 4 * 64 * 8);
  p.CST = (bf16_t*)take((size_t)768 * 16384 * 2);
  const size_t region = off;
  p.U0 = (bf16_t*)take((size_t)NROW * EIN * 2);
  p.CQN = (bf16_t*)take((size_t)NROW * 384 * 2);
  p.CKVN = (bf16_t*)take((size_t)NTROW * 256 * 2);
  p.KR = (bf16_t*)take((size_t)NTROW * 32 * 2);
  p.QB = (bf16_t*)take((size_t)NROW * 512 * 2);
  p.KB = (bf16_t*)take((size_t)NTROW * 128 * 2);
  p.VB = (bf16_t*)take((size_t)NTROW * 128 * 2);
  p.Q = (bf16_t*)take((size_t)NROW * 768 * 2);
  p.KV = (bf16_t*)take((size_t)NTROW * 1024 * 2);
  const size_t end0 = off;
  off = region;
  p.U1 = (bf16_t*)take((size_t)NROW * OIN * 2);
  p.QD = (bf16_t*)take((size_t)NROW * 512 * 2);
  p.KD = (bf16_t*)take((size_t)NTROW * 512 * 2);
  p.VD = (bf16_t*)take((size_t)NTROW * 512 * 2);
  const size_t end1 = off;
  const size_t need = end0 > end1 ? end0 : end1;
  if (need > ws_size) { fprintf(stderr, "workspace too small: need %zu have %zu\n", need, ws_size); return; }

#if SINGLE_LAUNCH
  static int grid_blocks = 0;
  if (!grid_blocks) {
    int dev = 0, cus = 0, per_cu = 0;
    hipGetDevice(&dev);
    hipDeviceGetAttribute(&cus, hipDeviceAttributeMultiprocessorCount, dev);
    hipFuncSetAttribute((const void*)mk_fwd, hipFuncAttributeMaxDynamicSharedMemorySize, LDS_BYTES);
    hipOccupancyMaxActiveBlocksPerMultiprocessor(&per_cu, mk_fwd, 512, LDS_BYTES);
    if (per_cu < 1) per_cu = 1;
    grid_blocks = cus;
  }
  p.phase_lo = 0; p.phase_hi = NPHASE;
  hipMemsetAsync(p.BAR, 0, (size_t)((char*)(p.CNT + 2 * 48 * 64 + 64) - (char*)p.BAR), stream);
  void* args[] = {&p};
  hipError_t e = hipLaunchCooperativeKernel((void*)mk_fwd, dim3(grid_blocks), dim3(512), args, LDS_BYTES, stream);
  if (e != hipSuccess) fprintf(stderr, "cooperative launch failed: %s (grid %d)\n", hipGetErrorString(e), grid_blocks);
#else
  launch_phases<0>(p, stream);
#endif
}
```
